# Optimizing an MI355X kernel written in HIP

```python
import math
import jax, jax.numpy as jnp
from jax import lax
import numpy as np

D_MODEL = 2048
BATCH = 4
SEQ = 2048
DEPTH = 2

N_A_LAYERS = DEPTH // 2
N_B_LAYERS = DEPTH - N_A_LAYERS
N_DENSE_LAYERS = (DEPTH + 1) // 2
N_MOE_LAYERS = DEPTH // 2
EPS = 1e-6

CHUNK = 128
GMLP_HALF = 2 * D_MODEL
GMLP_GROUPS = 8
GMLP_GROUP_CH = GMLP_HALF // GMLP_GROUPS

HEAD_DIM = 128
N_KV_HEADS = D_MODEL // HEAD_DIM
KV_WIDTH = N_KV_HEADS * HEAD_DIM
DILATED_GROUPS = ((128, 1), (512, 4), (2048, 16))
N_DIL_GROUPS = len(DILATED_GROUPS)
N_Q_HEADS = N_DIL_GROUPS * N_KV_HEADS
BLOCK = 128
NEG = -1e30

D_FF = 7168
N_EXPERTS = 8
TOP_K = 2
MOE_BLOCK = 256

kernel_name = "yoco_gmlp_dilated_moe_hybrid"


def _rmsnorm(x, g):
    xf = x.astype(jnp.float32)
    y = xf * lax.rsqrt(jnp.mean(xf * xf, axis=-1, keepdims=True) + EPS)
    return (y * g.astype(jnp.float32)).astype(x.dtype)


def _swiglu(x, w_gu, w_down):
    g, u = jnp.split(x @ w_gu, 2, axis=-1)
    return (jax.nn.silu(g) * u) @ w_down


def _gmlp_mixer(h, w_in, b_in, g_v, w_s, b_s, w_out):
    B, S, _ = h.shape
    z = jax.nn.gelu(h @ w_in + b_in)
    u, v = jnp.split(z, 2, axis=-1)
    v = _rmsnorm(v, g_v).reshape(B, S // CHUNK, CHUNK, GMLP_GROUPS, GMLP_GROUP_CH)
    mask = jnp.tril(jnp.ones((CHUNK, CHUNK), w_s.dtype))
    ws = w_s * mask
    mixed = jnp.einsum('gts,bcsgd->bctgd', ws, v) + b_s.T[:, :, None]
    return (u * mixed.reshape(B, S, GMLP_HALF)) @ w_out


def _to_sub(x, d):
    B, S, H, E = x.shape
    return x.reshape(B, S // d, d, H, E).transpose(0, 2, 3, 1, 4)


def _dilated_branch(q, k, v, window, dilation, base_slopes):
    B, S, H, E = q.shape
    d = dilation
    steps_max = window // dilation
    L = S // d
    nb = -(-L // BLOCK)
    Lp = nb * BLOCK
    qs = jnp.pad(_to_sub(q, d), ((0, 0), (0, 0), (0, 0), (0, Lp - L), (0, 0)))
    qb = qs.reshape(B, d, H, nb, BLOCK, E)

    def banded(x):
        xp = jnp.pad(_to_sub(x, d), ((0, 0), (0, 0), (0, 0), (BLOCK, Lp - L), (0, 0)))
        xp = xp.reshape(B, d, H, nb + 1, BLOCK, E)
        return jnp.concatenate([xp[:, :, :, :-1], xp[:, :, :, 1:]], axis=4)

    kb = banded(k).astype(jnp.float32)
    vb = banded(v).astype(jnp.float32)
    s = jnp.einsum('bdhnqe,bdhnke->bdhnqk', qb.astype(jnp.float32), kb) * (E ** -0.5)
    j = jnp.arange(BLOCK)[:, None]
    kk = jnp.arange(2 * BLOCK)[None, :]
    steps = BLOCK + j - kk
    key_idx = jnp.arange(nb)[:, None, None] * BLOCK + kk[None] - BLOCK
    valid = (steps >= 0) & (steps <= steps_max) & (key_idx >= 0)
    slopes = base_slopes / dilation
    dist = (steps * dilation).astype(jnp.float32)
    s = jnp.where(valid, s - slopes[:, None, None, None] * dist, NEG)
    m = jnp.max(s, axis=-1, keepdims=True)
    p = jnp.exp(s - m)
    den = jnp.sum(p, axis=-1, keepdims=True)
    o = jnp.einsum('bdhnqk,bdhnke->bdhnqe', p, vb) / den
    lse = (m + jnp.log(den))[..., 0]
    o = o.reshape(B, d, H, Lp, E)[:, :, :, :L].transpose(0, 3, 1, 2, 4).reshape(B, S, H, E)
    lse = lse.reshape(B, d, H, Lp)[:, :, :, :L].transpose(0, 3, 1, 2).reshape(B, S, H)
    return o, lse


def _dilated_mixer(h, k, v, w_q, w_o):
    B, S, _ = h.shape
    q = (h @ w_q).reshape(B, S, N_DIL_GROUPS, N_KV_HEADS, HEAD_DIM)
    base = jnp.exp2(-8.0 * jnp.arange(1, N_KV_HEADS + 1, dtype=jnp.float32) / N_KV_HEADS)
    outs, lses = [], []
    for gi, (window, dilation) in enumerate(DILATED_GROUPS):
        o, lse = _dilated_branch(q[:, :, gi], k, v, window, dilation, base)
        outs.append(o)
        lses.append(lse)
    alpha = jax.nn.softmax(jnp.stack(lses, axis=0), axis=0)
    o = jnp.sum(alpha[..., None] * jnp.stack(outs, axis=0), axis=0)
    return o.reshape(B, S, KV_WIDTH).astype(h.dtype) @ w_o


def _moe_ffn(h, w_router, w_gu, w_down):
    B, S, D = h.shape
    N = B * S
    xt = h.reshape(N, D)
    logits = (xt @ w_router).astype(jnp.float32)
    top_vals, top_idx = lax.top_k(logits, TOP_K)
    gates = jax.nn.softmax(top_vals, axis=-1)
    n_assign = N * TOP_K
    exp_flat = top_idx.reshape(-1)
    tok_flat = jnp.repeat(jnp.arange(N), TOP_K)
    gate_flat = gates.reshape(-1)
    order = jnp.argsort(exp_flat)
    e_sorted = exp_flat[order]
    tok_sorted = tok_flat[order]
    gate_sorted = gate_flat[order]
    counts = jnp.bincount(exp_flat, length=N_EXPERTS)
    starts = jnp.cumsum(counts) - counts
    padded = (counts + MOE_BLOCK - 1) // MOE_BLOCK * MOE_BLOCK
    pend = jnp.cumsum(padded)
    pstarts = pend - padded
    dest = pstarts[e_sorted] + (jnp.arange(n_assign) - starts[e_sorted])
    n_blocks = -(-n_assign // MOE_BLOCK) + N_EXPERTS
    xs = jnp.zeros((n_blocks * MOE_BLOCK, D), h.dtype).at[dest].set(xt[tok_sorted])
    block_expert = jnp.clip(
        jnp.searchsorted(pend, jnp.arange(n_blocks) * MOE_BLOCK, side='right'), 0, N_EXPERTS - 1)

    def expert_block(args):
        xb, e = args
        return _swiglu(xb, w_gu[e], w_down[e])

    ys = lax.map(expert_block, (xs.reshape(n_blocks, MOE_BLOCK, D), block_expert))
    contrib = ys.reshape(-1, D)[dest] * gate_sorted[:, None].astype(h.dtype)
    out = jnp.zeros((N, D), h.dtype).at[tok_sorted].add(contrib)
    return out.reshape(B, S, D)


def setup_inputs(seed: int = 0) -> dict:
    key = jax.random.key(seed)
    ks = jax.random.split(key, 18)

    def nrm(k, shape, scale):
        return jax.random.normal(k, shape, jnp.float32) * scale

    D = D_MODEL
    return {
        "x": nrm(ks[0], (BATCH, SEQ, D), 1.0),
        "norm_gains": 1.0 + nrm(ks[1], (DEPTH, 4, D), 0.05),
        "a_w_in": nrm(ks[2], (N_A_LAYERS, D, 2 * GMLP_HALF), D ** -0.5),
        "a_b_in": nrm(ks[3], (N_A_LAYERS, 2 * GMLP_HALF), 0.02),
        "a_norm_v": 1.0 + nrm(ks[4], (N_A_LAYERS, GMLP_HALF), 0.05),
        "a_w_s": nrm(ks[5], (N_A_LAYERS, GMLP_GROUPS, CHUNK, CHUNK), CHUNK ** -0.5),
        "a_b_s": 1.0 + nrm(ks[6], (N_A_LAYERS, GMLP_GROUPS, CHUNK), 0.05),
        "a_w_out": nrm(ks[7], (N_A_LAYERS, GMLP_HALF, D), GMLP_HALF ** -0.5),
        "kv_norm": 1.0 + nrm(ks[8], (D,), 0.05),
        "w_kv": nrm(ks[9], (D, 2 * KV_WIDTH), D ** -0.5),
        "b_w_q": nrm(ks[10], (N_B_LAYERS, D, N_Q_HEADS * HEAD_DIM), D ** -0.5),
        "b_w_o": nrm(ks[11], (N_B_LAYERS, KV_WIDTH, D), KV_WIDTH ** -0.5),
        "ffn_w_gu": nrm(ks[12], (N_DENSE_LAYERS, D, 2 * D_FF), D ** -0.5),
        "ffn_w_down": nrm(ks[13], (N_DENSE_LAYERS, D_FF, D), D_FF ** -0.5),
        "moe_router": nrm(ks[14], (N_MOE_LAYERS, D, N_EXPERTS), D ** -0.5),
        "moe_w_gu": nrm(ks[15], (N_MOE_LAYERS, N_EXPERTS, D, 2 * D_FF), D ** -0.5),
        "moe_w_down": nrm(ks[16], (N_MOE_LAYERS, N_EXPERTS, D_FF, D), D_FF ** -0.5),
    }


def reference(x, norm_gains, a_w_in, a_b_in, a_norm_v, a_w_s, a_b_s, a_w_out,
              kv_norm, w_kv, b_w_q, b_w_o, ffn_w_gu, ffn_w_down,
              moe_router, moe_w_gu, moe_w_down):
    B, S, _ = x.shape
    h = x
    k_shared = v_shared = None
    for layer in range(DEPTH):
        g = norm_gains[layer]
        if layer < N_A_LAYERS:
            i = layer
            mix = _gmlp_mixer(_rmsnorm(h, g[0]), a_w_in[i], a_b_in[i], a_norm_v[i],
                              a_w_s[i], a_b_s[i], a_w_out[i])
        else:
            if layer == N_A_LAYERS:
                kv = _rmsnorm(h, kv_norm) @ w_kv
                k_shared, v_shared = jnp.split(kv.reshape(B, S, 2 * N_KV_HEADS, HEAD_DIM), 2, axis=2)
            i = layer - N_A_LAYERS
            mix = _dilated_mixer(_rmsnorm(h, g[0]), k_shared, v_shared, b_w_q[i], b_w_o[i])
        h = h + _rmsnorm(mix, g[1])
        hn = _rmsnorm(h, g[2])
        if layer % 2 == 0:
            f = _swiglu(hn, ffn_w_gu[layer // 2], ffn_w_down[layer // 2])
        else:
            j = layer // 2
            f = _moe_ffn(hn, moe_router[j], moe_w_gu[j], moe_w_down[j])
        h = h + _rmsnorm(f, g[3])
    return h
```

```cpp
#include <hip/hip_runtime.h>
#include <stdint.h>
#include <stdio.h>

typedef unsigned short bf16_t;

constexpr int NTOK = 8192, DM = 2048, SEQ = 2048, GH = 4096  , DFF = 7168, NEXP = 8;
constexpr int NQ = 6144, NKV = 4096;
constexpr int MAXSLOT = 16384 + NEXP * 256;
constexpr float EPS = 1e-6f;

constexpr size_t AL(size_t x) { return (x + 255) & ~(size_t)255; }
constexpr size_t OFF_CTRL = 0;
constexpr size_t CTRL_BYTES = 1 << 16;
constexpr int C_CNT = 0  , C_PSTART = 16  , C_BLKEXP = 32  ;
constexpr int SSP_N = 64;
constexpr size_t OFF_SSP  = AL(OFF_CTRL + CTRL_BYTES);
constexpr size_t OFF_XN   = AL(OFF_SSP + (size_t)NTOK * SSP_N * 4);
constexpr size_t OFF_XNQ  = AL(OFF_XN + (size_t)NTOK * DM * 2);
constexpr size_t OFF_U    = AL(OFF_XNQ + (size_t)NTOK * DM * 2);
constexpr size_t OFF_VT   = AL(OFF_U + (size_t)NTOK * GH * 2);
constexpr size_t OFF_GT   = AL(OFF_VT + (size_t)NTOK * GH * 2);
constexpr size_t OFF_MIX  = AL(OFF_GT + (size_t)NTOK * GH * 2);
constexpr size_t OFF_H1   = AL(OFF_MIX + (size_t)NTOK * DM * 4);
constexpr size_t OFF_H2   = AL(OFF_H1 + (size_t)NTOK * DM * 4);
constexpr size_t OFF_H3   = AL(OFF_H2 + (size_t)NTOK * DM * 4);
constexpr size_t OFF_ACT  = AL(OFF_H3 + (size_t)NTOK * DM * 4);
constexpr size_t OFF_KV   = AL(OFF_ACT + (size_t)NTOK * DFF * 2);
constexpr size_t OFF_Q    = AL(OFF_KV + (size_t)NTOK * NKV * 2);
constexpr size_t OFF_OG   = AL(OFF_Q + (size_t)NTOK * NQ * 2);
constexpr size_t OFF_LSE  = AL(OFF_OG + (size_t)3 * NTOK * DM * 2);
constexpr size_t OFF_OM   = AL(OFF_LSE + (size_t)3 * NTOK * 16 * 4);
constexpr size_t OFF_TOKE = AL(OFF_OM + (size_t)NTOK * DM * 2);
constexpr size_t OFF_TOKP = AL(OFF_TOKE + (size_t)NTOK * 2 * 4);
constexpr size_t OFF_TOKG = AL(OFF_TOKP + (size_t)NTOK * 2 * 4);
constexpr size_t OFF_TOKS = AL(OFF_TOKG + (size_t)NTOK * 2 * 4);
constexpr size_t OFF_XS   = AL(OFF_TOKS + (size_t)NTOK * 2 * 4);
constexpr size_t OFF_ACT2 = AL(OFF_XS + (size_t)MAXSLOT * DM * 2);
constexpr size_t OFF_Y    = AL(OFF_ACT2 + (size_t)MAXSLOT * DFF * 2);
constexpr size_t WS_NEED  = AL(OFF_Y + (size_t)MAXSLOT * DM * 4);

__device__ __forceinline__ float bf2f(unsigned v) { return __uint_as_float(v << 16); }
__device__ __forceinline__ bf16_t f2bf(float f) { unsigned u = __float_as_uint(f); u += 0x7FFFu + ((u >> 16) & 1u); return (bf16_t)(u >> 16); }
__device__ __forceinline__ unsigned pack2(float lo, float hi) { return (unsigned)f2bf(lo) | ((unsigned)f2bf(hi) << 16); }
__device__ __forceinline__ float gelu_tanh(float x) { const float t = 1.5957691216057308f * (x + 0.044715f * x * x * x); return x / (1.0f + __expf(-t)); }
__device__ __forceinline__ float silu(float x) { return x / (1.0f + __expf(-x)); }
__device__ __forceinline__ float wave_sum(float v) { for (int o = 32; o >= 1; o >>= 1) v += __shfl_xor(v, o); return v; }
__device__ __forceinline__ float wave_max(float v) { for (int o = 32; o >= 1; o >>= 1) v = fmaxf(v, __shfl_xor(v, o)); return v; }

__device__ __forceinline__ float ssp_sum(const float* ssp, int row, int np) { float t = 0.f; for (int i = 0; i < np; ++i) t += ssp[(size_t)row * SSP_N + i]; return t; }

enum { EPI_GELU_UV = 0, EPI_F32_SS = 1, EPI_SWIGLU = 2, EPI_BF16 = 3, EPI_MOE_SWIGLU = 4, EPI_MOE_F32 = 5 };
struct GemmArgs {
    const bf16_t* A; int lda; const float* W; const float* W2; int ldw; int K;
    const float* bias; bf16_t* o1; bf16_t* o2; float* of; float* ss; int ldo;
    const int* blk_expert; size_t wstride; int pad0;
};
template <int EPI> __global__ __launch_bounds__(256) void k_gemm(GemmArgs g) {
    constexpr bool DUAL = (EPI == EPI_SWIGLU || EPI == EPI_MOE_SWIGLU);
    constexpr bool MOE = (EPI == EPI_MOE_SWIGLU || EPI == EPI_MOE_F32);
    __shared__ float As[16][68];
    __shared__ float Bs[16][64];
    __shared__ float Bs2[DUAL ? 16 : 1][64];
    const int m0 = blockIdx.y * 64, n0 = blockIdx.x * 64, tid = threadIdx.x, tx = tid & 15, ty = tid >> 4;
    const float* W = g.W; const float* W2 = g.W2;
    if (MOE) { const int e = g.blk_expert[m0 >> 8]; if (e < 0) return; W += (size_t)e * g.wstride; if (DUAL) W2 += (size_t)e * g.wstride; }
    float acc[4][4], acc2[4][4];
#pragma unroll
    for (int i = 0; i < 4; ++i)
#pragma unroll
        for (int j = 0; j < 4; ++j) { acc[i][j] = 0.f; acc2[i][j] = 0.f; }
    const int ar = tid >> 2, akq = (tid & 3) * 4, bk = tid >> 4, bn = (tid & 15) * 4;
    for (int k0 = 0; k0 < g.K; k0 += 16) {
        { const uint2 v = *(const uint2*)(g.A + (size_t)(m0 + ar) * g.lda + k0 + akq);
          As[akq + 0][ar] = bf2f(v.x & 0xffffu); As[akq + 1][ar] = bf2f(v.x >> 16); As[akq + 2][ar] = bf2f(v.y & 0xffffu); As[akq + 3][ar] = bf2f(v.y >> 16); }
        { *(float4*)&Bs[bk][bn] = *(const float4*)(W + (size_t)(k0 + bk) * g.ldw + n0 + bn);
          if (DUAL) *(float4*)&Bs2[bk][bn] = *(const float4*)(W2 + (size_t)(k0 + bk) * g.ldw + n0 + bn); }
        __syncthreads();
#pragma unroll
        for (int kk = 0; kk < 16; ++kk) {
            const float4 a = *(const float4*)&As[kk][ty * 4]; const float4 b = *(const float4*)&Bs[kk][tx * 4];
            const float av[4] = {a.x, a.y, a.z, a.w}, bv[4] = {b.x, b.y, b.z, b.w};
#pragma unroll
            for (int i = 0; i < 4; ++i)
#pragma unroll
                for (int j = 0; j < 4; ++j) acc[i][j] = fmaf(av[i], bv[j], acc[i][j]);
            if (DUAL) { const float4 b2 = *(const float4*)&Bs2[kk][tx * 4]; const float bw[4] = {b2.x, b2.y, b2.z, b2.w};
#pragma unroll
                for (int i = 0; i < 4; ++i)
#pragma unroll
                    for (int j = 0; j < 4; ++j) acc2[i][j] = fmaf(av[i], bw[j], acc2[i][j]); }
        }
        __syncthreads();
    }
#pragma unroll
    for (int i = 0; i < 4; ++i) {
        const int m = m0 + ty * 4 + i; float ssp = 0.f;
#pragma unroll
        for (int j = 0; j < 4; ++j) {
            const int n = n0 + tx * 4 + j; const float a = acc[i][j];
            if (EPI == EPI_GELU_UV) { const float v = gelu_tanh(a + g.bias[n]);
                if (n < GH) g.o1[(size_t)m * GH + n] = f2bf(v); else { g.o2[(size_t)(n - GH) * NTOK + m] = f2bf(v); ssp += v * v; } }
            else if (EPI == EPI_F32_SS) { g.of[(size_t)m * g.ldo + n] = a; ssp += a * a; }
            else if (EPI == EPI_SWIGLU || EPI == EPI_MOE_SWIGLU) { g.o1[(size_t)m * g.ldo + n] = f2bf(silu(a) * acc2[i][j]); }
            else if (EPI == EPI_BF16) { g.o1[(size_t)m * g.ldo + n] = f2bf(a); }
            else if (EPI == EPI_MOE_F32) { g.of[(size_t)m * g.ldo + n] = a; }
        }
        if (EPI == EPI_F32_SS || (EPI == EPI_GELU_UV && n0 >= GH)) { ssp += __shfl_xor(ssp, 1); ssp += __shfl_xor(ssp, 2); ssp += __shfl_xor(ssp, 4); ssp += __shfl_xor(ssp, 8);
            if (tx == 0) g.ss[(size_t)m * SSP_N + ((EPI == EPI_GELU_UV ? n0 - GH : n0) >> 6)] = ssp; }
    }
}

__global__ __launch_bounds__(256) void k_norm0(const float* x, const float* gain, bf16_t* xn) {
    const int row = blockIdx.x * 4 + (threadIdx.x >> 6), lane = threadIdx.x & 63;
    const float4* xr = (const float4*)(x + (size_t)row * DM); float4 v[8]; float ss = 0.f;
#pragma unroll
    for (int i = 0; i < 8; ++i) { v[i] = xr[lane + 64 * i]; ss += v[i].x * v[i].x + v[i].y * v[i].y + v[i].z * v[i].z + v[i].w * v[i].w; }
    ss = wave_sum(ss); const float rstd = rsqrtf(ss * (1.0f / DM) + EPS);
#pragma unroll
    for (int i = 0; i < 8; ++i) { const float4 gg = ((const float4*)gain)[lane + 64 * i];
        uint2 w; w.x = pack2(v[i].x * rstd * gg.x, v[i].y * rstd * gg.y); w.y = pack2(v[i].z * rstd * gg.z, v[i].w * rstd * gg.w);
        *(uint2*)(xn + (size_t)row * DM + (lane + 64 * i) * 4) = w; }
}
__global__ __launch_bounds__(256) void k_resnorm(const float* base, const float* mix, const float* ssmix, int np, const float* g_post, float* hout,
                                                 const float* g1, bf16_t* xn1, const float* g2, bf16_t* xn2) {
    const int row = blockIdx.x * 4 + (threadIdx.x >> 6), lane = threadIdx.x & 63;
    const float rm = rsqrtf(ssp_sum(ssmix, row, np) * (1.0f / DM) + EPS);
    float4 h[8]; float ss = 0.f;
#pragma unroll
    for (int i = 0; i < 8; ++i) { const size_t o = (size_t)row * DM / 4 + lane + 64 * i; const float4 b = ((const float4*)base)[o], m = ((const float4*)mix)[o], gp = ((const float4*)g_post)[lane + 64 * i];
        h[i].x = b.x + m.x * rm * gp.x; h[i].y = b.y + m.y * rm * gp.y; h[i].z = b.z + m.z * rm * gp.z; h[i].w = b.w + m.w * rm * gp.w;
        ((float4*)hout)[o] = h[i]; ss += h[i].x * h[i].x + h[i].y * h[i].y + h[i].z * h[i].z + h[i].w * h[i].w; }
    ss = wave_sum(ss); const float rstd = rsqrtf(ss * (1.0f / DM) + EPS);
#pragma unroll
    for (int i = 0; i < 8; ++i) { const float4 gg = ((const float4*)g1)[lane + 64 * i];
        uint2 w; w.x = pack2(h[i].x * rstd * gg.x, h[i].y * rstd * gg.y); w.y = pack2(h[i].z * rstd * gg.z, h[i].w * rstd * gg.w);
        *(uint2*)(xn1 + (size_t)row * DM + (lane + 64 * i) * 4) = w;
        if (xn2) { const float4 g2v = ((const float4*)g2)[lane + 64 * i];
            uint2 w2; w2.x = pack2(h[i].x * rstd * g2v.x, h[i].y * rstd * g2v.y); w2.y = pack2(h[i].z * rstd * g2v.z, h[i].w * rstd * g2v.w);
            *(uint2*)(xn2 + (size_t)row * DM + (lane + 64 * i) * 4) = w2; } }
}
__global__ __launch_bounds__(256) void k_router(const float* base, const float* mix, const float* ssmix, int np, const float* g_post, float* hout, const float* g_pre,
                                                const float* wr  , bf16_t* xn, int* counts, int* tok_e, int* tok_p, float* tok_g) {
    const int row = blockIdx.x * 4 + (threadIdx.x >> 6), lane = threadIdx.x & 63;
    const float rm = rsqrtf(ssp_sum(ssmix, row, np) * (1.0f / DM) + EPS);
    float4 h[8]; float ss = 0.f;
#pragma unroll
    for (int i = 0; i < 8; ++i) { const size_t o = (size_t)row * DM / 4 + lane + 64 * i; const float4 b = ((const float4*)base)[o], m = ((const float4*)mix)[o], gp = ((const float4*)g_post)[lane + 64 * i];
        h[i].x = b.x + m.x * rm * gp.x; h[i].y = b.y + m.y * rm * gp.y; h[i].z = b.z + m.z * rm * gp.z; h[i].w = b.w + m.w * rm * gp.w;
        ((float4*)hout)[o] = h[i]; ss += h[i].x * h[i].x + h[i].y * h[i].y + h[i].z * h[i].z + h[i].w * h[i].w; }
    ss = wave_sum(ss); const float rstd = rsqrtf(ss * (1.0f / DM) + EPS);
    float lg[8];
#pragma unroll
    for (int e = 0; e < 8; ++e) lg[e] = 0.f;
#pragma unroll
    for (int i = 0; i < 8; ++i) { const float4 gg = ((const float4*)g_pre)[lane + 64 * i];
        const float n0 = h[i].x * rstd * gg.x, n1 = h[i].y * rstd * gg.y, n2 = h[i].z * rstd * gg.z, n3 = h[i].w * rstd * gg.w;
        uint2 w; w.x = pack2(n0, n1); w.y = pack2(n2, n3);
        *(uint2*)(xn + (size_t)row * DM + (lane + 64 * i) * 4) = w;
        const int k = (lane + 64 * i) * 4; const float4* wp = (const float4*)(wr + (size_t)k * 8);
        const float nn[4] = {n0, n1, n2, n3};
#pragma unroll
        for (int j = 0; j < 4; ++j) { const float4 a = wp[2 * j], b = wp[2 * j + 1];
            lg[0] = fmaf(nn[j], a.x, lg[0]); lg[1] = fmaf(nn[j], a.y, lg[1]); lg[2] = fmaf(nn[j], a.z, lg[2]); lg[3] = fmaf(nn[j], a.w, lg[3]);
            lg[4] = fmaf(nn[j], b.x, lg[4]); lg[5] = fmaf(nn[j], b.y, lg[5]); lg[6] = fmaf(nn[j], b.z, lg[6]); lg[7] = fmaf(nn[j], b.w, lg[7]); } }
#pragma unroll
    for (int e = 0; e < 8; ++e) lg[e] = wave_sum(lg[e]);
    if (lane == 0) {
        int e1 = 0; float v1 = lg[0];
#pragma unroll
        for (int e = 1; e < 8; ++e) if (lg[e] > v1) { v1 = lg[e]; e1 = e; }
        int e2 = -1; float v2 = -3.0e38f;
#pragma unroll
        for (int e = 0; e < 8; ++e) if (e != e1 && lg[e] > v2) { v2 = lg[e]; e2 = e; }
        const float p2 = __expf(v2 - v1), inv = 1.0f / (1.0f + p2);
        const int q1 = atomicAdd(&counts[e1], 1), q2 = atomicAdd(&counts[e2], 1);
        tok_e[row * 2] = e1; tok_e[row * 2 + 1] = e2; tok_p[row * 2] = q1; tok_p[row * 2 + 1] = q2; tok_g[row * 2] = inv; tok_g[row * 2 + 1] = p2 * inv;
    }
}
__global__ void k_moe_setup(const int* counts, int* pstart, int* blk_expert) {
    if (threadIdx.x == 0 && blockIdx.x == 0) { int p = 0; int b = 0;
        for (int e = 0; e < NEXP; ++e) { pstart[e] = p; const int nb = (counts[e] + 255) >> 8; for (int i = 0; i < nb; ++i) blk_expert[b++] = e; p += nb * 256; }
        pstart[NEXP] = p; for (; b < MAXSLOT / 256; ++b) blk_expert[b] = -1; }
}
__global__ __launch_bounds__(256) void k_gather(const bf16_t* xn, const int* tok_e, const int* tok_p, const int* pstart, const int* counts, int* tok_s, bf16_t* xs) {
    const int w = blockIdx.x * 4 + (threadIdx.x >> 6), lane = threadIdx.x & 63;
    if (w < NTOK * 2) { const int e = tok_e[w], slot = pstart[e] + tok_p[w]; if (lane == 0) tok_s[w] = slot;
        const uint4* s = (const uint4*)(xn + (size_t)(w >> 1) * DM); uint4* d = (uint4*)(xs + (size_t)slot * DM);
#pragma unroll
        for (int i = 0; i < 4; ++i) d[lane + 64 * i] = s[lane + 64 * i]; }
    else { const int e = (w - NTOK * 2) >> 8, j = (w - NTOK * 2) & 255, c = counts[e], r = c + j, pad = ((c + 255) >> 8) << 8;
        if (r < pad) { uint4* d = (uint4*)(xs + (size_t)(pstart[e] + r) * DM); const uint4 z = make_uint4(0, 0, 0, 0);
#pragma unroll
            for (int i = 0; i < 4; ++i) d[lane + 64 * i] = z; } }
}
__global__ __launch_bounds__(256) void k_final(const float* h3, const float* Y, const int* tok_s, const float* tok_g, const float* gain, float* out) {
    const int row = blockIdx.x * 4 + (threadIdx.x >> 6), lane = threadIdx.x & 63;
    const int s1 = tok_s[row * 2], s2 = tok_s[row * 2 + 1]; const float g1 = tok_g[row * 2], g2 = tok_g[row * 2 + 1];
    float4 f[8]; float ss = 0.f;
#pragma unroll
    for (int i = 0; i < 8; ++i) { const float4 a = ((const float4*)(Y + (size_t)s1 * DM))[lane + 64 * i], b = ((const float4*)(Y + (size_t)s2 * DM))[lane + 64 * i];
        f[i].x = a.x * g1 + b.x * g2; f[i].y = a.y * g1 + b.y * g2; f[i].z = a.z * g1 + b.z * g2; f[i].w = a.w * g1 + b.w * g2;
        ss += f[i].x * f[i].x + f[i].y * f[i].y + f[i].z * f[i].z + f[i].w * f[i].w; }
    ss = wave_sum(ss); const float rstd = rsqrtf(ss * (1.0f / DM) + EPS);
#pragma unroll
    for (int i = 0; i < 8; ++i) { const size_t o = (size_t)row * DM / 4 + lane + 64 * i; const float4 b = ((const float4*)h3)[o], gg = ((const float4*)gain)[lane + 64 * i]; float4 r;
        r.x = b.x + f[i].x * rstd * gg.x; r.y = b.y + f[i].y * rstd * gg.y; r.z = b.z + f[i].z * rstd * gg.z; r.w = b.w + f[i].w * rstd * gg.w; ((float4*)out)[o] = r; }
}

__global__ __launch_bounds__(128) void k_sgu(const bf16_t* U, const bf16_t* VT, const float* vss, int np, const float* ws, const float* bs, const float* gv, bf16_t* GT) {
    __shared__ float wsT[128][128];
    const int ch = blockIdx.x, g = blockIdx.y, cb = blockIdx.z, t = threadIdx.x;
    for (int s = 0; s < 128; ++s) { const float rs = rsqrtf(ssp_sum(vss, ch * 128 + s, np) * (1.0f / GH) + EPS); wsT[s][t] = (s <= t) ? ws[((size_t)g * 128 + t) * 128 + s] * rs : 0.f; }
    __syncthreads();
    const int tok = ch * 128 + t; const float b = bs[g * 128 + t];
    for (int cc = 0; cc < 64; ++cc) { const int c = g * 512 + cb * 64 + cc; const bf16_t* vp = VT + (size_t)c * NTOK + ch * 128; float acc = 0.f;
        for (int s = 0; s < 128; ++s) acc = fmaf(wsT[s][t], bf2f(vp[s]), acc);
        const float u = bf2f(U[(size_t)tok * GH + c]); GT[(size_t)tok * GH + c] = f2bf(u * (gv[c] * acc + b)); }
}

__global__ __launch_bounds__(64) void k_attn(const bf16_t* Q, const bf16_t* KV, bf16_t* OG, float* LSE) {
    __shared__ float qs[128]; __shared__ float ps[132];
    const int tok = blockIdx.x, h = blockIdx.y, lane = threadIdx.x, b = tok / SEQ, pos = tok % SEQ;
    const float slope = exp2f(-0.5f * (float)(h + 1));
    for (int gi = 0; gi < 3; ++gi) { const int d = gi == 0 ? 1 : (gi == 1 ? 4 : 16); const int l = pos / d; const int nk = (l < 128 ? l : 128) + 1;
        __syncthreads();
        { const bf16_t* qp = Q + (size_t)tok * NQ + gi * 2048 + h * 128; qs[lane] = bf2f(qp[lane]); qs[lane + 64] = bf2f(qp[lane + 64]); }
        __syncthreads();
        float sc[3]; float mx = -3.0e38f;
#pragma unroll
        for (int jj = 0; jj < 3; ++jj) { const int j = lane + 64 * jj; sc[jj] = -3.0e38f;
            if (j < nk) { const bf16_t* kp = KV + (size_t)(b * SEQ + pos - j * d) * NKV + h * 128; float a = 0.f;
                for (int e = 0; e < 128; e += 8) { const uint4 kv = *(const uint4*)(kp + e);
                    a = fmaf(qs[e], bf2f(kv.x & 0xffffu), a); a = fmaf(qs[e + 1], bf2f(kv.x >> 16), a); a = fmaf(qs[e + 2], bf2f(kv.y & 0xffffu), a); a = fmaf(qs[e + 3], bf2f(kv.y >> 16), a);
                    a = fmaf(qs[e + 4], bf2f(kv.z & 0xffffu), a); a = fmaf(qs[e + 5], bf2f(kv.z >> 16), a); a = fmaf(qs[e + 6], bf2f(kv.w & 0xffffu), a); a = fmaf(qs[e + 7], bf2f(kv.w >> 16), a); }
                sc[jj] = a * 0.08838834764831845f - slope * (float)j; mx = fmaxf(mx, sc[jj]); } }
        mx = wave_max(mx); float den = 0.f;
#pragma unroll
        for (int jj = 0; jj < 3; ++jj) { const int j = lane + 64 * jj; if (j < nk) { const float p = __expf(sc[jj] - mx); ps[j] = p; den += p; } }
        den = wave_sum(den);
        __syncthreads();
        float o0 = 0.f, o1 = 0.f;
        for (int j = 0; j < nk; ++j) { const unsigned vv = *(const unsigned*)(KV + (size_t)(b * SEQ + pos - j * d) * NKV + 2048 + h * 128 + lane * 2); const float p = ps[j];
            o0 = fmaf(p, bf2f(vv & 0xffffu), o0); o1 = fmaf(p, bf2f(vv >> 16), o1); }
        const float inv = 1.0f / den;
        *(unsigned*)(OG + ((size_t)gi * NTOK + tok) * DM + h * 128 + lane * 2) = pack2(o0 * inv, o1 * inv);
        if (lane == 0) LSE[((size_t)gi * NTOK + tok) * 16 + h] = mx + __logf(den);
    }
}
__global__ __launch_bounds__(256) void k_merge(const bf16_t* OG, const float* LSE, bf16_t* OM) {
    const size_t i = (size_t)blockIdx.x * 256 + threadIdx.x;
    const int tok = (int)(i >> 8), c8 = (int)(i & 255), h = c8 >> 4;
    const float l0 = LSE[((size_t)0 * NTOK + tok) * 16 + h], l1 = LSE[((size_t)1 * NTOK + tok) * 16 + h], l2 = LSE[((size_t)2 * NTOK + tok) * 16 + h];
    const float m = fmaxf(l0, fmaxf(l1, l2)); const float a0 = __expf(l0 - m), a1 = __expf(l1 - m), a2 = __expf(l2 - m), inv = 1.0f / (a0 + a1 + a2);
    const uint4 x0 = *(const uint4*)(OG + ((size_t)0 * NTOK + tok) * DM + c8 * 8), x1 = *(const uint4*)(OG + ((size_t)1 * NTOK + tok) * DM + c8 * 8), x2 = *(const uint4*)(OG + ((size_t)2 * NTOK + tok) * DM + c8 * 8);
    const unsigned w0[4] = {x0.x, x0.y, x0.z, x0.w}, w1[4] = {x1.x, x1.y, x1.z, x1.w}, w2[4] = {x2.x, x2.y, x2.z, x2.w}; unsigned r[4];
#pragma unroll
    for (int j = 0; j < 4; ++j) { const float lo = (a0 * bf2f(w0[j] & 0xffffu) + a1 * bf2f(w1[j] & 0xffffu) + a2 * bf2f(w2[j] & 0xffffu)) * inv;
        const float hi = (a0 * bf2f(w0[j] >> 16) + a1 * bf2f(w1[j] >> 16) + a2 * bf2f(w2[j] >> 16)) * inv; r[j] = pack2(lo, hi); }
    *(uint4*)(OM + (size_t)tok * DM + c8 * 8) = make_uint4(r[0], r[1], r[2], r[3]);
}

extern "C" void kernel_launch(void* const* d_in, const int* in_sizes, int n_in, void* d_out, int out_size, void* d_ws, size_t ws_size, hipStream_t stream) {
    (void)in_sizes; (void)n_in; (void)out_size;
    if (ws_size < WS_NEED) { fprintf(stderr, "workspace too small: %zu < %zu\n", ws_size, (size_t)WS_NEED); return; }
    const float* x = (const float*)d_in[0]; const float* gains = (const float*)d_in[1]; const float* a_w_in = (const float*)d_in[2]; const float* a_b_in = (const float*)d_in[3];
    const float* a_norm_v = (const float*)d_in[4]; const float* a_w_s = (const float*)d_in[5]; const float* a_b_s = (const float*)d_in[6]; const float* a_w_out = (const float*)d_in[7];
    const float* kv_norm = (const float*)d_in[8]; const float* w_kv = (const float*)d_in[9]; const float* w_q = (const float*)d_in[10]; const float* w_o = (const float*)d_in[11];
    const float* ffn_w_gu = (const float*)d_in[12]; const float* ffn_w_down = (const float*)d_in[13]; const float* moe_router = (const float*)d_in[14];
    const float* moe_w_gu = (const float*)d_in[15]; const float* moe_w_down = (const float*)d_in[16];
    char* ws = (char*)d_ws; int* ictrl = (int*)(ws + OFF_CTRL); float* SSP = (float*)(ws + OFF_SSP);
    bf16_t* XN = (bf16_t*)(ws + OFF_XN); bf16_t* XNQ = (bf16_t*)(ws + OFF_XNQ); bf16_t* U = (bf16_t*)(ws + OFF_U); bf16_t* VT = (bf16_t*)(ws + OFF_VT); bf16_t* GT = (bf16_t*)(ws + OFF_GT);
    float* MIX = (float*)(ws + OFF_MIX); float* H1 = (float*)(ws + OFF_H1); float* H2 = (float*)(ws + OFF_H2); float* H3 = (float*)(ws + OFF_H3);
    bf16_t* ACT = (bf16_t*)(ws + OFF_ACT); bf16_t* KV = (bf16_t*)(ws + OFF_KV); bf16_t* Q = (bf16_t*)(ws + OFF_Q); bf16_t* OG = (bf16_t*)(ws + OFF_OG); float* LSE = (float*)(ws + OFF_LSE);
    bf16_t* OM = (bf16_t*)(ws + OFF_OM); int* TOKE = (int*)(ws + OFF_TOKE); int* TOKP = (int*)(ws + OFF_TOKP); float* TOKG = (float*)(ws + OFF_TOKG); int* TOKS = (int*)(ws + OFF_TOKS);
    bf16_t* XS = (bf16_t*)(ws + OFF_XS); bf16_t* ACT2 = (bf16_t*)(ws + OFF_ACT2); float* Y = (float*)(ws + OFF_Y);
    const float* g00 = gains, * g01 = gains + DM, * g02 = gains + 2 * DM, * g03 = gains + 3 * DM, * g10 = gains + 4 * DM, * g11 = gains + 5 * DM, * g12 = gains + 6 * DM, * g13 = gains + 7 * DM;

    (void)hipMemsetAsync(ws + OFF_CTRL, 0, CTRL_BYTES, stream);
    k_norm0<<<NTOK / 4, 256, 0, stream>>>(x, g00, XN);
    { GemmArgs g{}; g.A = XN; g.lda = DM; g.W = a_w_in; g.ldw = 2 * GH; g.K = DM; g.bias = a_b_in; g.o1 = U; g.o2 = VT; g.ss = SSP;
      k_gemm<EPI_GELU_UV><<<dim3(2 * GH / 64, NTOK / 64), 256, 0, stream>>>(g); }
    k_sgu<<<dim3(64, 8, 8), 128, 0, stream>>>(U, VT, SSP, GH / 64, a_w_s, a_b_s, a_norm_v, GT);
    { GemmArgs g{}; g.A = GT; g.lda = GH; g.W = a_w_out; g.ldw = DM; g.K = GH; g.of = MIX; g.ss = SSP; g.ldo = DM;
      k_gemm<EPI_F32_SS><<<dim3(DM / 64, NTOK / 64), 256, 0, stream>>>(g); }
    k_resnorm<<<NTOK / 4, 256, 0, stream>>>(x, MIX, SSP, DM / 64, g01, H1, g02, XN, nullptr, nullptr);
    { GemmArgs g{}; g.A = XN; g.lda = DM; g.W = ffn_w_gu; g.W2 = ffn_w_gu + DFF; g.ldw = 2 * DFF; g.K = DM; g.o1 = ACT; g.ldo = DFF;
      k_gemm<EPI_SWIGLU><<<dim3(DFF / 64, NTOK / 64), 256, 0, stream>>>(g); }
    { GemmArgs g{}; g.A = ACT; g.lda = DFF; g.W = ffn_w_down; g.ldw = DM; g.K = DFF; g.of = MIX; g.ss = SSP; g.ldo = DM;
      k_gemm<EPI_F32_SS><<<dim3(DM / 64, NTOK / 64), 256, 0, stream>>>(g); }
    k_resnorm<<<NTOK / 4, 256, 0, stream>>>(H1, MIX, SSP, DM / 64, g03, H2, kv_norm, XN, g10, XNQ);
    { GemmArgs g{}; g.A = XN; g.lda = DM; g.W = w_kv; g.ldw = NKV; g.K = DM; g.o1 = KV; g.ldo = NKV;
      k_gemm<EPI_BF16><<<dim3(NKV / 64, NTOK / 64), 256, 0, stream>>>(g); }
    { GemmArgs g{}; g.A = XNQ; g.lda = DM; g.W = w_q; g.ldw = NQ; g.K = DM; g.o1 = Q; g.ldo = NQ;
      k_gemm<EPI_BF16><<<dim3(NQ / 64, NTOK / 64), 256, 0, stream>>>(g); }
    k_attn<<<dim3(NTOK, 16), 64, 0, stream>>>(Q, KV, OG, LSE);
    k_merge<<<NTOK * DM / 8 / 256, 256, 0, stream>>>(OG, LSE, OM);
    { GemmArgs g{}; g.A = OM; g.lda = DM; g.W = w_o; g.ldw = DM; g.K = DM; g.of = MIX; g.ss = SSP; g.ldo = DM;
      k_gemm<EPI_F32_SS><<<dim3(DM / 64, NTOK / 64), 256, 0, stream>>>(g); }
    k_router<<<NTOK / 4, 256, 0, stream>>>(H2, MIX, SSP, DM / 64, g11, H3, g12, moe_router, XN, ictrl + C_CNT, TOKE, TOKP, TOKG);
    k_moe_setup<<<1, 64, 0, stream>>>(ictrl + C_CNT, ictrl + C_PSTART, ictrl + C_BLKEXP);
    k_gather<<<(NTOK * 2 + NEXP * 256) / 4, 256, 0, stream>>>(XN, TOKE, TOKP, ictrl + C_PSTART, ictrl + C_CNT, TOKS, XS);
    { GemmArgs g{}; g.A = XS; g.lda = DM; g.W = moe_w_gu; g.W2 = moe_w_gu + DFF; g.ldw = 2 * DFF; g.K = DM; g.o1 = ACT2; g.ldo = DFF; g.blk_expert = ictrl + C_BLKEXP; g.wstride = (size_t)DM * 2 * DFF;
      k_gemm<EPI_MOE_SWIGLU><<<dim3(DFF / 64, MAXSLOT / 64), 256, 0, stream>>>(g); }
    { GemmArgs g{}; g.A = ACT2; g.lda = DFF; g.W = moe_w_down; g.ldw = DM; g.K = DFF; g.of = Y; g.ldo = DM; g.blk_expert = ictrl + C_BLKEXP; g.wstride = (size_t)DFF * DM;
      k_gemm<EPI_MOE_F32><<<dim3(DM / 64, MAXSLOT / 64), 256, 0, stream>>>(g); }
    k_final<<<NTOK / 4, 256, 0, stream>>>(H3, Y, TOKS, TOKG, g13, (float*)d_out);
}
```

```cpp
#include <hip/hip_runtime.h>
#include <stdint.h>
#include <stdio.h>

typedef unsigned short bf16_t;

constexpr int NTOK = 8192, DM = 2048, SEQ = 2048, GH = 4096  , DFF = 7168, NEXP = 8;
constexpr int NQ = 6144, NKV = 4096;
constexpr int ECAP = NTOK, MAXSLOT = NEXP * ECAP;
constexpr float EPS = 1e-6f;

constexpr size_t AL(size_t x) { return (x + 255) & ~(size_t)255; }
constexpr size_t OFF_CTRL = 0;
constexpr size_t CTRL_BYTES = 1 << 16;
constexpr int C_CNT = 0  ;
constexpr int SSP_N = 64;
constexpr size_t OFF_SSP  = AL(OFF_CTRL + CTRL_BYTES);
constexpr size_t OFF_XN   = AL(OFF_SSP + (size_t)NTOK * SSP_N * 4);
constexpr size_t OFF_XNQ  = AL(OFF_XN + (size_t)NTOK * DM * 2);
constexpr size_t OFF_U    = AL(OFF_XNQ + (size_t)NTOK * DM * 2);
constexpr size_t OFF_VT   = AL(OFF_U + (size_t)NTOK * GH * 2);
constexpr size_t OFF_GT   = AL(OFF_VT + (size_t)NTOK * GH * 2);
constexpr size_t OFF_MIX  = AL(OFF_GT + (size_t)NTOK * GH * 2);
constexpr size_t OFF_H1   = AL(OFF_MIX + (size_t)NTOK * DM * 4);
constexpr size_t OFF_H2   = AL(OFF_H1 + (size_t)NTOK * DM * 4);
constexpr size_t OFF_H3   = AL(OFF_H2 + (size_t)NTOK * DM * 4);
constexpr size_t OFF_ACT  = AL(OFF_H3 + (size_t)NTOK * DM * 4);
constexpr size_t OFF_KV   = AL(OFF_ACT + (size_t)NTOK * DFF * 2);
constexpr size_t OFF_Q    = AL(OFF_KV + (size_t)NTOK * NKV * 2);
constexpr size_t OFF_OG   = AL(OFF_Q + (size_t)NTOK * NQ * 2);
constexpr size_t OFF_LSE  = AL(OFF_OG + (size_t)3 * NTOK * DM * 2);
constexpr size_t OFF_OM   = AL(OFF_LSE + (size_t)3 * NTOK * 16 * 4);
constexpr size_t OFF_TOKG = AL(OFF_OM + (size_t)NTOK * DM * 2);
constexpr size_t OFF_TOKS = AL(OFF_TOKG + (size_t)NTOK * 2 * 4);
constexpr size_t OFF_XS   = AL(OFF_TOKS + (size_t)NTOK * 2 * 4);
constexpr size_t OFF_ACT2 = AL(OFF_XS + (size_t)MAXSLOT * DM);
constexpr size_t OFF_Y    = AL(OFF_ACT2 + (size_t)MAXSLOT * DFF);
constexpr size_t OFF_WIN_T  = AL(OFF_Y + (size_t)MAXSLOT * DM * 2);
constexpr size_t OFF_WOUT_T = AL(OFF_WIN_T + (size_t)2 * GH * DM * 2);
constexpr size_t OFF_WGU_T  = AL(OFF_WOUT_T + (size_t)DM * GH * 2);
constexpr size_t OFF_WDN_T  = AL(OFF_WGU_T + (size_t)2 * DFF * DM * 2);
constexpr size_t OFF_WKV_T  = AL(OFF_WDN_T + (size_t)DM * DFF * 2);
constexpr size_t OFF_WQ_T   = AL(OFF_WKV_T + (size_t)NKV * DM * 2);
constexpr size_t OFF_WO_T   = AL(OFF_WQ_T + (size_t)NQ * DM * 2);
constexpr size_t OFF_MGU_T  = AL(OFF_WO_T + (size_t)DM * DM * 2);
constexpr size_t OFF_MDN_T  = AL(OFF_MGU_T + (size_t)NEXP * 2 * DFF * DM);
constexpr size_t WS_NEED  = AL(OFF_MDN_T + (size_t)NEXP * DM * DFF);
constexpr size_t CTRL_BAR_BYTE = 4096;

__device__ __forceinline__ float bf2f(unsigned v) { return __uint_as_float(v << 16); }
__device__ __forceinline__ bf16_t f2bf(float f) { unsigned u = __float_as_uint(f); u += 0x7FFFu + ((u >> 16) & 1u); return (bf16_t)(u >> 16); }
__device__ __forceinline__ unsigned pack2(float lo, float hi) { return (unsigned)f2bf(lo) | ((unsigned)f2bf(hi) << 16); }
__device__ __forceinline__ float gelu_tanh(float x) { const float t = 1.5957691216057308f * (x + 0.044715f * x * x * x); return x / (1.0f + __expf(-t)); }
__device__ __forceinline__ float silu(float x) { return x / (1.0f + __expf(-x)); }
__device__ __forceinline__ float wave_sum(float v) { for (int o = 32; o >= 1; o >>= 1) v += __shfl_xor(v, o); return v; }
__device__ __forceinline__ float wave_max(float v) { for (int o = 32; o >= 1; o >>= 1) v = fmaxf(v, __shfl_xor(v, o)); return v; }

namespace pg8 {
#define PG8_LAS __attribute__((address_space(3)))
typedef unsigned short bf16_t;
typedef short bf16x8 __attribute__((ext_vector_type(8)));
typedef float f32x4 __attribute__((ext_vector_type(4)));
typedef unsigned u32x4 __attribute__((ext_vector_type(4)));
constexpr int BM = 256, BK = 64, HALF = 128, HTB = HALF * BK * 2  , STAGE_BYTES = 8 * HTB, NXCD = 8, WGM = 8;

__host__ __device__ __forceinline__ int lds_byte(int r, int c) { const int st = (r >> 4) * 2 + (c >> 5), rr = r & 15, cc = c & 31, ob = rr * 64 + cc * 2; return st * 1024 + (ob ^ (((ob >> 9) & 1) << 5)); }
__host__ __device__ __forceinline__ void stage_rc(int b, int& R, int& C) { const int st = b / 1024, sb = b % 1024, swz = sb ^ (((sb >> 9) & 1) << 5); R = (st >> 1) * 16 + swz / 64; C = (st & 1) * 32 + (swz % 64) / 2; }
__host__ __device__ __forceinline__ int perm32(int rho) { const int n = rho >> 4, i = rho & 15; return 8 * (i >> 2) + 4 * n + (i & 3); }

struct Unit { int pm, pn; };
struct Gemm { const bf16_t* A; const bf16_t* Bt; int M, N, K; int kt; };

struct StaticOrder {
    int nM, nN, nwg, G, c;
    __host__ __device__ void init(int M, int N, int G_, int c_) { nM = M / BM; nN = N / BM; nwg = nM * nN; G = G_; c = c_; }
    __host__ __device__ bool next(int i, Unit& u) const {
        const long L = (long)i * G + c; if (L >= nwg) return false;
        int wgid = (int)L; { const int q = nwg / NXCD, r = nwg % NXCD, xcd = wgid % NXCD, off = wgid / NXCD; wgid = (xcd < r ? xcd * (q + 1) : r * (q + 1) + (xcd - r) * q) + off; }
        const int nig = WGM * nN, gid = wgid / nig, fm = gid * WGM, gsz = (nM - fm) < WGM ? (nM - fm) : WGM;
        u.pm = fm + ((wgid % nig) % gsz); u.pn = (wgid % nig) / gsz; return true;
    }
    __device__ __forceinline__ void a_ready(const Unit&) const {}
    __device__ __forceinline__ void done(const Unit&) const {}
};
__device__ __forceinline__ unsigned cvt_pk_bf16(float lo, float hi) { unsigned r; asm volatile("v_cvt_pk_bf16_f32 %0, %1, %2" : "=v"(r) : "v"(lo), "v"(hi)); return r; }
typedef float f32x2 __attribute__((ext_vector_type(2)));
typedef int pg8_v4i __attribute__((ext_vector_type(4))); typedef int pg8_v8i __attribute__((ext_vector_type(8)));
__device__ __forceinline__ pg8_v8i pg8_cat(bf16x8 a, bf16x8 b) { return __builtin_shufflevector(__builtin_bit_cast(pg8_v4i, a), __builtin_bit_cast(pg8_v4i, b), 0, 1, 2, 3, 4, 5, 6, 7); }
template <bool F8> struct pg8_frag; template <> struct pg8_frag<false> { bf16x8 v[2]; }; template <> struct pg8_frag<true> { pg8_v8i v; };
template <class Epi, class Sched, bool STAMP = false, bool F8 = false>
__device__ __forceinline__ void gemm_phase(PG8_LAS unsigned char* lds, const Gemm g, const Sched& S, const Epi& E, unsigned long long* stamps) {
    const int tid = threadIdx.x, wid = __builtin_amdgcn_readfirstlane(tid >> 6), lane = tid & 63, wr = wid >> 2, wc = wid & 3, fr = lane & 15, fq = lane >> 4;
    const int K = F8 ? (g.K >> 1) : g.K  , nt = g.kt ? g.kt : K / BK;
    int ts_lo = 0, ts_hi = 0, nts = 0; const unsigned long long rt_entry = STAMP ? (unsigned long long)wall_clock64() : 0ull;
#define PG8_STAMP() do { if (STAMP && wid == 0 && nts < 64) { const unsigned long long _c = (unsigned long long)clock64(); \
        ts_lo = (lane == nts) ? (int)(unsigned)_c : ts_lo; ts_hi = (lane == nts) ? (int)(unsigned)(_c >> 32) : ts_hi; ++nts; } } while (0)
    PG8_STAMP();
    unsigned voffA[2], voffB[2];
#pragma unroll
    for (int i = 0; i < 2; ++i) { int R, C; stage_rc(tid * 16 + i * 8192, R, C); const int Rb = Epi::PERM ? ((R & ~31) + perm32(R & 31)) : R;
        voffA[i] = (unsigned)(R * K + C) * 2u; voffB[i] = (unsigned)(Rb * K + C) * 2u; }
    const size_t kstep = (size_t)(BK * 2);
    const size_t hstep = (size_t)HALF * K * 2;
    const size_t tstep = 2 * hstep;
    const unsigned ldsw = (unsigned)wid * 1024u;
    const int aoff = lds_byte(wr * 64 + fr, fq * 8), boff = lds_byte(wc * 32 + fr, fq * 8);
#define PG8_SA(b, h) (((b) * 2 + (h)) * HTB)
#define PG8_SB(b, h) ((4 + (b) * 2 + (h)) * HTB)
#define PG8_STAGE(bufoff, gbase, voff) do { _Pragma("unroll") for (int _i = 0; _i < 2; ++_i) \
        __builtin_amdgcn_global_load_lds((const unsigned*)((const char*)(gbase) + (voff)[_i]), (PG8_LAS unsigned*)(lds + (bufoff) + ldsw + _i * 8192), 16, 0, 0); } while (0)
#define PG8_LDA(dst, b, h) do { _Pragma("unroll") for (int m = 0; m < 4; ++m) { const bf16x8 _l0 = *(const PG8_LAS bf16x8*)(lds + PG8_SA(b, h) + aoff + m * 2048), _l1 = *(const PG8_LAS bf16x8*)(lds + PG8_SA(b, h) + aoff + m * 2048 + 1024); \
        if constexpr (F8) dst[m].v = pg8_cat(_l0, _l1); else { dst[m].v[0] = _l0; dst[m].v[1] = _l1; } } } while (0)
#define PG8_LDB(dst, b, h) do { _Pragma("unroll") for (int n = 0; n < 2; ++n) { const bf16x8 _l0 = *(const PG8_LAS bf16x8*)(lds + PG8_SB(b, h) + boff + n * 2048), _l1 = *(const PG8_LAS bf16x8*)(lds + PG8_SB(b, h) + boff + n * 2048 + 1024); \
        if constexpr (F8) dst[n].v = pg8_cat(_l0, _l1); else { dst[n].v[0] = _l0; dst[n].v[1] = _l1; } } } while (0)
#define PG8_MMA(ai, bj, At, Bt) do { __builtin_amdgcn_s_setprio(1); _Pragma("unroll") for (int m = 0; m < 4; ++m) _Pragma("unroll") for (int n = 0; n < 2; ++n) { \
        if constexpr (F8) asm volatile("v_mfma_scale_f32_16x16x128_f8f6f4 %0, %1, %2, %0, %3, %3 op_sel_hi:[0,0,0]" : "+v"(acc[ai][bj][m][n]) : "v"(Bt[n].v), "v"(At[m].v), "v"(sc127)); \
        else { _Pragma("unroll") for (int k = 0; k < 2; ++k) acc[ai][bj][m][n] = __builtin_amdgcn_mfma_f32_16x16x32_bf16(Bt[n].v[k], At[m].v[k], acc[ai][bj][m][n], 0, 0, 0); } } __builtin_amdgcn_s_setprio(0); } while (0)
#define PG8_WAIT_V(n) asm volatile("s_waitcnt vmcnt(" #n ")" ::: "memory")
#define PG8_WAIT_L(n) asm volatile("s_waitcnt lgkmcnt(" #n ")" ::: "memory")
#define PG8_BAR __builtin_amdgcn_s_barrier()
#define PG8_SCHED __builtin_amdgcn_sched_barrier(0)
    Unit cur, nxt; int ui = 0;
    const int sc127 = 0x7f7f7f7f; (void)sc127;
    if (!S.next(0, cur)) return;
    f32x4 acc[2][2][4][2];
#pragma unroll
    for (int a = 0; a < 2; ++a)
#pragma unroll
        for (int b = 0; b < 2; ++b)
#pragma unroll
            for (int m = 0; m < 4; ++m)
#pragma unroll
                for (int n = 0; n < 2; ++n) acc[a][b][m][n] = (f32x4){0.f, 0.f, 0.f, 0.f};
    pg8_frag<F8> At[4], B0[2], B1[2];
    const char* cA = (const char*)g.A + (size_t)cur.pm * tstep; const char* cB = (const char*)g.Bt + (size_t)cur.pn * tstep;
    S.a_ready(cur);
    PG8_STAGE(PG8_SB(0, 0), cB, voffB); PG8_STAGE(PG8_SA(0, 0), cA, voffA); PG8_STAGE(PG8_SB(0, 1), cB + hstep, voffB); PG8_STAGE(PG8_SA(0, 1), cA + hstep, voffA);
    if (wr == 1) PG8_BAR;
    PG8_WAIT_V(4); PG8_BAR;
    PG8_STAGE(PG8_SB(1, 0), cB + kstep, voffB); PG8_STAGE(PG8_SA(1, 0), cA + kstep, voffA); PG8_STAGE(PG8_SB(1, 1), cB + hstep + kstep, voffB);
    PG8_WAIT_V(6); PG8_BAR;
    PG8_STAMP();
    for (;;) {
        const bool has_next = S.next(ui + 1, nxt);
        const char* nA = has_next ? (const char*)g.A + (size_t)nxt.pm * tstep : cA; const char* nB = has_next ? (const char*)g.Bt + (size_t)nxt.pn * tstep : cB;
        for (int t = 0; t < nt; t += 2) {
            const bool last = (t == nt - 2);
            const char* a1 = cA + (size_t)(t + 1) * kstep;
            const char* a2 = last ? nA : cA + (size_t)(t + 2) * kstep; const char* b2 = last ? nB : cB + (size_t)(t + 2) * kstep;
            const char* a3 = a2 + kstep; const char* b3 = b2 + kstep;
            if (last && has_next) S.a_ready(nxt);
            PG8_LDB(B0, 0, 0); PG8_SCHED; PG8_LDA(At, 0, 0); PG8_STAGE(PG8_SA(1, 1), a1 + hstep, voffA);
            PG8_WAIT_L(8); PG8_BAR; PG8_WAIT_L(0); PG8_MMA(0, 0, At, B0); PG8_BAR; PG8_SCHED;
            PG8_LDB(B1, 0, 1); PG8_STAGE(PG8_SB(0, 0), b2, voffB);
            PG8_BAR; PG8_WAIT_L(0); PG8_MMA(0, 1, At, B1); PG8_BAR;
            PG8_LDA(At, 0, 1); PG8_STAGE(PG8_SA(0, 0), a2, voffA);
            PG8_BAR; PG8_WAIT_L(0); PG8_MMA(1, 0, At, B0); PG8_BAR; PG8_SCHED;
            PG8_STAGE(PG8_SB(0, 1), b2 + hstep, voffB);
            PG8_WAIT_V(6); PG8_BAR; PG8_MMA(1, 1, At, B1); PG8_BAR;
            PG8_LDB(B0, 1, 0); PG8_SCHED; PG8_LDA(At, 1, 0); PG8_STAGE(PG8_SA(0, 1), a2 + hstep, voffA);
            PG8_WAIT_L(8); PG8_BAR; PG8_WAIT_L(0); PG8_MMA(0, 0, At, B0); PG8_BAR; PG8_SCHED;
            PG8_LDB(B1, 1, 1); PG8_STAGE(PG8_SB(1, 0), b3, voffB);
            PG8_BAR; PG8_WAIT_L(0); PG8_MMA(0, 1, At, B1); PG8_BAR;
            PG8_LDA(At, 1, 1); PG8_STAGE(PG8_SA(1, 0), a3, voffA);
            PG8_BAR; PG8_WAIT_L(0); PG8_MMA(1, 0, At, B0); PG8_BAR; PG8_SCHED;
            PG8_STAGE(PG8_SB(1, 1), b3 + hstep, voffB);
            PG8_WAIT_V(6); PG8_BAR; PG8_MMA(1, 1, At, B1); PG8_BAR;
        }
        PG8_STAMP();
        if constexpr (F8) {
            asm volatile("s_nop 15\n\ts_nop 15" ::: "memory");
#pragma unroll
            for (int a = 0; a < 2; ++a)
#pragma unroll
                for (int b = 0; b < 2; ++b)
#pragma unroll
                    for (int m = 0; m < 4; ++m) asm volatile("" : "+v"(acc[a][b][m][0]), "+v"(acc[a][b][m][1]));
        }
        if constexpr (!Epi::AFTER_DRAIN) { E(acc, cur, wr, wc, fr, fq); S.done(cur); }
        PG8_STAMP();
        if (!has_next) break;
#pragma unroll
        for (int a = 0; a < 2; ++a)
#pragma unroll
            for (int b = 0; b < 2; ++b)
#pragma unroll
                for (int m = 0; m < 4; ++m)
#pragma unroll
                    for (int n = 0; n < 2; ++n) acc[a][b][m][n] = (f32x4){0.f, 0.f, 0.f, 0.f};
        cur = nxt; cA = nA; cB = nB; ++ui;
    }
    PG8_WAIT_V(0);
    if (wr == 0) PG8_BAR;
    PG8_BAR;
    if constexpr (Epi::AFTER_DRAIN) { E.fused(acc, cur, wr, wc, fr, fq, lds, wid, lane); S.done(cur); }
    PG8_STAMP();
    if (STAMP && wid == 0) { stamps[lane] = lane < nts ? (((unsigned long long)(unsigned)ts_hi << 32) | (unsigned)ts_lo) : 0ull;
        if (lane == 62) stamps[62] = rt_entry; if (lane == 63) stamps[63] = (unsigned long long)wall_clock64(); }
#undef PG8_STAMP
#undef PG8_SA
#undef PG8_SB
#undef PG8_STAGE
#undef PG8_LDA
#undef PG8_LDB
#undef PG8_MMA
#undef PG8_WAIT_V
#undef PG8_WAIT_L
#undef PG8_BAR
#undef PG8_SCHED
}
}
#define XB_TMO      128
#define XB_XCNT(j)  (256  + 64 * (j))
#define XB_XSUB(j)  (1280 + 64 * (j))
#define XB_XGEN(j)  (2304 + 64 * (j))
#define XB_TOP      3328
#define XB_TOPGEN   3392
#define XCD_BAR_WORDS 3456
#define XB_SPIN_CAP (1u << 18)
#define LAS __attribute__((address_space(3)))

__device__ __forceinline__ unsigned xb_ld(unsigned* p)              { return __hip_atomic_load(p, __ATOMIC_RELAXED, __HIP_MEMORY_SCOPE_AGENT); }
__device__ __forceinline__ unsigned xb_add(unsigned* p, unsigned v) { return __hip_atomic_fetch_add(p, v, __ATOMIC_RELAXED, __HIP_MEMORY_SCOPE_AGENT); }
__device__ __forceinline__ unsigned xb_xcc_id() { return (unsigned)__builtin_amdgcn_s_getreg((3 << 11) | 20) & 0xFu; }
#define XB_SPIN(cond, bar) do { unsigned _sp = 0; while (cond) { __builtin_amdgcn_s_sleep(1); \
    if ((++_sp & 255u) == 0u) { if (xb_ld(&(bar)[XB_TMO])) break; if (_sp > XB_SPIN_CAP) { atomicAdd(&(bar)[XB_TMO], 1u); break; } } } } while (0)

struct XcdBarrier {
    unsigned* bar; unsigned x;
    volatile LAS unsigned* st;
};

__device__ __forceinline__ XcdBarrier xcd_barrier_post(unsigned* bar, volatile LAS unsigned* st) {
    XcdBarrier b; b.bar = bar; b.x = xb_xcc_id(); b.st = st;
    if (threadIdx.x == 0) (void)xb_add(&bar[XB_XCNT(b.x)], 1u);
    return b;
}
__device__ __forceinline__ void xcd_barrier_complete(unsigned* bar, unsigned x, unsigned& nloc, unsigned& nx) {
    const unsigned G = gridDim.x * gridDim.y * gridDim.z;
    unsigned sum, cnt, mine, sp = 0u;
    for (;;) {
        sum = 0u; cnt = 0u; mine = 0u;
#pragma unroll
        for (unsigned j = 0; j < 16; ++j) { const unsigned c = xb_ld(&bar[XB_XCNT(j)]); sum += c; cnt += (c > 0u) ? 1u : 0u; mine = (j == x) ? c : mine; }
        if (sum == G) break;
        __builtin_amdgcn_s_sleep(1);
        if ((++sp & 255u) == 0u) { if (xb_ld(&bar[XB_TMO])) break; if (sp > XB_SPIN_CAP) { atomicAdd(&bar[XB_TMO], 1u); break; } }
    }
    nloc = mine > 0u ? mine : 1u; nx = cnt > 0u ? cnt : 1u;
}

__device__ __forceinline__ void xcd_barrier(const XcdBarrier& b) {
    asm volatile("s_waitcnt vmcnt(0)" ::: "memory");
    __syncthreads();
    if (threadIdx.x == 0) {
        unsigned* bar = b.bar;
        __builtin_amdgcn_s_waitcnt(0);
        unsigned nloc = b.st[0], nx = b.st[1];
        if (nloc == 0u) { xcd_barrier_complete(bar, b.x, nloc, nx); b.st[0] = nloc; b.st[1] = nx; }
        const unsigned old = xb_add(&bar[XB_XSUB(b.x)], 1u);
        const unsigned gen = old / nloc;
        if (old + 1u == (gen + 1u) * nloc) {
            __builtin_amdgcn_fence(__ATOMIC_RELEASE, "agent");
            asm volatile("s_waitcnt vmcnt(0)" ::: "memory");
            const unsigned og = xb_add(&bar[XB_TOP], 1u);
            const unsigned tg = og / nx;
            if (og + 1u == (tg + 1u) * nx) xb_add(&bar[XB_TOPGEN], 1u);
            else XB_SPIN(xb_ld(&bar[XB_TOPGEN]) == tg, bar);
            __builtin_amdgcn_fence(__ATOMIC_ACQUIRE, "agent");
            xb_add(&bar[XB_XGEN(b.x)], 1u);
            asm volatile("s_waitcnt vmcnt(0)" ::: "memory");
        } else {
            XB_SPIN(xb_ld(&bar[XB_XGEN(b.x)]) == gen, bar);
            __builtin_amdgcn_fence(__ATOMIC_ACQUIRE, "agent");
            asm volatile("s_waitcnt vmcnt(0)" ::: "memory");
        }
    }
    __syncthreads();
}


#define LAS3 __attribute__((address_space(3)))
using pg8::bf16x8; using pg8::f32x4; using pg8::u32x4; using pg8::Unit;
constexpr int MK_THREADS = 512, MK_LDS_BYTES = 147456  , MK_LDS_BAR = MK_LDS_BYTES - 16;
constexpr int NPH = 16;

struct Params {
    const float* x; const float* gains; const float* a_w_in; const float* a_b_in; const float* a_norm_v; const float* a_w_s; const float* a_b_s; const float* a_w_out;
    const float* kv_norm; const float* w_kv; const float* w_q; const float* w_o; const float* ffn_w_gu; const float* ffn_w_down; const float* moe_router; const float* moe_w_gu; const float* moe_w_down;
    float* out; unsigned char* ws;
};

typedef __bf16 bf16x2_t __attribute__((ext_vector_type(2)));
__device__ __forceinline__ unsigned cvtpk(float lo, float hi) { const bf16x2_t v = {(__bf16)lo, (__bf16)hi}; return __builtin_bit_cast(unsigned, v); }
__device__ __forceinline__ float gelu_fast(float x) { const float t = x + 0.044715f * x * x * x; return x * __builtin_amdgcn_rcpf(1.0f + __builtin_amdgcn_exp2f(-2.3022081985f * t)); }
__device__ __forceinline__ float silu_fast(float x) { return x * __builtin_amdgcn_rcpf(1.0f + __builtin_amdgcn_exp2f(-1.4426950409f * x)); }

constexpr float F8_SA1 = 16.f, F8_SW1 = 1024.f, F8_SA2 = 8.f, F8_SW2 = 2048.f;
__device__ __forceinline__ unsigned pack4_fp8(float a, float b, float c, float d) {
    a = __builtin_amdgcn_fmed3f(a, -448.f, 448.f); b = __builtin_amdgcn_fmed3f(b, -448.f, 448.f); c = __builtin_amdgcn_fmed3f(c, -448.f, 448.f); d = __builtin_amdgcn_fmed3f(d, -448.f, 448.f);
    int w = __builtin_amdgcn_cvt_pk_fp8_f32(a, b, 0, false); w = __builtin_amdgcn_cvt_pk_fp8_f32(c, d, w, true); return (unsigned)w; }
struct CTile { const float* src; bf16_t* dst; int N, K; int f8; float scale; };
constexpr int CT0 = 16 * 128, CT1 = CT0 + 32 * 32, CT2 = CT1 + 16 * 224, CT3 = CT2 + 56 * 32, CT4 = CT3 + 16 * 64, CT5 = CT4 + 16 * 96, CT6 = CT5 + 16 * 32, CT7 = CT6 + 8 * 16 * 224, CT8 = CT7 + 8 * 56 * 32;
__device__ __forceinline__ CTile conv_decode(const Params& p, int t) {
    const float* S; bf16_t* D; int K, N, inter = 0, tt, f8 = 0; float scale = 1.f;
    unsigned char* ws = p.ws;
    if (t < CT0)      { S = p.a_w_in;     D = (bf16_t*)(ws + OFF_WIN_T);  K = DM;  N = 2 * GH;  tt = t; }
    else if (t < CT1) { S = p.a_w_out;    D = (bf16_t*)(ws + OFF_WOUT_T); K = GH;  N = DM;      tt = t - CT0; }
    else if (t < CT2) { S = p.ffn_w_gu;   D = (bf16_t*)(ws + OFF_WGU_T);  K = DM;  N = 2 * DFF; tt = t - CT1; inter = 1; }
    else if (t < CT3) { S = p.ffn_w_down; D = (bf16_t*)(ws + OFF_WDN_T);  K = DFF; N = DM;      tt = t - CT2; }
    else if (t < CT4) { S = p.w_kv;       D = (bf16_t*)(ws + OFF_WKV_T);  K = DM;  N = NKV;     tt = t - CT3; }
    else if (t < CT5) { S = p.w_q;        D = (bf16_t*)(ws + OFF_WQ_T);   K = DM;  N = NQ;      tt = t - CT4; }
    else if (t < CT6) { S = p.w_o;        D = (bf16_t*)(ws + OFF_WO_T);   K = DM;  N = DM;      tt = t - CT5; }
    else if (t < CT7) { S = p.moe_w_gu;   D = (bf16_t*)(ws + OFF_MGU_T);  K = DM;  N = 2 * DFF; tt = t - CT6; inter = 1; f8 = 1; scale = F8_SW1; }
    else              { S = p.moe_w_down; D = (bf16_t*)(ws + OFF_MDN_T);  K = DFF; N = DM;      tt = t - CT7; f8 = 1; scale = F8_SW2; }
    const int KT = K >> 7, NT = N >> 6, per = KT * NT, b = tt / per, r = tt - b * per, kt = r / NT, nt = r - kt * NT, n0 = nt * 64;
    int drow = n0;
    if (inter) drow = n0 < DFF ? ((n0 >> 7) * 256 + (n0 & 127)) : (((n0 - DFF) >> 7) * 256 + 128 + ((n0 - DFF) & 127));
    CTile c; c.src = S + (size_t)b * K * N + (size_t)(kt * 128) * N + n0; c.N = N; c.K = K; c.f8 = f8; c.scale = scale;
    if (f8) c.dst = (bf16_t*)((unsigned char*)D + (size_t)b * N * K + (size_t)drow * K + kt * 128); else c.dst = D + (size_t)b * N * K + (size_t)drow * K + kt * 128;
    return c;
}
__device__ __forceinline__ void conv_to_lds(const CTile& c, const float4 (&r)[4], LAS3 unsigned* W, int n4, int kr) {
    if (c.f8) { const float sc = c.scale; LAS3 unsigned* w = W + (n4 * 4) * 33 + kr;
        w[0] = pack4_fp8(r[0].x * sc, r[1].x * sc, r[2].x * sc, r[3].x * sc); w[33] = pack4_fp8(r[0].y * sc, r[1].y * sc, r[2].y * sc, r[3].y * sc);
        w[66] = pack4_fp8(r[0].z * sc, r[1].z * sc, r[2].z * sc, r[3].z * sc); w[99] = pack4_fp8(r[0].w * sc, r[1].w * sc, r[2].w * sc, r[3].w * sc); }
    else {
#pragma unroll
        for (int i = 0; i < 2; ++i) { LAS3 unsigned* w = W + (n4 * 4) * 65 + kr + 32 * i;
            w[0] = cvtpk(r[2 * i].x, r[2 * i + 1].x); w[65] = cvtpk(r[2 * i].y, r[2 * i + 1].y); w[130] = cvtpk(r[2 * i].z, r[2 * i + 1].z); w[195] = cvtpk(r[2 * i].w, r[2 * i + 1].w); } }
}
__device__ __forceinline__ void conv_from_lds(const CTile& c, const LAS3 unsigned* W, int tid) {
    if (c.f8) { const int n = tid >> 3, kc = tid & 7; const LAS3 unsigned* q = W + n * 33 + kc * 4;
        uint4 w; w.x = q[0]; w.y = q[1]; w.z = q[2]; w.w = q[3]; __builtin_nontemporal_store((u32x4){w.x, w.y, w.z, w.w}, (u32x4*)((unsigned char*)c.dst + (size_t)n * c.K + kc * 16)); }
    else {
#pragma unroll
        for (int i = 0; i < 2; ++i) { const int it = tid + 512 * i, kc = it & 15, n = it >> 4; const LAS3 unsigned* q = W + n * 65 + kc * 4;
            uint4 w; w.x = q[0]; w.y = q[1]; w.z = q[2]; w.w = q[3]; __builtin_nontemporal_store((u32x4){w.x, w.y, w.z, w.w}, (u32x4*)(c.dst + (size_t)n * c.K + kc * 8)); } }
}
constexpr int CV_NT = 4;
__device__ __forceinline__ void phase_convert(const Params& p, LAS3 unsigned char* lds, int t0, int t1) {
    LAS3 unsigned* LT = (LAS3 unsigned*)lds;
    const int tid = threadIdx.x, n4 = tid & 15, kr = tid >> 4, G = (int)gridDim.x;
    int t = t0 + (int)blockIdx.x;
#define CONV_LOAD(T, R) do { _Pragma("unroll") for (int j = 0; j < 4; ++j) { const int row = (T).f8 ? 4 * kr + j : 2 * (kr + 32 * (j >> 1)) + (j & 1); { const f32x4 _v = __builtin_nontemporal_load((const f32x4*)((T).src + (size_t)row * (T).N + n4 * 4)); R[j] = make_float4(_v[0], _v[1], _v[2], _v[3]); } } } while (0)
    if (t < t1) {
        CTile c[CV_NT]; bool h[CV_NT]; float4 r[CV_NT][4];
#pragma unroll
        for (int q = 0; q < CV_NT; ++q) { h[q] = t + q * G < t1; c[q] = conv_decode(p, h[q] ? t + q * G : t); if (h[q]) CONV_LOAD(c[q], r[q]); }
        int buf = 0;
        for (;;) {
            LAS3 unsigned* W = LT + buf * (CV_NT * 4160);
#pragma unroll
            for (int q = 0; q < CV_NT; ++q) if (h[q]) conv_to_lds(c[q], r[q], W + q * 4160, n4, kr);
            const int tn = t + CV_NT * G; const bool has = tn < t1;
            CTile cn[CV_NT]; bool hn[CV_NT];
#pragma unroll
            for (int q = 0; q < CV_NT; ++q) { hn[q] = tn + q * G < t1; cn[q] = c[q]; if (hn[q]) { cn[q] = conv_decode(p, tn + q * G); CONV_LOAD(cn[q], r[q]); } }
            __syncthreads();
#pragma unroll
            for (int q = 0; q < CV_NT; ++q) if (h[q]) conv_from_lds(c[q], W + q * 4160, tid);
            if (!has) break;
#pragma unroll
            for (int q = 0; q < CV_NT; ++q) { c[q] = cn[q]; h[q] = hn[q]; }
            t = tn; buf ^= 1;
        }
    }
#undef CONV_LOAD
    __syncthreads();
}

__device__ __forceinline__ void row_norm0(const Params& p, int row, int lane) {
    const float* gain = p.gains; bf16_t* xn = (bf16_t*)(p.ws + OFF_XN);
    const float4* xr = (const float4*)(p.x + (size_t)row * DM); float4 v[8]; float ss = 0.f;
#pragma unroll
    for (int i = 0; i < 8; ++i) { v[i] = xr[lane + 64 * i]; ss += v[i].x * v[i].x + v[i].y * v[i].y + v[i].z * v[i].z + v[i].w * v[i].w; }
    ss = wave_sum(ss); const float rstd = rsqrtf(ss * (1.0f / DM) + EPS);
#pragma unroll
    for (int i = 0; i < 8; ++i) { const float4 gg = ((const float4*)gain)[lane + 64 * i];
        uint2 w; w.x = cvtpk(v[i].x * rstd * gg.x, v[i].y * rstd * gg.y); w.y = cvtpk(v[i].z * rstd * gg.z, v[i].w * rstd * gg.w);
        *(uint2*)(xn + (size_t)row * DM + (lane + 64 * i) * 4) = w; }
}

struct EpiGeluU {
    static constexpr bool PERM = true, AFTER_DRAIN = false;
    bf16_t* O; int ldc; const float* bias;
    __device__ __forceinline__ void operator()(const f32x4 (&acc)[2][2][4][2], const Unit& u, int wr, int wc, int fr, int fq) const {
        asm volatile("" : "+v"(fr), "+v"(fq));
        const int row0 = u.pm * 256 + wr * 64 + fr, col0 = u.pn * 256 + wc * 32 + 8 * fq;
        f32x4 bv[2][2];
#pragma unroll
        for (int bj = 0; bj < 2; ++bj)
#pragma unroll
            for (int n = 0; n < 2; ++n) bv[bj][n] = *(const f32x4*)(bias + col0 + bj * 128 + 4 * n);
#pragma unroll
        for (int ai = 0; ai < 2; ++ai)
#pragma unroll
            for (int m = 0; m < 4; ++m) { bf16_t* rowp = O + (size_t)(row0 + ai * 128 + m * 16) * ldc + col0;
#pragma unroll
                for (int bj = 0; bj < 2; ++bj) { const f32x4 v0 = acc[ai][bj][m][0] + bv[bj][0], v1 = acc[ai][bj][m][1] + bv[bj][1];
                    u32x4 w; w.x = cvtpk(gelu_fast(v0[0]), gelu_fast(v0[1])); w.y = cvtpk(gelu_fast(v0[2]), gelu_fast(v0[3])); w.z = cvtpk(gelu_fast(v1[0]), gelu_fast(v1[1])); w.w = cvtpk(gelu_fast(v1[2]), gelu_fast(v1[3]));
                    *(u32x4*)(rowp + bj * 128) = w; } }
    }
};
struct EpiGeluVT {
    static constexpr bool PERM = true, AFTER_DRAIN = false;
    bf16_t* O; const float* bias; float* ssp;
    __device__ __forceinline__ void operator()(const f32x4 (&acc)[2][2][4][2], const Unit& u, int wr, int wc, int fr, int fq) const {
        asm volatile("" : "+v"(fr), "+v"(fq));
        const int row0 = u.pm * 256 + wr * 64 + fr, col0 = u.pn * 256 + wc * 32 + 8 * fq;
        f32x4 cs[2][2];
#pragma unroll
        for (int bj = 0; bj < 2; ++bj)
#pragma unroll
            for (int n = 0; n < 2; ++n) cs[bj][n] = (f32x4){0.f, 0.f, 0.f, 0.f};
#pragma unroll
        for (int ai = 0; ai < 2; ++ai)
#pragma unroll
            for (int m = 0; m < 4; ++m) { const int row = row0 + ai * 128 + m * 16; const float b = bias[row]; bf16_t* rowp = O + (size_t)row * NTOK + col0;
#pragma unroll
                for (int bj = 0; bj < 2; ++bj) { f32x4 v0 = acc[ai][bj][m][0] + b, v1 = acc[ai][bj][m][1] + b;
#pragma unroll
                    for (int j = 0; j < 4; ++j) { v0[j] = gelu_fast(v0[j]); v1[j] = gelu_fast(v1[j]); }
                    cs[bj][0] += v0 * v0; cs[bj][1] += v1 * v1;
                    u32x4 w; w.x = cvtpk(v0[0], v0[1]); w.y = cvtpk(v0[2], v0[3]); w.z = cvtpk(v1[0], v1[1]); w.w = cvtpk(v1[2], v1[3]);
                    *(u32x4*)(rowp + bj * 128) = w; } }
        const int slot = u.pm * 2 + wr;
#pragma unroll
        for (int bj = 0; bj < 2; ++bj)
#pragma unroll
            for (int n = 0; n < 2; ++n)
#pragma unroll
                for (int j = 0; j < 4; ++j) { float s = cs[bj][n][j]; s += __shfl_xor(s, 1); s += __shfl_xor(s, 2); s += __shfl_xor(s, 4); s += __shfl_xor(s, 8);
                    if (fr == 0) ssp[(size_t)(col0 + bj * 128 + 4 * n + j) * SSP_N + slot] = s; }
    }
};
struct EpiF32SS {
    static constexpr bool PERM = false, AFTER_DRAIN = false;
    float* C; int ldc; float* ssp; int pnmod; float scale;
    __device__ __forceinline__ void operator()(const f32x4 (&acc)[2][2][4][2], const Unit& u, int wr, int wc, int fr, int fq) const {
        asm volatile("" : "+v"(fr), "+v"(fq));
        const int pnl = u.pn % pnmod; const int row0 = u.pm * 256 + wr * 64 + fr, col0 = pnl * 256 + wc * 32 + 4 * fq;
#pragma unroll
        for (int ai = 0; ai < 2; ++ai)
#pragma unroll
            for (int m = 0; m < 4; ++m) { const int row = row0 + ai * 128 + m * 16; float* rowp = C + (size_t)row * ldc + col0; float s = 0.f;
#pragma unroll
                for (int bj = 0; bj < 2; ++bj)
#pragma unroll
                    for (int n = 0; n < 2; ++n) { const f32x4 v = acc[ai][bj][m][n] * scale; *(f32x4*)(rowp + bj * 128 + n * 16) = v; s += (v[0] * v[0] + v[1] * v[1]) + (v[2] * v[2] + v[3] * v[3]); }
                if (ssp) { s += __shfl_xor(s, 16); s += __shfl_xor(s, 32); if (fq == 0) ssp[(size_t)row * SSP_N + pnl * 4 + wc] = s; } }
    }
};
struct EpiSwiglu {
    static constexpr bool PERM = true, AFTER_DRAIN = false;
    bf16_t* O; int ldc; int pnmod;
    __device__ __forceinline__ void operator()(const f32x4 (&acc)[2][2][4][2], const Unit& u, int wr, int wc, int fr, int fq) const {
        asm volatile("" : "+v"(fr), "+v"(fq));
        const int pnl = u.pn % pnmod; const int row0 = u.pm * 256 + wr * 64 + fr, col0 = pnl * 128 + wc * 32 + 8 * fq;
#pragma unroll
        for (int ai = 0; ai < 2; ++ai)
#pragma unroll
            for (int m = 0; m < 4; ++m) { bf16_t* rowp = O + (size_t)(row0 + ai * 128 + m * 16) * ldc + col0;
                const f32x4 g0 = acc[ai][0][m][0], g1 = acc[ai][0][m][1], u0 = acc[ai][1][m][0], u1 = acc[ai][1][m][1];
                u32x4 w; w.x = cvtpk(silu_fast(g0[0]) * u0[0], silu_fast(g0[1]) * u0[1]); w.y = cvtpk(silu_fast(g0[2]) * u0[2], silu_fast(g0[3]) * u0[3]);
                w.z = cvtpk(silu_fast(g1[0]) * u1[0], silu_fast(g1[1]) * u1[1]); w.w = cvtpk(silu_fast(g1[2]) * u1[2], silu_fast(g1[3]) * u1[3]);
                *(u32x4*)rowp = w; }
    }
};
struct EpiBf16P {
    static constexpr bool PERM = true, AFTER_DRAIN = false;
    bf16_t* O; int ldc;
    __device__ __forceinline__ void operator()(const f32x4 (&acc)[2][2][4][2], const Unit& u, int wr, int wc, int fr, int fq) const {
        asm volatile("" : "+v"(fr), "+v"(fq));
        const int row0 = u.pm * 256 + wr * 64 + fr, col0 = u.pn * 256 + wc * 32 + 8 * fq;
#pragma unroll
        for (int ai = 0; ai < 2; ++ai)
#pragma unroll
            for (int m = 0; m < 4; ++m) { bf16_t* rowp = O + (size_t)(row0 + ai * 128 + m * 16) * ldc + col0;
#pragma unroll
                for (int bj = 0; bj < 2; ++bj) { const f32x4 v0 = acc[ai][bj][m][0], v1 = acc[ai][bj][m][1];
                    u32x4 w; w.x = cvtpk(v0[0], v0[1]); w.y = cvtpk(v0[2], v0[3]); w.z = cvtpk(v1[0], v1[1]); w.w = cvtpk(v1[2], v1[3]);
                    *(u32x4*)(rowp + bj * 128) = w; } }
    }
};

struct EpiSwiglu8 {
    static constexpr bool PERM = true, AFTER_DRAIN = false;
    unsigned char* O; int ldc; int pnmod; float inv, oscale;
    __device__ __forceinline__ void operator()(const f32x4 (&acc)[2][2][4][2], const Unit& u, int wr, int wc, int fr, int fq) const {
        asm volatile("" : "+v"(fr), "+v"(fq));
        const int pnl = u.pn % pnmod; const int row0 = u.pm * 256 + wr * 64 + fr, col0 = pnl * 128 + wc * 32 + 8 * fq;
#pragma unroll
        for (int ai = 0; ai < 2; ++ai)
#pragma unroll
            for (int m = 0; m < 4; ++m) { unsigned char* rowp = O + (size_t)(row0 + ai * 128 + m * 16) * ldc + col0;
                const f32x4 g0 = acc[ai][0][m][0] * inv, g1 = acc[ai][0][m][1] * inv, u0 = acc[ai][1][m][0] * (inv * oscale), u1 = acc[ai][1][m][1] * (inv * oscale);
                uint2 w; w.x = pack4_fp8(silu_fast(g0[0]) * u0[0], silu_fast(g0[1]) * u0[1], silu_fast(g0[2]) * u0[2], silu_fast(g0[3]) * u0[3]);
                w.y = pack4_fp8(silu_fast(g1[0]) * u1[0], silu_fast(g1[1]) * u1[1], silu_fast(g1[2]) * u1[2], silu_fast(g1[3]) * u1[3]);
                *(uint2*)rowp = w; }
    }
};

struct EpiBf16S {
    static constexpr bool PERM = true, AFTER_DRAIN = false;
    bf16_t* O; int ldc; int pnmod; float scale;
    __device__ __forceinline__ void operator()(const f32x4 (&acc)[2][2][4][2], const Unit& u, int wr, int wc, int fr, int fq) const {
        asm volatile("" : "+v"(fr), "+v"(fq));
        const int pnl = u.pn % pnmod; const int row0 = u.pm * 256 + wr * 64 + fr, col0 = pnl * 256 + wc * 32 + 8 * fq;
#pragma unroll
        for (int ai = 0; ai < 2; ++ai)
#pragma unroll
            for (int m = 0; m < 4; ++m) { bf16_t* rowp = O + (size_t)(row0 + ai * 128 + m * 16) * ldc + col0;
#pragma unroll
                for (int bj = 0; bj < 2; ++bj) { const f32x4 v0 = acc[ai][bj][m][0] * scale, v1 = acc[ai][bj][m][1] * scale;
                    u32x4 w; w.x = cvtpk(v0[0], v0[1]); w.y = cvtpk(v0[2], v0[3]); w.z = cvtpk(v1[0], v1[1]); w.w = cvtpk(v1[2], v1[3]);
                    *(u32x4*)(rowp + bj * 128) = w; } }
    }
};

struct EpiBf16H {
    static constexpr bool PERM = true, AFTER_DRAIN = false;
    bf16_t* O; int nrows;
    __device__ __forceinline__ void operator()(const f32x4 (&acc)[2][2][4][2], const Unit& u, int wr, int wc, int fr, int fq) const {
        asm volatile("" : "+v"(fr), "+v"(fq));
        const int row0 = u.pm * 256 + wr * 64 + fr, cin = wc * 32 + 8 * fq;
#pragma unroll
        for (int bj = 0; bj < 2; ++bj) { bf16_t* hp = O + (size_t)(u.pn * 2 + bj) * nrows * 128 + cin;
#pragma unroll
            for (int ai = 0; ai < 2; ++ai)
#pragma unroll
                for (int m = 0; m < 4; ++m) { const f32x4 v0 = acc[ai][bj][m][0], v1 = acc[ai][bj][m][1];
                    u32x4 w; w.x = cvtpk(v0[0], v0[1]); w.y = cvtpk(v0[2], v0[3]); w.z = cvtpk(v1[0], v1[1]); w.w = cvtpk(v1[2], v1[3]);
                    *(u32x4*)(hp + (size_t)(row0 + ai * 128 + m * 16) * 128) = w; } }
    }
};

struct EpiBf16SS {
    static constexpr bool PERM = true, AFTER_DRAIN = false;
    bf16_t* C; int ldc; float* ssp;
    __device__ __forceinline__ void operator()(const f32x4 (&acc)[2][2][4][2], const Unit& u, int wr, int wc, int fr, int fq) const {
        asm volatile("" : "+v"(fr), "+v"(fq));
        const int row0 = u.pm * 256 + wr * 64 + fr, col0 = u.pn * 256 + wc * 32 + 8 * fq;
#pragma unroll
        for (int ai = 0; ai < 2; ++ai)
#pragma unroll
            for (int m = 0; m < 4; ++m) { const int row = row0 + ai * 128 + m * 16; bf16_t* rowp = C + (size_t)row * ldc + col0; float s = 0.f;
#pragma unroll
                for (int bj = 0; bj < 2; ++bj) { const f32x4 v0 = acc[ai][bj][m][0], v1 = acc[ai][bj][m][1];
                    s += (v0[0] * v0[0] + v0[1] * v0[1]) + (v0[2] * v0[2] + v0[3] * v0[3]); s += (v1[0] * v1[0] + v1[1] * v1[1]) + (v1[2] * v1[2] + v1[3] * v1[3]);
                    u32x4 w; w.x = cvtpk(v0[0], v0[1]); w.y = cvtpk(v0[2], v0[3]); w.z = cvtpk(v1[0], v1[1]); w.w = cvtpk(v1[2], v1[3]);
                    *(u32x4*)(rowp + bj * 128) = w; }
                s += __shfl_xor(s, 16); s += __shfl_xor(s, 32); if (fq == 0) ssp[(size_t)row * SSP_N + u.pn * 4 + wc] = s; }
    }
};

__device__ __forceinline__ int ld_i(const int* p) { return __hip_atomic_load(p, __ATOMIC_RELAXED, __HIP_MEMORY_SCOPE_AGENT); }
__device__ __forceinline__ float ssp_sum32(const float* ssp, int row) {
    const f32x4* q = (const f32x4*)(ssp + (size_t)row * SSP_N); float t = 0.f;
#pragma unroll
    for (int i = 0; i < 8; ++i) { const f32x4 v = q[i]; t += v[0]; t += v[1]; t += v[2]; t += v[3]; }
    return t;
}

template <bool BF> __device__ __forceinline__ float4 ld4(const void* base, size_t idx4) {
    if constexpr (BF) { const uint2 w = ((const uint2*)base)[idx4]; return make_float4(bf2f(w.x & 0xffffu), bf2f(w.x >> 16), bf2f(w.y & 0xffffu), bf2f(w.y >> 16)); }
    else return ((const float4*)base)[idx4];
}
__device__ __forceinline__ void st4bf(bf16_t* base, size_t idx4, float4 v) { uint2 w; w.x = cvtpk(v.x, v.y); w.y = cvtpk(v.z, v.w); ((uint2*)base)[idx4] = w; }
struct RowIn { float4 b[8]; uint2 m[8]; };
template <bool BFBASE> __device__ __forceinline__ void row_load(RowIn& r, const void* base, const bf16_t* mix, int row, int lane) {
#pragma unroll
    for (int i = 0; i < 8; ++i) { const size_t o = (size_t)row * (DM / 4) + lane + 64 * i; r.b[i] = ld4<BFBASE>(base, o); r.m[i] = ((const uint2*)mix)[o]; }
}
__device__ __forceinline__ void row_resnorm_c(const RowIn& r, const float* ssp, const float* g_post, bf16_t* hout, const float* g1, bf16_t* xn1, const float* g2, bf16_t* xn2, int row, int lane) {
    const float rm = rsqrtf(ssp_sum32(ssp, row) * (1.0f / DM) + EPS);
    float4 h[8]; float ss = 0.f;
#pragma unroll
    for (int i = 0; i < 8; ++i) { const size_t o = (size_t)row * (DM / 4) + lane + 64 * i; const float4 b = r.b[i], gp = ((const float4*)g_post)[lane + 64 * i];
        const float4 m = make_float4(bf2f(r.m[i].x & 0xffffu), bf2f(r.m[i].x >> 16), bf2f(r.m[i].y & 0xffffu), bf2f(r.m[i].y >> 16));
        h[i].x = b.x + m.x * rm * gp.x; h[i].y = b.y + m.y * rm * gp.y; h[i].z = b.z + m.z * rm * gp.z; h[i].w = b.w + m.w * rm * gp.w;
        st4bf(hout, o, h[i]); ss += h[i].x * h[i].x + h[i].y * h[i].y + h[i].z * h[i].z + h[i].w * h[i].w; }
    ss = wave_sum(ss); const float rstd = rsqrtf(ss * (1.0f / DM) + EPS);
#pragma unroll
    for (int i = 0; i < 8; ++i) { const float4 gg = ((const float4*)g1)[lane + 64 * i];
        uint2 w; w.x = cvtpk(h[i].x * rstd * gg.x, h[i].y * rstd * gg.y); w.y = cvtpk(h[i].z * rstd * gg.z, h[i].w * rstd * gg.w);
        *(uint2*)(xn1 + (size_t)row * DM + (lane + 64 * i) * 4) = w;
        if (xn2) { const float4 g2v = ((const float4*)g2)[lane + 64 * i];
            uint2 w2; w2.x = cvtpk(h[i].x * rstd * g2v.x, h[i].y * rstd * g2v.y); w2.y = cvtpk(h[i].z * rstd * g2v.z, h[i].w * rstd * g2v.w);
            *(uint2*)(xn2 + (size_t)row * DM + (lane + 64 * i) * 4) = w2; } }
}
template <bool BFBASE> __device__ __forceinline__ void phase_resnorm(const void* base, const bf16_t* mix, const float* ssp, const float* g_post, bf16_t* hout, const float* g1, bf16_t* xn1, const float* g2, bf16_t* xn2, int wave, int lane, int G) {
    int row = blockIdx.x * 8 + wave; if (row >= NTOK) return;
    RowIn cur, nxt; row_load<BFBASE>(cur, base, mix, row, lane);
    for (;;) { const int nrow = row + G * 8; const bool has = nrow < NTOK;
        if (has) row_load<BFBASE>(nxt, base, mix, nrow, lane);
        row_resnorm_c(cur, ssp, g_post, hout, g1, xn1, g2, xn2, row, lane);
        if (!has) break; cur = nxt; row = nrow; }
}
__device__ __forceinline__ void row_router(const bf16_t* base, const bf16_t* mix, const float* ssp, const float* g_post, bf16_t* hout, const float* g_pre, const LAS3 float* wT  , unsigned char* xs8,
                                           int* counts, int* tok_s, float* tok_g, int row, int lane) {
    const float rm = rsqrtf(ssp_sum32(ssp, row) * (1.0f / DM) + EPS);
    float4 h[8]; float ss = 0.f;
#pragma unroll
    for (int i = 0; i < 8; ++i) { const size_t o = (size_t)row * (DM / 4) + lane + 64 * i; const float4 b = ld4<true>(base, o), m = ld4<true>(mix, o), gp = ((const float4*)g_post)[lane + 64 * i];
        h[i].x = b.x + m.x * rm * gp.x; h[i].y = b.y + m.y * rm * gp.y; h[i].z = b.z + m.z * rm * gp.z; h[i].w = b.w + m.w * rm * gp.w;
        st4bf(hout, o, h[i]); ss += h[i].x * h[i].x + h[i].y * h[i].y + h[i].z * h[i].z + h[i].w * h[i].w;
        if (i & 1) asm volatile("" ::: "memory"); }
    ss = wave_sum(ss); const float rstd = rsqrtf(ss * (1.0f / DM) + EPS);
    float lg[8]; unsigned q8[8];
#pragma unroll
    for (int e = 0; e < 8; ++e) lg[e] = 0.f;
#pragma unroll
    for (int i = 0; i < 8; ++i) { const float4 gg = ((const float4*)g_pre)[lane + 64 * i];
        const float n0 = h[i].x * rstd * gg.x, n1 = h[i].y * rstd * gg.y, n2 = h[i].z * rstd * gg.z, n3 = h[i].w * rstd * gg.w;
        q8[i] = pack4_fp8(n0 * F8_SA1, n1 * F8_SA1, n2 * F8_SA1, n3 * F8_SA1); asm volatile("" : "+v"(q8[i]));
        const int k = (lane + 64 * i) * 4;
#pragma unroll
        for (int e = 0; e < 8; ++e) { const f32x4 w = *(const LAS3 f32x4*)(wT + e * DM + k); lg[e] = fmaf(n0, w[0], lg[e]); lg[e] = fmaf(n1, w[1], lg[e]); lg[e] = fmaf(n2, w[2], lg[e]); lg[e] = fmaf(n3, w[3], lg[e]); }
        asm volatile("" ::: "memory"); }
#pragma unroll
    for (int e = 0; e < 8; ++e) lg[e] = wave_sum(lg[e]);
    int s1 = 0, s2 = 0;
    if (lane == 0) {
        int e1 = 0; float v1 = lg[0];
#pragma unroll
        for (int e = 1; e < 8; ++e) if (lg[e] > v1) { v1 = lg[e]; e1 = e; }
        int e2 = 0; float v2 = -3.0e38f;
#pragma unroll
        for (int e = 0; e < 8; ++e) if (e != e1 && lg[e] > v2) { v2 = lg[e]; e2 = e; }
        const float p2 = __expf(v2 - v1), inv = 1.0f / (1.0f + p2);
        s1 = e1 * ECAP + atomicAdd(&counts[e1], 1); s2 = e2 * ECAP + atomicAdd(&counts[e2], 1);
        tok_s[row * 2] = s1; tok_s[row * 2 + 1] = s2; tok_g[row * 2] = inv; tok_g[row * 2 + 1] = p2 * inv;
    }
    s1 = __builtin_amdgcn_readfirstlane(s1); s2 = __builtin_amdgcn_readfirstlane(s2);
    unsigned* d1 = (unsigned*)(xs8 + (size_t)s1 * DM); unsigned* d2 = (unsigned*)(xs8 + (size_t)s2 * DM);
#pragma unroll
    for (int i = 0; i < 8; ++i) { d1[lane + 64 * i] = q8[i]; d2[lane + 64 * i] = q8[i]; }
}
constexpr int KSPLIT = 4, C_TFLAG = 8192;
__device__ __forceinline__ void row_final(const bf16_t* h3, const bf16_t* Y, const float* Yp, const int* tflag, const int* tok_s, const float* tok_g, const float* gain, float* out, int row, int lane) {
    const int s1 = tok_s[row * 2], s2 = tok_s[row * 2 + 1]; const float g1 = tok_g[row * 2], g2 = tok_g[row * 2 + 1];
    float4 f[8]; float ss = 0.f;
#pragma unroll
    for (int i = 0; i < 8; ++i) {
        float4 a, b;
        { const int fl = tflag[(s1 >> 8) * 8 + i];
          if (fl == 0) { const uint2 w = ((const uint2*)(Y + (size_t)s1 * DM))[lane + 64 * i]; a = make_float4(bf2f(w.x & 0xffffu), bf2f(w.x >> 16), bf2f(w.y & 0xffffu), bf2f(w.y >> 16)); }
          else { const float4* q = (const float4*)(Yp + ((size_t)(fl - 1) * KSPLIT) * 65536 + (size_t)(s1 & 255) * 256) + lane; a = q[0];
#pragma unroll
              for (int k = 1; k < KSPLIT; ++k) { const float4 t = q[(size_t)k * 16384]; a.x += t.x; a.y += t.y; a.z += t.z; a.w += t.w; } } }
        { const int fl = tflag[(s2 >> 8) * 8 + i];
          if (fl == 0) { const uint2 w = ((const uint2*)(Y + (size_t)s2 * DM))[lane + 64 * i]; b = make_float4(bf2f(w.x & 0xffffu), bf2f(w.x >> 16), bf2f(w.y & 0xffffu), bf2f(w.y >> 16)); }
          else { const float4* q = (const float4*)(Yp + ((size_t)(fl - 1) * KSPLIT) * 65536 + (size_t)(s2 & 255) * 256) + lane; b = q[0];
#pragma unroll
              for (int k = 1; k < KSPLIT; ++k) { const float4 t = q[(size_t)k * 16384]; b.x += t.x; b.y += t.y; b.z += t.z; b.w += t.w; } } }
        f[i].x = a.x * g1 + b.x * g2; f[i].y = a.y * g1 + b.y * g2; f[i].z = a.z * g1 + b.z * g2; f[i].w = a.w * g1 + b.w * g2;
        ss += f[i].x * f[i].x + f[i].y * f[i].y + f[i].z * f[i].z + f[i].w * f[i].w; }
    ss = wave_sum(ss); const float rstd = rsqrtf(ss * (1.0f / DM) + EPS);
#pragma unroll
    for (int i = 0; i < 8; ++i) { const size_t o = (size_t)row * (DM / 4) + lane + 64 * i; const float4 b = ld4<true>(h3, o), gg = ((const float4*)gain)[lane + 64 * i]; float4 r;
        r.x = b.x + f[i].x * rstd * gg.x; r.y = b.y + f[i].y * rstd * gg.y; r.z = b.z + f[i].z * rstd * gg.z; r.w = b.w + f[i].w * rstd * gg.w; ((float4*)out)[o] = r; }
}
constexpr int MOE_TBL_OFF = 131072;
struct MoeOrder : pg8::StaticOrder {
    const LAS3 int* tbl; int NT; int lim;
    __device__ __forceinline__ bool next(int i, Unit& u) const { if ((long)i * G + c >= lim) return false; if (!pg8::StaticOrder::next(i, u)) return false;
        const int v = tbl[u.pm]; u.pm = v & 0xffff; u.pn += (v >> 16) * NT; return true; }
};
__device__ __forceinline__ int moe_table(const int* counts, LAS3 unsigned char* lds) {
    LAS3 int* tbl = (LAS3 int*)(lds + MOE_TBL_OFF); const int t = threadIdx.x; int q = 0, mine = -1;
#pragma unroll
    for (int e = 0; e < NEXP; ++e) { const int nb = (ld_i(counts + e) + 255) >> 8; if (t >= q && t < q + nb) mine = (e << 16) | (e * (ECAP / 256) + (t - q)); q += nb; }
    if (mine >= 0) tbl[t] = mine;
    __syncthreads();
    return q;
}

struct LeftOrder : pg8::StaticOrder {
    const LAS3 int* tbl; int NT; int L;
    __device__ __forceinline__ bool next(int i, Unit& u) const { if (i != 0 || L < 0) return false;
        pg8::StaticOrder t = *this; t.c = L; if (!t.pg8::StaticOrder::next(0, u)) return false;
        const int v = tbl[u.pm]; u.pm = v & 0xffff; u.pn += (v >> 16) * NT; return true; }
};
struct EpiF32Part {
    static constexpr bool PERM = false, AFTER_DRAIN = false;
    float* P; float scale; int* tflag; int li; int pnmod; int mark;
    __device__ __forceinline__ void operator()(const f32x4 (&acc)[2][2][4][2], const Unit& u, int wr, int wc, int fr, int fq) const {
        asm volatile("" : "+v"(fr), "+v"(fq));
        if (mark && threadIdx.x == 0) tflag[u.pm * 8 + (u.pn % pnmod)] = li + 1;
        const int r0 = wr * 64 + fr, c0 = wc * 32 + 4 * fq;
#pragma unroll
        for (int ai = 0; ai < 2; ++ai)
#pragma unroll
            for (int m = 0; m < 4; ++m) { float* rowp = P + (size_t)(r0 + ai * 128 + m * 16) * 256 + c0;
#pragma unroll
                for (int bj = 0; bj < 2; ++bj)
#pragma unroll
                    for (int n = 0; n < 2; ++n) *(f32x4*)(rowp + bj * 128 + n * 16) = acc[ai][bj][m][n] * scale; }
    }
};

__device__ __forceinline__ void stage_router(const float* wr, LAS3 unsigned char* lds) {
    LAS3 float* wT = (LAS3 float*)lds; const int t = threadIdx.x; float4 v[8];
#pragma unroll
    for (int j = 0; j < 8; ++j) v[j] = ((const float4*)(wr + (size_t)t * 32))[j];
    const float a[32] = {v[0].x, v[0].y, v[0].z, v[0].w, v[1].x, v[1].y, v[1].z, v[1].w, v[2].x, v[2].y, v[2].z, v[2].w, v[3].x, v[3].y, v[3].z, v[3].w,
                         v[4].x, v[4].y, v[4].z, v[4].w, v[5].x, v[5].y, v[5].z, v[5].w, v[6].x, v[6].y, v[6].z, v[6].w, v[7].x, v[7].y, v[7].z, v[7].w};
#pragma unroll
    for (int e = 0; e < 8; ++e) *(LAS3 f32x4*)(wT + e * DM + t * 4) = (f32x4){a[e], a[8 + e], a[16 + e], a[24 + e]};
    __syncthreads();
}

__device__ __forceinline__ void phase_sgu(const Params& p, LAS3 unsigned char* lds) {
    const int tid = threadIdx.x, lane = tid & 63, wave = __builtin_amdgcn_readfirstlane(tid >> 6), fr = lane & 15, fq = lane >> 4;
    unsigned char* ws = p.ws;
    const bf16_t* U = (const bf16_t*)(ws + OFF_U); const bf16_t* VT = (const bf16_t*)(ws + OFF_VT); bf16_t* GT = (bf16_t*)(ws + OFF_GT); const float* SSP = (const float*)(ws + OFF_SSP);
    LAS3 float* rs = (LAS3 float*)(lds + 36864);
    for (int unit = blockIdx.x; unit < 512; unit += (int)gridDim.x) {
        const int ch = unit >> 3, g = unit & 7;
        __syncthreads();
        if (tid < 128) rs[tid] = rsqrtf(ssp_sum32(SSP, ch * 128 + tid) * (1.0f / GH) + EPS);
        bf16x8 bfrag[4][4];
#pragma unroll
        for (int n = 0; n < 4; ++n) { const int chrow = g * 512 + wave * 64 + (n >> 1) * 32 + 8 * (fr >> 2) + 4 * (n & 1) + (fr & 3);
#pragma unroll
            for (int ks = 0; ks < 4; ++ks) bfrag[n][ks] = *(const bf16x8*)(VT + (size_t)chrow * NTOK + ch * 128 + ks * 32 + fq * 8); }
        __syncthreads();
        { const int t = tid >> 2, s0 = (tid & 3) * 32; const float* wp = p.a_w_s + ((size_t)g * 128 + t) * 128 + s0;
#pragma unroll
          for (int q = 0; q < 4; ++q) { const float4 a = *(const float4*)(wp + q * 8), b = *(const float4*)(wp + q * 8 + 4); float v[8] = {a.x, a.y, a.z, a.w, b.x, b.y, b.z, b.w};
#pragma unroll
              for (int j = 0; j < 8; ++j) { const int s = s0 + q * 8 + j; v[j] = (s <= t) ? v[j] * rs[s] : 0.f; }
              u32x4 w; w.x = cvtpk(v[0], v[1]); w.y = cvtpk(v[2], v[3]); w.z = cvtpk(v[4], v[5]); w.w = cvtpk(v[6], v[7]);
              *(LAS3 u32x4*)(lds + t * 272 + (s0 + q * 8) * 2) = w; } }
        __syncthreads();
#pragma unroll
        for (int mt = 0; mt < 8; ++mt) {
            f32x4 acc[4];
#pragma unroll
            for (int n = 0; n < 4; ++n) acc[n] = (f32x4){0.f, 0.f, 0.f, 0.f};
            const int nks = (16 * mt + 15) / 32 + 1;
#pragma unroll
            for (int ks = 0; ks < 4; ++ks) if (ks < nks) { const bf16x8 a = *(const LAS3 bf16x8*)(lds + (16 * mt + fr) * 272 + (ks * 32 + fq * 8) * 2);
#pragma unroll
                for (int n = 0; n < 4; ++n) acc[n] = __builtin_amdgcn_mfma_f32_16x16x32_bf16(bfrag[n][ks], a, acc[n], 0, 0, 0); }
            const int tl = 16 * mt + fr, tok = ch * 128 + tl; const float b = p.a_b_s[g * 128 + tl];
#pragma unroll
            for (int pp = 0; pp < 2; ++pp) { const int c0 = g * 512 + wave * 64 + pp * 32 + 8 * fq;
                const u32x4 uu = *(const u32x4*)(U + (size_t)tok * GH + c0); const f32x4 g0 = *(const f32x4*)(p.a_norm_v + c0), g1 = *(const f32x4*)(p.a_norm_v + c0 + 4);
                const f32x4 a0 = acc[2 * pp], a1 = acc[2 * pp + 1];
                u32x4 w;
                w.x = cvtpk(bf2f(uu.x & 0xffffu) * (g0[0] * a0[0] + b), bf2f(uu.x >> 16) * (g0[1] * a0[1] + b));
                w.y = cvtpk(bf2f(uu.y & 0xffffu) * (g0[2] * a0[2] + b), bf2f(uu.y >> 16) * (g0[3] * a0[3] + b));
                w.z = cvtpk(bf2f(uu.z & 0xffffu) * (g1[0] * a1[0] + b), bf2f(uu.z >> 16) * (g1[1] * a1[1] + b));
                w.w = cvtpk(bf2f(uu.w & 0xffffu) * (g1[2] * a1[2] + b), bf2f(uu.w >> 16) * (g1[3] * a1[3] + b));
                *(u32x4*)(GT + (size_t)tok * GH + c0) = w; }
        }
    }
    __syncthreads();
}

constexpr int AT_KP = 272, AT_VP = 288, AT_VOFF = 256 * AT_KP, AT_UNITS = 3072;
typedef short s16x4 __attribute__((ext_vector_type(4)));
struct AtUnit { int gi, b, h, r, n, dsh; };
__device__ __forceinline__ AtUnit at_decode(int unit) { AtUnit u; u.gi = unit >> 10; const int rem = unit & 1023; u.b = rem >> 8; u.h = (rem >> 4) & 15; const int rn = rem & 15;
    u.dsh = 2 * u.gi; const int nbsh = 4 - u.dsh; u.r = rn >> nbsh; u.n = rn & ((1 << nbsh) - 1); return u; }
#define AT_TR4(o0, o1, o2, o3, f0, f1, f2, f3) asm volatile("ds_read_b64_tr_b16 %0, %4 offset:%5\n\tds_read_b64_tr_b16 %1, %4 offset:%6\n\tds_read_b64_tr_b16 %2, %4 offset:%7\n\tds_read_b64_tr_b16 %3, %4 offset:%8" \
        : "=&v"(o0), "=&v"(o1), "=&v"(o2), "=&v"(o3) : "v"(vrow), "i"(f0), "i"(f1), "i"(f2), "i"(f3) : "memory")
__device__ __forceinline__ void phase_attn(const Params& p, LAS3 unsigned char* lds) {
    const int tid = threadIdx.x, lane = tid & 63, wave = __builtin_amdgcn_readfirstlane(tid >> 6), fr = lane & 15, fq = lane >> 4, G = (int)gridDim.x;
    unsigned char* ws = p.ws;
    const bf16_t* Q = (const bf16_t*)(ws + OFF_Q); const bf16_t* KV = (const bf16_t*)(ws + OFF_KV); bf16_t* OG = (bf16_t*)(ws + OFF_OG); float* LSE = (float*)(ws + OFF_LSE);
    const unsigned vbase = (unsigned)(size_t)(lds + AT_VOFF);
    const unsigned vrow = vbase + (unsigned)((16 * wave + 4 * fq + ((lane & 15) >> 2)) * AT_VP + (lane & 3) * 8);
    const int srow = tid >> 4, c16 = tid & 15;
    int unit = blockIdx.x;
    if (unit < AT_UNITS) {
        AtUnit cu = at_decode(unit);
        u32x4 kreg[8], vreg[8]; bf16x8 qf[4], qn[4];
#define AT_LOADQ(U, D) do { const int _tok = (U).b * SEQ + ((((U).n << 7) + wave * 16 + fr) << (U).dsh) + (U).r; _Pragma("unroll") for (int ks = 0; ks < 4; ++ks) D[ks] = *(const bf16x8*)(Q + (size_t)_tok * NQ + (U).gi * 2048 + (U).h * 128 + ks * 32 + fq * 8); } while (0)
#define AT_LOAD(U) do { _Pragma("unroll") for (int ps = 0; ps < 8; ++ps) if ((U).n > 0 || ps >= 4) { const int lk = ((U).n - 1) * 128 + ps * 32 + srow; \
            const bf16_t* src = KV + ((size_t)(U).h * NTOK + (U).b * SEQ + (lk << (U).dsh) + (U).r) * 128 + c16 * 8; kreg[ps] = *(const u32x4*)src; vreg[ps] = *(const u32x4*)(src + (size_t)16 * NTOK * 128); } } while (0)
        AT_LOAD(cu); AT_LOADQ(cu, qn);
        for (;;) {
            asm volatile("" ::: "memory"); __builtin_amdgcn_s_barrier(); asm volatile("" ::: "memory");
#pragma unroll
            for (int ps = 0; ps < 8; ++ps) if (cu.n > 0 || ps >= 4) { const int kk = ps * 32 + srow;
                *(LAS3 u32x4*)(lds + kk * AT_KP + c16 * 16) = kreg[ps]; *(LAS3 u32x4*)(lds + AT_VOFF + kk * AT_VP + c16 * 16) = vreg[ps]; }
            const int jq = wave * 16 + fr, qtok = cu.b * SEQ + (((cu.n << 7) + jq) << cu.dsh) + cu.r;
#pragma unroll
            for (int ks = 0; ks < 4; ++ks) qf[ks] = qn[ks];
            const int un = unit + G; const bool hasn = un < AT_UNITS; AtUnit nu = cu;
            if (hasn) { nu = at_decode(un); AT_LOAD(nu); AT_LOADQ(nu, qn); }
            asm volatile("s_waitcnt lgkmcnt(0)" ::: "memory"); __builtin_amdgcn_s_barrier(); asm volatile("" ::: "memory");
            const int c_lo = cu.n == 0 ? (8 - wave) : 0;
            f32x4 sc[9];
#pragma unroll
            for (int c = 0; c < 9; ++c) { sc[c] = (f32x4){0.f, 0.f, 0.f, 0.f};
                if (c >= c_lo) {
#pragma unroll
                    for (int ks = 0; ks < 4; ++ks) { const bf16x8 kf = *(const LAS3 bf16x8*)(lds + (16 * (wave + c) + fr) * AT_KP + (ks * 32 + fq * 8) * 2);
                        sc[c] = __builtin_amdgcn_mfma_f32_16x16x32_bf16(kf, qf[ks], sc[c], 0, 0, 0); } } }
            const float slope2 = exp2f(-0.5f * (float)(cu.h + 1)) * 1.4426950409f; const int dq = fr - 4 * fq; const float t0 = slope2 * (float)(128 + dq); float mx = -3.0e38f;
#pragma unroll
            for (int c = 0; c < 9; ++c) {
                if (c >= c_lo) {
#pragma unroll
                    for (int q = 0; q < 4; ++q) { float s2 = fmaf(sc[c][q], 0.08838834764831845f * 1.4426950409f, fmaf(slope2, (float)(16 * c + q), -t0));
                        if (c == 0) s2 = (dq - q <= 0) ? s2 : -3.0e38f;
                        if (c == 8) s2 = (dq - q >= 0) ? s2 : -3.0e38f;
                        sc[c][q] = s2; mx = fmaxf(mx, s2); }
                } else { sc[c] = (f32x4){-3.0e38f, -3.0e38f, -3.0e38f, -3.0e38f}; } }
            mx = fmaxf(mx, __shfl_xor(mx, 16)); mx = fmaxf(mx, __shfl_xor(mx, 32));
            float den = 0.f;
#pragma unroll
            for (int c = 0; c < 9; ++c) {
                if (c >= c_lo) {
#pragma unroll
                    for (int q = 0; q < 4; ++q) { const float e = __builtin_amdgcn_exp2f(sc[c][q] - mx); sc[c][q] = e; den += e; }
                } else { sc[c] = (f32x4){0.f, 0.f, 0.f, 0.f}; } }
            den += __shfl_xor(den, 16); den += __shfl_xor(den, 32);
            f32x4 o[8];
#pragma unroll
            for (int et = 0; et < 8; ++et) o[et] = (f32x4){0.f, 0.f, 0.f, 0.f};
#pragma unroll
            for (int pp = 0; pp < 5; ++pp) {
                if (2 * pp + 1 >= c_lo) {
                    u32x4 pw; pw.x = cvtpk(sc[2 * pp][0], sc[2 * pp][1]); pw.y = cvtpk(sc[2 * pp][2], sc[2 * pp][3]);
                    if (pp < 4) { pw.z = cvtpk(sc[2 * pp + 1][0], sc[2 * pp + 1][1]); pw.w = cvtpk(sc[2 * pp + 1][2], sc[2 * pp + 1][3]); } else { pw.z = 0u; pw.w = 0u; }
                    const bf16x8 pf = __builtin_bit_cast(bf16x8, pw);
                    constexpr int R1 = 16 * AT_VP;
                    const int r0 = (32 * pp) * AT_VP, r1 = (pp < 4 ? (32 * pp + 16) : (32 * pp)) * AT_VP; (void)R1;
                    s16x4 a0, a1, a2, a3, a4, a5, a6, a7, b0, b1, b2, b3, b4, b5, b6, b7;
                    AT_TR4(a0, a1, a2, a3, r0, r0 + 32, r0 + 64, r0 + 96); AT_TR4(a4, a5, a6, a7, r0 + 128, r0 + 160, r0 + 192, r0 + 224);
                    AT_TR4(b0, b1, b2, b3, r1, r1 + 32, r1 + 64, r1 + 96); AT_TR4(b4, b5, b6, b7, r1 + 128, r1 + 160, r1 + 192, r1 + 224);
                    asm volatile("s_waitcnt lgkmcnt(0)" : "+v"(a0), "+v"(a1), "+v"(a2), "+v"(a3), "+v"(a4), "+v"(a5), "+v"(a6), "+v"(a7), "+v"(b0), "+v"(b1), "+v"(b2), "+v"(b3), "+v"(b4), "+v"(b5), "+v"(b6), "+v"(b7) :: "memory");
                    if (2 * pp < c_lo) { const s16x4 z = {0, 0, 0, 0}; a0 = z; a1 = z; a2 = z; a3 = z; a4 = z; a5 = z; a6 = z; a7 = z; }
#define AT_PV(et, A, B) o[et] = __builtin_amdgcn_mfma_f32_16x16x32_bf16((bf16x8){A[0], A[1], A[2], A[3], B[0], B[1], B[2], B[3]}, pf, o[et], 0, 0, 0)
                    AT_PV(0, a0, b0); AT_PV(1, a1, b1); AT_PV(2, a2, b2); AT_PV(3, a3, b3); AT_PV(4, a4, b4); AT_PV(5, a5, b5); AT_PV(6, a6, b6); AT_PV(7, a7, b7);
#undef AT_PV
                } }
            const float inv = 1.0f / den;
            bf16_t* op = OG + ((size_t)cu.gi * NTOK + qtok) * DM + cu.h * 128 + 4 * fq;
#pragma unroll
            for (int et = 0; et < 8; ++et) { uint2 w; w.x = cvtpk(o[et][0] * inv, o[et][1] * inv); w.y = cvtpk(o[et][2] * inv, o[et][3] * inv); *(uint2*)(op + et * 16) = w; }
            if (fq == 0) LSE[((size_t)cu.gi * NTOK + qtok) * 16 + cu.h] = (mx + __log2f(den)) * 0.6931471806f;
            if (!hasn) break;
            unit = un; cu = nu;
        }
#undef AT_LOAD
#undef AT_LOADQ
    }
    __syncthreads();
}
#undef AT_TR4

__device__ __forceinline__ void phase_merge(const Params& p) {
    unsigned char* ws = p.ws; const bf16_t* OG = (const bf16_t*)(ws + OFF_OG); const float* LSE = (const float*)(ws + OFF_LSE); bf16_t* OM = (bf16_t*)(ws + OFF_OM);
    for (size_t i = (size_t)blockIdx.x * MK_THREADS + threadIdx.x; i < (size_t)NTOK * 256; i += (size_t)gridDim.x * MK_THREADS) {
        const int tok = (int)(i >> 8), c8 = (int)(i & 255), h = c8 >> 4;
        const float l0 = LSE[((size_t)0 * NTOK + tok) * 16 + h], l1 = LSE[((size_t)1 * NTOK + tok) * 16 + h], l2 = LSE[((size_t)2 * NTOK + tok) * 16 + h];
        const float m = fmaxf(l0, fmaxf(l1, l2)); const float a0 = __expf(l0 - m), a1 = __expf(l1 - m), a2 = __expf(l2 - m), inv = 1.0f / (a0 + a1 + a2);
        const uint4 x0 = *(const uint4*)(OG + ((size_t)0 * NTOK + tok) * DM + c8 * 8), x1 = *(const uint4*)(OG + ((size_t)1 * NTOK + tok) * DM + c8 * 8), x2 = *(const uint4*)(OG + ((size_t)2 * NTOK + tok) * DM + c8 * 8);
        const unsigned w0[4] = {x0.x, x0.y, x0.z, x0.w}, w1[4] = {x1.x, x1.y, x1.z, x1.w}, w2[4] = {x2.x, x2.y, x2.z, x2.w}; unsigned rr[4];
#pragma unroll
        for (int j = 0; j < 4; ++j) { const float lo = (a0 * bf2f(w0[j] & 0xffffu) + a1 * bf2f(w1[j] & 0xffffu) + a2 * bf2f(w2[j] & 0xffffu)) * inv;
            const float hi = (a0 * bf2f(w0[j] >> 16) + a1 * bf2f(w1[j] >> 16) + a2 * bf2f(w2[j] >> 16)) * inv; rr[j] = cvtpk(lo, hi); }
        *(uint4*)(OM + (size_t)tok * DM + c8 * 8) = make_uint4(rr[0], rr[1], rr[2], rr[3]);
    }
}
#define PHASE2_BODY phase_sgu(p, lds);
#define PHASE9_BODY phase_attn(p, lds);
#define PHASE10_BODY phase_merge(p);

__global__ void __launch_bounds__(MK_THREADS, 2) mega(Params p, int lo, int hi) {
    extern __shared__ __attribute__((aligned(16))) unsigned char shm[];
    LAS3 unsigned char* lds = (LAS3 unsigned char*)shm;
    const int tid = threadIdx.x, wave = __builtin_amdgcn_readfirstlane(tid >> 6), G = (int)gridDim.x;
#define MK_LANE() ((int)__builtin_amdgcn_mbcnt_hi(~0u, __builtin_amdgcn_mbcnt_lo(~0u, 0u)))
    unsigned char* ws = p.ws;
    volatile LAS3 unsigned* xbw = (volatile LAS3 unsigned*)(lds + MK_LDS_BAR);
    if (tid < 4) xbw[tid] = 0u;
    __syncthreads();
    XcdBarrier bar; bar.bar = (unsigned*)(ws + OFF_CTRL + CTRL_BAR_BYTE); bar.x = 0; bar.st = xbw;
    if (hi - lo > 1) bar = xcd_barrier_post((unsigned*)(ws + OFF_CTRL + CTRL_BAR_BYTE), xbw);
#define IN(k) (lo <= (k) && (k) < hi)
#define SEAM(k) do { if (IN(k) && IN((k) + 1)) xcd_barrier(bar); } while (0)
    float* SSP = (float*)(ws + OFF_SSP);
    bf16_t* XN = (bf16_t*)(ws + OFF_XN); bf16_t* XNQ = (bf16_t*)(ws + OFF_XNQ);
    bf16_t* MIX = (bf16_t*)(ws + OFF_MIX); bf16_t* H1 = (bf16_t*)(ws + OFF_H1); bf16_t* H2 = (bf16_t*)(ws + OFF_H2); bf16_t* H3 = (bf16_t*)(ws + OFF_H3);
    int* ictrl = (int*)(ws + OFF_CTRL);
    const float* gains = p.gains;

    constexpr int CR0 = CT1, CR1 = 12800, CR3 = 17408, CR5 = 34304, CR6 = 42496, CR8 = CT8;
    static_assert(CR1 >= CT6, "every dense weight is converted by the end of P1");
    const bool conv_first = ((blockIdx.x >> 5) & 1) == 0;
    if (IN(0)) {
        phase_convert(p, lds, 0, CR0);
        { const int lane = MK_LANE(); for (int row = blockIdx.x * 8 + wave; row < NTOK; row += G * 8) row_norm0(p, row, lane); }
    }
    SEAM(0);
    if (IN(1)) {
        if (conv_first) phase_convert(p, lds, CR0, CR1);
        { pg8::Gemm g{XN, (const bf16_t*)(ws + OFF_WIN_T), NTOK, GH, DM}; pg8::StaticOrder S; S.init(NTOK, GH, G, (int)blockIdx.x);
          EpiGeluU E{(bf16_t*)(ws + OFF_U), GH, p.a_b_in};
          pg8::gemm_phase<EpiGeluU, pg8::StaticOrder>(lds, g, S, E, nullptr); }
        { pg8::Gemm g{(const bf16_t*)(ws + OFF_WIN_T) + (size_t)GH * DM, XN, GH, NTOK, DM}; pg8::StaticOrder S; S.init(GH, NTOK, G, (int)blockIdx.x);
          EpiGeluVT E{(bf16_t*)(ws + OFF_VT), p.a_b_in + GH, SSP};
          pg8::gemm_phase<EpiGeluVT, pg8::StaticOrder>(lds, g, S, E, nullptr); }
        if (!conv_first) phase_convert(p, lds, CR0, CR1);
    }
    SEAM(1);
    if (IN(2)) { PHASE2_BODY }
    SEAM(2);
    if (IN(3)) {
        if (conv_first) phase_convert(p, lds, CR1, CR3);
        pg8::Gemm g{(const bf16_t*)(ws + OFF_GT), (const bf16_t*)(ws + OFF_WOUT_T), NTOK, DM, GH}; pg8::StaticOrder S; S.init(NTOK, DM, G, (int)blockIdx.x);
        EpiBf16SS E{MIX, DM, SSP};
        pg8::gemm_phase<EpiBf16SS, pg8::StaticOrder>(lds, g, S, E, nullptr);
        if (!conv_first) phase_convert(p, lds, CR1, CR3);
    }
    SEAM(3);
    if (IN(4)) { phase_resnorm<false>(p.x, MIX, SSP, gains + DM, H1, gains + 2 * DM, XN, nullptr, nullptr, wave, MK_LANE(), G); }
    SEAM(4);
    if (IN(5)) {
        if (conv_first) phase_convert(p, lds, CR3, CR5);
        pg8::Gemm g{XN, (const bf16_t*)(ws + OFF_WGU_T), NTOK, 2 * DFF, DM}; pg8::StaticOrder S; S.init(NTOK, 2 * DFF, G, (int)blockIdx.x);
        EpiSwiglu E{(bf16_t*)(ws + OFF_ACT), DFF, 56};
        pg8::gemm_phase<EpiSwiglu, pg8::StaticOrder>(lds, g, S, E, nullptr);
        if (!conv_first) phase_convert(p, lds, CR3, CR5);
    }
    SEAM(5);
    if (IN(6)) {
        if (conv_first) phase_convert(p, lds, CR5, CR6);
        pg8::Gemm g{(const bf16_t*)(ws + OFF_ACT), (const bf16_t*)(ws + OFF_WDN_T), NTOK, DM, DFF}; pg8::StaticOrder S; S.init(NTOK, DM, G, (int)blockIdx.x);
        EpiBf16SS E{MIX, DM, SSP};
        pg8::gemm_phase<EpiBf16SS, pg8::StaticOrder>(lds, g, S, E, nullptr);
        if (!conv_first) phase_convert(p, lds, CR5, CR6);
    }
    SEAM(6);
    if (IN(7)) { phase_resnorm<true>(H1, MIX, SSP, gains + 3 * DM, H2, p.kv_norm, XN, gains + 4 * DM, XNQ, wave, MK_LANE(), G); }
    SEAM(7);
    if (IN(8)) {
        if (conv_first) phase_convert(p, lds, CR6, CR8);
        { pg8::Gemm g{XN, (const bf16_t*)(ws + OFF_WKV_T), NTOK, NKV, DM}; pg8::StaticOrder S; S.init(NTOK, NKV, G, (int)blockIdx.x);
          EpiBf16H E{(bf16_t*)(ws + OFF_KV), NTOK};
          pg8::gemm_phase<EpiBf16H, pg8::StaticOrder>(lds, g, S, E, nullptr); }
        { pg8::Gemm g{XNQ, (const bf16_t*)(ws + OFF_WQ_T), NTOK, NQ, DM}; pg8::StaticOrder S; S.init(NTOK, NQ, G, (int)blockIdx.x);
          EpiBf16P E{(bf16_t*)(ws + OFF_Q), NQ};
          pg8::gemm_phase<EpiBf16P, pg8::StaticOrder>(lds, g, S, E, nullptr); }
        if (!conv_first) phase_convert(p, lds, CR6, CR8);
    }
    SEAM(8);
    if (IN(9)) { PHASE9_BODY }
    SEAM(9);
    if (IN(10)) { PHASE10_BODY }
    SEAM(10);
    if (IN(11)) {
        pg8::Gemm g{(const bf16_t*)(ws + OFF_OM), (const bf16_t*)(ws + OFF_WO_T), NTOK, DM, DM}; pg8::StaticOrder S; S.init(NTOK, DM, G, (int)blockIdx.x);
        EpiBf16SS E{MIX, DM, SSP};
        pg8::gemm_phase<EpiBf16SS, pg8::StaticOrder>(lds, g, S, E, nullptr);
    }
    SEAM(11);
    if (IN(12)) { stage_router(p.moe_router, lds); const int lane = MK_LANE(); for (int row = blockIdx.x * 8 + wave; row < NTOK; row += G * 8) { int ln = lane; asm volatile("" : "+v"(ln));
        row_router(H2, MIX, SSP, gains + 5 * DM, H3, gains + 6 * DM, (const LAS3 float*)lds, ws + OFF_XS, ictrl + C_CNT, (int*)(ws + OFF_TOKS), (float*)(ws + OFF_TOKG), row, ln); } }
    SEAM(12);
    if (IN(13)) {
        const int nblk = moe_table(ictrl + C_CNT, lds);
        pg8::Gemm g{(const bf16_t*)(ws + OFF_XS), (const bf16_t*)(ws + OFF_MGU_T), nblk * 256, 2 * DFF, DM}; MoeOrder S; S.init(nblk * 256, 2 * DFF, G, (int)blockIdx.x); S.tbl = (const LAS3 int*)(lds + MOE_TBL_OFF); S.NT = 56; S.lim = 0x7fffffff;
        EpiSwiglu8 E{ws + OFF_ACT2, DFF, 56, 1.0f / (F8_SA1 * F8_SW1), F8_SA2};
        pg8::gemm_phase<EpiSwiglu8, MoeOrder, false, true>(lds, g, S, E, nullptr);
    }
    SEAM(13);
    if (IN(14)) {
        const int nblk = moe_table(ictrl + C_CNT, lds); const int nunits = nblk * 8; int lim = 2 * G < nunits ? 2 * G : nunits; if ((nunits - lim) * KSPLIT > G) lim = nunits;
        { pg8::Gemm g{(const bf16_t*)(ws + OFF_ACT2), (const bf16_t*)(ws + OFF_MDN_T), nblk * 256, DM, DFF}; MoeOrder S; S.init(nblk * 256, DM, G, (int)blockIdx.x); S.tbl = (const LAS3 int*)(lds + MOE_TBL_OFF); S.NT = 8; S.lim = lim;
          EpiBf16S E{(bf16_t*)(ws + OFF_Y), DM, 8, 1.0f / (F8_SA2 * F8_SW2)};
          pg8::gemm_phase<EpiBf16S, MoeOrder, false, true>(lds, g, S, E, nullptr); }
        { const int nleft = nunits - lim, item = (int)blockIdx.x, li = item / KSPLIT, ch = item - li * KSPLIT;
          constexpr int CKT = DFF / 128 / KSPLIT;
          pg8::Gemm g{(const bf16_t*)(ws + OFF_ACT2 + (size_t)ch * CKT * 128), (const bf16_t*)(ws + OFF_MDN_T + (size_t)ch * CKT * 128), nblk * 256, DM, DFF, CKT};
          LeftOrder S; S.init(nblk * 256, DM, G, 0); S.tbl = (const LAS3 int*)(lds + MOE_TBL_OFF); S.NT = 8; S.L = li < nleft ? lim + li : -1;
          EpiF32Part E{(float*)(ws + OFF_U) + ((size_t)li * KSPLIT + ch) * 65536, 1.0f / (F8_SA2 * F8_SW2), ictrl + C_TFLAG, li, 8, ch == 0};
          pg8::gemm_phase<EpiF32Part, LeftOrder, false, true>(lds, g, S, E, nullptr); }
    }
    SEAM(14);
    if (IN(15)) { const int lane = MK_LANE(); for (int row = blockIdx.x * 8 + wave; row < NTOK; row += G * 8)
        row_final(H3, (const bf16_t*)(ws + OFF_Y), (const float*)(ws + OFF_U)  , ictrl + C_TFLAG, (const int*)(ws + OFF_TOKS), (const float*)(ws + OFF_TOKG), gains + 7 * DM, p.out, row, lane); }
#undef IN
#undef SEAM
}

extern "C" void kernel_launch(void* const* d_in, const int* in_sizes, int n_in, void* d_out, int out_size, void* d_ws, size_t ws_size, hipStream_t stream) {
    (void)in_sizes; (void)n_in; (void)out_size;
    if (ws_size < WS_NEED) { fprintf(stderr, "workspace too small: %zu < %zu\n", ws_size, (size_t)WS_NEED); return; }
    static int grid = 0;
    if (grid == 0) {
        int dev = 0, cus = 0, per_cu = 0;
        if (hipGetDevice(&dev) != hipSuccess || hipDeviceGetAttribute(&cus, hipDeviceAttributeMultiprocessorCount, dev) != hipSuccess) { fprintf(stderr, "device query failed\n"); grid = -1; return; }
        if (hipFuncSetAttribute((const void*)mega, hipFuncAttributeMaxDynamicSharedMemorySize, MK_LDS_BYTES) != hipSuccess) { fprintf(stderr, "hipFuncSetAttribute failed\n"); grid = -1; return; }
        if (hipOccupancyMaxActiveBlocksPerMultiprocessor(&per_cu, (const void*)mega, MK_THREADS, MK_LDS_BYTES) != hipSuccess || per_cu < 1) { fprintf(stderr, "occupancy query: %d blocks per CU\n", per_cu); (void)hipGetLastError(); }
        grid = cus;
    }
    if (grid < 0) return;
    const float* const* in = (const float* const*)d_in;
    Params P{};
    P.x = in[0]; P.gains = in[1]; P.a_w_in = in[2]; P.a_b_in = in[3]; P.a_norm_v = in[4]; P.a_w_s = in[5]; P.a_b_s = in[6]; P.a_w_out = in[7]; P.kv_norm = in[8]; P.w_kv = in[9]; P.w_q = in[10]; P.w_o = in[11];
    P.ffn_w_gu = in[12]; P.ffn_w_down = in[13]; P.moe_router = in[14]; P.moe_w_gu = in[15]; P.moe_w_down = in[16]; P.out = (float*)d_out; P.ws = (unsigned char*)d_ws;
#define MEGA(lo, hi) hipLaunchKernelGGL(mega, dim3(grid), dim3(MK_THREADS), MK_LDS_BYTES, stream, P, (lo), (hi))

    (void)hipMemsetAsync((char*)d_ws + OFF_CTRL, 0, CTRL_BYTES, stream);
    MEGA(0, NPH);
}
```

```cpp
#include <hip/hip_runtime.h>
#include <stdint.h>
#include <stdio.h>

typedef unsigned short bf16_t;

constexpr int NTOK = 8192, DM = 2048, SEQ = 2048, GH = 4096  , DFF = 7168, NEXP = 8;
constexpr int NQ = 6144, NKV = 4096;
constexpr int ECAP = NTOK, MAXSLOT = NEXP * ECAP;
constexpr float EPS = 1e-6f;

constexpr size_t AL(size_t x) { return (x + 255) & ~(size_t)255; }
constexpr size_t OFF_CTRL = 0;
constexpr size_t CTRL_BYTES = 1 << 16;
constexpr int C_CNT = 0  ;
constexpr int SSP_N = 64;
constexpr size_t OFF_SSP  = AL(OFF_CTRL + CTRL_BYTES);
constexpr size_t OFF_XN   = AL(OFF_SSP + (size_t)NTOK * SSP_N * 4);
constexpr size_t OFF_XNQ  = AL(OFF_XN + (size_t)NTOK * DM * 2);
constexpr size_t OFF_U    = AL(OFF_XNQ + (size_t)NTOK * DM * 2);
constexpr size_t OFF_VT   = AL(OFF_U + (size_t)NTOK * GH * 2);
constexpr size_t OFF_GT   = AL(OFF_VT + (size_t)NTOK * GH * 2);
constexpr size_t OFF_MIX  = AL(OFF_GT + (size_t)NTOK * GH * 2);
constexpr size_t OFF_H1   = AL(OFF_MIX + (size_t)NTOK * DM * 4);
constexpr size_t OFF_H2   = AL(OFF_H1 + (size_t)NTOK * DM * 4);
constexpr size_t OFF_H3   = AL(OFF_H2 + (size_t)NTOK * DM * 4);
constexpr size_t OFF_ACT  = AL(OFF_H3 + (size_t)NTOK * DM * 4);
constexpr size_t OFF_KV   = AL(OFF_ACT + (size_t)NTOK * DFF * 2);
constexpr size_t OFF_Q    = AL(OFF_KV + (size_t)NTOK * NKV * 2);
constexpr size_t OFF_OG   = AL(OFF_Q + (size_t)NTOK * NQ * 2);
constexpr size_t OFF_LSE  = AL(OFF_OG + (size_t)3 * NTOK * DM * 2);
constexpr size_t OFF_OM   = AL(OFF_LSE + (size_t)3 * NTOK * 16 * 4);
constexpr size_t OFF_TOKG = AL(OFF_OM + (size_t)NTOK * DM * 2);
constexpr size_t OFF_TOKS = AL(OFF_TOKG + (size_t)NTOK * 2 * 4);
constexpr size_t OFF_XS   = AL(OFF_TOKS + (size_t)NTOK * 2 * 4);
constexpr size_t OFF_ACT2 = AL(OFF_XS + (size_t)MAXSLOT * DM);
constexpr size_t OFF_Y    = AL(OFF_ACT2 + (size_t)MAXSLOT * DFF);
constexpr size_t OFF_WIN_T  = AL(OFF_Y + (size_t)MAXSLOT * DM * 2);
constexpr size_t OFF_WOUT_T = AL(OFF_WIN_T + (size_t)2 * GH * DM * 2);
constexpr size_t OFF_WGU_T  = AL(OFF_WOUT_T + (size_t)DM * GH * 2);
constexpr size_t OFF_WDN_T  = AL(OFF_WGU_T + (size_t)2 * DFF * DM * 2);
constexpr size_t OFF_WKV_T  = AL(OFF_WDN_T + (size_t)DM * DFF * 2);
constexpr size_t OFF_WQ_T   = AL(OFF_WKV_T + (size_t)NKV * DM * 2);
constexpr size_t OFF_WO_T   = AL(OFF_WQ_T + (size_t)NQ * DM * 2);
constexpr size_t OFF_MGU_T  = AL(OFF_WO_T + (size_t)DM * DM * 2);
constexpr size_t OFF_MDN_T  = AL(OFF_MGU_T + (size_t)NEXP * 2 * DFF * DM);
constexpr size_t WS_NEED  = AL(OFF_MDN_T + (size_t)NEXP * DM * DFF);
constexpr size_t CTRL_BAR_BYTE = 4096;

__device__ __forceinline__ float bf2f(unsigned v) { return __uint_as_float(v << 16); }
__device__ __forceinline__ bf16_t f2bf(float f) { unsigned u = __float_as_uint(f); u += 0x7FFFu + ((u >> 16) & 1u); return (bf16_t)(u >> 16); }
__device__ __forceinline__ unsigned pack2(float lo, float hi) { return (unsigned)f2bf(lo) | ((unsigned)f2bf(hi) << 16); }
__device__ __forceinline__ float gelu_tanh(float x) { const float t = 1.5957691216057308f * (x + 0.044715f * x * x * x); return x / (1.0f + __expf(-t)); }
__device__ __forceinline__ float silu(float x) { return x / (1.0f + __expf(-x)); }
__device__ __forceinline__ float wave_sum(float v) { for (int o = 32; o >= 1; o >>= 1) v += __shfl_xor(v, o); return v; }
__device__ __forceinline__ float wave_max(float v) { for (int o = 32; o >= 1; o >>= 1) v = fmaxf(v, __shfl_xor(v, o)); return v; }

namespace pg8 {
#define PG8_LAS __attribute__((address_space(3)))
typedef unsigned short bf16_t;
typedef short bf16x8 __attribute__((ext_vector_type(8)));
typedef float f32x4 __attribute__((ext_vector_type(4)));
typedef unsigned u32x4 __attribute__((ext_vector_type(4)));
constexpr int BM = 256, BK = 64, HALF = 128, HTB = HALF * BK * 2  , STAGE_BYTES = 8 * HTB, NXCD = 8, WGM = 8;

__host__ __device__ __forceinline__ int lds_byte(int r, int c) { const int st = (r >> 4) * 2 + (c >> 5), rr = r & 15, cc = c & 31, ob = rr * 64 + cc * 2; return st * 1024 + (ob ^ (((ob >> 9) & 1) << 5)); }
__host__ __device__ __forceinline__ void stage_rc(int b, int& R, int& C) { const int st = b / 1024, sb = b % 1024, swz = sb ^ (((sb >> 9) & 1) << 5); R = (st >> 1) * 16 + swz / 64; C = (st & 1) * 32 + (swz % 64) / 2; }
__host__ __device__ __forceinline__ int perm32(int rho) { const int n = rho >> 4, i = rho & 15; return 8 * (i >> 2) + 4 * n + (i & 3); }

struct Unit { int pm, pn; };
struct Gemm { const bf16_t* A; const bf16_t* Bt; int M, N, K; int kt; };

struct StaticOrder {
    int nM, nN, nwg, G, c;
    __host__ __device__ void init(int M, int N, int G_, int c_) { nM = M / BM; nN = N / BM; nwg = nM * nN; G = G_; c = c_; }
    __host__ __device__ bool next(int i, Unit& u) const {
        const long L = (long)i * G + c; if (L >= nwg) return false;
        int wgid = (int)L; { const int q = nwg / NXCD, r = nwg % NXCD, xcd = wgid % NXCD, off = wgid / NXCD; wgid = (xcd < r ? xcd * (q + 1) : r * (q + 1) + (xcd - r) * q) + off; }
        const int nig = WGM * nN, gid = wgid / nig, fm = gid * WGM, gsz = (nM - fm) < WGM ? (nM - fm) : WGM;
        u.pm = fm + ((wgid % nig) % gsz); u.pn = (wgid % nig) / gsz; return true;
    }
    __device__ __forceinline__ void a_ready(const Unit&) const {}
    __device__ __forceinline__ void done(const Unit&) const {}
};
__device__ __forceinline__ unsigned cvt_pk_bf16(float lo, float hi) { unsigned r; asm volatile("v_cvt_pk_bf16_f32 %0, %1, %2" : "=v"(r) : "v"(lo), "v"(hi)); return r; }
typedef float f32x2 __attribute__((ext_vector_type(2)));
typedef int pg8_v4i __attribute__((ext_vector_type(4))); typedef int pg8_v8i __attribute__((ext_vector_type(8)));
__device__ __forceinline__ pg8_v8i pg8_cat(bf16x8 a, bf16x8 b) { return __builtin_shufflevector(__builtin_bit_cast(pg8_v4i, a), __builtin_bit_cast(pg8_v4i, b), 0, 1, 2, 3, 4, 5, 6, 7); }
template <bool F8> struct pg8_frag; template <> struct pg8_frag<false> { bf16x8 v[2]; }; template <> struct pg8_frag<true> { pg8_v8i v; };
template <class Epi, class Sched, bool STAMP = false, bool F8 = false>
__device__ __forceinline__ void gemm_phase(PG8_LAS unsigned char* lds, const Gemm g, const Sched& S, const Epi& E, unsigned long long* stamps) {
    const int tid = threadIdx.x, wid = __builtin_amdgcn_readfirstlane(tid >> 6), lane = tid & 63, wr = wid >> 2, wc = wid & 3, fr = lane & 15, fq = lane >> 4;
    const int K = F8 ? (g.K >> 1) : g.K  , nt = g.kt ? g.kt : K / BK;
    int ts_lo = 0, ts_hi = 0, nts = 0; const unsigned long long rt_entry = STAMP ? (unsigned long long)wall_clock64() : 0ull;
#define PG8_STAMP() do { if (STAMP && wid == 0 && nts < 64) { const unsigned long long _c = (unsigned long long)clock64(); \
        ts_lo = (lane == nts) ? (int)(unsigned)_c : ts_lo; ts_hi = (lane == nts) ? (int)(unsigned)(_c >> 32) : ts_hi; ++nts; } } while (0)
    PG8_STAMP();
    unsigned voffA[2], voffB[2];
#pragma unroll
    for (int i = 0; i < 2; ++i) { int R, C; stage_rc(tid * 16 + i * 8192, R, C); const int Rb = Epi::PERM ? ((R & ~31) + perm32(R & 31)) : R;
        voffA[i] = (unsigned)(R * K + C) * 2u; voffB[i] = (unsigned)(Rb * K + C) * 2u; }
    const size_t kstep = (size_t)(BK * 2);
    const size_t hstep = (size_t)HALF * K * 2;
    const size_t tstep = 2 * hstep;
    const unsigned ldsw = (unsigned)wid * 1024u;
    const int aoff = lds_byte(wr * 64 + fr, fq * 8), boff = lds_byte(wc * 32 + fr, fq * 8);
#define PG8_SA(b, h) (((b) * 2 + (h)) * HTB)
#define PG8_SB(b, h) ((4 + (b) * 2 + (h)) * HTB)
#define PG8_STAGE(bufoff, gbase, voff) do { _Pragma("unroll") for (int _i = 0; _i < 2; ++_i) \
        __builtin_amdgcn_global_load_lds((const unsigned*)((const char*)(gbase) + (voff)[_i]), (PG8_LAS unsigned*)(lds + (bufoff) + ldsw + _i * 8192), 16, 0, 0); } while (0)
#define PG8_LDA(dst, b, h) do { _Pragma("unroll") for (int m = 0; m < 4; ++m) { const bf16x8 _l0 = *(const PG8_LAS bf16x8*)(lds + PG8_SA(b, h) + aoff + m * 2048), _l1 = *(const PG8_LAS bf16x8*)(lds + PG8_SA(b, h) + aoff + m * 2048 + 1024); \
        if constexpr (F8) dst[m].v = pg8_cat(_l0, _l1); else { dst[m].v[0] = _l0; dst[m].v[1] = _l1; } } } while (0)
#define PG8_LDB(dst, b, h) do { _Pragma("unroll") for (int n = 0; n < 2; ++n) { const bf16x8 _l0 = *(const PG8_LAS bf16x8*)(lds + PG8_SB(b, h) + boff + n * 2048), _l1 = *(const PG8_LAS bf16x8*)(lds + PG8_SB(b, h) + boff + n * 2048 + 1024); \
        if constexpr (F8) dst[n].v = pg8_cat(_l0, _l1); else { dst[n].v[0] = _l0; dst[n].v[1] = _l1; } } } while (0)
#define PG8_MMA(ai, bj, At, Bt) do { __builtin_amdgcn_s_setprio(1); _Pragma("unroll") for (int m = 0; m < 4; ++m) _Pragma("unroll") for (int n = 0; n < 2; ++n) { \
        if constexpr (F8) asm volatile("v_mfma_scale_f32_16x16x128_f8f6f4 %0, %1, %2, %0, %3, %3 op_sel_hi:[0,0,0]" : "+v"(acc[ai][bj][m][n]) : "v"(Bt[n].v), "v"(At[m].v), "v"(sc127)); \
        else { _Pragma("unroll") for (int k = 0; k < 2; ++k) acc[ai][bj][m][n] = __builtin_amdgcn_mfma_f32_16x16x32_bf16(Bt[n].v[k], At[m].v[k], acc[ai][bj][m][n], 0, 0, 0); } } __builtin_amdgcn_s_setprio(0); } while (0)
#define PG8_WAIT_V(n) asm volatile("s_waitcnt vmcnt(" #n ")" ::: "memory")
#define PG8_WAIT_L(n) asm volatile("s_waitcnt lgkmcnt(" #n ")" ::: "memory")
#define PG8_BAR __builtin_amdgcn_s_barrier()
#define PG8_SCHED __builtin_amdgcn_sched_barrier(0)
    Unit cur, nxt; int ui = 0;
    const int sc127 = 0x7f7f7f7f; (void)sc127;
    if (!S.next(0, cur)) return;
    f32x4 acc[2][2][4][2];
#pragma unroll
    for (int a = 0; a < 2; ++a)
#pragma unroll
        for (int b = 0; b < 2; ++b)
#pragma unroll
            for (int m = 0; m < 4; ++m)
#pragma unroll
                for (int n = 0; n < 2; ++n) acc[a][b][m][n] = (f32x4){0.f, 0.f, 0.f, 0.f};
    pg8_frag<F8> At[4], B0[2], B1[2];
    const char* cA = (const char*)g.A + (size_t)cur.pm * tstep; const char* cB = (const char*)g.Bt + (size_t)cur.pn * tstep;
    S.a_ready(cur);
    PG8_STAGE(PG8_SB(0, 0), cB, voffB); PG8_STAGE(PG8_SA(0, 0), cA, voffA); PG8_STAGE(PG8_SB(0, 1), cB + hstep, voffB); PG8_STAGE(PG8_SA(0, 1), cA + hstep, voffA);
    if (wr == 1) PG8_BAR;
    PG8_WAIT_V(4); PG8_BAR;
    PG8_STAGE(PG8_SB(1, 0), cB + kstep, voffB); PG8_STAGE(PG8_SA(1, 0), cA + kstep, voffA); PG8_STAGE(PG8_SB(1, 1), cB + hstep + kstep, voffB);
    PG8_WAIT_V(6); PG8_BAR;
    PG8_STAMP();
    for (;;) {
        const bool has_next = S.next(ui + 1, nxt);
        const char* nA = has_next ? (const char*)g.A + (size_t)nxt.pm * tstep : cA; const char* nB = has_next ? (const char*)g.Bt + (size_t)nxt.pn * tstep : cB;
        for (int t = 0; t < nt; t += 2) {
            const bool last = (t == nt - 2);
            const char* a1 = cA + (size_t)(t + 1) * kstep;
            const char* a2 = last ? nA : cA + (size_t)(t + 2) * kstep; const char* b2 = last ? nB : cB + (size_t)(t + 2) * kstep;
            const char* a3 = a2 + kstep; const char* b3 = b2 + kstep;
            if (last && has_next) S.a_ready(nxt);
            PG8_LDB(B0, 0, 0); PG8_SCHED; PG8_LDA(At, 0, 0); PG8_STAGE(PG8_SA(1, 1), a1 + hstep, voffA);
            PG8_WAIT_L(8); PG8_BAR; PG8_WAIT_L(0); PG8_MMA(0, 0, At, B0); PG8_BAR; PG8_SCHED;
            PG8_LDB(B1, 0, 1); PG8_STAGE(PG8_SB(0, 0), b2, voffB);
            PG8_BAR; PG8_WAIT_L(0); PG8_MMA(0, 1, At, B1); PG8_BAR;
            PG8_LDA(At, 0, 1); PG8_STAGE(PG8_SA(0, 0), a2, voffA);
            PG8_BAR; PG8_WAIT_L(0); PG8_MMA(1, 0, At, B0); PG8_BAR; PG8_SCHED;
            PG8_STAGE(PG8_SB(0, 1), b2 + hstep, voffB);
            PG8_WAIT_V(6); PG8_BAR; PG8_MMA(1, 1, At, B1); PG8_BAR;
            PG8_LDB(B0, 1, 0); PG8_SCHED; PG8_LDA(At, 1, 0); PG8_STAGE(PG8_SA(0, 1), a2 + hstep, voffA);
            PG8_WAIT_L(8); PG8_BAR; PG8_WAIT_L(0); PG8_MMA(0, 0, At, B0); PG8_BAR; PG8_SCHED;
            PG8_LDB(B1, 1, 1); PG8_STAGE(PG8_SB(1, 0), b3, voffB);
            PG8_BAR; PG8_WAIT_L(0); PG8_MMA(0, 1, At, B1); PG8_BAR;
            PG8_LDA(At, 1, 1); PG8_STAGE(PG8_SA(1, 0), a3, voffA);
            PG8_BAR; PG8_WAIT_L(0); PG8_MMA(1, 0, At, B0); PG8_BAR; PG8_SCHED;
            PG8_STAGE(PG8_SB(1, 1), b3 + hstep, voffB);
            PG8_WAIT_V(6); PG8_BAR; PG8_MMA(1, 1, At, B1); PG8_BAR;
        }
        PG8_STAMP();
        if constexpr (F8) {
            asm volatile("s_nop 15\n\ts_nop 15" ::: "memory");
#pragma unroll
            for (int a = 0; a < 2; ++a)
#pragma unroll
                for (int b = 0; b < 2; ++b)
#pragma unroll
                    for (int m = 0; m < 4; ++m) asm volatile("" : "+v"(acc[a][b][m][0]), "+v"(acc[a][b][m][1]));
        }
        if constexpr (!Epi::AFTER_DRAIN) { E(acc, cur, wr, wc, fr, fq); S.done(cur); }
        PG8_STAMP();
        if (!has_next) break;
#pragma unroll
        for (int a = 0; a < 2; ++a)
#pragma unroll
            for (int b = 0; b < 2; ++b)
#pragma unroll
                for (int m = 0; m < 4; ++m)
#pragma unroll
                    for (int n = 0; n < 2; ++n) acc[a][b][m][n] = (f32x4){0.f, 0.f, 0.f, 0.f};
        cur = nxt; cA = nA; cB = nB; ++ui;
    }
    PG8_WAIT_V(0);
    if (wr == 0) PG8_BAR;
    PG8_BAR;
    if constexpr (Epi::AFTER_DRAIN) { E.fused(acc, cur, wr, wc, fr, fq, lds, wid, lane); S.done(cur); }
    PG8_STAMP();
    if (STAMP && wid == 0) { stamps[lane] = lane < nts ? (((unsigned long long)(unsigned)ts_hi << 32) | (unsigned)ts_lo) : 0ull;
        if (lane == 62) stamps[62] = rt_entry; if (lane == 63) stamps[63] = (unsigned long long)wall_clock64(); }
#undef PG8_STAMP
#undef PG8_SA
#undef PG8_SB
#undef PG8_STAGE
#undef PG8_LDA
#undef PG8_LDB
#undef PG8_MMA
#undef PG8_WAIT_V
#undef PG8_WAIT_L
#undef PG8_BAR
#undef PG8_SCHED
}
}
#define XB_TMO      128
#define XB_XCNT(j)  (256  + 64 * (j))
#define XB_XSUB(j)  (1280 + 64 * (j))
#define XB_XGEN(j)  (2304 + 64 * (j))
#define XB_TOP      3328
#define XB_TOPGEN   3392
#define XCD_BAR_WORDS 3456
#define XB_SPIN_CAP (1u << 18)
#define LAS __attribute__((address_space(3)))

__device__ __forceinline__ unsigned xb_ld(unsigned* p)              { return __hip_atomic_load(p, __ATOMIC_RELAXED, __HIP_MEMORY_SCOPE_AGENT); }
__device__ __forceinline__ unsigned xb_add(unsigned* p, unsigned v) { return __hip_atomic_fetch_add(p, v, __ATOMIC_RELAXED, __HIP_MEMORY_SCOPE_AGENT); }
__device__ __forceinline__ unsigned xb_xcc_id() { return (unsigned)__builtin_amdgcn_s_getreg((3 << 11) | 20) & 0xFu; }
#define XB_SPIN(cond, bar) do { unsigned _sp = 0; while (cond) { __builtin_amdgcn_s_sleep(1); \
    if ((++_sp & 255u) == 0u) { if (xb_ld(&(bar)[XB_TMO])) break; if (_sp > XB_SPIN_CAP) { atomicAdd(&(bar)[XB_TMO], 1u); break; } } } } while (0)

struct XcdBarrier {
    unsigned* bar; unsigned x;
    volatile LAS unsigned* st;
};

__device__ __forceinline__ XcdBarrier xcd_barrier_post(unsigned* bar, volatile LAS unsigned* st) {
    XcdBarrier b; b.bar = bar; b.x = xb_xcc_id(); b.st = st;
    if (threadIdx.x == 0) (void)xb_add(&bar[XB_XCNT(b.x)], 1u);
    return b;
}
__device__ __forceinline__ void xcd_barrier_complete(unsigned* bar, unsigned x, unsigned& nloc, unsigned& nx) {
    const unsigned G = gridDim.x * gridDim.y * gridDim.z;
    unsigned sum, cnt, mine, sp = 0u;
    for (;;) {
        sum = 0u; cnt = 0u; mine = 0u;
#pragma unroll
        for (unsigned j = 0; j < 16; ++j) { const unsigned c = xb_ld(&bar[XB_XCNT(j)]); sum += c; cnt += (c > 0u) ? 1u : 0u; mine = (j == x) ? c : mine; }
        if (sum == G) break;
        __builtin_amdgcn_s_sleep(1);
        if ((++sp & 255u) == 0u) { if (xb_ld(&bar[XB_TMO])) break; if (sp > XB_SPIN_CAP) { atomicAdd(&bar[XB_TMO], 1u); break; } }
    }
    nloc = mine > 0u ? mine : 1u; nx = cnt > 0u ? cnt : 1u;
}

__device__ __forceinline__ void xcd_barrier(const XcdBarrier& b) {
    asm volatile("s_waitcnt vmcnt(0)" ::: "memory");
    __syncthreads();
    if (threadIdx.x == 0) {
        unsigned* bar = b.bar;
        __builtin_amdgcn_s_waitcnt(0);
        unsigned nloc = b.st[0], nx = b.st[1];
        if (nloc == 0u) { xcd_barrier_complete(bar, b.x, nloc, nx); b.st[0] = nloc; b.st[1] = nx; }
        const unsigned old = xb_add(&bar[XB_XSUB(b.x)], 1u);
        const unsigned gen = old / nloc;
        if (old + 1u == (gen + 1u) * nloc) {
            __builtin_amdgcn_fence(__ATOMIC_RELEASE, "agent");
            asm volatile("s_waitcnt vmcnt(0)" ::: "memory");
            const unsigned og = xb_add(&bar[XB_TOP], 1u);
            const unsigned tg = og / nx;
            if (og + 1u == (tg + 1u) * nx) xb_add(&bar[XB_TOPGEN], 1u);
            else XB_SPIN(xb_ld(&bar[XB_TOPGEN]) == tg, bar);
            __builtin_amdgcn_fence(__ATOMIC_ACQUIRE, "agent");
            xb_add(&bar[XB_XGEN(b.x)], 1u);
            asm volatile("s_waitcnt vmcnt(0)" ::: "memory");
        } else {
            XB_SPIN(xb_ld(&bar[XB_XGEN(b.x)]) == gen, bar);
            __builtin_amdgcn_fence(__ATOMIC_ACQUIRE, "agent");
            asm volatile("s_waitcnt vmcnt(0)" ::: "memory");
        }
    }
    __syncthreads();
}


#define LAS3 __attribute__((address_space(3)))
using pg8::bf16x8; using pg8::f32x4; using pg8::u32x4; using pg8::Unit;
constexpr int MK_THREADS = 512, MK_LDS_BYTES = 147456  , MK_LDS_BAR = MK_LDS_BYTES - 16;
constexpr int NPH = 16;

struct Params {
    const float* x; const float* gains; const float* a_w_in; const float* a_b_in; const float* a_norm_v; const float* a_w_s; const float* a_b_s; const float* a_w_out;
    const float* kv_norm; const float* w_kv; const float* w_q; const float* w_o; const float* ffn_w_gu; const float* ffn_w_down; const float* moe_router; const float* moe_w_gu; const float* moe_w_down;
    float* out; unsigned char* ws;
};

typedef __bf16 bf16x2_t __attribute__((ext_vector_type(2)));
__device__ __forceinline__ unsigned cvtpk(float lo, float hi) { const bf16x2_t v = {(__bf16)lo, (__bf16)hi}; return __builtin_bit_cast(unsigned, v); }
__device__ __forceinline__ float gelu_fast(float x) { const float t = x + 0.044715f * x * x * x; return x * __builtin_amdgcn_rcpf(1.0f + __builtin_amdgcn_exp2f(-2.3022081985f * t)); }
__device__ __forceinline__ float silu_fast(float x) { return x * __builtin_amdgcn_rcpf(1.0f + __builtin_amdgcn_exp2f(-1.4426950409f * x)); }

constexpr float F8_SA1 = 16.f, F8_SW1 = 1024.f, F8_SA2 = 8.f, F8_SW2 = 2048.f;
__device__ __forceinline__ unsigned pack4_fp8(float a, float b, float c, float d) {
    a = __builtin_amdgcn_fmed3f(a, -448.f, 448.f); b = __builtin_amdgcn_fmed3f(b, -448.f, 448.f); c = __builtin_amdgcn_fmed3f(c, -448.f, 448.f); d = __builtin_amdgcn_fmed3f(d, -448.f, 448.f);
    int w = __builtin_amdgcn_cvt_pk_fp8_f32(a, b, 0, false); w = __builtin_amdgcn_cvt_pk_fp8_f32(c, d, w, true); return (unsigned)w; }
struct CTile { const float* src; bf16_t* dst; int N, K; int f8; float scale; };
constexpr int CT0 = 16 * 128, CT1 = CT0 + 32 * 32, CT2 = CT1 + 16 * 224, CT3 = CT2 + 56 * 32, CT4 = CT3 + 16 * 64, CT5 = CT4 + 16 * 96, CT6 = CT5 + 16 * 32, CT7 = CT6 + 8 * 16 * 224, CT8 = CT7 + 8 * 56 * 32;
__device__ __forceinline__ CTile conv_decode(const Params& p, int t) {
    const float* S; bf16_t* D; int K, N, inter = 0, tt, f8 = 0; float scale = 1.f;
    unsigned char* ws = p.ws;
    if (t < CT0)      { S = p.a_w_in;     D = (bf16_t*)(ws + OFF_WIN_T);  K = DM;  N = 2 * GH;  tt = t; }
    else if (t < CT1) { S = p.a_w_out;    D = (bf16_t*)(ws + OFF_WOUT_T); K = GH;  N = DM;      tt = t - CT0; }
    else if (t < CT2) { S = p.ffn_w_gu;   D = (bf16_t*)(ws + OFF_WGU_T);  K = DM;  N = 2 * DFF; tt = t - CT1; inter = 1; }
    else if (t < CT3) { S = p.ffn_w_down; D = (bf16_t*)(ws + OFF_WDN_T);  K = DFF; N = DM;      tt = t - CT2; }
    else if (t < CT4) { S = p.w_kv;       D = (bf16_t*)(ws + OFF_WKV_T);  K = DM;  N = NKV;     tt = t - CT3; }
    else if (t < CT5) { S = p.w_q;        D = (bf16_t*)(ws + OFF_WQ_T);   K = DM;  N = NQ;      tt = t - CT4; }
    else if (t < CT6) { S = p.w_o;        D = (bf16_t*)(ws + OFF_WO_T);   K = DM;  N = DM;      tt = t - CT5; }
    else if (t < CT7) { S = p.moe_w_gu;   D = (bf16_t*)(ws + OFF_MGU_T);  K = DM;  N = 2 * DFF; tt = t - CT6; inter = 1; f8 = 1; scale = F8_SW1; }
    else              { S = p.moe_w_down; D = (bf16_t*)(ws + OFF_MDN_T);  K = DFF; N = DM;      tt = t - CT7; f8 = 1; scale = F8_SW2; }
    const int KT = K >> 7, NT = N >> 6, per = KT * NT, b = tt / per, r = tt - b * per, kt = r / NT, nt = r - kt * NT, n0 = nt * 64;
    int drow = n0;
    if (inter) drow = n0 < DFF ? ((n0 >> 7) * 256 + (n0 & 127)) : (((n0 - DFF) >> 7) * 256 + 128 + ((n0 - DFF) & 127));
    CTile c; c.src = S + (size_t)b * K * N + (size_t)(kt * 128) * N + n0; c.N = N; c.K = K; c.f8 = f8; c.scale = scale;
    if (f8) c.dst = (bf16_t*)((unsigned char*)D + (size_t)b * N * K + (size_t)drow * K + kt * 128); else c.dst = D + (size_t)b * N * K + (size_t)drow * K + kt * 128;
    return c;
}
__device__ __forceinline__ void conv_to_lds(const CTile& c, const float4 (&r)[4], LAS3 unsigned* W, int n4, int kr) {
    if (c.f8) { const float sc = c.scale; LAS3 unsigned* w = W + (n4 * 4) * 33 + kr;
        w[0] = pack4_fp8(r[0].x * sc, r[1].x * sc, r[2].x * sc, r[3].x * sc); w[33] = pack4_fp8(r[0].y * sc, r[1].y * sc, r[2].y * sc, r[3].y * sc);
        w[66] = pack4_fp8(r[0].z * sc, r[1].z * sc, r[2].z * sc, r[3].z * sc); w[99] = pack4_fp8(r[0].w * sc, r[1].w * sc, r[2].w * sc, r[3].w * sc); }
    else {
#pragma unroll
        for (int i = 0; i < 2; ++i) { LAS3 unsigned* w = W + (n4 * 4) * 65 + kr + 32 * i;
            w[0] = cvtpk(r[2 * i].x, r[2 * i + 1].x); w[65] = cvtpk(r[2 * i].y, r[2 * i + 1].y); w[130] = cvtpk(r[2 * i].z, r[2 * i + 1].z); w[195] = cvtpk(r[2 * i].w, r[2 * i + 1].w); } }
}
__device__ __forceinline__ void conv_from_lds(const CTile& c, const LAS3 unsigned* W, int tid) {
    if (c.f8) { const int n = tid >> 3, kc = tid & 7; const LAS3 unsigned* q = W + n * 33 + kc * 4;
        uint4 w; w.x = q[0]; w.y = q[1]; w.z = q[2]; w.w = q[3]; __builtin_nontemporal_store((u32x4){w.x, w.y, w.z, w.w}, (u32x4*)((unsigned char*)c.dst + (size_t)n * c.K + kc * 16)); }
    else {
#pragma unroll
        for (int i = 0; i < 2; ++i) { const int it = tid + 512 * i, kc = it & 15, n = it >> 4; const LAS3 unsigned* q = W + n * 65 + kc * 4;
            uint4 w; w.x = q[0]; w.y = q[1]; w.z = q[2]; w.w = q[3]; __builtin_nontemporal_store((u32x4){w.x, w.y, w.z, w.w}, (u32x4*)(c.dst + (size_t)n * c.K + kc * 8)); } }
}
constexpr int CV_NT = 4;
__device__ __forceinline__ void phase_convert(const Params& p, LAS3 unsigned char* lds, int t0, int t1) {
    LAS3 unsigned* LT = (LAS3 unsigned*)lds;
    const int tid = threadIdx.x, n4 = tid & 15, kr = tid >> 4, G = (int)gridDim.x;
    int t = t0 + (int)blockIdx.x;
#define CONV_LOAD(T, R) do { _Pragma("unroll") for (int j = 0; j < 4; ++j) { const int row = (T).f8 ? 4 * kr + j : 2 * (kr + 32 * (j >> 1)) + (j & 1); { const f32x4 _v = __builtin_nontemporal_load((const f32x4*)((T).src + (size_t)row * (T).N + n4 * 4)); R[j] = make_float4(_v[0], _v[1], _v[2], _v[3]); } } } while (0)
    if (t < t1) {
        CTile c[CV_NT]; bool h[CV_NT]; float4 r[CV_NT][4];
#pragma unroll
        for (int q = 0; q < CV_NT; ++q) { h[q] = t + q * G < t1; c[q] = conv_decode(p, h[q] ? t + q * G : t); if (h[q]) CONV_LOAD(c[q], r[q]); }
        int buf = 0;
        for (;;) {
            LAS3 unsigned* W = LT + buf * (CV_NT * 4160);
#pragma unroll
            for (int q = 0; q < CV_NT; ++q) if (h[q]) conv_to_lds(c[q], r[q], W + q * 4160, n4, kr);
            const int tn = t + CV_NT * G; const bool has = tn < t1;
            CTile cn[CV_NT]; bool hn[CV_NT];
#pragma unroll
            for (int q = 0; q < CV_NT; ++q) { hn[q] = tn + q * G < t1; cn[q] = c[q]; if (hn[q]) { cn[q] = conv_decode(p, tn + q * G); CONV_LOAD(cn[q], r[q]); } }
            __syncthreads();
#pragma unroll
            for (int q = 0; q < CV_NT; ++q) if (h[q]) conv_from_lds(c[q], W + q * 4160, tid);
            if (!has) break;
#pragma unroll
            for (int q = 0; q < CV_NT; ++q) { c[q] = cn[q]; h[q] = hn[q]; }
            t = tn; buf ^= 1;
        }
    }
#undef CONV_LOAD
    __syncthreads();
}

__device__ __forceinline__ void row_norm0(const Params& p, int row, int lane) {
    const float* gain = p.gains; bf16_t* xn = (bf16_t*)(p.ws + OFF_XN);
    const float4* xr = (const float4*)(p.x + (size_t)row * DM); float4 v[8]; float ss = 0.f;
#pragma unroll
    for (int i = 0; i < 8; ++i) { v[i] = xr[lane + 64 * i]; ss += v[i].x * v[i].x + v[i].y * v[i].y + v[i].z * v[i].z + v[i].w * v[i].w; }
    ss = wave_sum(ss); const float rstd = rsqrtf(ss * (1.0f / DM) + EPS);
#pragma unroll
    for (int i = 0; i < 8; ++i) { const float4 gg = ((const float4*)gain)[lane + 64 * i];
        uint2 w; w.x = cvtpk(v[i].x * rstd * gg.x, v[i].y * rstd * gg.y); w.y = cvtpk(v[i].z * rstd * gg.z, v[i].w * rstd * gg.w);
        *(uint2*)(xn + (size_t)row * DM + (lane + 64 * i) * 4) = w; }
}

struct EpiGeluU {
    static constexpr bool PERM = true, AFTER_DRAIN = false;
    bf16_t* O; int ldc; const float* bias;
    __device__ __forceinline__ void operator()(const f32x4 (&acc)[2][2][4][2], const Unit& u, int wr, int wc, int fr, int fq) const {
        asm volatile("" : "+v"(fr), "+v"(fq));
        const int row0 = u.pm * 256 + wr * 64 + fr, col0 = u.pn * 256 + wc * 32 + 8 * fq;
        f32x4 bv[2][2];
#pragma unroll
        for (int bj = 0; bj < 2; ++bj)
#pragma unroll
            for (int n = 0; n < 2; ++n) bv[bj][n] = *(const f32x4*)(bias + col0 + bj * 128 + 4 * n);
#pragma unroll
        for (int ai = 0; ai < 2; ++ai)
#pragma unroll
            for (int m = 0; m < 4; ++m) { bf16_t* rowp = O + (size_t)(row0 + ai * 128 + m * 16) * ldc + col0;
#pragma unroll
                for (int bj = 0; bj < 2; ++bj) { const f32x4 v0 = acc[ai][bj][m][0] + bv[bj][0], v1 = acc[ai][bj][m][1] + bv[bj][1];
                    u32x4 w; w.x = cvtpk(gelu_fast(v0[0]), gelu_fast(v0[1])); w.y = cvtpk(gelu_fast(v0[2]), gelu_fast(v0[3])); w.z = cvtpk(gelu_fast(v1[0]), gelu_fast(v1[1])); w.w = cvtpk(gelu_fast(v1[2]), gelu_fast(v1[3]));
                    *(u32x4*)(rowp + bj * 128) = w; } }
    }
};
struct EpiGeluVT {
    static constexpr bool PERM = true, AFTER_DRAIN = false;
    bf16_t* O; const float* bias; float* ssp;
    __device__ __forceinline__ void operator()(const f32x4 (&acc)[2][2][4][2], const Unit& u, int wr, int wc, int fr, int fq) const {
        asm volatile("" : "+v"(fr), "+v"(fq));
        const int row0 = u.pm * 256 + wr * 64 + fr, col0 = u.pn * 256 + wc * 32 + 8 * fq;
        f32x4 cs[2][2];
#pragma unroll
        for (int bj = 0; bj < 2; ++bj)
#pragma unroll
            for (int n = 0; n < 2; ++n) cs[bj][n] = (f32x4){0.f, 0.f, 0.f, 0.f};
#pragma unroll
        for (int ai = 0; ai < 2; ++ai)
#pragma unroll
            for (int m = 0; m < 4; ++m) { const int row = row0 + ai * 128 + m * 16; const float b = bias[row]; bf16_t* rowp = O + (size_t)row * NTOK + col0;
#pragma unroll
                for (int bj = 0; bj < 2; ++bj) { f32x4 v0 = acc[ai][bj][m][0] + b, v1 = acc[ai][bj][m][1] + b;
#pragma unroll
                    for (int j = 0; j < 4; ++j) { v0[j] = gelu_fast(v0[j]); v1[j] = gelu_fast(v1[j]); }
                    cs[bj][0] += v0 * v0; cs[bj][1] += v1 * v1;
                    u32x4 w; w.x = cvtpk(v0[0], v0[1]); w.y = cvtpk(v0[2], v0[3]); w.z = cvtpk(v1[0], v1[1]); w.w = cvtpk(v1[2], v1[3]);
                    *(u32x4*)(rowp + bj * 128) = w; } }
        const int slot = u.pm * 2 + wr;
#pragma unroll
        for (int bj = 0; bj < 2; ++bj)
#pragma unroll
            for (int n = 0; n < 2; ++n)
#pragma unroll
                for (int j = 0; j < 4; ++j) { float s = cs[bj][n][j]; s += __shfl_xor(s, 1); s += __shfl_xor(s, 2); s += __shfl_xor(s, 4); s += __shfl_xor(s, 8);
                    if (fr == 0) ssp[(size_t)(col0 + bj * 128 + 4 * n + j) * SSP_N + slot] = s; }
    }
};
struct EpiF32SS {
    static constexpr bool PERM = false, AFTER_DRAIN = false;
    float* C; int ldc; float* ssp; int pnmod; float scale;
    __device__ __forceinline__ void operator()(const f32x4 (&acc)[2][2][4][2], const Unit& u, int wr, int wc, int fr, int fq) const {
        asm volatile("" : "+v"(fr), "+v"(fq));
        const int pnl = u.pn % pnmod; const int row0 = u.pm * 256 + wr * 64 + fr, col0 = pnl * 256 + wc * 32 + 4 * fq;
#pragma unroll
        for (int ai = 0; ai < 2; ++ai)
#pragma unroll
            for (int m = 0; m < 4; ++m) { const int row = row0 + ai * 128 + m * 16; float* rowp = C + (size_t)row * ldc + col0; float s = 0.f;
#pragma unroll
                for (int bj = 0; bj < 2; ++bj)
#pragma unroll
                    for (int n = 0; n < 2; ++n) { const f32x4 v = acc[ai][bj][m][n] * scale; *(f32x4*)(rowp + bj * 128 + n * 16) = v; s += (v[0] * v[0] + v[1] * v[1]) + (v[2] * v[2] + v[3] * v[3]); }
                if (ssp) { s += __shfl_xor(s, 16); s += __shfl_xor(s, 32); if (fq == 0) ssp[(size_t)row * SSP_N + pnl * 4 + wc] = s; } }
    }
};
struct EpiSwiglu {
    static constexpr bool PERM = true, AFTER_DRAIN = false;
    bf16_t* O; int ldc; int pnmod;
    __device__ __forceinline__ void operator()(const f32x4 (&acc)[2][2][4][2], const Unit& u, int wr, int wc, int fr, int fq) const {
        asm volatile("" : "+v"(fr), "+v"(fq));
        const int pnl = u.pn % pnmod; const int row0 = u.pm * 256 + wr * 64 + fr, col0 = pnl * 128 + wc * 32 + 8 * fq;
#pragma unroll
        for (int ai = 0; ai < 2; ++ai)
#pragma unroll
            for (int m = 0; m < 4; ++m) { bf16_t* rowp = O + (size_t)(row0 + ai * 128 + m * 16) * ldc + col0;
                const f32x4 g0 = acc[ai][0][m][0], g1 = acc[ai][0][m][1], u0 = acc[ai][1][m][0], u1 = acc[ai][1][m][1];
                u32x4 w; w.x = cvtpk(silu_fast(g0[0]) * u0[0], silu_fast(g0[1]) * u0[1]); w.y = cvtpk(silu_fast(g0[2]) * u0[2], silu_fast(g0[3]) * u0[3]);
                w.z = cvtpk(silu_fast(g1[0]) * u1[0], silu_fast(g1[1]) * u1[1]); w.w = cvtpk(silu_fast(g1[2]) * u1[2], silu_fast(g1[3]) * u1[3]);
                *(u32x4*)rowp = w; }
    }
};
struct EpiBf16P {
    static constexpr bool PERM = true, AFTER_DRAIN = false;
    bf16_t* O; int ldc;
    __device__ __forceinline__ void operator()(const f32x4 (&acc)[2][2][4][2], const Unit& u, int wr, int wc, int fr, int fq) const {
        asm volatile("" : "+v"(fr), "+v"(fq));
        const int row0 = u.pm * 256 + wr * 64 + fr, col0 = u.pn * 256 + wc * 32 + 8 * fq;
#pragma unroll
        for (int ai = 0; ai < 2; ++ai)
#pragma unroll
            for (int m = 0; m < 4; ++m) { bf16_t* rowp = O + (size_t)(row0 + ai * 128 + m * 16) * ldc + col0;
#pragma unroll
                for (int bj = 0; bj < 2; ++bj) { const f32x4 v0 = acc[ai][bj][m][0], v1 = acc[ai][bj][m][1];
                    u32x4 w; w.x = cvtpk(v0[0], v0[1]); w.y = cvtpk(v0[2], v0[3]); w.z = cvtpk(v1[0], v1[1]); w.w = cvtpk(v1[2], v1[3]);
                    *(u32x4*)(rowp + bj * 128) = w; } }
    }
};

struct EpiSwiglu8 {
    static constexpr bool PERM = true, AFTER_DRAIN = false;
    unsigned char* O; int ldc; int pnmod; float inv, oscale;
    __device__ __forceinline__ void operator()(const f32x4 (&acc)[2][2][4][2], const Unit& u, int wr, int wc, int fr, int fq) const {
        asm volatile("" : "+v"(fr), "+v"(fq));
        const int pnl = u.pn % pnmod; const int row0 = u.pm * 256 + wr * 64 + fr, col0 = pnl * 128 + wc * 32 + 8 * fq;
#pragma unroll
        for (int ai = 0; ai < 2; ++ai)
#pragma unroll
            for (int m = 0; m < 4; ++m) { unsigned char* rowp = O + (size_t)(row0 + ai * 128 + m * 16) * ldc + col0;
                const f32x4 g0 = acc[ai][0][m][0] * inv, g1 = acc[ai][0][m][1] * inv, u0 = acc[ai][1][m][0] * (inv * oscale), u1 = acc[ai][1][m][1] * (inv * oscale);
                uint2 w; w.x = pack4_fp8(silu_fast(g0[0]) * u0[0], silu_fast(g0[1]) * u0[1], silu_fast(g0[2]) * u0[2], silu_fast(g0[3]) * u0[3]);
                w.y = pack4_fp8(silu_fast(g1[0]) * u1[0], silu_fast(g1[1]) * u1[1], silu_fast(g1[2]) * u1[2], silu_fast(g1[3]) * u1[3]);
                *(uint2*)rowp = w; }
    }
};

struct EpiBf16S {
    static constexpr bool PERM = true, AFTER_DRAIN = false;
    bf16_t* O; int ldc; int pnmod; float scale;
    __device__ __forceinline__ void operator()(const f32x4 (&acc)[2][2][4][2], const Unit& u, int wr, int wc, int fr, int fq) const {
        asm volatile("" : "+v"(fr), "+v"(fq));
        const int pnl = u.pn % pnmod; const int row0 = u.pm * 256 + wr * 64 + fr, col0 = pnl * 256 + wc * 32 + 8 * fq;
#pragma unroll
        for (int ai = 0; ai < 2; ++ai)
#pragma unroll
            for (int m = 0; m < 4; ++m) { bf16_t* rowp = O + (size_t)(row0 + ai * 128 + m * 16) * ldc + col0;
#pragma unroll
                for (int bj = 0; bj < 2; ++bj) { const f32x4 v0 = acc[ai][bj][m][0] * scale, v1 = acc[ai][bj][m][1] * scale;
                    u32x4 w; w.x = cvtpk(v0[0], v0[1]); w.y = cvtpk(v0[2], v0[3]); w.z = cvtpk(v1[0], v1[1]); w.w = cvtpk(v1[2], v1[3]);
                    *(u32x4*)(rowp + bj * 128) = w; } }
    }
};

struct EpiBf16H {
    static constexpr bool PERM = true, AFTER_DRAIN = false;
    bf16_t* O; int nrows;
    __device__ __forceinline__ void operator()(const f32x4 (&acc)[2][2][4][2], const Unit& u, int wr, int wc, int fr, int fq) const {
        asm volatile("" : "+v"(fr), "+v"(fq));
        const int row0 = u.pm * 256 + wr * 64 + fr, cin = wc * 32 + 8 * fq;
#pragma unroll
        for (int bj = 0; bj < 2; ++bj) { bf16_t* hp = O + (size_t)(u.pn * 2 + bj) * nrows * 128 + cin;
#pragma unroll
            for (int ai = 0; ai < 2; ++ai)
#pragma unroll
                for (int m = 0; m < 4; ++m) { const f32x4 v0 = acc[ai][bj][m][0], v1 = acc[ai][bj][m][1];
                    u32x4 w; w.x = cvtpk(v0[0], v0[1]); w.y = cvtpk(v0[2], v0[3]); w.z = cvtpk(v1[0], v1[1]); w.w = cvtpk(v1[2], v1[3]);
                    *(u32x4*)(hp + (size_t)(row0 + ai * 128 + m * 16) * 128) = w; } }
    }
};

struct EpiBf16SS {
    static constexpr bool PERM = true, AFTER_DRAIN = false;
    bf16_t* C; int ldc; float* ssp;
    __device__ __forceinline__ void operator()(const f32x4 (&acc)[2][2][4][2], const Unit& u, int wr, int wc, int fr, int fq) const {
        asm volatile("" : "+v"(fr), "+v"(fq));
        const int row0 = u.pm * 256 + wr * 64 + fr, col0 = u.pn * 256 + wc * 32 + 8 * fq;
#pragma unroll
        for (int ai = 0; ai < 2; ++ai)
#pragma unroll
            for (int m = 0; m < 4; ++m) { const int row = row0 + ai * 128 + m * 16; bf16_t* rowp = C + (size_t)row * ldc + col0; float s = 0.f;
#pragma unroll
                for (int bj = 0; bj < 2; ++bj) { const f32x4 v0 = acc[ai][bj][m][0], v1 = acc[ai][bj][m][1];
                    s += (v0[0] * v0[0] + v0[1] * v0[1]) + (v0[2] * v0[2] + v0[3] * v0[3]); s += (v1[0] * v1[0] + v1[1] * v1[1]) + (v1[2] * v1[2] + v1[3] * v1[3]);
                    u32x4 w; w.x = cvtpk(v0[0], v0[1]); w.y = cvtpk(v0[2], v0[3]); w.z = cvtpk(v1[0], v1[1]); w.w = cvtpk(v1[2], v1[3]);
                    *(u32x4*)(rowp + bj * 128) = w; }
                s += __shfl_xor(s, 16); s += __shfl_xor(s, 32); if (fq == 0) ssp[(size_t)row * SSP_N + u.pn * 4 + wc] = s; }
    }
};

__device__ __forceinline__ int ld_i(const int* p) { return __hip_atomic_load(p, __ATOMIC_RELAXED, __HIP_MEMORY_SCOPE_AGENT); }
__device__ __forceinline__ float ssp_sum32(const float* ssp, int row) {
    const f32x4* q = (const f32x4*)(ssp + (size_t)row * SSP_N); float t = 0.f;
#pragma unroll
    for (int i = 0; i < 8; ++i) { const f32x4 v = q[i]; t += v[0]; t += v[1]; t += v[2]; t += v[3]; }
    return t;
}

template <bool BF> __device__ __forceinline__ float4 ld4(const void* base, size_t idx4) {
    if constexpr (BF) { const uint2 w = ((const uint2*)base)[idx4]; return make_float4(bf2f(w.x & 0xffffu), bf2f(w.x >> 16), bf2f(w.y & 0xffffu), bf2f(w.y >> 16)); }
    else return ((const float4*)base)[idx4];
}
__device__ __forceinline__ void st4bf(bf16_t* base, size_t idx4, float4 v) { uint2 w; w.x = cvtpk(v.x, v.y); w.y = cvtpk(v.z, v.w); ((uint2*)base)[idx4] = w; }
struct RowIn { float4 b[8]; uint2 m[8]; };
template <bool BFBASE> __device__ __forceinline__ void row_load(RowIn& r, const void* base, const bf16_t* mix, int row, int lane) {
#pragma unroll
    for (int i = 0; i < 8; ++i) { const size_t o = (size_t)row * (DM / 4) + lane + 64 * i; r.b[i] = ld4<BFBASE>(base, o); r.m[i] = ((const uint2*)mix)[o]; }
}
__device__ __forceinline__ void row_resnorm_c(const RowIn& r, const float* ssp, const float* g_post, bf16_t* hout, const float* g1, bf16_t* xn1, const float* g2, bf16_t* xn2, int row, int lane) {
    const float rm = rsqrtf(ssp_sum32(ssp, row) * (1.0f / DM) + EPS);
    float4 h[8]; float ss = 0.f;
#pragma unroll
    for (int i = 0; i < 8; ++i) { const size_t o = (size_t)row * (DM / 4) + lane + 64 * i; const float4 b = r.b[i], gp = ((const float4*)g_post)[lane + 64 * i];
        const float4 m = make_float4(bf2f(r.m[i].x & 0xffffu), bf2f(r.m[i].x >> 16), bf2f(r.m[i].y & 0xffffu), bf2f(r.m[i].y >> 16));
        h[i].x = b.x + m.x * rm * gp.x; h[i].y = b.y + m.y * rm * gp.y; h[i].z = b.z + m.z * rm * gp.z; h[i].w = b.w + m.w * rm * gp.w;
        st4bf(hout, o, h[i]); ss += h[i].x * h[i].x + h[i].y * h[i].y + h[i].z * h[i].z + h[i].w * h[i].w; }
    ss = wave_sum(ss); const float rstd = rsqrtf(ss * (1.0f / DM) + EPS);
#pragma unroll
    for (int i = 0; i < 8; ++i) { const float4 gg = ((const float4*)g1)[lane + 64 * i];
        uint2 w; w.x = cvtpk(h[i].x * rstd * gg.x, h[i].y * rstd * gg.y); w.y = cvtpk(h[i].z * rstd * gg.z, h[i].w * rstd * gg.w);
        *(uint2*)(xn1 + (size_t)row * DM + (lane + 64 * i) * 4) = w;
        if (xn2) { const float4 g2v = ((const float4*)g2)[lane + 64 * i];
            uint2 w2; w2.x = cvtpk(h[i].x * rstd * g2v.x, h[i].y * rstd * g2v.y); w2.y = cvtpk(h[i].z * rstd * g2v.z, h[i].w * rstd * g2v.w);
            *(uint2*)(xn2 + (size_t)row * DM + (lane + 64 * i) * 4) = w2; } }
}
template <bool BFBASE> __device__ __forceinline__ void phase_resnorm(const void* base, const bf16_t* mix, const float* ssp, const float* g_post, bf16_t* hout, const float* g1, bf16_t* xn1, const float* g2, bf16_t* xn2, int wave, int lane, int G) {
    int row = blockIdx.x * 8 + wave; if (row >= NTOK) return;
    RowIn cur, nxt; row_load<BFBASE>(cur, base, mix, row, lane);
    for (;;) { const int nrow = row + G * 8; const bool has = nrow < NTOK;
        if (has) row_load<BFBASE>(nxt, base, mix, nrow, lane);
        row_resnorm_c(cur, ssp, g_post, hout, g1, xn1, g2, xn2, row, lane);
        if (!has) break; cur = nxt; row = nrow; }
}
__device__ __forceinline__ void row_router(const bf16_t* base, const bf16_t* mix, const float* ssp, const float* g_post, bf16_t* hout, const float* g_pre, const LAS3 float* wT  , unsigned char* xs8,
                                           int* counts, int* tok_s, float* tok_g, int row, int lane) {
    const float rm = rsqrtf(ssp_sum32(ssp, row) * (1.0f / DM) + EPS);
    float4 h[8]; float ss = 0.f;
#pragma unroll
    for (int i = 0; i < 8; ++i) { const size_t o = (size_t)row * (DM / 4) + lane + 64 * i; const float4 b = ld4<true>(base, o), m = ld4<true>(mix, o), gp = ((const float4*)g_post)[lane + 64 * i];
        h[i].x = b.x + m.x * rm * gp.x; h[i].y = b.y + m.y * rm * gp.y; h[i].z = b.z + m.z * rm * gp.z; h[i].w = b.w + m.w * rm * gp.w;
        st4bf(hout, o, h[i]); ss += h[i].x * h[i].x + h[i].y * h[i].y + h[i].z * h[i].z + h[i].w * h[i].w;
        if (i & 1) asm volatile("" ::: "memory"); }
    ss = wave_sum(ss); const float rstd = rsqrtf(ss * (1.0f / DM) + EPS);
    float lg[8]; unsigned q8[8];
#pragma unroll
    for (int e = 0; e < 8; ++e) lg[e] = 0.f;
#pragma unroll
    for (int i = 0; i < 8; ++i) { const float4 gg = ((const float4*)g_pre)[lane + 64 * i];
        const float n0 = h[i].x * rstd * gg.x, n1 = h[i].y * rstd * gg.y, n2 = h[i].z * rstd * gg.z, n3 = h[i].w * rstd * gg.w;
        q8[i] = pack4_fp8(n0 * F8_SA1, n1 * F8_SA1, n2 * F8_SA1, n3 * F8_SA1); asm volatile("" : "+v"(q8[i]));
        const int k = (lane + 64 * i) * 4;
#pragma unroll
        for (int e = 0; e < 8; ++e) { const f32x4 w = *(const LAS3 f32x4*)(wT + e * DM + k); lg[e] = fmaf(n0, w[0], lg[e]); lg[e] = fmaf(n1, w[1], lg[e]); lg[e] = fmaf(n2, w[2], lg[e]); lg[e] = fmaf(n3, w[3], lg[e]); }
        asm volatile("" ::: "memory"); }
#pragma unroll
    for (int e = 0; e < 8; ++e) lg[e] = wave_sum(lg[e]);
    int s1 = 0, s2 = 0;
    if (lane == 0) {
        int e1 = 0; float v1 = lg[0];
#pragma unroll
        for (int e = 1; e < 8; ++e) if (lg[e] > v1) { v1 = lg[e]; e1 = e; }
        int e2 = 0; float v2 = -3.0e38f;
#pragma unroll
        for (int e = 0; e < 8; ++e) if (e != e1 && lg[e] > v2) { v2 = lg[e]; e2 = e; }
        const float p2 = __expf(v2 - v1), inv = 1.0f / (1.0f + p2);
        s1 = e1 * ECAP + atomicAdd(&counts[e1], 1); s2 = e2 * ECAP + atomicAdd(&counts[e2], 1);
        tok_s[row * 2] = s1; tok_s[row * 2 + 1] = s2; tok_g[row * 2] = inv; tok_g[row * 2 + 1] = p2 * inv;
    }
    s1 = __builtin_amdgcn_readfirstlane(s1); s2 = __builtin_amdgcn_readfirstlane(s2);
    unsigned* d1 = (unsigned*)(xs8 + (size_t)s1 * DM); unsigned* d2 = (unsigned*)(xs8 + (size_t)s2 * DM);
#pragma unroll
    for (int i = 0; i < 8; ++i) { d1[lane + 64 * i] = q8[i]; d2[lane + 64 * i] = q8[i]; }
}
constexpr int KSPLIT = 4, C_TFLAG = 8192;
__device__ __forceinline__ void row_final(const bf16_t* h3, const bf16_t* Y, const float* Yp, const int* tflag, const int* tok_s, const float* tok_g, const float* gain, float* out, int row, int lane) {
    const int s1 = tok_s[row * 2], s2 = tok_s[row * 2 + 1]; const float g1 = tok_g[row * 2], g2 = tok_g[row * 2 + 1];
    float4 f[8]; float ss = 0.f;
#pragma unroll
    for (int i = 0; i < 8; ++i) {
        float4 a, b;
        { const int fl = tflag[(s1 >> 8) * 8 + i];
          if (fl == 0) { const uint2 w = ((const uint2*)(Y + (size_t)s1 * DM))[lane + 64 * i]; a = make_float4(bf2f(w.x & 0xffffu), bf2f(w.x >> 16), bf2f(w.y & 0xffffu), bf2f(w.y >> 16)); }
          else { const float4* q = (const float4*)(Yp + ((size_t)(fl - 1) * KSPLIT) * 65536 + (size_t)(s1 & 255) * 256) + lane; a = q[0];
#pragma unroll
              for (int k = 1; k < KSPLIT; ++k) { const float4 t = q[(size_t)k * 16384]; a.x += t.x; a.y += t.y; a.z += t.z; a.w += t.w; } } }
        { const int fl = tflag[(s2 >> 8) * 8 + i];
          if (fl == 0) { const uint2 w = ((const uint2*)(Y + (size_t)s2 * DM))[lane + 64 * i]; b = make_float4(bf2f(w.x & 0xffffu), bf2f(w.x >> 16), bf2f(w.y & 0xffffu), bf2f(w.y >> 16)); }
          else { const float4* q = (const float4*)(Yp + ((size_t)(fl - 1) * KSPLIT) * 65536 + (size_t)(s2 & 255) * 256) + lane; b = q[0];
#pragma unroll
              for (int k = 1; k < KSPLIT; ++k) { const float4 t = q[(size_t)k * 16384]; b.x += t.x; b.y += t.y; b.z += t.z; b.w += t.w; } } }
        f[i].x = a.x * g1 + b.x * g2; f[i].y = a.y * g1 + b.y * g2; f[i].z = a.z * g1 + b.z * g2; f[i].w = a.w * g1 + b.w * g2;
        ss += f[i].x * f[i].x + f[i].y * f[i].y + f[i].z * f[i].z + f[i].w * f[i].w; }
    ss = wave_sum(ss); const float rstd = rsqrtf(ss * (1.0f / DM) + EPS);
#pragma unroll
    for (int i = 0; i < 8; ++i) { const size_t o = (size_t)row * (DM / 4) + lane + 64 * i; const float4 b = ld4<true>(h3, o), gg = ((const float4*)gain)[lane + 64 * i]; float4 r;
        r.x = b.x + f[i].x * rstd * gg.x; r.y = b.y + f[i].y * rstd * gg.y; r.z = b.z + f[i].z * rstd * gg.z; r.w = b.w + f[i].w * rstd * gg.w; ((float4*)out)[o] = r; }
}
constexpr int MOE_TBL_OFF = 131072;
struct MoeOrder : pg8::StaticOrder {
    const LAS3 int* tbl; int NT; int lim;
    __device__ __forceinline__ bool next(int i, Unit& u) const { if ((long)i * G + c >= lim) return false; if (!pg8::StaticOrder::next(i, u)) return false;
        const int v = tbl[u.pm]; u.pm = v & 0xffff; u.pn += (v >> 16) * NT; return true; }
};
__device__ __forceinline__ int moe_table(const int* counts, LAS3 unsigned char* lds) {
    LAS3 int* tbl = (LAS3 int*)(lds + MOE_TBL_OFF); const int t = threadIdx.x; int q = 0, mine = -1;
#pragma unroll
    for (int e = 0; e < NEXP; ++e) { const int nb = (ld_i(counts + e) + 255) >> 8; if (t >= q && t < q + nb) mine = (e << 16) | (e * (ECAP / 256) + (t - q)); q += nb; }
    if (mine >= 0) tbl[t] = mine;
    __syncthreads();
    return q;
}

struct LeftOrder : pg8::StaticOrder {
    const LAS3 int* tbl; int NT; int L;
    __device__ __forceinline__ bool next(int i, Unit& u) const { if (i != 0 || L < 0) return false;
        pg8::StaticOrder t = *this; t.c = L; if (!t.pg8::StaticOrder::next(0, u)) return false;
        const int v = tbl[u.pm]; u.pm = v & 0xffff; u.pn += (v >> 16) * NT; return true; }
};
struct EpiF32Part {
    static constexpr bool PERM = false, AFTER_DRAIN = false;
    float* P; float scale; int* tflag; int li; int pnmod; int mark;
    __device__ __forceinline__ void operator()(const f32x4 (&acc)[2][2][4][2], const Unit& u, int wr, int wc, int fr, int fq) const {
        asm volatile("" : "+v"(fr), "+v"(fq));
        if (mark && threadIdx.x == 0) tflag[u.pm * 8 + (u.pn % pnmod)] = li + 1;
        const int r0 = wr * 64 + fr, c0 = wc * 32 + 4 * fq;
#pragma unroll
        for (int ai = 0; ai < 2; ++ai)
#pragma unroll
            for (int m = 0; m < 4; ++m) { float* rowp = P + (size_t)(r0 + ai * 128 + m * 16) * 256 + c0;
#pragma unroll
                for (int bj = 0; bj < 2; ++bj)
#pragma unroll
                    for (int n = 0; n < 2; ++n) *(f32x4*)(rowp + bj * 128 + n * 16) = acc[ai][bj][m][n] * scale; }
    }
};

__device__ __forceinline__ void stage_router(const float* wr, LAS3 unsigned char* lds) {
    LAS3 float* wT = (LAS3 float*)lds; const int t = threadIdx.x; float4 v[8];
#pragma unroll
    for (int j = 0; j < 8; ++j) v[j] = ((const float4*)(wr + (size_t)t * 32))[j];
    const float a[32] = {v[0].x, v[0].y, v[0].z, v[0].w, v[1].x, v[1].y, v[1].z, v[1].w, v[2].x, v[2].y, v[2].z, v[2].w, v[3].x, v[3].y, v[3].z, v[3].w,
                         v[4].x, v[4].y, v[4].z, v[4].w, v[5].x, v[5].y, v[5].z, v[5].w, v[6].x, v[6].y, v[6].z, v[6].w, v[7].x, v[7].y, v[7].z, v[7].w};
#pragma unroll
    for (int e = 0; e < 8; ++e) *(LAS3 f32x4*)(wT + e * DM + t * 4) = (f32x4){a[e], a[8 + e], a[16 + e], a[24 + e]};
    __syncthreads();
}

__device__ __forceinline__ void phase_sgu(const Params& p, LAS3 unsigned char* lds) {
    const int tid = threadIdx.x, lane = tid & 63, wave = __builtin_amdgcn_readfirstlane(tid >> 6), fr = lane & 15, fq = lane >> 4;
    unsigned char* ws = p.ws;
    const bf16_t* U = (const bf16_t*)(ws + OFF_U); const bf16_t* VT = (const bf16_t*)(ws + OFF_VT); bf16_t* GT = (bf16_t*)(ws + OFF_GT); const float* SSP = (const float*)(ws + OFF_SSP);
    LAS3 float* rs = (LAS3 float*)(lds + 36864);
    for (int unit = blockIdx.x; unit < 512; unit += (int)gridDim.x) {
        const int ch = unit >> 3, g = unit & 7;
        __syncthreads();
        if (tid < 128) rs[tid] = rsqrtf(ssp_sum32(SSP, ch * 128 + tid) * (1.0f / GH) + EPS);
        bf16x8 bfrag[4][4];
#pragma unroll
        for (int n = 0; n < 4; ++n) { const int chrow = g * 512 + wave * 64 + (n >> 1) * 32 + 8 * (fr >> 2) + 4 * (n & 1) + (fr & 3);
#pragma unroll
            for (int ks = 0; ks < 4; ++ks) bfrag[n][ks] = *(const bf16x8*)(VT + (size_t)chrow * NTOK + ch * 128 + ks * 32 + fq * 8); }
        __syncthreads();
        { const int t = tid >> 2, s0 = (tid & 3) * 32; const float* wp = p.a_w_s + ((size_t)g * 128 + t) * 128 + s0;
#pragma unroll
          for (int q = 0; q < 4; ++q) { const float4 a = *(const float4*)(wp + q * 8), b = *(const float4*)(wp + q * 8 + 4); float v[8] = {a.x, a.y, a.z, a.w, b.x, b.y, b.z, b.w};
#pragma unroll
              for (int j = 0; j < 8; ++j) { const int s = s0 + q * 8 + j; v[j] = (s <= t) ? v[j] * rs[s] : 0.f; }
              u32x4 w; w.x = cvtpk(v[0], v[1]); w.y = cvtpk(v[2], v[3]); w.z = cvtpk(v[4], v[5]); w.w = cvtpk(v[6], v[7]);
              *(LAS3 u32x4*)(lds + t * 272 + (s0 + q * 8) * 2) = w; } }
        __syncthreads();
        u32x4 ureg[8][2];
#pragma unroll
        for (int mt = 0; mt < 8; ++mt)
#pragma unroll
            for (int pp = 0; pp < 2; ++pp) ureg[mt][pp] = *(const u32x4*)(U + (size_t)(ch * 128 + 16 * mt + fr) * GH + g * 512 + wave * 64 + pp * 32 + 8 * fq);
#pragma unroll
        for (int mt = 0; mt < 8; ++mt) {
            f32x4 acc[4];
#pragma unroll
            for (int n = 0; n < 4; ++n) acc[n] = (f32x4){0.f, 0.f, 0.f, 0.f};
            const int nks = (16 * mt + 15) / 32 + 1;
#pragma unroll
            for (int ks = 0; ks < 4; ++ks) if (ks < nks) { const bf16x8 a = *(const LAS3 bf16x8*)(lds + (16 * mt + fr) * 272 + (ks * 32 + fq * 8) * 2);
#pragma unroll
                for (int n = 0; n < 4; ++n) acc[n] = __builtin_amdgcn_mfma_f32_16x16x32_bf16(bfrag[n][ks], a, acc[n], 0, 0, 0); }
            const int tl = 16 * mt + fr, tok = ch * 128 + tl; const float b = p.a_b_s[g * 128 + tl];
#pragma unroll
            for (int pp = 0; pp < 2; ++pp) { const int c0 = g * 512 + wave * 64 + pp * 32 + 8 * fq;
                const u32x4 uu = ureg[mt][pp]; const f32x4 g0 = *(const f32x4*)(p.a_norm_v + c0), g1 = *(const f32x4*)(p.a_norm_v + c0 + 4);
                const f32x4 a0 = acc[2 * pp], a1 = acc[2 * pp + 1];
                u32x4 w;
                w.x = cvtpk(bf2f(uu.x & 0xffffu) * (g0[0] * a0[0] + b), bf2f(uu.x >> 16) * (g0[1] * a0[1] + b));
                w.y = cvtpk(bf2f(uu.y & 0xffffu) * (g0[2] * a0[2] + b), bf2f(uu.y >> 16) * (g0[3] * a0[3] + b));
                w.z = cvtpk(bf2f(uu.z & 0xffffu) * (g1[0] * a1[0] + b), bf2f(uu.z >> 16) * (g1[1] * a1[1] + b));
                w.w = cvtpk(bf2f(uu.w & 0xffffu) * (g1[2] * a1[2] + b), bf2f(uu.w >> 16) * (g1[3] * a1[3] + b));
                *(u32x4*)(GT + (size_t)tok * GH + c0) = w; }
        }
    }
    __syncthreads();
}

constexpr int AT_KP = 272, AT_VP = 288, AT_VOFF = 256 * AT_KP, AT_UNITS = 3072;
typedef short s16x4 __attribute__((ext_vector_type(4)));
struct AtUnit { int gi, b, h, r, n, dsh; };
__device__ __forceinline__ AtUnit at_decode(int unit) { AtUnit u; u.gi = unit >> 10; const int rem = unit & 1023; u.b = rem >> 8; u.h = (rem >> 4) & 15; const int rn = rem & 15;
    u.dsh = 2 * u.gi; const int nbsh = 4 - u.dsh; u.r = rn >> nbsh; u.n = rn & ((1 << nbsh) - 1); return u; }
#define AT_TR4(o0, o1, o2, o3, f0, f1, f2, f3) asm volatile("ds_read_b64_tr_b16 %0, %4 offset:%5\n\tds_read_b64_tr_b16 %1, %4 offset:%6\n\tds_read_b64_tr_b16 %2, %4 offset:%7\n\tds_read_b64_tr_b16 %3, %4 offset:%8" \
        : "=&v"(o0), "=&v"(o1), "=&v"(o2), "=&v"(o3) : "v"(vrow), "i"(f0), "i"(f1), "i"(f2), "i"(f3) : "memory")
__device__ __forceinline__ void phase_attn(const Params& p, LAS3 unsigned char* lds) {
    const int tid = threadIdx.x, lane = tid & 63, wave = __builtin_amdgcn_readfirstlane(tid >> 6), fr = lane & 15, fq = lane >> 4, G = (int)gridDim.x;
    unsigned char* ws = p.ws;
    const bf16_t* Q = (const bf16_t*)(ws + OFF_Q); const bf16_t* KV = (const bf16_t*)(ws + OFF_KV); bf16_t* OG = (bf16_t*)(ws + OFF_OG); float* LSE = (float*)(ws + OFF_LSE);
    const unsigned vbase = (unsigned)(size_t)(lds + AT_VOFF);
    const unsigned vrow = vbase + (unsigned)((16 * wave + 4 * fq + ((lane & 15) >> 2)) * AT_VP + (lane & 3) * 8);
    const int srow = tid >> 4, c16 = tid & 15;
    int unit = blockIdx.x;
    if (unit < AT_UNITS) {
        AtUnit cu = at_decode(unit);
        u32x4 kreg[8], vreg[8]; bf16x8 qf[4], qn[4];
#define AT_LOADQ(U, D) do { const int _tok = (U).b * SEQ + ((((U).n << 7) + wave * 16 + fr) << (U).dsh) + (U).r; _Pragma("unroll") for (int ks = 0; ks < 4; ++ks) D[ks] = *(const bf16x8*)(Q + (size_t)_tok * NQ + (U).gi * 2048 + (U).h * 128 + ks * 32 + fq * 8); } while (0)
#define AT_LOAD(U) do { _Pragma("unroll") for (int ps = 0; ps < 8; ++ps) if ((U).n > 0 || ps >= 4) { const int lk = ((U).n - 1) * 128 + ps * 32 + srow; \
            const bf16_t* src = KV + ((size_t)(U).h * NTOK + (U).b * SEQ + (lk << (U).dsh) + (U).r) * 128 + c16 * 8; kreg[ps] = *(const u32x4*)src; vreg[ps] = *(const u32x4*)(src + (size_t)16 * NTOK * 128); } } while (0)
        AT_LOAD(cu); AT_LOADQ(cu, qn);
        for (;;) {
            asm volatile("" ::: "memory"); __builtin_amdgcn_s_barrier(); asm volatile("" ::: "memory");
#pragma unroll
            for (int ps = 0; ps < 8; ++ps) if (cu.n > 0 || ps >= 4) { const int kk = ps * 32 + srow;
                *(LAS3 u32x4*)(lds + kk * AT_KP + c16 * 16) = kreg[ps]; *(LAS3 u32x4*)(lds + AT_VOFF + kk * AT_VP + c16 * 16) = vreg[ps]; }
            const int jq = wave * 16 + fr, qtok = cu.b * SEQ + (((cu.n << 7) + jq) << cu.dsh) + cu.r;
#pragma unroll
            for (int ks = 0; ks < 4; ++ks) qf[ks] = qn[ks];
            const int un = unit + G; const bool hasn = un < AT_UNITS; AtUnit nu = cu;
            if (hasn) { nu = at_decode(un); AT_LOAD(nu); AT_LOADQ(nu, qn); }
            asm volatile("s_waitcnt lgkmcnt(0)" ::: "memory"); __builtin_amdgcn_s_barrier(); asm volatile("" ::: "memory");
            const int c_lo = cu.n == 0 ? (8 - wave) : 0;
            f32x4 sc[9];
#pragma unroll
            for (int c = 0; c < 9; ++c) { sc[c] = (f32x4){0.f, 0.f, 0.f, 0.f};
                if (c >= c_lo) {
#pragma unroll
                    for (int ks = 0; ks < 4; ++ks) { const bf16x8 kf = *(const LAS3 bf16x8*)(lds + (16 * (wave + c) + fr) * AT_KP + (ks * 32 + fq * 8) * 2);
                        sc[c] = __builtin_amdgcn_mfma_f32_16x16x32_bf16(kf, qf[ks], sc[c], 0, 0, 0); } } }
            const float slope2 = exp2f(-0.5f * (float)(cu.h + 1)) * 1.4426950409f; const int dq = fr - 4 * fq; const float t0 = slope2 * (float)(128 + dq); float mx = -3.0e38f;
#pragma unroll
            for (int c = 0; c < 9; ++c) {
                if (c >= c_lo) {
#pragma unroll
                    for (int q = 0; q < 4; ++q) { float s2 = fmaf(sc[c][q], 0.08838834764831845f * 1.4426950409f, fmaf(slope2, (float)(16 * c + q), -t0));
                        if (c == 0) s2 = (dq - q <= 0) ? s2 : -3.0e38f;
                        if (c == 8) s2 = (dq - q >= 0) ? s2 : -3.0e38f;
                        sc[c][q] = s2; mx = fmaxf(mx, s2); }
                } else { sc[c] = (f32x4){-3.0e38f, -3.0e38f, -3.0e38f, -3.0e38f}; } }
            mx = fmaxf(mx, __shfl_xor(mx, 16)); mx = fmaxf(mx, __shfl_xor(mx, 32));
            float den = 0.f;
#pragma unroll
            for (int c = 0; c < 9; ++c) {
                if (c >= c_lo) {
#pragma unroll
                    for (int q = 0; q < 4; ++q) { const float e = __builtin_amdgcn_exp2f(sc[c][q] - mx); sc[c][q] = e; den += e; }
                } else { sc[c] = (f32x4){0.f, 0.f, 0.f, 0.f}; } }
            den += __shfl_xor(den, 16); den += __shfl_xor(den, 32);
            f32x4 o[8];
#pragma unroll
            for (int et = 0; et < 8; ++et) o[et] = (f32x4){0.f, 0.f, 0.f, 0.f};
#pragma unroll
            for (int pp = 0; pp < 5; ++pp) {
                if (2 * pp + 1 >= c_lo) {
                    u32x4 pw; pw.x = cvtpk(sc[2 * pp][0], sc[2 * pp][1]); pw.y = cvtpk(sc[2 * pp][2], sc[2 * pp][3]);
                    if (pp < 4) { pw.z = cvtpk(sc[2 * pp + 1][0], sc[2 * pp + 1][1]); pw.w = cvtpk(sc[2 * pp + 1][2], sc[2 * pp + 1][3]); } else { pw.z = 0u; pw.w = 0u; }
                    const bf16x8 pf = __builtin_bit_cast(bf16x8, pw);
                    constexpr int R1 = 16 * AT_VP;
                    const int r0 = (32 * pp) * AT_VP, r1 = (pp < 4 ? (32 * pp + 16) : (32 * pp)) * AT_VP; (void)R1;
                    s16x4 a0, a1, a2, a3, a4, a5, a6, a7, b0, b1, b2, b3, b4, b5, b6, b7;
                    AT_TR4(a0, a1, a2, a3, r0, r0 + 32, r0 + 64, r0 + 96); AT_TR4(a4, a5, a6, a7, r0 + 128, r0 + 160, r0 + 192, r0 + 224);
                    AT_TR4(b0, b1, b2, b3, r1, r1 + 32, r1 + 64, r1 + 96); AT_TR4(b4, b5, b6, b7, r1 + 128, r1 + 160, r1 + 192, r1 + 224);
                    asm volatile("s_waitcnt lgkmcnt(0)" : "+v"(a0), "+v"(a1), "+v"(a2), "+v"(a3), "+v"(a4), "+v"(a5), "+v"(a6), "+v"(a7), "+v"(b0), "+v"(b1), "+v"(b2), "+v"(b3), "+v"(b4), "+v"(b5), "+v"(b6), "+v"(b7) :: "memory");
                    if (2 * pp < c_lo) { const s16x4 z = {0, 0, 0, 0}; a0 = z; a1 = z; a2 = z; a3 = z; a4 = z; a5 = z; a6 = z; a7 = z; }
#define AT_PV(et, A, B) o[et] = __builtin_amdgcn_mfma_f32_16x16x32_bf16((bf16x8){A[0], A[1], A[2], A[3], B[0], B[1], B[2], B[3]}, pf, o[et], 0, 0, 0)
                    AT_PV(0, a0, b0); AT_PV(1, a1, b1); AT_PV(2, a2, b2); AT_PV(3, a3, b3); AT_PV(4, a4, b4); AT_PV(5, a5, b5); AT_PV(6, a6, b6); AT_PV(7, a7, b7);
#undef AT_PV
                } }
            const float inv = 1.0f / den;
            bf16_t* op = OG + ((size_t)cu.gi * NTOK + qtok) * DM + cu.h * 128 + 4 * fq;
#pragma unroll
            for (int et = 0; et < 8; ++et) { uint2 w; w.x = cvtpk(o[et][0] * inv, o[et][1] * inv); w.y = cvtpk(o[et][2] * inv, o[et][3] * inv); *(uint2*)(op + et * 16) = w; }
            if (fq == 0) LSE[((size_t)cu.gi * NTOK + qtok) * 16 + cu.h] = (mx + __log2f(den)) * 0.6931471806f;
            if (!hasn) break;
            unit = un; cu = nu;
        }
#undef AT_LOAD
#undef AT_LOADQ
    }
    __syncthreads();
}
#undef AT_TR4

__device__ __forceinline__ void phase_merge(const Params& p) {
    unsigned char* ws = p.ws; const bf16_t* OG = (const bf16_t*)(ws + OFF_OG); const float* LSE = (const float*)(ws + OFF_LSE); bf16_t* OM = (bf16_t*)(ws + OFF_OM);
    for (size_t i = (size_t)blockIdx.x * MK_THREADS + threadIdx.x; i < (size_t)NTOK * 256; i += (size_t)gridDim.x * MK_THREADS) {
        const int tok = (int)(i >> 8), c8 = (int)(i & 255), h = c8 >> 4;
        const float l0 = LSE[((size_t)0 * NTOK + tok) * 16 + h], l1 = LSE[((size_t)1 * NTOK + tok) * 16 + h], l2 = LSE[((size_t)2 * NTOK + tok) * 16 + h];
        const float m = fmaxf(l0, fmaxf(l1, l2)); const float a0 = __expf(l0 - m), a1 = __expf(l1 - m), a2 = __expf(l2 - m), inv = 1.0f / (a0 + a1 + a2);
        const uint4 x0 = *(const uint4*)(OG + ((size_t)0 * NTOK + tok) * DM + c8 * 8), x1 = *(const uint4*)(OG + ((size_t)1 * NTOK + tok) * DM + c8 * 8), x2 = *(const uint4*)(OG + ((size_t)2 * NTOK + tok) * DM + c8 * 8);
        const unsigned w0[4] = {x0.x, x0.y, x0.z, x0.w}, w1[4] = {x1.x, x1.y, x1.z, x1.w}, w2[4] = {x2.x, x2.y, x2.z, x2.w}; unsigned rr[4];
#pragma unroll
        for (int j = 0; j < 4; ++j) { const float lo = (a0 * bf2f(w0[j] & 0xffffu) + a1 * bf2f(w1[j] & 0xffffu) + a2 * bf2f(w2[j] & 0xffffu)) * inv;
            const float hi = (a0 * bf2f(w0[j] >> 16) + a1 * bf2f(w1[j] >> 16) + a2 * bf2f(w2[j] >> 16)) * inv; rr[j] = cvtpk(lo, hi); }
        *(uint4*)(OM + (size_t)tok * DM + c8 * 8) = make_uint4(rr[0], rr[1], rr[2], rr[3]);
    }
}
#define PHASE2_BODY phase_sgu(p, lds);
#define PHASE9_BODY phase_attn(p, lds);
#define PHASE10_BODY phase_merge(p);

__global__ void __launch_bounds__(MK_THREADS, 2) mega(Params p, int lo, int hi) {
    extern __shared__ __attribute__((aligned(16))) unsigned char shm[];
    LAS3 unsigned char* lds = (LAS3 unsigned char*)shm;
    const int tid = threadIdx.x, wave = __builtin_amdgcn_readfirstlane(tid >> 6), G = (int)gridDim.x;
#define MK_LANE() ((int)__builtin_amdgcn_mbcnt_hi(~0u, __builtin_amdgcn_mbcnt_lo(~0u, 0u)))
    unsigned char* ws = p.ws;
    volatile LAS3 unsigned* xbw = (volatile LAS3 unsigned*)(lds + MK_LDS_BAR);
    if (tid < 4) xbw[tid] = 0u;
    __syncthreads();
    XcdBarrier bar; bar.bar = (unsigned*)(ws + OFF_CTRL + CTRL_BAR_BYTE); bar.x = 0; bar.st = xbw;
    if (hi - lo > 1) bar = xcd_barrier_post((unsigned*)(ws + OFF_CTRL + CTRL_BAR_BYTE), xbw);
#define IN(k) (lo <= (k) && (k) < hi)
#define SEAM(k) do { if (IN(k) && IN((k) + 1)) xcd_barrier(bar); } while (0)
    float* SSP = (float*)(ws + OFF_SSP);
    bf16_t* XN = (bf16_t*)(ws + OFF_XN); bf16_t* XNQ = (bf16_t*)(ws + OFF_XNQ);
    bf16_t* MIX = (bf16_t*)(ws + OFF_MIX); bf16_t* H1 = (bf16_t*)(ws + OFF_H1); bf16_t* H2 = (bf16_t*)(ws + OFF_H2); bf16_t* H3 = (bf16_t*)(ws + OFF_H3);
    int* ictrl = (int*)(ws + OFF_CTRL);
    const float* gains = p.gains;

    constexpr int CR0 = CT1, CR1 = 12800, CR3 = 17408, CR5 = 34304, CR6 = 42496, CR8 = CT8;
    static_assert(CR1 >= CT6, "every dense weight is converted by the end of P1");
    const bool conv_first = (blockIdx.x & 1) == 0;
    if (IN(0)) {
        phase_convert(p, lds, 0, CR0);
        { const int lane = MK_LANE(); for (int row = blockIdx.x * 8 + wave; row < NTOK; row += G * 8) row_norm0(p, row, lane); }
    }
    SEAM(0);
    if (IN(1)) {
        if (conv_first) phase_convert(p, lds, CR0, CR1);
        { pg8::Gemm g{XN, (const bf16_t*)(ws + OFF_WIN_T), NTOK, GH, DM}; pg8::StaticOrder S; S.init(NTOK, GH, G, (int)blockIdx.x);
          EpiGeluU E{(bf16_t*)(ws + OFF_U), GH, p.a_b_in};
          pg8::gemm_phase<EpiGeluU, pg8::StaticOrder>(lds, g, S, E, nullptr); }
        { pg8::Gemm g{(const bf16_t*)(ws + OFF_WIN_T) + (size_t)GH * DM, XN, GH, NTOK, DM}; pg8::StaticOrder S; S.init(GH, NTOK, G, (int)blockIdx.x);
          EpiGeluVT E{(bf16_t*)(ws + OFF_VT), p.a_b_in + GH, SSP};
          pg8::gemm_phase<EpiGeluVT, pg8::StaticOrder>(lds, g, S, E, nullptr); }
        if (!conv_first) phase_convert(p, lds, CR0, CR1);
    }
    SEAM(1);
    if (IN(2)) { PHASE2_BODY }
    SEAM(2);
    if (IN(3)) {
        if (conv_first) phase_convert(p, lds, CR1, CR3);
        pg8::Gemm g{(const bf16_t*)(ws + OFF_GT), (const bf16_t*)(ws + OFF_WOUT_T), NTOK, DM, GH}; pg8::StaticOrder S; S.init(NTOK, DM, G, (int)blockIdx.x);
        EpiBf16SS E{MIX, DM, SSP};
        pg8::gemm_phase<EpiBf16SS, pg8::StaticOrder>(lds, g, S, E, nullptr);
        if (!conv_first) phase_convert(p, lds, CR1, CR3);
    }
    SEAM(3);
    if (IN(4)) { phase_resnorm<false>(p.x, MIX, SSP, gains + DM, H1, gains + 2 * DM, XN, nullptr, nullptr, wave, MK_LANE(), G); }
    SEAM(4);
    if (IN(5)) {
        if (conv_first) phase_convert(p, lds, CR3, CR5);
        pg8::Gemm g{XN, (const bf16_t*)(ws + OFF_WGU_T), NTOK, 2 * DFF, DM}; pg8::StaticOrder S; S.init(NTOK, 2 * DFF, G, (int)blockIdx.x);
        EpiSwiglu E{(bf16_t*)(ws + OFF_ACT), DFF, 56};
        pg8::gemm_phase<EpiSwiglu, pg8::StaticOrder>(lds, g, S, E, nullptr);
        if (!conv_first) phase_convert(p, lds, CR3, CR5);
    }
    SEAM(5);
    if (IN(6)) {
        if (conv_first) phase_convert(p, lds, CR5, CR6);
        pg8::Gemm g{(const bf16_t*)(ws + OFF_ACT), (const bf16_t*)(ws + OFF_WDN_T), NTOK, DM, DFF}; pg8::StaticOrder S; S.init(NTOK, DM, G, (int)blockIdx.x);
        EpiBf16SS E{MIX, DM, SSP};
        pg8::gemm_phase<EpiBf16SS, pg8::StaticOrder>(lds, g, S, E, nullptr);
        if (!conv_first) phase_convert(p, lds, CR5, CR6);
    }
    SEAM(6);
    if (IN(7)) { phase_resnorm<true>(H1, MIX, SSP, gains + 3 * DM, H2, p.kv_norm, XN, gains + 4 * DM, XNQ, wave, MK_LANE(), G); }
    SEAM(7);
    if (IN(8)) {
        if (conv_first) phase_convert(p, lds, CR6, CR8);
        { pg8::Gemm g{XN, (const bf16_t*)(ws + OFF_WKV_T), NTOK, NKV, DM}; pg8::StaticOrder S; S.init(NTOK, NKV, G, (int)blockIdx.x);
          EpiBf16H E{(bf16_t*)(ws + OFF_KV), NTOK};
          pg8::gemm_phase<EpiBf16H, pg8::StaticOrder>(lds, g, S, E, nullptr); }
        { pg8::Gemm g{XNQ, (const bf16_t*)(ws + OFF_WQ_T), NTOK, NQ, DM}; pg8::StaticOrder S; S.init(NTOK, NQ, G, (int)blockIdx.x);
          EpiBf16P E{(bf16_t*)(ws + OFF_Q), NQ};
          pg8::gemm_phase<EpiBf16P, pg8::StaticOrder>(lds, g, S, E, nullptr); }
        if (!conv_first) phase_convert(p, lds, CR6, CR8);
    }
    SEAM(8);
    if (IN(9)) { PHASE9_BODY }
    SEAM(9);
    if (IN(10)) { PHASE10_BODY }
    SEAM(10);
    if (IN(11)) {
        pg8::Gemm g{(const bf16_t*)(ws + OFF_OM), (const bf16_t*)(ws + OFF_WO_T), NTOK, DM, DM}; pg8::StaticOrder S; S.init(NTOK, DM, G, (int)blockIdx.x);
        EpiBf16SS E{MIX, DM, SSP};
        pg8::gemm_phase<EpiBf16SS, pg8::StaticOrder>(lds, g, S, E, nullptr);
    }
    SEAM(11);
    if (IN(12)) { stage_router(p.moe_router, lds); const int lane = MK_LANE(); for (int row = blockIdx.x * 8 + wave; row < NTOK; row += G * 8) { int ln = lane; asm volatile("" : "+v"(ln));
        row_router(H2, MIX, SSP, gains + 5 * DM, H3, gains + 6 * DM, (const LAS3 float*)lds, ws + OFF_XS, ictrl + C_CNT, (int*)(ws + OFF_TOKS), (float*)(ws + OFF_TOKG), row, ln); } }
    SEAM(12);
    if (IN(13)) {
        const int nblk = moe_table(ictrl + C_CNT, lds);
        pg8::Gemm g{(const bf16_t*)(ws + OFF_XS), (const bf16_t*)(ws + OFF_MGU_T), nblk * 256, 2 * DFF, DM}; MoeOrder S; S.init(nblk * 256, 2 * DFF, G, (int)blockIdx.x); S.tbl = (const LAS3 int*)(lds + MOE_TBL_OFF); S.NT = 56; S.lim = 0x7fffffff;
        EpiSwiglu8 E{ws + OFF_ACT2, DFF, 56, 1.0f / (F8_SA1 * F8_SW1), F8_SA2};
        pg8::gemm_phase<EpiSwiglu8, MoeOrder, false, true>(lds, g, S, E, nullptr);
    }
    SEAM(13);
    if (IN(14)) {
        const int nblk = moe_table(ictrl + C_CNT, lds); const int nunits = nblk * 8; int lim = 2 * G < nunits ? 2 * G : nunits; if ((nunits - lim) * KSPLIT > G) lim = nunits;
        { pg8::Gemm g{(const bf16_t*)(ws + OFF_ACT2), (const bf16_t*)(ws + OFF_MDN_T), nblk * 256, DM, DFF}; MoeOrder S; S.init(nblk * 256, DM, G, (int)blockIdx.x); S.tbl = (const LAS3 int*)(lds + MOE_TBL_OFF); S.NT = 8; S.lim = lim;
          EpiBf16S E{(bf16_t*)(ws + OFF_Y), DM, 8, 1.0f / (F8_SA2 * F8_SW2)};
          pg8::gemm_phase<EpiBf16S, MoeOrder, false, true>(lds, g, S, E, nullptr); }
        { const int nleft = nunits - lim, item = (int)blockIdx.x, li = item / KSPLIT, ch = item - li * KSPLIT;
          constexpr int CKT = DFF / 128 / KSPLIT;
          pg8::Gemm g{(const bf16_t*)(ws + OFF_ACT2 + (size_t)ch * CKT * 128), (const bf16_t*)(ws + OFF_MDN_T + (size_t)ch * CKT * 128), nblk * 256, DM, DFF, CKT};
          LeftOrder S; S.init(nblk * 256, DM, G, 0); S.tbl = (const LAS3 int*)(lds + MOE_TBL_OFF); S.NT = 8; S.L = li < nleft ? lim + li : -1;
          EpiF32Part E{(float*)(ws + OFF_U) + ((size_t)li * KSPLIT + ch) * 65536, 1.0f / (F8_SA2 * F8_SW2), ictrl + C_TFLAG, li, 8, ch == 0};
          pg8::gemm_phase<EpiF32Part, LeftOrder, false, true>(lds, g, S, E, nullptr); }
    }
    SEAM(14);
    if (IN(15)) { const int lane = MK_LANE(); for (int row = blockIdx.x * 8 + wave; row < NTOK; row += G * 8)
        row_final(H3, (const bf16_t*)(ws + OFF_Y), (const float*)(ws + OFF_U)  , ictrl + C_TFLAG, (const int*)(ws + OFF_TOKS), (const float*)(ws + OFF_TOKG), gains + 7 * DM, p.out, row, lane); }
#undef IN
#undef SEAM
}

extern "C" void kernel_launch(void* const* d_in, const int* in_sizes, int n_in, void* d_out, int out_size, void* d_ws, size_t ws_size, hipStream_t stream) {
    (void)in_sizes; (void)n_in; (void)out_size;
    if (ws_size < WS_NEED) { fprintf(stderr, "workspace too small: %zu < %zu\n", ws_size, (size_t)WS_NEED); return; }
    static int grid = 0;
    if (grid == 0) {
        int dev = 0, cus = 0, per_cu = 0;
        if (hipGetDevice(&dev) != hipSuccess || hipDeviceGetAttribute(&cus, hipDeviceAttributeMultiprocessorCount, dev) != hipSuccess) { fprintf(stderr, "device query failed\n"); grid = -1; return; }
        if (hipFuncSetAttribute((const void*)mega, hipFuncAttributeMaxDynamicSharedMemorySize, MK_LDS_BYTES) != hipSuccess) { fprintf(stderr, "hipFuncSetAttribute failed\n"); grid = -1; return; }
        if (hipOccupancyMaxActiveBlocksPerMultiprocessor(&per_cu, (const void*)mega, MK_THREADS, MK_LDS_BYTES) != hipSuccess || per_cu < 1) { fprintf(stderr, "occupancy query: %d blocks per CU\n", per_cu); (void)hipGetLastError(); }
        grid = cus;
    }
    if (grid < 0) return;
    const float* const* in = (const float* const*)d_in;
    Params P{};
    P.x = in[0]; P.gains = in[1]; P.a_w_in = in[2]; P.a_b_in = in[3]; P.a_norm_v = in[4]; P.a_w_s = in[5]; P.a_b_s = in[6]; P.a_w_out = in[7]; P.kv_norm = in[8]; P.w_kv = in[9]; P.w_q = in[10]; P.w_o = in[11];
    P.ffn_w_gu = in[12]; P.ffn_w_down = in[13]; P.moe_router = in[14]; P.moe_w_gu = in[15]; P.moe_w_down = in[16]; P.out = (float*)d_out; P.ws = (unsigned char*)d_ws;
#define MEGA(lo, hi) hipLaunchKernelGGL(mega, dim3(grid), dim3(MK_THREADS), MK_LDS_BYTES, stream, P, (lo), (hi))

    (void)hipMemsetAsync((char*)d_ws + OFF_CTRL, 0, CTRL_BYTES, stream);
    MEGA(0, NPH);
}
```

```cpp
#include <hip/hip_runtime.h>
#include <stdint.h>
#include <stdio.h>

typedef unsigned short bf16_t;

constexpr int NTOK = 8192, DM = 2048, SEQ = 2048, GH = 4096  , DFF = 7168, NEXP = 8;
constexpr int NQ = 6144, NKV = 4096;
constexpr int ECAP = NTOK, MAXSLOT = NEXP * ECAP;
constexpr float EPS = 1e-6f;

constexpr size_t AL(size_t x) { return (x + 255) & ~(size_t)255; }
constexpr size_t OFF_CTRL = 0;
constexpr size_t CTRL_BYTES = 1 << 16;
constexpr int C_CNT = 0  ;
constexpr int SSP_N = 64;
constexpr size_t OFF_SSP  = AL(OFF_CTRL + CTRL_BYTES);
constexpr size_t OFF_XN   = AL(OFF_SSP + (size_t)NTOK * SSP_N * 4);
constexpr size_t OFF_XNQ  = AL(OFF_XN + (size_t)NTOK * DM * 2);
constexpr size_t OFF_U    = AL(OFF_XNQ + (size_t)NTOK * DM * 2);
constexpr size_t OFF_VT   = AL(OFF_U + (size_t)NTOK * GH * 2);
constexpr size_t OFF_GT   = AL(OFF_VT + (size_t)NTOK * GH * 2);
constexpr size_t OFF_MIX  = AL(OFF_GT + (size_t)NTOK * GH * 2);
constexpr size_t OFF_H1   = AL(OFF_MIX + (size_t)NTOK * DM * 4);
constexpr size_t OFF_H2   = AL(OFF_H1 + (size_t)NTOK * DM * 4);
constexpr size_t OFF_H3   = AL(OFF_H2 + (size_t)NTOK * DM * 4);
constexpr size_t OFF_ACT  = AL(OFF_H3 + (size_t)NTOK * DM * 4);
constexpr size_t OFF_KV   = AL(OFF_ACT + (size_t)NTOK * DFF * 2);
constexpr size_t OFF_Q    = AL(OFF_KV + (size_t)NTOK * NKV * 2);
constexpr size_t OFF_OG   = AL(OFF_Q + (size_t)NTOK * NQ * 2);
constexpr size_t OFF_LSE  = AL(OFF_OG + (size_t)3 * NTOK * DM * 2);
constexpr size_t OFF_OM   = AL(OFF_LSE + (size_t)3 * NTOK * 16 * 4);
constexpr size_t OFF_TOKG = AL(OFF_OM + (size_t)NTOK * DM * 2);
constexpr size_t OFF_TOKS = AL(OFF_TOKG + (size_t)NTOK * 2 * 4);
constexpr size_t OFF_XS   = AL(OFF_TOKS + (size_t)NTOK * 2 * 4);
constexpr size_t OFF_ACT2 = AL(OFF_XS + (size_t)MAXSLOT * DM);
constexpr size_t OFF_Y    = AL(OFF_ACT2 + (size_t)MAXSLOT * DFF);
constexpr size_t OFF_WIN_T  = AL(OFF_Y + (size_t)MAXSLOT * DM * 2);
constexpr size_t OFF_WOUT_T = AL(OFF_WIN_T + (size_t)2 * GH * DM * 2);
constexpr size_t OFF_WGU_T  = AL(OFF_WOUT_T + (size_t)DM * GH * 2);
constexpr size_t OFF_WDN_T  = AL(OFF_WGU_T + (size_t)2 * DFF * DM * 2);
constexpr size_t OFF_WKV_T  = AL(OFF_WDN_T + (size_t)DM * DFF * 2);
constexpr size_t OFF_WQ_T   = AL(OFF_WKV_T + (size_t)NKV * DM * 2);
constexpr size_t OFF_WO_T   = AL(OFF_WQ_T + (size_t)NQ * DM * 2);
constexpr size_t OFF_MGU_T  = AL(OFF_WO_T + (size_t)DM * DM * 2);
constexpr size_t OFF_MDN_T  = AL(OFF_MGU_T + (size_t)NEXP * 2 * DFF * DM);
constexpr size_t WS_NEED  = AL(OFF_MDN_T + (size_t)NEXP * DM * DFF);
constexpr size_t CTRL_BAR_BYTE = 4096;

__device__ __forceinline__ float bf2f(unsigned v) { return __uint_as_float(v << 16); }
__device__ __forceinline__ bf16_t f2bf(float f) { unsigned u = __float_as_uint(f); u += 0x7FFFu + ((u >> 16) & 1u); return (bf16_t)(u >> 16); }
__device__ __forceinline__ unsigned pack2(float lo, float hi) { return (unsigned)f2bf(lo) | ((unsigned)f2bf(hi) << 16); }
__device__ __forceinline__ float gelu_tanh(float x) { const float t = 1.5957691216057308f * (x + 0.044715f * x * x * x); return x / (1.0f + __expf(-t)); }
__device__ __forceinline__ float silu(float x) { return x / (1.0f + __expf(-x)); }
__device__ __forceinline__ float wave_sum(float v) { for (int o = 32; o >= 1; o >>= 1) v += __shfl_xor(v, o); return v; }
__device__ __forceinline__ float wave_max(float v) { for (int o = 32; o >= 1; o >>= 1) v = fmaxf(v, __shfl_xor(v, o)); return v; }

namespace pg8 {
#define PG8_LAS __attribute__((address_space(3)))
typedef unsigned short bf16_t;
typedef short bf16x8 __attribute__((ext_vector_type(8)));
typedef float f32x4 __attribute__((ext_vector_type(4)));
typedef unsigned u32x4 __attribute__((ext_vector_type(4)));
constexpr int BM = 256, BK = 64, HALF = 128, HTB = HALF * BK * 2  , STAGE_BYTES = 8 * HTB, NXCD = 8, WGM = 8;

__host__ __device__ __forceinline__ int lds_byte(int r, int c) { const int st = (r >> 4) * 2 + (c >> 5), rr = r & 15, cc = c & 31, ob = rr * 64 + cc * 2; return st * 1024 + (ob ^ (((ob >> 9) & 1) << 5)); }
__host__ __device__ __forceinline__ void stage_rc(int b, int& R, int& C) { const int st = b / 1024, sb = b % 1024, swz = sb ^ (((sb >> 9) & 1) << 5); R = (st >> 1) * 16 + swz / 64; C = (st & 1) * 32 + (swz % 64) / 2; }
__host__ __device__ __forceinline__ int perm32(int rho) { const int n = rho >> 4, i = rho & 15; return 8 * (i >> 2) + 4 * n + (i & 3); }

struct Unit { int pm, pn; };
struct Gemm { const bf16_t* A; const bf16_t* Bt; int M, N, K; int kt; };

struct StaticOrder {
    int nM, nN, nwg, G, c;
    __host__ __device__ void init(int M, int N, int G_, int c_) { nM = M / BM; nN = N / BM; nwg = nM * nN; G = G_; c = c_; }
    __host__ __device__ bool next(int i, Unit& u) const {
        const long L = (long)i * G + c; if (L >= nwg) return false;
        int wgid = (int)L; { const int q = nwg / NXCD, r = nwg % NXCD, xcd = wgid % NXCD, off = wgid / NXCD; wgid = (xcd < r ? xcd * (q + 1) : r * (q + 1) + (xcd - r) * q) + off; }
        const int nig = WGM * nN, gid = wgid / nig, fm = gid * WGM, gsz = (nM - fm) < WGM ? (nM - fm) : WGM;
        u.pm = fm + ((wgid % nig) % gsz); u.pn = (wgid % nig) / gsz; return true;
    }
    __device__ __forceinline__ void a_ready(const Unit&) const {}
    __device__ __forceinline__ void done(const Unit&) const {}
};
__device__ __forceinline__ unsigned cvt_pk_bf16(float lo, float hi) { unsigned r; asm volatile("v_cvt_pk_bf16_f32 %0, %1, %2" : "=v"(r) : "v"(lo), "v"(hi)); return r; }
typedef float f32x2 __attribute__((ext_vector_type(2)));
typedef int pg8_v4i __attribute__((ext_vector_type(4))); typedef int pg8_v8i __attribute__((ext_vector_type(8)));
__device__ __forceinline__ pg8_v8i pg8_cat(bf16x8 a, bf16x8 b) { return __builtin_shufflevector(__builtin_bit_cast(pg8_v4i, a), __builtin_bit_cast(pg8_v4i, b), 0, 1, 2, 3, 4, 5, 6, 7); }
template <bool F8> struct pg8_frag; template <> struct pg8_frag<false> { bf16x8 v[2]; }; template <> struct pg8_frag<true> { pg8_v8i v; };
template <class Epi, class Sched, bool STAMP = false, bool F8 = false>
__device__ __forceinline__ void gemm_phase(PG8_LAS unsigned char* lds, const Gemm g, const Sched& S, const Epi& E, unsigned long long* stamps) {
    const int tid = threadIdx.x, wid = __builtin_amdgcn_readfirstlane(tid >> 6), lane = tid & 63, wr = wid >> 2, wc = wid & 3, fr = lane & 15, fq = lane >> 4;
    const int K = F8 ? (g.K >> 1) : g.K  , nt = g.kt ? g.kt : K / BK;
    int ts_lo = 0, ts_hi = 0, nts = 0; const unsigned long long rt_entry = STAMP ? (unsigned long long)wall_clock64() : 0ull;
#define PG8_STAMP() do { if (STAMP && wid == 0 && nts < 64) { const unsigned long long _c = (unsigned long long)clock64(); \
        ts_lo = (lane == nts) ? (int)(unsigned)_c : ts_lo; ts_hi = (lane == nts) ? (int)(unsigned)(_c >> 32) : ts_hi; ++nts; } } while (0)
    PG8_STAMP();
    unsigned voffA[2], voffB[2];
#pragma unroll
    for (int i = 0; i < 2; ++i) { int R, C; stage_rc(tid * 16 + i * 8192, R, C); const int Rb = Epi::PERM ? ((R & ~31) + perm32(R & 31)) : R;
        voffA[i] = (unsigned)(R * K + C) * 2u; voffB[i] = (unsigned)(Rb * K + C) * 2u; }
    const size_t kstep = (size_t)(BK * 2);
    const size_t hstep = (size_t)HALF * K * 2;
    const size_t tstep = 2 * hstep;
    const unsigned ldsw = (unsigned)wid * 1024u;
    const int aoff = lds_byte(wr * 64 + fr, fq * 8), boff = lds_byte(wc * 32 + fr, fq * 8);
#define PG8_SA(b, h) (((b) * 2 + (h)) * HTB)
#define PG8_SB(b, h) ((4 + (b) * 2 + (h)) * HTB)
#define PG8_STAGE(bufoff, gbase, voff) do { _Pragma("unroll") for (int _i = 0; _i < 2; ++_i) \
        __builtin_amdgcn_global_load_lds((const unsigned*)((const char*)(gbase) + (voff)[_i]), (PG8_LAS unsigned*)(lds + (bufoff) + ldsw + _i * 8192), 16, 0, 0); } while (0)
#define PG8_LDA(dst, b, h) do { _Pragma("unroll") for (int m = 0; m < 4; ++m) { const bf16x8 _l0 = *(const PG8_LAS bf16x8*)(lds + PG8_SA(b, h) + aoff + m * 2048), _l1 = *(const PG8_LAS bf16x8*)(lds + PG8_SA(b, h) + aoff + m * 2048 + 1024); \
        if constexpr (F8) dst[m].v = pg8_cat(_l0, _l1); else { dst[m].v[0] = _l0; dst[m].v[1] = _l1; } } } while (0)
#define PG8_LDB(dst, b, h) do { _Pragma("unroll") for (int n = 0; n < 2; ++n) { const bf16x8 _l0 = *(const PG8_LAS bf16x8*)(lds + PG8_SB(b, h) + boff + n * 2048), _l1 = *(const PG8_LAS bf16x8*)(lds + PG8_SB(b, h) + boff + n * 2048 + 1024); \
        if constexpr (F8) dst[n].v = pg8_cat(_l0, _l1); else { dst[n].v[0] = _l0; dst[n].v[1] = _l1; } } } while (0)
#define PG8_MMA(ai, bj, At, Bt) do { __builtin_amdgcn_s_setprio(1); _Pragma("unroll") for (int m = 0; m < 4; ++m) _Pragma("unroll") for (int n = 0; n < 2; ++n) { \
        if constexpr (F8) asm volatile("v_mfma_scale_f32_16x16x128_f8f6f4 %0, %1, %2, %0, %3, %3 op_sel_hi:[0,0,0]" : "+v"(acc[ai][bj][m][n]) : "v"(Bt[n].v), "v"(At[m].v), "v"(sc127)); \
        else { _Pragma("unroll") for (int k = 0; k < 2; ++k) acc[ai][bj][m][n] = __builtin_amdgcn_mfma_f32_16x16x32_bf16(Bt[n].v[k], At[m].v[k], acc[ai][bj][m][n], 0, 0, 0); } } __builtin_amdgcn_s_setprio(0); } while (0)
#define PG8_WAIT_V(n) asm volatile("s_waitcnt vmcnt(" #n ")" ::: "memory")
#define PG8_WAIT_L(n) asm volatile("s_waitcnt lgkmcnt(" #n ")" ::: "memory")
#define PG8_BAR __builtin_amdgcn_s_barrier()
#define PG8_SCHED __builtin_amdgcn_sched_barrier(0)
    Unit cur, nxt; int ui = 0;
    const int sc127 = 0x7f7f7f7f; (void)sc127;
    if (!S.next(0, cur)) return;
    f32x4 acc[2][2][4][2];
#pragma unroll
    for (int a = 0; a < 2; ++a)
#pragma unroll
        for (int b = 0; b < 2; ++b)
#pragma unroll
            for (int m = 0; m < 4; ++m)
#pragma unroll
                for (int n = 0; n < 2; ++n) acc[a][b][m][n] = (f32x4){0.f, 0.f, 0.f, 0.f};
    pg8_frag<F8> At[4], B0[2], B1[2];
    const char* cA = (const char*)g.A + (size_t)cur.pm * tstep; const char* cB = (const char*)g.Bt + (size_t)cur.pn * tstep;
    S.a_ready(cur);
    PG8_STAGE(PG8_SB(0, 0), cB, voffB); PG8_STAGE(PG8_SA(0, 0), cA, voffA); PG8_STAGE(PG8_SB(0, 1), cB + hstep, voffB); PG8_STAGE(PG8_SA(0, 1), cA + hstep, voffA);
    if (wr == 1) PG8_BAR;
    PG8_WAIT_V(4); PG8_BAR;
    PG8_STAGE(PG8_SB(1, 0), cB + kstep, voffB); PG8_STAGE(PG8_SA(1, 0), cA + kstep, voffA); PG8_STAGE(PG8_SB(1, 1), cB + hstep + kstep, voffB);
    PG8_WAIT_V(6); PG8_BAR;
    PG8_STAMP();
    for (;;) {
        const bool has_next = S.next(ui + 1, nxt);
        const char* nA = has_next ? (const char*)g.A + (size_t)nxt.pm * tstep : cA; const char* nB = has_next ? (const char*)g.Bt + (size_t)nxt.pn * tstep : cB;
        for (int t = 0; t < nt; t += 2) {
            const bool last = (t == nt - 2);
            const char* a1 = cA + (size_t)(t + 1) * kstep;
            const char* a2 = last ? nA : cA + (size_t)(t + 2) * kstep; const char* b2 = last ? nB : cB + (size_t)(t + 2) * kstep;
            const char* a3 = a2 + kstep; const char* b3 = b2 + kstep;
            if (last && has_next) S.a_ready(nxt);
            PG8_LDB(B0, 0, 0); PG8_SCHED; PG8_LDA(At, 0, 0); PG8_STAGE(PG8_SA(1, 1), a1 + hstep, voffA);
            PG8_WAIT_L(8); PG8_BAR; PG8_WAIT_L(0); PG8_MMA(0, 0, At, B0); PG8_BAR; PG8_SCHED;
            PG8_LDB(B1, 0, 1); PG8_STAGE(PG8_SB(0, 0), b2, voffB);
            PG8_BAR; PG8_WAIT_L(0); PG8_MMA(0, 1, At, B1); PG8_BAR;
            PG8_LDA(At, 0, 1); PG8_STAGE(PG8_SA(0, 0), a2, voffA);
            PG8_BAR; PG8_WAIT_L(0); PG8_MMA(1, 0, At, B0); PG8_BAR; PG8_SCHED;
            PG8_STAGE(PG8_SB(0, 1), b2 + hstep, voffB);
            PG8_WAIT_V(6); PG8_BAR; PG8_MMA(1, 1, At, B1); PG8_BAR;
            PG8_LDB(B0, 1, 0); PG8_SCHED; PG8_LDA(At, 1, 0); PG8_STAGE(PG8_SA(0, 1), a2 + hstep, voffA);
            PG8_WAIT_L(8); PG8_BAR; PG8_WAIT_L(0); PG8_MMA(0, 0, At, B0); PG8_BAR; PG8_SCHED;
            PG8_LDB(B1, 1, 1); PG8_STAGE(PG8_SB(1, 0), b3, voffB);
            PG8_BAR; PG8_WAIT_L(0); PG8_MMA(0, 1, At, B1); PG8_BAR;
            PG8_LDA(At, 1, 1); PG8_STAGE(PG8_SA(1, 0), a3, voffA);
            PG8_BAR; PG8_WAIT_L(0); PG8_MMA(1, 0, At, B0); PG8_BAR; PG8_SCHED;
            PG8_STAGE(PG8_SB(1, 1), b3 + hstep, voffB);
            PG8_WAIT_V(6); PG8_BAR; PG8_MMA(1, 1, At, B1); PG8_BAR;
        }
        PG8_STAMP();
        if constexpr (F8) {
            asm volatile("s_nop 15\n\ts_nop 15" ::: "memory");
#pragma unroll
            for (int a = 0; a < 2; ++a)
#pragma unroll
                for (int b = 0; b < 2; ++b)
#pragma unroll
                    for (int m = 0; m < 4; ++m) asm volatile("" : "+v"(acc[a][b][m][0]), "+v"(acc[a][b][m][1]));
        }
        if constexpr (!Epi::AFTER_DRAIN) { E(acc, cur, wr, wc, fr, fq); S.done(cur); }
        PG8_STAMP();
        if (!has_next) break;
#pragma unroll
        for (int a = 0; a < 2; ++a)
#pragma unroll
            for (int b = 0; b < 2; ++b)
#pragma unroll
                for (int m = 0; m < 4; ++m)
#pragma unroll
                    for (int n = 0; n < 2; ++n) acc[a][b][m][n] = (f32x4){0.f, 0.f, 0.f, 0.f};
        cur = nxt; cA = nA; cB = nB; ++ui;
    }
    PG8_WAIT_V(0);
    if (wr == 0) PG8_BAR;
    PG8_BAR;
    if constexpr (Epi::AFTER_DRAIN) { E.fused(acc, cur, wr, wc, fr, fq, lds, wid, lane); S.done(cur); }
    PG8_STAMP();
    if (STAMP && wid == 0) { stamps[lane] = lane < nts ? (((unsigned long long)(unsigned)ts_hi << 32) | (unsigned)ts_lo) : 0ull;
        if (lane == 62) stamps[62] = rt_entry; if (lane == 63) stamps[63] = (unsigned long long)wall_clock64(); }
#undef PG8_STAMP
#undef PG8_SA
#undef PG8_SB
#undef PG8_STAGE
#undef PG8_LDA
#undef PG8_LDB
#undef PG8_MMA
#undef PG8_WAIT_V
#undef PG8_WAIT_L
#undef PG8_BAR
#undef PG8_SCHED
}
}
#define XB_TMO      128
#define XB_XCNT(j)  (256  + 64 * (j))
#define XB_XSUB(j)  (1280 + 64 * (j))
#define XB_XGEN(j)  (2304 + 64 * (j))
#define XB_TOP      3328
#define XB_TOPGEN   3392
#define XCD_BAR_WORDS 3456
#define XB_SPIN_CAP (1u << 18)
#define LAS __attribute__((address_space(3)))

__device__ __forceinline__ unsigned xb_ld(unsigned* p)              { return __hip_atomic_load(p, __ATOMIC_RELAXED, __HIP_MEMORY_SCOPE_AGENT); }
__device__ __forceinline__ unsigned xb_add(unsigned* p, unsigned v) { return __hip_atomic_fetch_add(p, v, __ATOMIC_RELAXED, __HIP_MEMORY_SCOPE_AGENT); }
__device__ __forceinline__ unsigned xb_xcc_id() { return (unsigned)__builtin_amdgcn_s_getreg((3 << 11) | 20) & 0xFu; }
#define XB_SPIN(cond, bar) do { unsigned _sp = 0; while (cond) { __builtin_amdgcn_s_sleep(1); \
    if ((++_sp & 255u) == 0u) { if (xb_ld(&(bar)[XB_TMO])) break; if (_sp > XB_SPIN_CAP) { atomicAdd(&(bar)[XB_TMO], 1u); break; } } } } while (0)

struct XcdBarrier {
    unsigned* bar; unsigned x;
    volatile LAS unsigned* st;
};

__device__ __forceinline__ XcdBarrier xcd_barrier_post(unsigned* bar, volatile LAS unsigned* st) {
    XcdBarrier b; b.bar = bar; b.x = xb_xcc_id(); b.st = st;
    if (threadIdx.x == 0) (void)xb_add(&bar[XB_XCNT(b.x)], 1u);
    return b;
}
__device__ __forceinline__ void xcd_barrier_complete(unsigned* bar, unsigned x, unsigned& nloc, unsigned& nx) {
    const unsigned G = gridDim.x * gridDim.y * gridDim.z;
    unsigned sum, cnt, mine, sp = 0u;
    for (;;) {
        sum = 0u; cnt = 0u; mine = 0u;
#pragma unroll
        for (unsigned j = 0; j < 16; ++j) { const unsigned c = xb_ld(&bar[XB_XCNT(j)]); sum += c; cnt += (c > 0u) ? 1u : 0u; mine = (j == x) ? c : mine; }
        if (sum == G) break;
        __builtin_amdgcn_s_sleep(1);
        if ((++sp & 255u) == 0u) { if (xb_ld(&bar[XB_TMO])) break; if (sp > XB_SPIN_CAP) { atomicAdd(&bar[XB_TMO], 1u); break; } }
    }
    nloc = mine > 0u ? mine : 1u; nx = cnt > 0u ? cnt : 1u;
}

__device__ __forceinline__ void xcd_barrier(const XcdBarrier& b) {
    asm volatile("s_waitcnt vmcnt(0)" ::: "memory");
    __syncthreads();
    if (threadIdx.x == 0) {
        unsigned* bar = b.bar;
        __builtin_amdgcn_s_waitcnt(0);
        unsigned nloc = b.st[0], nx = b.st[1];
        if (nloc == 0u) { xcd_barrier_complete(bar, b.x, nloc, nx); b.st[0] = nloc; b.st[1] = nx; }
        const unsigned old = xb_add(&bar[XB_XSUB(b.x)], 1u);
        const unsigned gen = old / nloc;
        if (old + 1u == (gen + 1u) * nloc) {
            __builtin_amdgcn_fence(__ATOMIC_RELEASE, "agent");
            asm volatile("s_waitcnt vmcnt(0)" ::: "memory");
            const unsigned og = xb_add(&bar[XB_TOP], 1u);
            const unsigned tg = og / nx;
            if (og + 1u == (tg + 1u) * nx) xb_add(&bar[XB_TOPGEN], 1u);
            else XB_SPIN(xb_ld(&bar[XB_TOPGEN]) == tg, bar);
            __builtin_amdgcn_fence(__ATOMIC_ACQUIRE, "agent");
            xb_add(&bar[XB_XGEN(b.x)], 1u);
            asm volatile("s_waitcnt vmcnt(0)" ::: "memory");
        } else {
            XB_SPIN(xb_ld(&bar[XB_XGEN(b.x)]) == gen, bar);
            __builtin_amdgcn_fence(__ATOMIC_ACQUIRE, "agent");
            asm volatile("s_waitcnt vmcnt(0)" ::: "memory");
        }
    }
    __syncthreads();
}


#define LAS3 __attribute__((address_space(3)))
using pg8::bf16x8; using pg8::f32x4; using pg8::u32x4; using pg8::Unit;
constexpr int MK_THREADS = 512, MK_LDS_BYTES = 147456  , MK_LDS_BAR = MK_LDS_BYTES - 16;
constexpr int NPH = 16;

struct Params {
    const float* x; const float* gains; const float* a_w_in; const float* a_b_in; const float* a_norm_v; const float* a_w_s; const float* a_b_s; const float* a_w_out;
    const float* kv_norm; const float* w_kv; const float* w_q; const float* w_o; const float* ffn_w_gu; const float* ffn_w_down; const float* moe_router; const float* moe_w_gu; const float* moe_w_down;
    float* out; unsigned char* ws;
};

typedef __bf16 bf16x2_t __attribute__((ext_vector_type(2)));
__device__ __forceinline__ unsigned cvtpk(float lo, float hi) { const bf16x2_t v = {(__bf16)lo, (__bf16)hi}; return __builtin_bit_cast(unsigned, v); }
__device__ __forceinline__ float gelu_fast(float x) { const float t = x + 0.044715f * x * x * x; return x * __builtin_amdgcn_rcpf(1.0f + __builtin_amdgcn_exp2f(-2.3022081985f * t)); }
__device__ __forceinline__ float silu_fast(float x) { return x * __builtin_amdgcn_rcpf(1.0f + __builtin_amdgcn_exp2f(-1.4426950409f * x)); }
__device__ __forceinline__ f32x4 exp2_4(f32x4 a) { return (f32x4){__builtin_amdgcn_exp2f(a[0]), __builtin_amdgcn_exp2f(a[1]), __builtin_amdgcn_exp2f(a[2]), __builtin_amdgcn_exp2f(a[3])}; }
__device__ __forceinline__ f32x4 rcp_4(f32x4 a) { return (f32x4){__builtin_amdgcn_rcpf(a[0]), __builtin_amdgcn_rcpf(a[1]), __builtin_amdgcn_rcpf(a[2]), __builtin_amdgcn_rcpf(a[3])}; }
__device__ __forceinline__ f32x4 swiglu_4(f32x4 G, f32x4 U, float kexp, float kout) {
    const f32x4 r = rcp_4(exp2_4(G * kexp) + 1.0f); return (G * U) * (r * kout); }
__device__ __forceinline__ f32x4 gelu_4(f32x4 v) { const f32x4 t = (v * v * 0.044715f + 1.0f) * v; const f32x4 r = rcp_4(exp2_4(t * -2.3022081985f) + 1.0f); return v * r; }

constexpr float F8_SA1 = 16.f, F8_SW1 = 1024.f, F8_SA2 = 8.f, F8_SW2 = 2048.f;
__device__ __forceinline__ unsigned pack4_fp8(float a, float b, float c, float d) {
    a = __builtin_amdgcn_fmed3f(a, -448.f, 448.f); b = __builtin_amdgcn_fmed3f(b, -448.f, 448.f); c = __builtin_amdgcn_fmed3f(c, -448.f, 448.f); d = __builtin_amdgcn_fmed3f(d, -448.f, 448.f);
    int w = __builtin_amdgcn_cvt_pk_fp8_f32(a, b, 0, false); w = __builtin_amdgcn_cvt_pk_fp8_f32(c, d, w, true); return (unsigned)w; }
struct CTile { const float* src; bf16_t* dst; int N, K; int f8; float scale; };
constexpr int CT0 = 16 * 128, CT1 = CT0 + 32 * 32, CT2 = CT1 + 16 * 224, CT3 = CT2 + 56 * 32, CT4 = CT3 + 16 * 64, CT5 = CT4 + 16 * 96, CT6 = CT5 + 16 * 32, CT7 = CT6 + 8 * 16 * 224, CT8 = CT7 + 8 * 56 * 32;
__device__ __forceinline__ CTile conv_decode(const Params& p, int t) {
    const float* S; bf16_t* D; int K, N, inter = 0, tt, f8 = 0; float scale = 1.f;
    unsigned char* ws = p.ws;
    if (t < CT0)      { S = p.a_w_in;     D = (bf16_t*)(ws + OFF_WIN_T);  K = DM;  N = 2 * GH;  tt = t; }
    else if (t < CT1) { S = p.a_w_out;    D = (bf16_t*)(ws + OFF_WOUT_T); K = GH;  N = DM;      tt = t - CT0; }
    else if (t < CT2) { S = p.ffn_w_gu;   D = (bf16_t*)(ws + OFF_WGU_T);  K = DM;  N = 2 * DFF; tt = t - CT1; inter = 1; }
    else if (t < CT3) { S = p.ffn_w_down; D = (bf16_t*)(ws + OFF_WDN_T);  K = DFF; N = DM;      tt = t - CT2; }
    else if (t < CT4) { S = p.w_kv;       D = (bf16_t*)(ws + OFF_WKV_T);  K = DM;  N = NKV;     tt = t - CT3; }
    else if (t < CT5) { S = p.w_q;        D = (bf16_t*)(ws + OFF_WQ_T);   K = DM;  N = NQ;      tt = t - CT4; }
    else if (t < CT6) { S = p.w_o;        D = (bf16_t*)(ws + OFF_WO_T);   K = DM;  N = DM;      tt = t - CT5; }
    else if (t < CT7) { S = p.moe_w_gu;   D = (bf16_t*)(ws + OFF_MGU_T);  K = DM;  N = 2 * DFF; tt = t - CT6; inter = 1; f8 = 1; scale = F8_SW1; }
    else              { S = p.moe_w_down; D = (bf16_t*)(ws + OFF_MDN_T);  K = DFF; N = DM;      tt = t - CT7; f8 = 1; scale = F8_SW2; }
    const int KT = K >> 7, NT = N >> 6, per = KT * NT, b = tt / per, r = tt - b * per, kt = r / NT, nt = r - kt * NT, n0 = nt * 64;
    int drow = n0;
    if (inter) drow = n0 < DFF ? ((n0 >> 7) * 256 + (n0 & 127)) : (((n0 - DFF) >> 7) * 256 + 128 + ((n0 - DFF) & 127));
    CTile c; c.src = S + (size_t)b * K * N + (size_t)(kt * 128) * N + n0; c.N = N; c.K = K; c.f8 = f8; c.scale = scale;
    if (f8) c.dst = (bf16_t*)((unsigned char*)D + (size_t)b * N * K + (size_t)drow * K + kt * 128); else c.dst = D + (size_t)b * N * K + (size_t)drow * K + kt * 128;
    return c;
}
__device__ __forceinline__ void conv_to_lds(const CTile& c, const float4 (&r)[4], LAS3 unsigned* W, int n4, int kr) {
    if (c.f8) { const float sc = c.scale; LAS3 unsigned* w = W + (n4 * 4) * 33 + kr;
        w[0] = pack4_fp8(r[0].x * sc, r[1].x * sc, r[2].x * sc, r[3].x * sc); w[33] = pack4_fp8(r[0].y * sc, r[1].y * sc, r[2].y * sc, r[3].y * sc);
        w[66] = pack4_fp8(r[0].z * sc, r[1].z * sc, r[2].z * sc, r[3].z * sc); w[99] = pack4_fp8(r[0].w * sc, r[1].w * sc, r[2].w * sc, r[3].w * sc); }
    else {
#pragma unroll
        for (int i = 0; i < 2; ++i) { LAS3 unsigned* w = W + (n4 * 4) * 65 + kr + 32 * i;
            w[0] = cvtpk(r[2 * i].x, r[2 * i + 1].x); w[65] = cvtpk(r[2 * i].y, r[2 * i + 1].y); w[130] = cvtpk(r[2 * i].z, r[2 * i + 1].z); w[195] = cvtpk(r[2 * i].w, r[2 * i + 1].w); } }
}
__device__ __forceinline__ void conv_from_lds(const CTile& c, const LAS3 unsigned* W, int tid) {
    if (c.f8) { const int n = tid >> 3, kc = tid & 7; const LAS3 unsigned* q = W + n * 33 + kc * 4;
        uint4 w; w.x = q[0]; w.y = q[1]; w.z = q[2]; w.w = q[3]; __builtin_nontemporal_store((u32x4){w.x, w.y, w.z, w.w}, (u32x4*)((unsigned char*)c.dst + (size_t)n * c.K + kc * 16)); }
    else {
#pragma unroll
        for (int i = 0; i < 2; ++i) { const int it = tid + 512 * i, kc = it & 15, n = it >> 4; const LAS3 unsigned* q = W + n * 65 + kc * 4;
            uint4 w; w.x = q[0]; w.y = q[1]; w.z = q[2]; w.w = q[3]; __builtin_nontemporal_store((u32x4){w.x, w.y, w.z, w.w}, (u32x4*)(c.dst + (size_t)n * c.K + kc * 8)); } }
}
constexpr int CV_NT = 4;
__device__ __forceinline__ void phase_convert(const Params& p, LAS3 unsigned char* lds, int t0, int t1) {
    LAS3 unsigned* LT = (LAS3 unsigned*)lds;
    const int tid = threadIdx.x, n4 = tid & 15, kr = tid >> 4, G = (int)gridDim.x;
    int t = t0 + (int)blockIdx.x;
#define CONV_LOAD(T, R) do { _Pragma("unroll") for (int j = 0; j < 4; ++j) { const int row = (T).f8 ? 4 * kr + j : 2 * (kr + 32 * (j >> 1)) + (j & 1); { const f32x4 _v = __builtin_nontemporal_load((const f32x4*)((T).src + (size_t)row * (T).N + n4 * 4)); R[j] = make_float4(_v[0], _v[1], _v[2], _v[3]); } } } while (0)
    if (t < t1) {
        CTile c[CV_NT]; bool h[CV_NT]; float4 r[CV_NT][4];
#pragma unroll
        for (int q = 0; q < CV_NT; ++q) { h[q] = t + q * G < t1; c[q] = conv_decode(p, h[q] ? t + q * G : t); if (h[q]) CONV_LOAD(c[q], r[q]); }
        int buf = 0;
        for (;;) {
            LAS3 unsigned* W = LT + buf * (CV_NT * 4160);
#pragma unroll
            for (int q = 0; q < CV_NT; ++q) if (h[q]) conv_to_lds(c[q], r[q], W + q * 4160, n4, kr);
            const int tn = t + CV_NT * G; const bool has = tn < t1;
            CTile cn[CV_NT]; bool hn[CV_NT];
#pragma unroll
            for (int q = 0; q < CV_NT; ++q) { hn[q] = tn + q * G < t1; cn[q] = c[q]; if (hn[q]) { cn[q] = conv_decode(p, tn + q * G); CONV_LOAD(cn[q], r[q]); } }
            __syncthreads();
#pragma unroll
            for (int q = 0; q < CV_NT; ++q) if (h[q]) conv_from_lds(c[q], W + q * 4160, tid);
            if (!has) break;
#pragma unroll
            for (int q = 0; q < CV_NT; ++q) { c[q] = cn[q]; h[q] = hn[q]; }
            t = tn; buf ^= 1;
        }
    }
#undef CONV_LOAD
    __syncthreads();
}

__device__ __forceinline__ void row_norm0(const Params& p, int row, int lane) {
    const float* gain = p.gains; bf16_t* xn = (bf16_t*)(p.ws + OFF_XN);
    const float4* xr = (const float4*)(p.x + (size_t)row * DM); float4 v[8]; float ss = 0.f;
#pragma unroll
    for (int i = 0; i < 8; ++i) { v[i] = xr[lane + 64 * i]; ss += v[i].x * v[i].x + v[i].y * v[i].y + v[i].z * v[i].z + v[i].w * v[i].w; }
    ss = wave_sum(ss); const float rstd = rsqrtf(ss * (1.0f / DM) + EPS);
#pragma unroll
    for (int i = 0; i < 8; ++i) { const float4 gg = ((const float4*)gain)[lane + 64 * i];
        uint2 w; w.x = cvtpk(v[i].x * rstd * gg.x, v[i].y * rstd * gg.y); w.y = cvtpk(v[i].z * rstd * gg.z, v[i].w * rstd * gg.w);
        *(uint2*)(xn + (size_t)row * DM + (lane + 64 * i) * 4) = w; }
}

struct EpiGeluU {
    static constexpr bool PERM = true, AFTER_DRAIN = false;
    bf16_t* O; int ldc; const float* bias;
    __device__ __forceinline__ void operator()(const f32x4 (&acc)[2][2][4][2], const Unit& u, int wr, int wc, int fr, int fq) const {
        asm volatile("" : "+v"(fr), "+v"(fq));
        const int row0 = u.pm * 256 + wr * 64 + fr, col0 = u.pn * 256 + wc * 32 + 8 * fq;
        f32x4 bv[2][2];
#pragma unroll
        for (int bj = 0; bj < 2; ++bj)
#pragma unroll
            for (int n = 0; n < 2; ++n) bv[bj][n] = *(const f32x4*)(bias + col0 + bj * 128 + 4 * n);
#pragma unroll
        for (int ai = 0; ai < 2; ++ai)
#pragma unroll
            for (int m = 0; m < 4; ++m) { bf16_t* rowp = O + (size_t)(row0 + ai * 128 + m * 16) * ldc + col0;
#pragma unroll
                for (int bj = 0; bj < 2; ++bj) { const f32x4 v0 = acc[ai][bj][m][0] + bv[bj][0], v1 = acc[ai][bj][m][1] + bv[bj][1];
                    const f32x4 y0 = gelu_4(v0), y1 = gelu_4(v1);
                    u32x4 w; w.x = cvtpk(y0[0], y0[1]); w.y = cvtpk(y0[2], y0[3]); w.z = cvtpk(y1[0], y1[1]); w.w = cvtpk(y1[2], y1[3]);
                    *(u32x4*)(rowp + bj * 128) = w; } }
    }
};
struct EpiGeluVT {
    static constexpr bool PERM = true, AFTER_DRAIN = false;
    bf16_t* O; const float* bias; float* ssp;
    __device__ __forceinline__ void operator()(const f32x4 (&acc)[2][2][4][2], const Unit& u, int wr, int wc, int fr, int fq) const {
        asm volatile("" : "+v"(fr), "+v"(fq));
        const int row0 = u.pm * 256 + wr * 64 + fr, col0 = u.pn * 256 + wc * 32 + 8 * fq;
        f32x4 cs[2][2];
#pragma unroll
        for (int bj = 0; bj < 2; ++bj)
#pragma unroll
            for (int n = 0; n < 2; ++n) cs[bj][n] = (f32x4){0.f, 0.f, 0.f, 0.f};
#pragma unroll
        for (int ai = 0; ai < 2; ++ai)
#pragma unroll
            for (int m = 0; m < 4; ++m) { const int row = row0 + ai * 128 + m * 16; const float b = bias[row]; bf16_t* rowp = O + (size_t)row * NTOK + col0;
#pragma unroll
                for (int bj = 0; bj < 2; ++bj) { f32x4 v0 = acc[ai][bj][m][0] + b, v1 = acc[ai][bj][m][1] + b;
                    v0 = gelu_4(v0); v1 = gelu_4(v1);
                    cs[bj][0] += v0 * v0; cs[bj][1] += v1 * v1;
                    u32x4 w; w.x = cvtpk(v0[0], v0[1]); w.y = cvtpk(v0[2], v0[3]); w.z = cvtpk(v1[0], v1[1]); w.w = cvtpk(v1[2], v1[3]);
                    *(u32x4*)(rowp + bj * 128) = w; } }
        const int slot = u.pm * 2 + wr;
#pragma unroll
        for (int bj = 0; bj < 2; ++bj)
#pragma unroll
            for (int n = 0; n < 2; ++n)
#pragma unroll
                for (int j = 0; j < 4; ++j) { float s = cs[bj][n][j]; s += __shfl_xor(s, 1); s += __shfl_xor(s, 2); s += __shfl_xor(s, 4); s += __shfl_xor(s, 8);
                    if (fr == 0) ssp[(size_t)(col0 + bj * 128 + 4 * n + j) * SSP_N + slot] = s; }
    }
};
struct EpiF32SS {
    static constexpr bool PERM = false, AFTER_DRAIN = false;
    float* C; int ldc; float* ssp; int pnmod; float scale;
    __device__ __forceinline__ void operator()(const f32x4 (&acc)[2][2][4][2], const Unit& u, int wr, int wc, int fr, int fq) const {
        asm volatile("" : "+v"(fr), "+v"(fq));
        const int pnl = u.pn % pnmod; const int row0 = u.pm * 256 + wr * 64 + fr, col0 = pnl * 256 + wc * 32 + 4 * fq;
#pragma unroll
        for (int ai = 0; ai < 2; ++ai)
#pragma unroll
            for (int m = 0; m < 4; ++m) { const int row = row0 + ai * 128 + m * 16; float* rowp = C + (size_t)row * ldc + col0; float s = 0.f;
#pragma unroll
                for (int bj = 0; bj < 2; ++bj)
#pragma unroll
                    for (int n = 0; n < 2; ++n) { const f32x4 v = acc[ai][bj][m][n] * scale; *(f32x4*)(rowp + bj * 128 + n * 16) = v; s += (v[0] * v[0] + v[1] * v[1]) + (v[2] * v[2] + v[3] * v[3]); }
                if (ssp) { s += __shfl_xor(s, 16); s += __shfl_xor(s, 32); if (fq == 0) ssp[(size_t)row * SSP_N + pnl * 4 + wc] = s; } }
    }
};
struct EpiSwiglu {
    static constexpr bool PERM = true, AFTER_DRAIN = false;
    bf16_t* O; int ldc; int pnmod;
    __device__ __forceinline__ void operator()(const f32x4 (&acc)[2][2][4][2], const Unit& u, int wr, int wc, int fr, int fq) const {
        asm volatile("" : "+v"(fr), "+v"(fq));
        const int pnl = u.pn % pnmod; const int row0 = u.pm * 256 + wr * 64 + fr, col0 = pnl * 128 + wc * 32 + 8 * fq;
#pragma unroll
        for (int ai = 0; ai < 2; ++ai)
#pragma unroll
            for (int m = 0; m < 4; ++m) { bf16_t* rowp = O + (size_t)(row0 + ai * 128 + m * 16) * ldc + col0;
                const f32x4 o0 = swiglu_4(acc[ai][0][m][0], acc[ai][1][m][0], -1.4426950409f, 1.0f), o1 = swiglu_4(acc[ai][0][m][1], acc[ai][1][m][1], -1.4426950409f, 1.0f);
                u32x4 w; w.x = cvtpk(o0[0], o0[1]); w.y = cvtpk(o0[2], o0[3]); w.z = cvtpk(o1[0], o1[1]); w.w = cvtpk(o1[2], o1[3]);
                *(u32x4*)rowp = w; }
    }
};
struct EpiBf16P {
    static constexpr bool PERM = true, AFTER_DRAIN = false;
    bf16_t* O; int ldc;
    __device__ __forceinline__ void operator()(const f32x4 (&acc)[2][2][4][2], const Unit& u, int wr, int wc, int fr, int fq) const {
        asm volatile("" : "+v"(fr), "+v"(fq));
        const int row0 = u.pm * 256 + wr * 64 + fr, col0 = u.pn * 256 + wc * 32 + 8 * fq;
#pragma unroll
        for (int ai = 0; ai < 2; ++ai)
#pragma unroll
            for (int m = 0; m < 4; ++m) { bf16_t* rowp = O + (size_t)(row0 + ai * 128 + m * 16) * ldc + col0;
#pragma unroll
                for (int bj = 0; bj < 2; ++bj) { const f32x4 v0 = acc[ai][bj][m][0], v1 = acc[ai][bj][m][1];
                    u32x4 w; w.x = cvtpk(v0[0], v0[1]); w.y = cvtpk(v0[2], v0[3]); w.z = cvtpk(v1[0], v1[1]); w.w = cvtpk(v1[2], v1[3]);
                    *(u32x4*)(rowp + bj * 128) = w; } }
    }
};

struct EpiSwiglu8 {
    static constexpr bool PERM = true, AFTER_DRAIN = false;
    unsigned char* O; int ldc; int pnmod; float inv, oscale;
    __device__ __forceinline__ void operator()(const f32x4 (&acc)[2][2][4][2], const Unit& u, int wr, int wc, int fr, int fq) const {
        asm volatile("" : "+v"(fr), "+v"(fq));
        const int pnl = u.pn % pnmod; const int row0 = u.pm * 256 + wr * 64 + fr, col0 = pnl * 128 + wc * 32 + 8 * fq;
#pragma unroll
        for (int ai = 0; ai < 2; ++ai)
#pragma unroll
            for (int m = 0; m < 4; ++m) { unsigned char* rowp = O + (size_t)(row0 + ai * 128 + m * 16) * ldc + col0;
                const float kexp = -1.4426950409f * inv, kout = inv * inv * oscale;
                const f32x4 o0 = swiglu_4(acc[ai][0][m][0], acc[ai][1][m][0], kexp, kout), o1 = swiglu_4(acc[ai][0][m][1], acc[ai][1][m][1], kexp, kout);
                uint2 w; w.x = pack4_fp8(o0[0], o0[1], o0[2], o0[3]); w.y = pack4_fp8(o1[0], o1[1], o1[2], o1[3]);
                *(uint2*)rowp = w; }
    }
};

struct EpiBf16S {
    static constexpr bool PERM = true, AFTER_DRAIN = false;
    bf16_t* O; int ldc; int pnmod; float scale;
    __device__ __forceinline__ void operator()(const f32x4 (&acc)[2][2][4][2], const Unit& u, int wr, int wc, int fr, int fq) const {
        asm volatile("" : "+v"(fr), "+v"(fq));
        const int pnl = u.pn % pnmod; const int row0 = u.pm * 256 + wr * 64 + fr, col0 = pnl * 256 + wc * 32 + 8 * fq;
#pragma unroll
        for (int ai = 0; ai < 2; ++ai)
#pragma unroll
            for (int m = 0; m < 4; ++m) { bf16_t* rowp = O + (size_t)(row0 + ai * 128 + m * 16) * ldc + col0;
#pragma unroll
                for (int bj = 0; bj < 2; ++bj) { const f32x4 v0 = acc[ai][bj][m][0] * scale, v1 = acc[ai][bj][m][1] * scale;
                    u32x4 w; w.x = cvtpk(v0[0], v0[1]); w.y = cvtpk(v0[2], v0[3]); w.z = cvtpk(v1[0], v1[1]); w.w = cvtpk(v1[2], v1[3]);
                    *(u32x4*)(rowp + bj * 128) = w; } }
    }
};

struct EpiBf16H {
    static constexpr bool PERM = true, AFTER_DRAIN = false;
    bf16_t* O; int nrows;
    __device__ __forceinline__ void operator()(const f32x4 (&acc)[2][2][4][2], const Unit& u, int wr, int wc, int fr, int fq) const {
        asm volatile("" : "+v"(fr), "+v"(fq));
        const int row0 = u.pm * 256 + wr * 64 + fr, cin = wc * 32 + 8 * fq;
#pragma unroll
        for (int bj = 0; bj < 2; ++bj) { bf16_t* hp = O + (size_t)(u.pn * 2 + bj) * nrows * 128 + cin;
#pragma unroll
            for (int ai = 0; ai < 2; ++ai)
#pragma unroll
                for (int m = 0; m < 4; ++m) { const f32x4 v0 = acc[ai][bj][m][0], v1 = acc[ai][bj][m][1];
                    u32x4 w; w.x = cvtpk(v0[0], v0[1]); w.y = cvtpk(v0[2], v0[3]); w.z = cvtpk(v1[0], v1[1]); w.w = cvtpk(v1[2], v1[3]);
                    *(u32x4*)(hp + (size_t)(row0 + ai * 128 + m * 16) * 128) = w; } }
    }
};

struct EpiBf16SS {
    static constexpr bool PERM = true, AFTER_DRAIN = false;
    bf16_t* C; int ldc; float* ssp;
    __device__ __forceinline__ void operator()(const f32x4 (&acc)[2][2][4][2], const Unit& u, int wr, int wc, int fr, int fq) const {
        asm volatile("" : "+v"(fr), "+v"(fq));
        const int row0 = u.pm * 256 + wr * 64 + fr, col0 = u.pn * 256 + wc * 32 + 8 * fq;
#pragma unroll
        for (int ai = 0; ai < 2; ++ai)
#pragma unroll
            for (int m = 0; m < 4; ++m) { const int row = row0 + ai * 128 + m * 16; bf16_t* rowp = C + (size_t)row * ldc + col0; float s = 0.f;
#pragma unroll
                for (int bj = 0; bj < 2; ++bj) { const f32x4 v0 = acc[ai][bj][m][0], v1 = acc[ai][bj][m][1];
                    s += (v0[0] * v0[0] + v0[1] * v0[1]) + (v0[2] * v0[2] + v0[3] * v0[3]); s += (v1[0] * v1[0] + v1[1] * v1[1]) + (v1[2] * v1[2] + v1[3] * v1[3]);
                    u32x4 w; w.x = cvtpk(v0[0], v0[1]); w.y = cvtpk(v0[2], v0[3]); w.z = cvtpk(v1[0], v1[1]); w.w = cvtpk(v1[2], v1[3]);
                    *(u32x4*)(rowp + bj * 128) = w; }
                s += __shfl_xor(s, 16); s += __shfl_xor(s, 32); if (fq == 0) ssp[(size_t)row * SSP_N + u.pn * 4 + wc] = s; }
    }
};

__device__ __forceinline__ int ld_i(const int* p) { return __hip_atomic_load(p, __ATOMIC_RELAXED, __HIP_MEMORY_SCOPE_AGENT); }
__device__ __forceinline__ float ssp_sum32(const float* ssp, int row) {
    const f32x4* q = (const f32x4*)(ssp + (size_t)row * SSP_N); float t = 0.f;
#pragma unroll
    for (int i = 0; i < 8; ++i) { const f32x4 v = q[i]; t += v[0]; t += v[1]; t += v[2]; t += v[3]; }
    return t;
}

template <bool BF> __device__ __forceinline__ float4 ld4(const void* base, size_t idx4) {
    if constexpr (BF) { const uint2 w = ((const uint2*)base)[idx4]; return make_float4(bf2f(w.x & 0xffffu), bf2f(w.x >> 16), bf2f(w.y & 0xffffu), bf2f(w.y >> 16)); }
    else return ((const float4*)base)[idx4];
}
__device__ __forceinline__ void st4bf(bf16_t* base, size_t idx4, float4 v) { uint2 w; w.x = cvtpk(v.x, v.y); w.y = cvtpk(v.z, v.w); ((uint2*)base)[idx4] = w; }
struct RowIn { float4 b[8]; uint2 m[8]; };
template <bool BFBASE> __device__ __forceinline__ void row_load(RowIn& r, const void* base, const bf16_t* mix, int row, int lane) {
#pragma unroll
    for (int i = 0; i < 8; ++i) { const size_t o = (size_t)row * (DM / 4) + lane + 64 * i; r.b[i] = ld4<BFBASE>(base, o); r.m[i] = ((const uint2*)mix)[o]; }
}
__device__ __forceinline__ void row_resnorm_c(const RowIn& r, const float* ssp, const float* g_post, bf16_t* hout, const float* g1, bf16_t* xn1, const float* g2, bf16_t* xn2, int row, int lane) {
    const float rm = rsqrtf(ssp_sum32(ssp, row) * (1.0f / DM) + EPS);
    float4 h[8]; float ss = 0.f;
#pragma unroll
    for (int i = 0; i < 8; ++i) { const size_t o = (size_t)row * (DM / 4) + lane + 64 * i; const float4 b = r.b[i], gp = ((const float4*)g_post)[lane + 64 * i];
        const float4 m = make_float4(bf2f(r.m[i].x & 0xffffu), bf2f(r.m[i].x >> 16), bf2f(r.m[i].y & 0xffffu), bf2f(r.m[i].y >> 16));
        h[i].x = b.x + m.x * rm * gp.x; h[i].y = b.y + m.y * rm * gp.y; h[i].z = b.z + m.z * rm * gp.z; h[i].w = b.w + m.w * rm * gp.w;
        st4bf(hout, o, h[i]); ss += h[i].x * h[i].x + h[i].y * h[i].y + h[i].z * h[i].z + h[i].w * h[i].w; }
    ss = wave_sum(ss); const float rstd = rsqrtf(ss * (1.0f / DM) + EPS);
#pragma unroll
    for (int i = 0; i < 8; ++i) { const float4 gg = ((const float4*)g1)[lane + 64 * i];
        uint2 w; w.x = cvtpk(h[i].x * rstd * gg.x, h[i].y * rstd * gg.y); w.y = cvtpk(h[i].z * rstd * gg.z, h[i].w * rstd * gg.w);
        *(uint2*)(xn1 + (size_t)row * DM + (lane + 64 * i) * 4) = w;
        if (xn2) { const float4 g2v = ((const float4*)g2)[lane + 64 * i];
            uint2 w2; w2.x = cvtpk(h[i].x * rstd * g2v.x, h[i].y * rstd * g2v.y); w2.y = cvtpk(h[i].z * rstd * g2v.z, h[i].w * rstd * g2v.w);
            *(uint2*)(xn2 + (size_t)row * DM + (lane + 64 * i) * 4) = w2; } }
}
template <bool BFBASE> __device__ __forceinline__ void phase_resnorm(const void* base, const bf16_t* mix, const float* ssp, const float* g_post, bf16_t* hout, const float* g1, bf16_t* xn1, const float* g2, bf16_t* xn2, int wave, int lane, int G) {
    int row = blockIdx.x * 8 + wave; if (row >= NTOK) return;
    RowIn cur, nxt; row_load<BFBASE>(cur, base, mix, row, lane);
    for (;;) { const int nrow = row + G * 8; const bool has = nrow < NTOK;
        if (has) row_load<BFBASE>(nxt, base, mix, nrow, lane);
        row_resnorm_c(cur, ssp, g_post, hout, g1, xn1, g2, xn2, row, lane);
        if (!has) break; cur = nxt; row = nrow; }
}
__device__ __forceinline__ void row_router(const bf16_t* base, const bf16_t* mix, const float* ssp, const float* g_post, bf16_t* hout, const float* g_pre, const LAS3 float* wT  , unsigned char* xs8,
                                           int* counts, int* tok_s, float* tok_g, int row, int lane) {
    const float rm = rsqrtf(ssp_sum32(ssp, row) * (1.0f / DM) + EPS);
    float4 h[8]; float ss = 0.f;
#pragma unroll
    for (int i = 0; i < 8; ++i) { const size_t o = (size_t)row * (DM / 4) + lane + 64 * i; const float4 b = ld4<true>(base, o), m = ld4<true>(mix, o), gp = ((const float4*)g_post)[lane + 64 * i];
        h[i].x = b.x + m.x * rm * gp.x; h[i].y = b.y + m.y * rm * gp.y; h[i].z = b.z + m.z * rm * gp.z; h[i].w = b.w + m.w * rm * gp.w;
        st4bf(hout, o, h[i]); ss += h[i].x * h[i].x + h[i].y * h[i].y + h[i].z * h[i].z + h[i].w * h[i].w;
        if (i & 1) asm volatile("" ::: "memory"); }
    ss = wave_sum(ss); const float rstd = rsqrtf(ss * (1.0f / DM) + EPS);
    float lg[8]; unsigned q8[8];
#pragma unroll
    for (int e = 0; e < 8; ++e) lg[e] = 0.f;
#pragma unroll
    for (int i = 0; i < 8; ++i) { const float4 gg = ((const float4*)g_pre)[lane + 64 * i];
        const float n0 = h[i].x * rstd * gg.x, n1 = h[i].y * rstd * gg.y, n2 = h[i].z * rstd * gg.z, n3 = h[i].w * rstd * gg.w;
        q8[i] = pack4_fp8(n0 * F8_SA1, n1 * F8_SA1, n2 * F8_SA1, n3 * F8_SA1); asm volatile("" : "+v"(q8[i]));
        const int k = (lane + 64 * i) * 4;
#pragma unroll
        for (int e = 0; e < 8; ++e) { const f32x4 w = *(const LAS3 f32x4*)(wT + e * DM + k); lg[e] = fmaf(n0, w[0], lg[e]); lg[e] = fmaf(n1, w[1], lg[e]); lg[e] = fmaf(n2, w[2], lg[e]); lg[e] = fmaf(n3, w[3], lg[e]); }
        asm volatile("" ::: "memory"); }
#pragma unroll
    for (int e = 0; e < 8; ++e) lg[e] = wave_sum(lg[e]);
    int s1 = 0, s2 = 0;
    if (lane == 0) {
        int e1 = 0; float v1 = lg[0];
#pragma unroll
        for (int e = 1; e < 8; ++e) if (lg[e] > v1) { v1 = lg[e]; e1 = e; }
        int e2 = 0; float v2 = -3.0e38f;
#pragma unroll
        for (int e = 0; e < 8; ++e) if (e != e1 && lg[e] > v2) { v2 = lg[e]; e2 = e; }
        const float p2 = __expf(v2 - v1), inv = 1.0f / (1.0f + p2);
        s1 = e1 * ECAP + atomicAdd(&counts[e1], 1); s2 = e2 * ECAP + atomicAdd(&counts[e2], 1);
        tok_s[row * 2] = s1; tok_s[row * 2 + 1] = s2; tok_g[row * 2] = inv; tok_g[row * 2 + 1] = p2 * inv;
    }
    s1 = __builtin_amdgcn_readfirstlane(s1); s2 = __builtin_amdgcn_readfirstlane(s2);
    unsigned* d1 = (unsigned*)(xs8 + (size_t)s1 * DM); unsigned* d2 = (unsigned*)(xs8 + (size_t)s2 * DM);
#pragma unroll
    for (int i = 0; i < 8; ++i) { d1[lane + 64 * i] = q8[i]; d2[lane + 64 * i] = q8[i]; }
}
constexpr int KSPLIT = 4, C_TFLAG = 8192;
__device__ __forceinline__ void row_final(const bf16_t* h3, const bf16_t* Y, const float* Yp, const int* tflag, const int* tok_s, const float* tok_g, const float* gain, float* out, int row, int lane) {
    const int s1 = tok_s[row * 2], s2 = tok_s[row * 2 + 1]; const float g1 = tok_g[row * 2], g2 = tok_g[row * 2 + 1];
    float4 f[8]; float ss = 0.f;
#pragma unroll
    for (int i = 0; i < 8; ++i) {
        float4 a, b;
        { const int fl = tflag[(s1 >> 8) * 8 + i];
          if (fl == 0) { const uint2 w = ((const uint2*)(Y + (size_t)s1 * DM))[lane + 64 * i]; a = make_float4(bf2f(w.x & 0xffffu), bf2f(w.x >> 16), bf2f(w.y & 0xffffu), bf2f(w.y >> 16)); }
          else { const float4* q = (const float4*)(Yp + ((size_t)(fl - 1) * KSPLIT) * 65536 + (size_t)(s1 & 255) * 256) + lane; a = q[0];
#pragma unroll
              for (int k = 1; k < KSPLIT; ++k) { const float4 t = q[(size_t)k * 16384]; a.x += t.x; a.y += t.y; a.z += t.z; a.w += t.w; } } }
        { const int fl = tflag[(s2 >> 8) * 8 + i];
          if (fl == 0) { const uint2 w = ((const uint2*)(Y + (size_t)s2 * DM))[lane + 64 * i]; b = make_float4(bf2f(w.x & 0xffffu), bf2f(w.x >> 16), bf2f(w.y & 0xffffu), bf2f(w.y >> 16)); }
          else { const float4* q = (const float4*)(Yp + ((size_t)(fl - 1) * KSPLIT) * 65536 + (size_t)(s2 & 255) * 256) + lane; b = q[0];
#pragma unroll
              for (int k = 1; k < KSPLIT; ++k) { const float4 t = q[(size_t)k * 16384]; b.x += t.x; b.y += t.y; b.z += t.z; b.w += t.w; } } }
        f[i].x = a.x * g1 + b.x * g2; f[i].y = a.y * g1 + b.y * g2; f[i].z = a.z * g1 + b.z * g2; f[i].w = a.w * g1 + b.w * g2;
        ss += f[i].x * f[i].x + f[i].y * f[i].y + f[i].z * f[i].z + f[i].w * f[i].w; }
    ss = wave_sum(ss); const float rstd = rsqrtf(ss * (1.0f / DM) + EPS);
#pragma unroll
    for (int i = 0; i < 8; ++i) { const size_t o = (size_t)row * (DM / 4) + lane + 64 * i; const float4 b = ld4<true>(h3, o), gg = ((const float4*)gain)[lane + 64 * i]; float4 r;
        r.x = b.x + f[i].x * rstd * gg.x; r.y = b.y + f[i].y * rstd * gg.y; r.z = b.z + f[i].z * rstd * gg.z; r.w = b.w + f[i].w * rstd * gg.w; ((float4*)out)[o] = r; }
}
constexpr int MOE_TBL_OFF = 131072;
struct MoeOrder : pg8::StaticOrder {
    const LAS3 int* tbl; int NT; int lim;
    __device__ __forceinline__ bool next(int i, Unit& u) const { if ((long)i * G + c >= lim) return false; if (!pg8::StaticOrder::next(i, u)) return false;
        const int v = tbl[u.pm]; u.pm = v & 0xffff; u.pn += (v >> 16) * NT; return true; }
};
__device__ __forceinline__ int moe_table(const int* counts, LAS3 unsigned char* lds) {
    LAS3 int* tbl = (LAS3 int*)(lds + MOE_TBL_OFF); const int t = threadIdx.x; int q = 0, mine = -1;
#pragma unroll
    for (int e = 0; e < NEXP; ++e) { const int nb = (ld_i(counts + e) + 255) >> 8; if (t >= q && t < q + nb) mine = (e << 16) | (e * (ECAP / 256) + (t - q)); q += nb; }
    if (mine >= 0) tbl[t] = mine;
    __syncthreads();
    return q;
}

struct LeftOrder : pg8::StaticOrder {
    const LAS3 int* tbl; int NT; int L;
    __device__ __forceinline__ bool next(int i, Unit& u) const { if (i != 0 || L < 0) return false;
        pg8::StaticOrder t = *this; t.c = L; if (!t.pg8::StaticOrder::next(0, u)) return false;
        const int v = tbl[u.pm]; u.pm = v & 0xffff; u.pn += (v >> 16) * NT; return true; }
};
struct EpiF32Part {
    static constexpr bool PERM = false, AFTER_DRAIN = false;
    float* P; float scale; int* tflag; int li; int pnmod; int mark;
    __device__ __forceinline__ void operator()(const f32x4 (&acc)[2][2][4][2], const Unit& u, int wr, int wc, int fr, int fq) const {
        asm volatile("" : "+v"(fr), "+v"(fq));
        if (mark && threadIdx.x == 0) tflag[u.pm * 8 + (u.pn % pnmod)] = li + 1;
        const int r0 = wr * 64 + fr, c0 = wc * 32 + 4 * fq;
#pragma unroll
        for (int ai = 0; ai < 2; ++ai)
#pragma unroll
            for (int m = 0; m < 4; ++m) { float* rowp = P + (size_t)(r0 + ai * 128 + m * 16) * 256 + c0;
#pragma unroll
                for (int bj = 0; bj < 2; ++bj)
#pragma unroll
                    for (int n = 0; n < 2; ++n) *(f32x4*)(rowp + bj * 128 + n * 16) = acc[ai][bj][m][n] * scale; }
    }
};

__device__ __forceinline__ void stage_router(const float* wr, LAS3 unsigned char* lds) {
    LAS3 float* wT = (LAS3 float*)lds; const int t = threadIdx.x; float4 v[8];
#pragma unroll
    for (int j = 0; j < 8; ++j) v[j] = ((const float4*)(wr + (size_t)t * 32))[j];
    const float a[32] = {v[0].x, v[0].y, v[0].z, v[0].w, v[1].x, v[1].y, v[1].z, v[1].w, v[2].x, v[2].y, v[2].z, v[2].w, v[3].x, v[3].y, v[3].z, v[3].w,
                         v[4].x, v[4].y, v[4].z, v[4].w, v[5].x, v[5].y, v[5].z, v[5].w, v[6].x, v[6].y, v[6].z, v[6].w, v[7].x, v[7].y, v[7].z, v[7].w};
#pragma unroll
    for (int e = 0; e < 8; ++e) *(LAS3 f32x4*)(wT + e * DM + t * 4) = (f32x4){a[e], a[8 + e], a[16 + e], a[24 + e]};
    __syncthreads();
}

__device__ __forceinline__ void phase_sgu(const Params& p, LAS3 unsigned char* lds) {
    const int tid = threadIdx.x, lane = tid & 63, wave = __builtin_amdgcn_readfirstlane(tid >> 6), fr = lane & 15, fq = lane >> 4;
    unsigned char* ws = p.ws;
    const bf16_t* U = (const bf16_t*)(ws + OFF_U); const bf16_t* VT = (const bf16_t*)(ws + OFF_VT); bf16_t* GT = (bf16_t*)(ws + OFF_GT); const float* SSP = (const float*)(ws + OFF_SSP);
    LAS3 float* rs = (LAS3 float*)(lds + 36864);
    for (int unit = blockIdx.x; unit < 512; unit += (int)gridDim.x) {
        const int ch = unit >> 3, g = unit & 7;
        __syncthreads();
        if (tid < 128) rs[tid] = rsqrtf(ssp_sum32(SSP, ch * 128 + tid) * (1.0f / GH) + EPS);
        bf16x8 bfrag[4][4];
#pragma unroll
        for (int n = 0; n < 4; ++n) { const int chrow = g * 512 + wave * 64 + (n >> 1) * 32 + 8 * (fr >> 2) + 4 * (n & 1) + (fr & 3);
#pragma unroll
            for (int ks = 0; ks < 4; ++ks) bfrag[n][ks] = *(const bf16x8*)(VT + (size_t)chrow * NTOK + ch * 128 + ks * 32 + fq * 8); }
        __syncthreads();
        { const int t = tid >> 2, s0 = (tid & 3) * 32; const float* wp = p.a_w_s + ((size_t)g * 128 + t) * 128 + s0;
#pragma unroll
          for (int q = 0; q < 4; ++q) { const float4 a = *(const float4*)(wp + q * 8), b = *(const float4*)(wp + q * 8 + 4); float v[8] = {a.x, a.y, a.z, a.w, b.x, b.y, b.z, b.w};
#pragma unroll
              for (int j = 0; j < 8; ++j) { const int s = s0 + q * 8 + j; v[j] = (s <= t) ? v[j] * rs[s] : 0.f; }
              u32x4 w; w.x = cvtpk(v[0], v[1]); w.y = cvtpk(v[2], v[3]); w.z = cvtpk(v[4], v[5]); w.w = cvtpk(v[6], v[7]);
              *(LAS3 u32x4*)(lds + t * 272 + (s0 + q * 8) * 2) = w; } }
        __syncthreads();
#pragma unroll
        for (int mt = 0; mt < 8; ++mt) {
            f32x4 acc[4];
#pragma unroll
            for (int n = 0; n < 4; ++n) acc[n] = (f32x4){0.f, 0.f, 0.f, 0.f};
            const int nks = (16 * mt + 15) / 32 + 1;
#pragma unroll
            for (int ks = 0; ks < 4; ++ks) if (ks < nks) { const bf16x8 a = *(const LAS3 bf16x8*)(lds + (16 * mt + fr) * 272 + (ks * 32 + fq * 8) * 2);
#pragma unroll
                for (int n = 0; n < 4; ++n) acc[n] = __builtin_amdgcn_mfma_f32_16x16x32_bf16(bfrag[n][ks], a, acc[n], 0, 0, 0); }
            const int tl = 16 * mt + fr, tok = ch * 128 + tl; const float b = p.a_b_s[g * 128 + tl];
#pragma unroll
            for (int pp = 0; pp < 2; ++pp) { const int c0 = g * 512 + wave * 64 + pp * 32 + 8 * fq;
                const u32x4 uu = *(const u32x4*)(U + (size_t)tok * GH + c0); const f32x4 g0 = *(const f32x4*)(p.a_norm_v + c0), g1 = *(const f32x4*)(p.a_norm_v + c0 + 4);
                const f32x4 a0 = acc[2 * pp], a1 = acc[2 * pp + 1];
                u32x4 w;
                w.x = cvtpk(bf2f(uu.x & 0xffffu) * (g0[0] * a0[0] + b), bf2f(uu.x >> 16) * (g0[1] * a0[1] + b));
                w.y = cvtpk(bf2f(uu.y & 0xffffu) * (g0[2] * a0[2] + b), bf2f(uu.y >> 16) * (g0[3] * a0[3] + b));
                w.z = cvtpk(bf2f(uu.z & 0xffffu) * (g1[0] * a1[0] + b), bf2f(uu.z >> 16) * (g1[1] * a1[1] + b));
                w.w = cvtpk(bf2f(uu.w & 0xffffu) * (g1[2] * a1[2] + b), bf2f(uu.w >> 16) * (g1[3] * a1[3] + b));
                *(u32x4*)(GT + (size_t)tok * GH + c0) = w; }
        }
    }
    __syncthreads();
}

constexpr int AT_KP = 272, AT_VP = 288, AT_VOFF = 256 * AT_KP, AT_UNITS = 3072;
typedef short s16x4 __attribute__((ext_vector_type(4)));
struct AtUnit { int gi, b, h, r, n, dsh; };
__device__ __forceinline__ AtUnit at_decode(int unit) { AtUnit u; u.gi = unit >> 10; const int rem = unit & 1023; u.b = rem >> 8; u.h = (rem >> 4) & 15; const int rn = rem & 15;
    u.dsh = 2 * u.gi; const int nbsh = 4 - u.dsh; u.r = rn >> nbsh; u.n = rn & ((1 << nbsh) - 1); return u; }
#define AT_TR4(o0, o1, o2, o3, f0, f1, f2, f3) asm volatile("ds_read_b64_tr_b16 %0, %4 offset:%5\n\tds_read_b64_tr_b16 %1, %4 offset:%6\n\tds_read_b64_tr_b16 %2, %4 offset:%7\n\tds_read_b64_tr_b16 %3, %4 offset:%8" \
        : "=&v"(o0), "=&v"(o1), "=&v"(o2), "=&v"(o3) : "v"(vrow), "i"(f0), "i"(f1), "i"(f2), "i"(f3) : "memory")
__device__ __forceinline__ void phase_attn(const Params& p, LAS3 unsigned char* lds) {
    const int tid = threadIdx.x, lane = tid & 63, wave = __builtin_amdgcn_readfirstlane(tid >> 6), fr = lane & 15, fq = lane >> 4, G = (int)gridDim.x;
    unsigned char* ws = p.ws;
    const bf16_t* Q = (const bf16_t*)(ws + OFF_Q); const bf16_t* KV = (const bf16_t*)(ws + OFF_KV); bf16_t* OG = (bf16_t*)(ws + OFF_OG); float* LSE = (float*)(ws + OFF_LSE);
    const unsigned vbase = (unsigned)(size_t)(lds + AT_VOFF);
    const unsigned vrow = vbase + (unsigned)((16 * wave + 4 * fq + ((lane & 15) >> 2)) * AT_VP + (lane & 3) * 8);
    const int srow = tid >> 4, c16 = tid & 15;
    int unit = blockIdx.x;
    if (unit < AT_UNITS) {
        AtUnit cu = at_decode(unit);
        u32x4 kreg[8], vreg[8]; bf16x8 qf[4], qn[4];
#define AT_LOADQ(U, D) do { const int _tok = (U).b * SEQ + ((((U).n << 7) + wave * 16 + fr) << (U).dsh) + (U).r; _Pragma("unroll") for (int ks = 0; ks < 4; ++ks) D[ks] = *(const bf16x8*)(Q + (size_t)_tok * NQ + (U).gi * 2048 + (U).h * 128 + ks * 32 + fq * 8); } while (0)
#define AT_LOAD(U) do { _Pragma("unroll") for (int ps = 0; ps < 8; ++ps) if ((U).n > 0 || ps >= 4) { const int lk = ((U).n - 1) * 128 + ps * 32 + srow; \
            const bf16_t* src = KV + ((size_t)(U).h * NTOK + (U).b * SEQ + (lk << (U).dsh) + (U).r) * 128 + c16 * 8; kreg[ps] = *(const u32x4*)src; vreg[ps] = *(const u32x4*)(src + (size_t)16 * NTOK * 128); } } while (0)
        AT_LOAD(cu); AT_LOADQ(cu, qn);
        for (;;) {
            asm volatile("" ::: "memory"); __builtin_amdgcn_s_barrier(); asm volatile("" ::: "memory");
#pragma unroll
            for (int ps = 0; ps < 8; ++ps) if (cu.n > 0 || ps >= 4) { const int kk = ps * 32 + srow;
                *(LAS3 u32x4*)(lds + kk * AT_KP + c16 * 16) = kreg[ps]; *(LAS3 u32x4*)(lds + AT_VOFF + kk * AT_VP + c16 * 16) = vreg[ps]; }
            const int jq = wave * 16 + fr, qtok = cu.b * SEQ + (((cu.n << 7) + jq) << cu.dsh) + cu.r;
#pragma unroll
            for (int ks = 0; ks < 4; ++ks) qf[ks] = qn[ks];
            const int un = unit + G; const bool hasn = un < AT_UNITS; AtUnit nu = cu;
            if (hasn) { nu = at_decode(un); AT_LOAD(nu); AT_LOADQ(nu, qn); }
            asm volatile("s_waitcnt lgkmcnt(0)" ::: "memory"); __builtin_amdgcn_s_barrier(); asm volatile("" ::: "memory");
            const int c_lo = cu.n == 0 ? (8 - wave) : 0;
            f32x4 sc[9];
#pragma unroll
            for (int c = 0; c < 9; ++c) { sc[c] = (f32x4){0.f, 0.f, 0.f, 0.f};
                if (c >= c_lo) {
#pragma unroll
                    for (int ks = 0; ks < 4; ++ks) { const bf16x8 kf = *(const LAS3 bf16x8*)(lds + (16 * (wave + c) + fr) * AT_KP + (ks * 32 + fq * 8) * 2);
                        sc[c] = __builtin_amdgcn_mfma_f32_16x16x32_bf16(kf, qf[ks], sc[c], 0, 0, 0); } } }
            const float slope2 = exp2f(-0.5f * (float)(cu.h + 1)) * 1.4426950409f; const int dq = fr - 4 * fq; const float t0 = slope2 * (float)(128 + dq); float mx = -3.0e38f;
#pragma unroll
            for (int c = 0; c < 9; ++c) {
                if (c >= c_lo) {
#pragma unroll
                    for (int q = 0; q < 4; ++q) { float s2 = fmaf(sc[c][q], 0.08838834764831845f * 1.4426950409f, fmaf(slope2, (float)(16 * c + q), -t0));
                        if (c == 0) s2 = (dq - q <= 0) ? s2 : -3.0e38f;
                        if (c == 8) s2 = (dq - q >= 0) ? s2 : -3.0e38f;
                        sc[c][q] = s2; mx = fmaxf(mx, s2); }
                } else { sc[c] = (f32x4){-3.0e38f, -3.0e38f, -3.0e38f, -3.0e38f}; } }
            mx = fmaxf(mx, __shfl_xor(mx, 16)); mx = fmaxf(mx, __shfl_xor(mx, 32));
            float den = 0.f;
#pragma unroll
            for (int c = 0; c < 9; ++c) {
                if (c >= c_lo) {
#pragma unroll
                    for (int q = 0; q < 4; ++q) { const float e = __builtin_amdgcn_exp2f(sc[c][q] - mx); sc[c][q] = e; den += e; }
                } else { sc[c] = (f32x4){0.f, 0.f, 0.f, 0.f}; } }
            den += __shfl_xor(den, 16); den += __shfl_xor(den, 32);
            f32x4 o[8];
#pragma unroll
            for (int et = 0; et < 8; ++et) o[et] = (f32x4){0.f, 0.f, 0.f, 0.f};
#pragma unroll
            for (int pp = 0; pp < 5; ++pp) {
                if (2 * pp + 1 >= c_lo) {
                    u32x4 pw; pw.x = cvtpk(sc[2 * pp][0], sc[2 * pp][1]); pw.y = cvtpk(sc[2 * pp][2], sc[2 * pp][3]);
                    if (pp < 4) { pw.z = cvtpk(sc[2 * pp + 1][0], sc[2 * pp + 1][1]); pw.w = cvtpk(sc[2 * pp + 1][2], sc[2 * pp + 1][3]); } else { pw.z = 0u; pw.w = 0u; }
                    const bf16x8 pf = __builtin_bit_cast(bf16x8, pw);
                    constexpr int R1 = 16 * AT_VP;
                    const int r0 = (32 * pp) * AT_VP, r1 = (pp < 4 ? (32 * pp + 16) : (32 * pp)) * AT_VP; (void)R1;
                    s16x4 a0, a1, a2, a3, a4, a5, a6, a7, b0, b1, b2, b3, b4, b5, b6, b7;
                    AT_TR4(a0, a1, a2, a3, r0, r0 + 32, r0 + 64, r0 + 96); AT_TR4(a4, a5, a6, a7, r0 + 128, r0 + 160, r0 + 192, r0 + 224);
                    AT_TR4(b0, b1, b2, b3, r1, r1 + 32, r1 + 64, r1 + 96); AT_TR4(b4, b5, b6, b7, r1 + 128, r1 + 160, r1 + 192, r1 + 224);
                    asm volatile("s_waitcnt lgkmcnt(0)" : "+v"(a0), "+v"(a1), "+v"(a2), "+v"(a3), "+v"(a4), "+v"(a5), "+v"(a6), "+v"(a7), "+v"(b0), "+v"(b1), "+v"(b2), "+v"(b3), "+v"(b4), "+v"(b5), "+v"(b6), "+v"(b7) :: "memory");
                    if (2 * pp < c_lo) { const s16x4 z = {0, 0, 0, 0}; a0 = z; a1 = z; a2 = z; a3 = z; a4 = z; a5 = z; a6 = z; a7 = z; }
#define AT_PV(et, A, B) o[et] = __builtin_amdgcn_mfma_f32_16x16x32_bf16((bf16x8){A[0], A[1], A[2], A[3], B[0], B[1], B[2], B[3]}, pf, o[et], 0, 0, 0)
                    AT_PV(0, a0, b0); AT_PV(1, a1, b1); AT_PV(2, a2, b2); AT_PV(3, a3, b3); AT_PV(4, a4, b4); AT_PV(5, a5, b5); AT_PV(6, a6, b6); AT_PV(7, a7, b7);
#undef AT_PV
                } }
            const float inv = 1.0f / den;
            bf16_t* op = OG + ((size_t)cu.gi * NTOK + qtok) * DM + cu.h * 128 + 4 * fq;
#pragma unroll
            for (int et = 0; et < 8; ++et) { uint2 w; w.x = cvtpk(o[et][0] * inv, o[et][1] * inv); w.y = cvtpk(o[et][2] * inv, o[et][3] * inv); *(uint2*)(op + et * 16) = w; }
            if (fq == 0) LSE[((size_t)cu.gi * NTOK + qtok) * 16 + cu.h] = (mx + __log2f(den)) * 0.6931471806f;
            if (!hasn) break;
            unit = un; cu = nu;
        }
#undef AT_LOAD
#undef AT_LOADQ
    }
    __syncthreads();
}
#undef AT_TR4

__device__ __forceinline__ void phase_merge(const Params& p) {
    unsigned char* ws = p.ws; const bf16_t* OG = (const bf16_t*)(ws + OFF_OG); const float* LSE = (const float*)(ws + OFF_LSE); bf16_t* OM = (bf16_t*)(ws + OFF_OM);
    for (size_t i = (size_t)blockIdx.x * MK_THREADS + threadIdx.x; i < (size_t)NTOK * 256; i += (size_t)gridDim.x * MK_THREADS) {
        const int tok = (int)(i >> 8), c8 = (int)(i & 255), h = c8 >> 4;
        const float l0 = LSE[((size_t)0 * NTOK + tok) * 16 + h], l1 = LSE[((size_t)1 * NTOK + tok) * 16 + h], l2 = LSE[((size_t)2 * NTOK + tok) * 16 + h];
        const float m = fmaxf(l0, fmaxf(l1, l2)); const float a0 = __expf(l0 - m), a1 = __expf(l1 - m), a2 = __expf(l2 - m), inv = 1.0f / (a0 + a1 + a2);
        const uint4 x0 = *(const uint4*)(OG + ((size_t)0 * NTOK + tok) * DM + c8 * 8), x1 = *(const uint4*)(OG + ((size_t)1 * NTOK + tok) * DM + c8 * 8), x2 = *(const uint4*)(OG + ((size_t)2 * NTOK + tok) * DM + c8 * 8);
        const unsigned w0[4] = {x0.x, x0.y, x0.z, x0.w}, w1[4] = {x1.x, x1.y, x1.z, x1.w}, w2[4] = {x2.x, x2.y, x2.z, x2.w}; unsigned rr[4];
#pragma unroll
        for (int j = 0; j < 4; ++j) { const float lo = (a0 * bf2f(w0[j] & 0xffffu) + a1 * bf2f(w1[j] & 0xffffu) + a2 * bf2f(w2[j] & 0xffffu)) * inv;
            const float hi = (a0 * bf2f(w0[j] >> 16) + a1 * bf2f(w1[j] >> 16) + a2 * bf2f(w2[j] >> 16)) * inv; rr[j] = cvtpk(lo, hi); }
        *(uint4*)(OM + (size_t)tok * DM + c8 * 8) = make_uint4(rr[0], rr[1], rr[2], rr[3]);
    }
}
#define PHASE2_BODY phase_sgu(p, lds);
#define PHASE9_BODY phase_attn(p, lds);
#define PHASE10_BODY phase_merge(p);

__global__ void __launch_bounds__(MK_THREADS, 2) mega(Params p, int lo, int hi) {
    extern __shared__ __attribute__((aligned(16))) unsigned char shm[];
    LAS3 unsigned char* lds = (LAS3 unsigned char*)shm;
    const int tid = threadIdx.x, wave = __builtin_amdgcn_readfirstlane(tid >> 6), G = (int)gridDim.x;
#define MK_LANE() ((int)__builtin_amdgcn_mbcnt_hi(~0u, __builtin_amdgcn_mbcnt_lo(~0u, 0u)))
    unsigned char* ws = p.ws;
    volatile LAS3 unsigned* xbw = (volatile LAS3 unsigned*)(lds + MK_LDS_BAR);
    if (tid < 4) xbw[tid] = 0u;
    __syncthreads();
    XcdBarrier bar; bar.bar = (unsigned*)(ws + OFF_CTRL + CTRL_BAR_BYTE); bar.x = 0; bar.st = xbw;
    if (hi - lo > 1) bar = xcd_barrier_post((unsigned*)(ws + OFF_CTRL + CTRL_BAR_BYTE), xbw);
#define IN(k) (lo <= (k) && (k) < hi)
#define SEAM(k) do { if (IN(k) && IN((k) + 1)) xcd_barrier(bar); } while (0)
    float* SSP = (float*)(ws + OFF_SSP);
    bf16_t* XN = (bf16_t*)(ws + OFF_XN); bf16_t* XNQ = (bf16_t*)(ws + OFF_XNQ);
    bf16_t* MIX = (bf16_t*)(ws + OFF_MIX); bf16_t* H1 = (bf16_t*)(ws + OFF_H1); bf16_t* H2 = (bf16_t*)(ws + OFF_H2); bf16_t* H3 = (bf16_t*)(ws + OFF_H3);
    int* ictrl = (int*)(ws + OFF_CTRL);
    const float* gains = p.gains;

    constexpr int CR0 = CT1, CR1 = 12800, CR3 = 17408, CR5 = 34304, CR6 = 42496, CR8 = CT8;
    static_assert(CR1 >= CT6, "every dense weight is converted by the end of P1");
    const bool conv_first = (blockIdx.x & 1) == 0;
    if (IN(0)) {
        phase_convert(p, lds, 0, CR0);
        { const int lane = MK_LANE(); for (int row = blockIdx.x * 8 + wave; row < NTOK; row += G * 8) row_norm0(p, row, lane); }
    }
    SEAM(0);
    if (IN(1)) {
        if (conv_first) phase_convert(p, lds, CR0, CR1);
        { pg8::Gemm g{XN, (const bf16_t*)(ws + OFF_WIN_T), NTOK, GH, DM}; pg8::StaticOrder S; S.init(NTOK, GH, G, (int)blockIdx.x);
          EpiGeluU E{(bf16_t*)(ws + OFF_U), GH, p.a_b_in};
          pg8::gemm_phase<EpiGeluU, pg8::StaticOrder>(lds, g, S, E, nullptr); }
        { pg8::Gemm g{(const bf16_t*)(ws + OFF_WIN_T) + (size_t)GH * DM, XN, GH, NTOK, DM}; pg8::StaticOrder S; S.init(GH, NTOK, G, (int)blockIdx.x);
          EpiGeluVT E{(bf16_t*)(ws + OFF_VT), p.a_b_in + GH, SSP};
          pg8::gemm_phase<EpiGeluVT, pg8::StaticOrder>(lds, g, S, E, nullptr); }
        if (!conv_first) phase_convert(p, lds, CR0, CR1);
    }
    SEAM(1);
    if (IN(2)) { PHASE2_BODY }
    SEAM(2);
    if (IN(3)) {
        if (conv_first) phase_convert(p, lds, CR1, CR3);
        pg8::Gemm g{(const bf16_t*)(ws + OFF_GT), (const bf16_t*)(ws + OFF_WOUT_T), NTOK, DM, GH}; pg8::StaticOrder S; S.init(NTOK, DM, G, (int)blockIdx.x);
        EpiBf16SS E{MIX, DM, SSP};
        pg8::gemm_phase<EpiBf16SS, pg8::StaticOrder>(lds, g, S, E, nullptr);
        if (!conv_first) phase_convert(p, lds, CR1, CR3);
    }
    SEAM(3);
    if (IN(4)) { phase_resnorm<false>(p.x, MIX, SSP, gains + DM, H1, gains + 2 * DM, XN, nullptr, nullptr, wave, MK_LANE(), G); }
    SEAM(4);
    if (IN(5)) {
        if (conv_first) phase_convert(p, lds, CR3, CR5);
        pg8::Gemm g{XN, (const bf16_t*)(ws + OFF_WGU_T), NTOK, 2 * DFF, DM}; pg8::StaticOrder S; S.init(NTOK, 2 * DFF, G, (int)blockIdx.x);
        EpiSwiglu E{(bf16_t*)(ws + OFF_ACT), DFF, 56};
        pg8::gemm_phase<EpiSwiglu, pg8::StaticOrder>(lds, g, S, E, nullptr);
        if (!conv_first) phase_convert(p, lds, CR3, CR5);
    }
    SEAM(5);
    if (IN(6)) {
        if (conv_first) phase_convert(p, lds, CR5, CR6);
        pg8::Gemm g{(const bf16_t*)(ws + OFF_ACT), (const bf16_t*)(ws + OFF_WDN_T), NTOK, DM, DFF}; pg8::StaticOrder S; S.init(NTOK, DM, G, (int)blockIdx.x);
        EpiBf16SS E{MIX, DM, SSP};
        pg8::gemm_phase<EpiBf16SS, pg8::StaticOrder>(lds, g, S, E, nullptr);
        if (!conv_first) phase_convert(p, lds, CR5, CR6);
    }
    SEAM(6);
    if (IN(7)) { phase_resnorm<true>(H1, MIX, SSP, gains + 3 * DM, H2, p.kv_norm, XN, gains + 4 * DM, XNQ, wave, MK_LANE(), G); }
    SEAM(7);
    if (IN(8)) {
        if (conv_first) phase_convert(p, lds, CR6, CR8);
        { pg8::Gemm g{XN, (const bf16_t*)(ws + OFF_WKV_T), NTOK, NKV, DM}; pg8::StaticOrder S; S.init(NTOK, NKV, G, (int)blockIdx.x);
          EpiBf16H E{(bf16_t*)(ws + OFF_KV), NTOK};
          pg8::gemm_phase<EpiBf16H, pg8::StaticOrder>(lds, g, S, E, nullptr); }
        { pg8::Gemm g{XNQ, (const bf16_t*)(ws + OFF_WQ_T), NTOK, NQ, DM}; pg8::StaticOrder S; S.init(NTOK, NQ, G, (int)blockIdx.x);
          EpiBf16P E{(bf16_t*)(ws + OFF_Q), NQ};
          pg8::gemm_phase<EpiBf16P, pg8::StaticOrder>(lds, g, S, E, nullptr); }
        if (!conv_first) phase_convert(p, lds, CR6, CR8);
    }
    SEAM(8);
    if (IN(9)) { PHASE9_BODY }
    SEAM(9);
    if (IN(10)) { PHASE10_BODY }
    SEAM(10);
    if (IN(11)) {
        pg8::Gemm g{(const bf16_t*)(ws + OFF_OM), (const bf16_t*)(ws + OFF_WO_T), NTOK, DM, DM}; pg8::StaticOrder S; S.init(NTOK, DM, G, (int)blockIdx.x);
        EpiBf16SS E{MIX, DM, SSP};
        pg8::gemm_phase<EpiBf16SS, pg8::StaticOrder>(lds, g, S, E, nullptr);
    }
    SEAM(11);
    if (IN(12)) { stage_router(p.moe_router, lds); const int lane = MK_LANE(); for (int row = blockIdx.x * 8 + wave; row < NTOK; row += G * 8) { int ln = lane; asm volatile("" : "+v"(ln));
        row_router(H2, MIX, SSP, gains + 5 * DM, H3, gains + 6 * DM, (const LAS3 float*)lds, ws + OFF_XS, ictrl + C_CNT, (int*)(ws + OFF_TOKS), (float*)(ws + OFF_TOKG), row, ln); } }
    SEAM(12);
    if (IN(13)) {
        const int nblk = moe_table(ictrl + C_CNT, lds);
        pg8::Gemm g{(const bf16_t*)(ws + OFF_XS), (const bf16_t*)(ws + OFF_MGU_T), nblk * 256, 2 * DFF, DM}; MoeOrder S; S.init(nblk * 256, 2 * DFF, G, (int)blockIdx.x); S.tbl = (const LAS3 int*)(lds + MOE_TBL_OFF); S.NT = 56; S.lim = 0x7fffffff;
        EpiSwiglu8 E{ws + OFF_ACT2, DFF, 56, 1.0f / (F8_SA1 * F8_SW1), F8_SA2};
        pg8::gemm_phase<EpiSwiglu8, MoeOrder, false, true>(lds, g, S, E, nullptr);
    }
    SEAM(13);
    if (IN(14)) {
        const int nblk = moe_table(ictrl + C_CNT, lds); const int nunits = nblk * 8; int lim = 2 * G < nunits ? 2 * G : nunits; if ((nunits - lim) * KSPLIT > G) lim = nunits;
        { pg8::Gemm g{(const bf16_t*)(ws + OFF_ACT2), (const bf16_t*)(ws + OFF_MDN_T), nblk * 256, DM, DFF}; MoeOrder S; S.init(nblk * 256, DM, G, (int)blockIdx.x); S.tbl = (const LAS3 int*)(lds + MOE_TBL_OFF); S.NT = 8; S.lim = lim;
          EpiBf16S E{(bf16_t*)(ws + OFF_Y), DM, 8, 1.0f / (F8_SA2 * F8_SW2)};
          pg8::gemm_phase<EpiBf16S, MoeOrder, false, true>(lds, g, S, E, nullptr); }
        { const int nleft = nunits - lim, item = (int)blockIdx.x, li = item / KSPLIT, ch = item - li * KSPLIT;
          constexpr int CKT = DFF / 128 / KSPLIT;
          pg8::Gemm g{(const bf16_t*)(ws + OFF_ACT2 + (size_t)ch * CKT * 128), (const bf16_t*)(ws + OFF_MDN_T + (size_t)ch * CKT * 128), nblk * 256, DM, DFF, CKT};
          LeftOrder S; S.init(nblk * 256, DM, G, 0); S.tbl = (const LAS3 int*)(lds + MOE_TBL_OFF); S.NT = 8; S.L = li < nleft ? lim + li : -1;
          EpiF32Part E{(float*)(ws + OFF_U) + ((size_t)li * KSPLIT + ch) * 65536, 1.0f / (F8_SA2 * F8_SW2), ictrl + C_TFLAG, li, 8, ch == 0};
          pg8::gemm_phase<EpiF32Part, LeftOrder, false, true>(lds, g, S, E, nullptr); }
    }
    SEAM(14);
    if (IN(15)) { const int lane = MK_LANE(); for (int row = blockIdx.x * 8 + wave; row < NTOK; row += G * 8)
        row_final(H3, (const bf16_t*)(ws + OFF_Y), (const float*)(ws + OFF_U)  , ictrl + C_TFLAG, (const int*)(ws + OFF_TOKS), (const float*)(ws + OFF_TOKG), gains + 7 * DM, p.out, row, lane); }
#undef IN
#undef SEAM
}

extern "C" void kernel_launch(void* const* d_in, const int* in_sizes, int n_in, void* d_out, int out_size, void* d_ws, size_t ws_size, hipStream_t stream) {
    (void)in_sizes; (void)n_in; (void)out_size;
    if (ws_size < WS_NEED) { fprintf(stderr, "workspace too small: %zu < %zu\n", ws_size, (size_t)WS_NEED); return; }
    static int grid = 0;
    if (grid == 0) {
        int dev = 0, cus = 0, per_cu = 0;
        if (hipGetDevice(&dev) != hipSuccess || hipDeviceGetAttribute(&cus, hipDeviceAttributeMultiprocessorCount, dev) != hipSuccess) { fprintf(stderr, "device query failed\n"); grid = -1; return; }
        if (hipFuncSetAttribute((const void*)mega, hipFuncAttributeMaxDynamicSharedMemorySize, MK_LDS_BYTES) != hipSuccess) { fprintf(stderr, "hipFuncSetAttribute failed\n"); grid = -1; return; }
        if (hipOccupancyMaxActiveBlocksPerMultiprocessor(&per_cu, (const void*)mega, MK_THREADS, MK_LDS_BYTES) != hipSuccess || per_cu < 1) { fprintf(stderr, "occupancy query: %d blocks per CU\n", per_cu); (void)hipGetLastError(); }
        grid = cus;
    }
    if (grid < 0) return;
    const float* const* in = (const float* const*)d_in;
    Params P{};
    P.x = in[0]; P.gains = in[1]; P.a_w_in = in[2]; P.a_b_in = in[3]; P.a_norm_v = in[4]; P.a_w_s = in[5]; P.a_b_s = in[6]; P.a_w_out = in[7]; P.kv_norm = in[8]; P.w_kv = in[9]; P.w_q = in[10]; P.w_o = in[11];
    P.ffn_w_gu = in[12]; P.ffn_w_down = in[13]; P.moe_router = in[14]; P.moe_w_gu = in[15]; P.moe_w_down = in[16]; P.out = (float*)d_out; P.ws = (unsigned char*)d_ws;
#define MEGA(lo, hi) hipLaunchKernelGGL(mega, dim3(grid), dim3(MK_THREADS), MK_LDS_BYTES, stream, P, (lo), (hi))

    (void)hipMemsetAsync((char*)d_ws + OFF_CTRL, 0, CTRL_BYTES, stream);
    MEGA(0, NPH);
}
```

```cpp
#include <hip/hip_runtime.h>
#include <stdint.h>
#include <stdio.h>

typedef unsigned short bf16_t;

constexpr int NTOK = 8192, DM = 2048, SEQ = 2048, GH = 4096  , DFF = 7168, NEXP = 8;
constexpr int NQ = 6144, NKV = 4096;
constexpr int ECAP = NTOK, MAXSLOT = NEXP * ECAP;
constexpr float EPS = 1e-6f;

constexpr size_t AL(size_t x) { return (x + 255) & ~(size_t)255; }
constexpr size_t OFF_CTRL = 0;
constexpr size_t CTRL_BYTES = 1 << 16;
constexpr int C_CNT = 0  ;
constexpr int SSP_N = 64;
constexpr size_t OFF_SSP  = AL(OFF_CTRL + CTRL_BYTES);
constexpr size_t OFF_XN   = AL(OFF_SSP + (size_t)NTOK * SSP_N * 4);
constexpr size_t OFF_XNQ  = AL(OFF_XN + (size_t)NTOK * DM * 2);
constexpr size_t OFF_U    = AL(OFF_XNQ + (size_t)NTOK * DM * 2);
constexpr size_t OFF_VT   = AL(OFF_U + (size_t)NTOK * GH * 2);
constexpr size_t OFF_GT   = AL(OFF_VT + (size_t)NTOK * GH * 2);
constexpr size_t OFF_MIX  = AL(OFF_GT + (size_t)NTOK * GH * 2);
constexpr size_t OFF_H1   = AL(OFF_MIX + (size_t)NTOK * DM * 4);
constexpr size_t OFF_H2   = AL(OFF_H1 + (size_t)NTOK * DM * 4);
constexpr size_t OFF_H3   = AL(OFF_H2 + (size_t)NTOK * DM * 4);
constexpr size_t OFF_ACT  = AL(OFF_H3 + (size_t)NTOK * DM * 4);
constexpr size_t OFF_KV   = AL(OFF_ACT + (size_t)NTOK * DFF * 2);
constexpr size_t OFF_Q    = AL(OFF_KV + (size_t)NTOK * NKV * 2);
constexpr size_t OFF_OG   = AL(OFF_Q + (size_t)NTOK * NQ * 2);
constexpr size_t OFF_LSE  = AL(OFF_OG + (size_t)3 * NTOK * DM * 2);
constexpr size_t OFF_OM   = AL(OFF_LSE + (size_t)3 * NTOK * 16 * 4);
constexpr size_t OFF_TOKG = AL(OFF_OM + (size_t)NTOK * DM * 2);
constexpr size_t OFF_TOKS = AL(OFF_TOKG + (size_t)NTOK * 2 * 4);
constexpr size_t OFF_XS   = AL(OFF_TOKS + (size_t)NTOK * 2 * 4);
constexpr size_t OFF_ACT2 = AL(OFF_XS + (size_t)MAXSLOT * DM);
constexpr size_t OFF_Y    = AL(OFF_ACT2 + (size_t)MAXSLOT * DFF);
constexpr size_t OFF_WIN_T  = AL(OFF_Y + (size_t)MAXSLOT * DM * 2);
constexpr size_t OFF_WOUT_T = AL(OFF_WIN_T + (size_t)2 * GH * DM * 2);
constexpr size_t OFF_WGU_T  = AL(OFF_WOUT_T + (size_t)DM * GH * 2);
constexpr size_t OFF_WDN_T  = AL(OFF_WGU_T + (size_t)2 * DFF * DM * 2);
constexpr size_t OFF_WKV_T  = AL(OFF_WDN_T + (size_t)DM * DFF * 2);
constexpr size_t OFF_WQ_T   = AL(OFF_WKV_T + (size_t)NKV * DM * 2);
constexpr size_t OFF_WO_T   = AL(OFF_WQ_T + (size_t)NQ * DM * 2);
constexpr size_t OFF_MGU_T  = AL(OFF_WO_T + (size_t)DM * DM * 2);
constexpr size_t OFF_MDN_T  = AL(OFF_MGU_T + (size_t)NEXP * 2 * DFF * DM);
constexpr size_t WS_NEED  = AL(OFF_MDN_T + (size_t)NEXP * DM * DFF);
constexpr size_t CTRL_BAR_BYTE = 4096;

__device__ __forceinline__ float bf2f(unsigned v) { return __uint_as_float(v << 16); }
__device__ __forceinline__ bf16_t f2bf(float f) { unsigned u = __float_as_uint(f); u += 0x7FFFu + ((u >> 16) & 1u); return (bf16_t)(u >> 16); }
__device__ __forceinline__ unsigned pack2(float lo, float hi) { return (unsigned)f2bf(lo) | ((unsigned)f2bf(hi) << 16); }
__device__ __forceinline__ float gelu_tanh(float x) { const float t = 1.5957691216057308f * (x + 0.044715f * x * x * x); return x / (1.0f + __expf(-t)); }
__device__ __forceinline__ float silu(float x) { return x / (1.0f + __expf(-x)); }
__device__ __forceinline__ float wave_sum(float v) { for (int o = 32; o >= 1; o >>= 1) v += __shfl_xor(v, o); return v; }
__device__ __forceinline__ float wave_max(float v) { for (int o = 32; o >= 1; o >>= 1) v = fmaxf(v, __shfl_xor(v, o)); return v; }

namespace pg8 {
#define PG8_LAS __attribute__((address_space(3)))
typedef unsigned short bf16_t;
typedef short bf16x8 __attribute__((ext_vector_type(8)));
typedef float f32x4 __attribute__((ext_vector_type(4)));
typedef unsigned u32x4 __attribute__((ext_vector_type(4)));
constexpr int BM = 256, BK = 64, HALF = 128, HTB = HALF * BK * 2  , STAGE_BYTES = 8 * HTB, NXCD = 8, WGM = 8;

__host__ __device__ __forceinline__ int lds_byte(int r, int c) { const int st = (r >> 4) * 2 + (c >> 5), rr = r & 15, cc = c & 31, ob = rr * 64 + cc * 2; return st * 1024 + (ob ^ (((ob >> 9) & 1) << 5)); }
__host__ __device__ __forceinline__ void stage_rc(int b, int& R, int& C) { const int st = b / 1024, sb = b % 1024, swz = sb ^ (((sb >> 9) & 1) << 5); R = (st >> 1) * 16 + swz / 64; C = (st & 1) * 32 + (swz % 64) / 2; }
__host__ __device__ __forceinline__ int perm32(int rho) { const int n = rho >> 4, i = rho & 15; return 8 * (i >> 2) + 4 * n + (i & 3); }

struct Unit { int pm, pn; };
struct Gemm { const bf16_t* A; const bf16_t* Bt; int M, N, K; int kt; };

struct StaticOrder {
    int nM, nN, nwg, G, c;
    __host__ __device__ void init(int M, int N, int G_, int c_) { nM = M / BM; nN = N / BM; nwg = nM * nN; G = G_; c = c_; }
    __host__ __device__ bool next(int i, Unit& u) const {
        const long L = (long)i * G + c; if (L >= nwg) return false;
        int wgid = (int)L; { const int q = nwg / NXCD, r = nwg % NXCD, xcd = wgid % NXCD, off = wgid / NXCD; wgid = (xcd < r ? xcd * (q + 1) : r * (q + 1) + (xcd - r) * q) + off; }
        const int nig = WGM * nN, gid = wgid / nig, fm = gid * WGM, gsz = (nM - fm) < WGM ? (nM - fm) : WGM;
        u.pm = fm + ((wgid % nig) % gsz); u.pn = (wgid % nig) / gsz; return true;
    }
    __device__ __forceinline__ void a_ready(const Unit&) const {}
    __device__ __forceinline__ void done(const Unit&) const {}
};
__device__ __forceinline__ unsigned cvt_pk_bf16(float lo, float hi) { unsigned r; asm volatile("v_cvt_pk_bf16_f32 %0, %1, %2" : "=v"(r) : "v"(lo), "v"(hi)); return r; }
typedef float f32x2 __attribute__((ext_vector_type(2)));
typedef int pg8_v4i __attribute__((ext_vector_type(4))); typedef int pg8_v8i __attribute__((ext_vector_type(8)));
__device__ __forceinline__ pg8_v8i pg8_cat(bf16x8 a, bf16x8 b) { return __builtin_shufflevector(__builtin_bit_cast(pg8_v4i, a), __builtin_bit_cast(pg8_v4i, b), 0, 1, 2, 3, 4, 5, 6, 7); }
template <bool F8> struct pg8_frag; template <> struct pg8_frag<false> { bf16x8 v[2]; }; template <> struct pg8_frag<true> { pg8_v8i v; };
template <class Epi, class Sched, bool STAMP = false, bool F8 = false>
__device__ __forceinline__ void gemm_phase(PG8_LAS unsigned char* lds, const Gemm g, const Sched& S, const Epi& E, unsigned long long* stamps) {
    const int tid = threadIdx.x, wid = __builtin_amdgcn_readfirstlane(tid >> 6), lane = tid & 63, wr = wid >> 2, wc = wid & 3, fr = lane & 15, fq = lane >> 4;
    const int K = F8 ? (g.K >> 1) : g.K  , nt = g.kt ? g.kt : K / BK;
    int ts_lo = 0, ts_hi = 0, nts = 0; const unsigned long long rt_entry = STAMP ? (unsigned long long)wall_clock64() : 0ull;
#define PG8_STAMP() do { if (STAMP && wid == 0 && nts < 64) { const unsigned long long _c = (unsigned long long)clock64(); \
        ts_lo = (lane == nts) ? (int)(unsigned)_c : ts_lo; ts_hi = (lane == nts) ? (int)(unsigned)(_c >> 32) : ts_hi; ++nts; } } while (0)
    PG8_STAMP();
    unsigned voffA[2], voffB[2];
#pragma unroll
    for (int i = 0; i < 2; ++i) { int R, C; stage_rc(tid * 16 + i * 8192, R, C); const int Rb = Epi::PERM ? ((R & ~31) + perm32(R & 31)) : R;
        voffA[i] = (unsigned)(R * K + C) * 2u; voffB[i] = (unsigned)(Rb * K + C) * 2u; }
    const size_t kstep = (size_t)(BK * 2);
    const size_t hstep = (size_t)HALF * K * 2;
    const size_t tstep = 2 * hstep;
    const unsigned ldsw = (unsigned)wid * 1024u;
    const int aoff = lds_byte(wr * 64 + fr, fq * 8), boff = lds_byte(wc * 32 + fr, fq * 8);
#define PG8_SA(b, h) (((b) * 2 + (h)) * HTB)
#define PG8_SB(b, h) ((4 + (b) * 2 + (h)) * HTB)
#define PG8_STAGE(bufoff, gbase, voff) do { _Pragma("unroll") for (int _i = 0; _i < 2; ++_i) \
        __builtin_amdgcn_global_load_lds((const unsigned*)((const char*)(gbase) + (voff)[_i]), (PG8_LAS unsigned*)(lds + (bufoff) + ldsw + _i * 8192), 16, 0, 0); } while (0)
#define PG8_LDA(dst, b, h) do { _Pragma("unroll") for (int m = 0; m < 4; ++m) { const bf16x8 _l0 = *(const PG8_LAS bf16x8*)(lds + PG8_SA(b, h) + aoff + m * 2048), _l1 = *(const PG8_LAS bf16x8*)(lds + PG8_SA(b, h) + aoff + m * 2048 + 1024); \
        if constexpr (F8) dst[m].v = pg8_cat(_l0, _l1); else { dst[m].v[0] = _l0; dst[m].v[1] = _l1; } } } while (0)
#define PG8_LDB(dst, b, h) do { _Pragma("unroll") for (int n = 0; n < 2; ++n) { const bf16x8 _l0 = *(const PG8_LAS bf16x8*)(lds + PG8_SB(b, h) + boff + n * 2048), _l1 = *(const PG8_LAS bf16x8*)(lds + PG8_SB(b, h) + boff + n * 2048 + 1024); \
        if constexpr (F8) dst[n].v = pg8_cat(_l0, _l1); else { dst[n].v[0] = _l0; dst[n].v[1] = _l1; } } } while (0)
#define PG8_MMA(ai, bj, At, Bt) do { __builtin_amdgcn_s_setprio(1); _Pragma("unroll") for (int m = 0; m < 4; ++m) _Pragma("unroll") for (int n = 0; n < 2; ++n) { \
        if constexpr (F8) asm volatile("v_mfma_scale_f32_16x16x128_f8f6f4 %0, %1, %2, %0, %3, %3 op_sel_hi:[0,0,0]" : "+v"(acc[ai][bj][m][n]) : "v"(Bt[n].v), "v"(At[m].v), "v"(sc127)); \
        else { _Pragma("unroll") for (int k = 0; k < 2; ++k) acc[ai][bj][m][n] = __builtin_amdgcn_mfma_f32_16x16x32_bf16(Bt[n].v[k], At[m].v[k], acc[ai][bj][m][n], 0, 0, 0); } } __builtin_amdgcn_s_setprio(0); } while (0)
#define PG8_WAIT_V(n) asm volatile("s_waitcnt vmcnt(" #n ")" ::: "memory")
#define PG8_WAIT_L(n) asm volatile("s_waitcnt lgkmcnt(" #n ")" ::: "memory")
#define PG8_BAR __builtin_amdgcn_s_barrier()
#define PG8_SCHED __builtin_amdgcn_sched_barrier(0)
    Unit cur, nxt; int ui = 0;
    const int sc127 = 0x7f7f7f7f; (void)sc127;
    if (!S.next(0, cur)) return;
    f32x4 acc[2][2][4][2];
#pragma unroll
    for (int a = 0; a < 2; ++a)
#pragma unroll
        for (int b = 0; b < 2; ++b)
#pragma unroll
            for (int m = 0; m < 4; ++m)
#pragma unroll
                for (int n = 0; n < 2; ++n) acc[a][b][m][n] = (f32x4){0.f, 0.f, 0.f, 0.f};
    pg8_frag<F8> At[4], B0[2], B1[2];
    const char* cA = (const char*)g.A + (size_t)cur.pm * tstep; const char* cB = (const char*)g.Bt + (size_t)cur.pn * tstep;
    S.a_ready(cur);
    PG8_STAGE(PG8_SB(0, 0), cB, voffB); PG8_STAGE(PG8_SA(0, 0), cA, voffA); PG8_STAGE(PG8_SB(0, 1), cB + hstep, voffB); PG8_STAGE(PG8_SA(0, 1), cA + hstep, voffA);
    if (wr == 1) PG8_BAR;
    PG8_WAIT_V(4); PG8_BAR;
    PG8_STAGE(PG8_SB(1, 0), cB + kstep, voffB); PG8_STAGE(PG8_SA(1, 0), cA + kstep, voffA); PG8_STAGE(PG8_SB(1, 1), cB + hstep + kstep, voffB);
    PG8_WAIT_V(6); PG8_BAR;
    PG8_STAMP();
    for (;;) {
        const bool has_next = S.next(ui + 1, nxt);
        const char* nA = has_next ? (const char*)g.A + (size_t)nxt.pm * tstep : cA; const char* nB = has_next ? (const char*)g.Bt + (size_t)nxt.pn * tstep : cB;
        for (int t = 0; t < nt; t += 2) {
            const bool last = (t == nt - 2);
            const char* a1 = cA + (size_t)(t + 1) * kstep;
            const char* a2 = last ? nA : cA + (size_t)(t + 2) * kstep; const char* b2 = last ? nB : cB + (size_t)(t + 2) * kstep;
            const char* a3 = a2 + kstep; const char* b3 = b2 + kstep;
            if (last && has_next) S.a_ready(nxt);
            PG8_LDB(B0, 0, 0); PG8_SCHED; PG8_LDA(At, 0, 0); PG8_STAGE(PG8_SA(1, 1), a1 + hstep, voffA);
            PG8_WAIT_L(8); PG8_BAR; PG8_WAIT_L(0); PG8_MMA(0, 0, At, B0); PG8_BAR; PG8_SCHED;
            PG8_LDB(B1, 0, 1); PG8_STAGE(PG8_SB(0, 0), b2, voffB);
            PG8_BAR; PG8_WAIT_L(0); PG8_MMA(0, 1, At, B1); PG8_BAR;
            PG8_LDA(At, 0, 1); PG8_STAGE(PG8_SA(0, 0), a2, voffA);
            PG8_BAR; PG8_WAIT_L(0); PG8_MMA(1, 0, At, B0); PG8_BAR; PG8_SCHED;
            PG8_STAGE(PG8_SB(0, 1), b2 + hstep, voffB);
            PG8_WAIT_V(6); PG8_BAR; PG8_MMA(1, 1, At, B1); PG8_BAR;
            PG8_LDB(B0, 1, 0); PG8_SCHED; PG8_LDA(At, 1, 0); PG8_STAGE(PG8_SA(0, 1), a2 + hstep, voffA);
            PG8_WAIT_L(8); PG8_BAR; PG8_WAIT_L(0); PG8_MMA(0, 0, At, B0); PG8_BAR; PG8_SCHED;
            PG8_LDB(B1, 1, 1); PG8_STAGE(PG8_SB(1, 0), b3, voffB);
            PG8_BAR; PG8_WAIT_L(0); PG8_MMA(0, 1, At, B1); PG8_BAR;
            PG8_LDA(At, 1, 1); PG8_STAGE(PG8_SA(1, 0), a3, voffA);
            PG8_BAR; PG8_WAIT_L(0); PG8_MMA(1, 0, At, B0); PG8_BAR; PG8_SCHED;
            PG8_STAGE(PG8_SB(1, 1), b3 + hstep, voffB);
            PG8_WAIT_V(6); PG8_BAR; PG8_MMA(1, 1, At, B1); PG8_BAR;
        }
        PG8_STAMP();
        if constexpr (F8) {
            asm volatile("s_nop 15\n\ts_nop 15" ::: "memory");
#pragma unroll
            for (int a = 0; a < 2; ++a)
#pragma unroll
                for (int b = 0; b < 2; ++b)
#pragma unroll
                    for (int m = 0; m < 4; ++m) asm volatile("" : "+v"(acc[a][b][m][0]), "+v"(acc[a][b][m][1]));
        }
        if constexpr (!Epi::AFTER_DRAIN) { E(acc, cur, wr, wc, fr, fq); S.done(cur); }
        PG8_STAMP();
        if (!has_next) break;
#pragma unroll
        for (int a = 0; a < 2; ++a)
#pragma unroll
            for (int b = 0; b < 2; ++b)
#pragma unroll
                for (int m = 0; m < 4; ++m)
#pragma unroll
                    for (int n = 0; n < 2; ++n) acc[a][b][m][n] = (f32x4){0.f, 0.f, 0.f, 0.f};
        cur = nxt; cA = nA; cB = nB; ++ui;
    }
    PG8_WAIT_V(0);
    if (wr == 0) PG8_BAR;
    PG8_BAR;
    if constexpr (Epi::AFTER_DRAIN) { E.fused(acc, cur, wr, wc, fr, fq, lds, wid, lane); S.done(cur); }
    PG8_STAMP();
    if (STAMP && wid == 0) { stamps[lane] = lane < nts ? (((unsigned long long)(unsigned)ts_hi << 32) | (unsigned)ts_lo) : 0ull;
        if (lane == 62) stamps[62] = rt_entry; if (lane == 63) stamps[63] = (unsigned long long)wall_clock64(); }
#undef PG8_STAMP
#undef PG8_SA
#undef PG8_SB
#undef PG8_STAGE
#undef PG8_LDA
#undef PG8_LDB
#undef PG8_MMA
#undef PG8_WAIT_V
#undef PG8_WAIT_L
#undef PG8_BAR
#undef PG8_SCHED
}
}
#define XB_TMO      128
#define XB_XCNT(j)  (256  + 64 * (j))
#define XB_XSUB(j)  (1280 + 64 * (j))
#define XB_XGEN(j)  (2304 + 64 * (j))
#define XB_TOP      3328
#define XB_TOPGEN   3392
#define XCD_BAR_WORDS 3456
#define XB_SPIN_CAP (1u << 18)
#define LAS __attribute__((address_space(3)))

__device__ __forceinline__ unsigned xb_ld(unsigned* p)              { return __hip_atomic_load(p, __ATOMIC_RELAXED, __HIP_MEMORY_SCOPE_AGENT); }
__device__ __forceinline__ unsigned xb_add(unsigned* p, unsigned v) { return __hip_atomic_fetch_add(p, v, __ATOMIC_RELAXED, __HIP_MEMORY_SCOPE_AGENT); }
__device__ __forceinline__ unsigned xb_xcc_id() { return (unsigned)__builtin_amdgcn_s_getreg((3 << 11) | 20) & 0xFu; }
#define XB_SPIN(cond, bar) do { unsigned _sp = 0; while (cond) { __builtin_amdgcn_s_sleep(1); \
    if ((++_sp & 255u) == 0u) { if (xb_ld(&(bar)[XB_TMO])) break; if (_sp > XB_SPIN_CAP) { atomicAdd(&(bar)[XB_TMO], 1u); break; } } } } while (0)

struct XcdBarrier {
    unsigned* bar; unsigned x;
    volatile LAS unsigned* st;
};

__device__ __forceinline__ XcdBarrier xcd_barrier_post(unsigned* bar, volatile LAS unsigned* st) {
    XcdBarrier b; b.bar = bar; b.x = xb_xcc_id(); b.st = st;
    if (threadIdx.x == 0) (void)xb_add(&bar[XB_XCNT(b.x)], 1u);
    return b;
}
__device__ __forceinline__ void xcd_barrier_complete(unsigned* bar, unsigned x, unsigned& nloc, unsigned& nx) {
    const unsigned G = gridDim.x * gridDim.y * gridDim.z;
    unsigned sum, cnt, mine, sp = 0u;
    for (;;) {
        sum = 0u; cnt = 0u; mine = 0u;
#pragma unroll
        for (unsigned j = 0; j < 16; ++j) { const unsigned c = xb_ld(&bar[XB_XCNT(j)]); sum += c; cnt += (c > 0u) ? 1u : 0u; mine = (j == x) ? c : mine; }
        if (sum == G) break;
        __builtin_amdgcn_s_sleep(1);
        if ((++sp & 255u) == 0u) { if (xb_ld(&bar[XB_TMO])) break; if (sp > XB_SPIN_CAP) { atomicAdd(&bar[XB_TMO], 1u); break; } }
    }
    nloc = mine > 0u ? mine : 1u; nx = cnt > 0u ? cnt : 1u;
}

__device__ __forceinline__ void xcd_barrier(const XcdBarrier& b) {
    asm volatile("s_waitcnt vmcnt(0)" ::: "memory");
    __syncthreads();
    if (threadIdx.x == 0) {
        unsigned* bar = b.bar;
        __builtin_amdgcn_s_waitcnt(0);
        unsigned nloc = b.st[0], nx = b.st[1];
        if (nloc == 0u) { xcd_barrier_complete(bar, b.x, nloc, nx); b.st[0] = nloc; b.st[1] = nx; }
        const unsigned old = xb_add(&bar[XB_XSUB(b.x)], 1u);
        const unsigned gen = old / nloc;
        if (old + 1u == (gen + 1u) * nloc) {
            __builtin_amdgcn_fence(__ATOMIC_RELEASE, "agent");
            asm volatile("s_waitcnt vmcnt(0)" ::: "memory");
            const unsigned og = xb_add(&bar[XB_TOP], 1u);
            const unsigned tg = og / nx;
            if (og + 1u == (tg + 1u) * nx) xb_add(&bar[XB_TOPGEN], 1u);
            else XB_SPIN(xb_ld(&bar[XB_TOPGEN]) == tg, bar);
            __builtin_amdgcn_fence(__ATOMIC_ACQUIRE, "agent");
            xb_add(&bar[XB_XGEN(b.x)], 1u);
            asm volatile("s_waitcnt vmcnt(0)" ::: "memory");
        } else {
            XB_SPIN(xb_ld(&bar[XB_XGEN(b.x)]) == gen, bar);
            __builtin_amdgcn_fence(__ATOMIC_ACQUIRE, "agent");
            asm volatile("s_waitcnt vmcnt(0)" ::: "memory");
        }
    }
    __syncthreads();
}


#define LAS3 __attribute__((address_space(3)))
using pg8::bf16x8; using pg8::f32x4; using pg8::u32x4; using pg8::Unit;
constexpr int MK_THREADS = 512, MK_LDS_BYTES = 147456  , MK_LDS_BAR = MK_LDS_BYTES - 16;
constexpr int NPH = 16;

struct Params {
    const float* x; const float* gains; const float* a_w_in; const float* a_b_in; const float* a_norm_v; const float* a_w_s; const float* a_b_s; const float* a_w_out;
    const float* kv_norm; const float* w_kv; const float* w_q; const float* w_o; const float* ffn_w_gu; const float* ffn_w_down; const float* moe_router; const float* moe_w_gu; const float* moe_w_down;
    float* out; unsigned char* ws;
};

typedef __bf16 bf16x2_t __attribute__((ext_vector_type(2)));
__device__ __forceinline__ unsigned cvtpk(float lo, float hi) { const bf16x2_t v = {(__bf16)lo, (__bf16)hi}; return __builtin_bit_cast(unsigned, v); }
__device__ __forceinline__ float gelu_fast(float x) { const float t = x + 0.044715f * x * x * x; return x * __builtin_amdgcn_rcpf(1.0f + __builtin_amdgcn_exp2f(-2.3022081985f * t)); }
__device__ __forceinline__ float silu_fast(float x) { return x * __builtin_amdgcn_rcpf(1.0f + __builtin_amdgcn_exp2f(-1.4426950409f * x)); }
__device__ __forceinline__ f32x4 exp2_4(f32x4 a) { return (f32x4){__builtin_amdgcn_exp2f(a[0]), __builtin_amdgcn_exp2f(a[1]), __builtin_amdgcn_exp2f(a[2]), __builtin_amdgcn_exp2f(a[3])}; }
__device__ __forceinline__ f32x4 rcp_4(f32x4 a) { return (f32x4){__builtin_amdgcn_rcpf(a[0]), __builtin_amdgcn_rcpf(a[1]), __builtin_amdgcn_rcpf(a[2]), __builtin_amdgcn_rcpf(a[3])}; }
__device__ __forceinline__ f32x4 swiglu_4(f32x4 G, f32x4 U, float kexp, float kout) {
    const f32x4 r = rcp_4(exp2_4(G * kexp) + 1.0f); return (G * U) * (r * kout); }
__device__ __forceinline__ f32x4 gelu_4(f32x4 v) { const f32x4 t = (v * v * 0.044715f + 1.0f) * v; const f32x4 r = rcp_4(exp2_4(t * -2.3022081985f) + 1.0f); return v * r; }

constexpr float F8_SA1 = 16.f, F8_SW1 = 1024.f, F8_SA2 = 8.f, F8_SW2 = 2048.f;
__device__ __forceinline__ unsigned pack4_fp8(float a, float b, float c, float d) {
    a = __builtin_amdgcn_fmed3f(a, -448.f, 448.f); b = __builtin_amdgcn_fmed3f(b, -448.f, 448.f); c = __builtin_amdgcn_fmed3f(c, -448.f, 448.f); d = __builtin_amdgcn_fmed3f(d, -448.f, 448.f);
    int w = __builtin_amdgcn_cvt_pk_fp8_f32(a, b, 0, false); w = __builtin_amdgcn_cvt_pk_fp8_f32(c, d, w, true); return (unsigned)w; }
struct CTile { const float* src; bf16_t* dst; int N, K; int f8; float scale; };
constexpr int CT0 = 16 * 128, CT1 = CT0 + 32 * 32, CT2 = CT1 + 16 * 224, CT3 = CT2 + 56 * 32, CT4 = CT3 + 16 * 64, CT5 = CT4 + 16 * 96, CT6 = CT5 + 16 * 32, CT7 = CT6 + 8 * 16 * 224, CT8 = CT7 + 8 * 56 * 32;
__device__ __forceinline__ CTile conv_decode(const Params& p, int t) {
    const float* S; bf16_t* D; int K, N, inter = 0, tt, f8 = 0; float scale = 1.f;
    unsigned char* ws = p.ws;
    if (t < CT0)      { S = p.a_w_in;     D = (bf16_t*)(ws + OFF_WIN_T);  K = DM;  N = 2 * GH;  tt = t; }
    else if (t < CT1) { S = p.a_w_out;    D = (bf16_t*)(ws + OFF_WOUT_T); K = GH;  N = DM;      tt = t - CT0; }
    else if (t < CT2) { S = p.ffn_w_gu;   D = (bf16_t*)(ws + OFF_WGU_T);  K = DM;  N = 2 * DFF; tt = t - CT1; inter = 1; }
    else if (t < CT3) { S = p.ffn_w_down; D = (bf16_t*)(ws + OFF_WDN_T);  K = DFF; N = DM;      tt = t - CT2; }
    else if (t < CT4) { S = p.w_kv;       D = (bf16_t*)(ws + OFF_WKV_T);  K = DM;  N = NKV;     tt = t - CT3; }
    else if (t < CT5) { S = p.w_q;        D = (bf16_t*)(ws + OFF_WQ_T);   K = DM;  N = NQ;      tt = t - CT4; }
    else if (t < CT6) { S = p.w_o;        D = (bf16_t*)(ws + OFF_WO_T);   K = DM;  N = DM;      tt = t - CT5; }
    else if (t < CT7) { S = p.moe_w_gu;   D = (bf16_t*)(ws + OFF_MGU_T);  K = DM;  N = 2 * DFF; tt = t - CT6; inter = 1; f8 = 1; scale = F8_SW1; }
    else              { S = p.moe_w_down; D = (bf16_t*)(ws + OFF_MDN_T);  K = DFF; N = DM;      tt = t - CT7; f8 = 1; scale = F8_SW2; }
    const int KT = K >> 7, NT = N >> 6, per = KT * NT, b = tt / per, r = tt - b * per, kt = r / NT, nt = r - kt * NT, n0 = nt * 64;
    int drow = n0;
    if (inter) drow = n0 < DFF ? ((n0 >> 7) * 256 + (n0 & 127)) : (((n0 - DFF) >> 7) * 256 + 128 + ((n0 - DFF) & 127));
    CTile c; c.src = S + (size_t)b * K * N + (size_t)(kt * 128) * N + n0; c.N = N; c.K = K; c.f8 = f8; c.scale = scale;
    if (f8) c.dst = (bf16_t*)((unsigned char*)D + (size_t)b * N * K + (size_t)drow * K + kt * 128); else c.dst = D + (size_t)b * N * K + (size_t)drow * K + kt * 128;
    return c;
}
__device__ __forceinline__ void conv_to_lds(const CTile& c, const float4 (&r)[4], LAS3 unsigned* W, int n4, int kr) {
    if (c.f8) { const float sc = c.scale; LAS3 unsigned* w = W + (n4 * 4) * 33 + kr;
        w[0] = pack4_fp8(r[0].x * sc, r[1].x * sc, r[2].x * sc, r[3].x * sc); w[33] = pack4_fp8(r[0].y * sc, r[1].y * sc, r[2].y * sc, r[3].y * sc);
        w[66] = pack4_fp8(r[0].z * sc, r[1].z * sc, r[2].z * sc, r[3].z * sc); w[99] = pack4_fp8(r[0].w * sc, r[1].w * sc, r[2].w * sc, r[3].w * sc); }
    else {
#pragma unroll
        for (int i = 0; i < 2; ++i) { LAS3 unsigned* w = W + (n4 * 4) * 65 + kr + 32 * i;
            w[0] = cvtpk(r[2 * i].x, r[2 * i + 1].x); w[65] = cvtpk(r[2 * i].y, r[2 * i + 1].y); w[130] = cvtpk(r[2 * i].z, r[2 * i + 1].z); w[195] = cvtpk(r[2 * i].w, r[2 * i + 1].w); } }
}
__device__ __forceinline__ void conv_from_lds(const CTile& c, const LAS3 unsigned* W, int tid) {
    if (c.f8) { const int n = tid >> 3, kc = tid & 7; const LAS3 unsigned* q = W + n * 33 + kc * 4;
        uint4 w; w.x = q[0]; w.y = q[1]; w.z = q[2]; w.w = q[3]; __builtin_nontemporal_store((u32x4){w.x, w.y, w.z, w.w}, (u32x4*)((unsigned char*)c.dst + (size_t)n * c.K + kc * 16)); }
    else {
#pragma unroll
        for (int i = 0; i < 2; ++i) { const int it = tid + 512 * i, kc = it & 15, n = it >> 4; const LAS3 unsigned* q = W + n * 65 + kc * 4;
            uint4 w; w.x = q[0]; w.y = q[1]; w.z = q[2]; w.w = q[3]; __builtin_nontemporal_store((u32x4){w.x, w.y, w.z, w.w}, (u32x4*)(c.dst + (size_t)n * c.K + kc * 8)); } }
}
constexpr int CV_NT = 4;
__device__ __forceinline__ void phase_convert(const Params& p, LAS3 unsigned char* lds, int t0, int t1, int rank, int nrank) {
    LAS3 unsigned* LT = (LAS3 unsigned*)lds;
    const int tid = threadIdx.x, n4 = tid & 15, kr = tid >> 4, G = nrank;
    int t = t0 + rank;
#define CONV_LOAD(T, R) do { _Pragma("unroll") for (int j = 0; j < 4; ++j) { const int row = (T).f8 ? 4 * kr + j : 2 * (kr + 32 * (j >> 1)) + (j & 1); { const f32x4 _v = __builtin_nontemporal_load((const f32x4*)((T).src + (size_t)row * (T).N + n4 * 4)); R[j] = make_float4(_v[0], _v[1], _v[2], _v[3]); } } } while (0)
    if (t < t1) {
        CTile c[CV_NT]; bool h[CV_NT]; float4 r[CV_NT][4];
#pragma unroll
        for (int q = 0; q < CV_NT; ++q) { h[q] = t + q * G < t1; c[q] = conv_decode(p, h[q] ? t + q * G : t); if (h[q]) CONV_LOAD(c[q], r[q]); }
        int buf = 0;
        for (;;) {
            LAS3 unsigned* W = LT + buf * (CV_NT * 4160);
#pragma unroll
            for (int q = 0; q < CV_NT; ++q) if (h[q]) conv_to_lds(c[q], r[q], W + q * 4160, n4, kr);
            const int tn = t + CV_NT * G; const bool has = tn < t1;
            CTile cn[CV_NT]; bool hn[CV_NT];
#pragma unroll
            for (int q = 0; q < CV_NT; ++q) { hn[q] = tn + q * G < t1; cn[q] = c[q]; if (hn[q]) { cn[q] = conv_decode(p, tn + q * G); CONV_LOAD(cn[q], r[q]); } }
            __syncthreads();
#pragma unroll
            for (int q = 0; q < CV_NT; ++q) if (h[q]) conv_from_lds(c[q], W + q * 4160, tid);
            if (!has) break;
#pragma unroll
            for (int q = 0; q < CV_NT; ++q) { c[q] = cn[q]; h[q] = hn[q]; }
            t = tn; buf ^= 1;
        }
    }
#undef CONV_LOAD
    __syncthreads();
}

__device__ __forceinline__ void row_norm0(const Params& p, int row, int lane) {
    const float* gain = p.gains; bf16_t* xn = (bf16_t*)(p.ws + OFF_XN);
    const float4* xr = (const float4*)(p.x + (size_t)row * DM); float4 v[8]; float ss = 0.f;
#pragma unroll
    for (int i = 0; i < 8; ++i) { v[i] = xr[lane + 64 * i]; ss += v[i].x * v[i].x + v[i].y * v[i].y + v[i].z * v[i].z + v[i].w * v[i].w; }
    ss = wave_sum(ss); const float rstd = rsqrtf(ss * (1.0f / DM) + EPS);
#pragma unroll
    for (int i = 0; i < 8; ++i) { const float4 gg = ((const float4*)gain)[lane + 64 * i];
        uint2 w; w.x = cvtpk(v[i].x * rstd * gg.x, v[i].y * rstd * gg.y); w.y = cvtpk(v[i].z * rstd * gg.z, v[i].w * rstd * gg.w);
        *(uint2*)(xn + (size_t)row * DM + (lane + 64 * i) * 4) = w; }
}

struct EpiGeluU {
    static constexpr bool PERM = true, AFTER_DRAIN = false;
    bf16_t* O; int ldc; const float* bias;
    __device__ __forceinline__ void operator()(const f32x4 (&acc)[2][2][4][2], const Unit& u, int wr, int wc, int fr, int fq) const {
        asm volatile("" : "+v"(fr), "+v"(fq));
        const int row0 = u.pm * 256 + wr * 64 + fr, col0 = u.pn * 256 + wc * 32 + 8 * fq;
        f32x4 bv[2][2];
#pragma unroll
        for (int bj = 0; bj < 2; ++bj)
#pragma unroll
            for (int n = 0; n < 2; ++n) bv[bj][n] = *(const f32x4*)(bias + col0 + bj * 128 + 4 * n);
#pragma unroll
        for (int ai = 0; ai < 2; ++ai)
#pragma unroll
            for (int m = 0; m < 4; ++m) { bf16_t* rowp = O + (size_t)(row0 + ai * 128 + m * 16) * ldc + col0;
#pragma unroll
                for (int bj = 0; bj < 2; ++bj) { const f32x4 v0 = acc[ai][bj][m][0] + bv[bj][0], v1 = acc[ai][bj][m][1] + bv[bj][1];
                    const f32x4 y0 = gelu_4(v0), y1 = gelu_4(v1);
                    u32x4 w; w.x = cvtpk(y0[0], y0[1]); w.y = cvtpk(y0[2], y0[3]); w.z = cvtpk(y1[0], y1[1]); w.w = cvtpk(y1[2], y1[3]);
                    *(u32x4*)(rowp + bj * 128) = w; } }
    }
};
struct EpiGeluVT {
    static constexpr bool PERM = true, AFTER_DRAIN = false;
    bf16_t* O; const float* bias; float* ssp;
    __device__ __forceinline__ void operator()(const f32x4 (&acc)[2][2][4][2], const Unit& u, int wr, int wc, int fr, int fq) const {
        asm volatile("" : "+v"(fr), "+v"(fq));
        const int row0 = u.pm * 256 + wr * 64 + fr, col0 = u.pn * 256 + wc * 32 + 8 * fq;
        f32x4 cs[2][2];
#pragma unroll
        for (int bj = 0; bj < 2; ++bj)
#pragma unroll
            for (int n = 0; n < 2; ++n) cs[bj][n] = (f32x4){0.f, 0.f, 0.f, 0.f};
#pragma unroll
        for (int ai = 0; ai < 2; ++ai)
#pragma unroll
            for (int m = 0; m < 4; ++m) { const int row = row0 + ai * 128 + m * 16; const float b = bias[row]; bf16_t* rowp = O + (size_t)row * NTOK + col0;
#pragma unroll
                for (int bj = 0; bj < 2; ++bj) { f32x4 v0 = acc[ai][bj][m][0] + b, v1 = acc[ai][bj][m][1] + b;
                    v0 = gelu_4(v0); v1 = gelu_4(v1);
                    cs[bj][0] += v0 * v0; cs[bj][1] += v1 * v1;
                    u32x4 w; w.x = cvtpk(v0[0], v0[1]); w.y = cvtpk(v0[2], v0[3]); w.z = cvtpk(v1[0], v1[1]); w.w = cvtpk(v1[2], v1[3]);
                    *(u32x4*)(rowp + bj * 128) = w; } }
        const int slot = u.pm * 2 + wr;
#pragma unroll
        for (int bj = 0; bj < 2; ++bj)
#pragma unroll
            for (int n = 0; n < 2; ++n)
#pragma unroll
                for (int j = 0; j < 4; ++j) { float s = cs[bj][n][j]; s += __shfl_xor(s, 1); s += __shfl_xor(s, 2); s += __shfl_xor(s, 4); s += __shfl_xor(s, 8);
                    if (fr == 0) ssp[(size_t)(col0 + bj * 128 + 4 * n + j) * SSP_N + slot] = s; }
    }
};
struct EpiF32SS {
    static constexpr bool PERM = false, AFTER_DRAIN = false;
    float* C; int ldc; float* ssp; int pnmod; float scale;
    __device__ __forceinline__ void operator()(const f32x4 (&acc)[2][2][4][2], const Unit& u, int wr, int wc, int fr, int fq) const {
        asm volatile("" : "+v"(fr), "+v"(fq));
        const int pnl = u.pn % pnmod; const int row0 = u.pm * 256 + wr * 64 + fr, col0 = pnl * 256 + wc * 32 + 4 * fq;
#pragma unroll
        for (int ai = 0; ai < 2; ++ai)
#pragma unroll
            for (int m = 0; m < 4; ++m) { const int row = row0 + ai * 128 + m * 16; float* rowp = C + (size_t)row * ldc + col0; float s = 0.f;
#pragma unroll
                for (int bj = 0; bj < 2; ++bj)
#pragma unroll
                    for (int n = 0; n < 2; ++n) { const f32x4 v = acc[ai][bj][m][n] * scale; *(f32x4*)(rowp + bj * 128 + n * 16) = v; s += (v[0] * v[0] + v[1] * v[1]) + (v[2] * v[2] + v[3] * v[3]); }
                if (ssp) { s += __shfl_xor(s, 16); s += __shfl_xor(s, 32); if (fq == 0) ssp[(size_t)row * SSP_N + pnl * 4 + wc] = s; } }
    }
};
struct EpiSwiglu {
    static constexpr bool PERM = true, AFTER_DRAIN = false;
    bf16_t* O; int ldc; int pnmod;
    __device__ __forceinline__ void operator()(const f32x4 (&acc)[2][2][4][2], const Unit& u, int wr, int wc, int fr, int fq) const {
        asm volatile("" : "+v"(fr), "+v"(fq));
        const int pnl = u.pn % pnmod; const int row0 = u.pm * 256 + wr * 64 + fr, col0 = pnl * 128 + wc * 32 + 8 * fq;
#pragma unroll
        for (int ai = 0; ai < 2; ++ai)
#pragma unroll
            for (int m = 0; m < 4; ++m) { bf16_t* rowp = O + (size_t)(row0 + ai * 128 + m * 16) * ldc + col0;
                const f32x4 o0 = swiglu_4(acc[ai][0][m][0], acc[ai][1][m][0], -1.4426950409f, 1.0f), o1 = swiglu_4(acc[ai][0][m][1], acc[ai][1][m][1], -1.4426950409f, 1.0f);
                u32x4 w; w.x = cvtpk(o0[0], o0[1]); w.y = cvtpk(o0[2], o0[3]); w.z = cvtpk(o1[0], o1[1]); w.w = cvtpk(o1[2], o1[3]);
                *(u32x4*)rowp = w; }
    }
};
struct EpiBf16P {
    static constexpr bool PERM = true, AFTER_DRAIN = false;
    bf16_t* O; int ldc;
    __device__ __forceinline__ void operator()(const f32x4 (&acc)[2][2][4][2], const Unit& u, int wr, int wc, int fr, int fq) const {
        asm volatile("" : "+v"(fr), "+v"(fq));
        const int row0 = u.pm * 256 + wr * 64 + fr, col0 = u.pn * 256 + wc * 32 + 8 * fq;
#pragma unroll
        for (int ai = 0; ai < 2; ++ai)
#pragma unroll
            for (int m = 0; m < 4; ++m) { bf16_t* rowp = O + (size_t)(row0 + ai * 128 + m * 16) * ldc + col0;
#pragma unroll
                for (int bj = 0; bj < 2; ++bj) { const f32x4 v0 = acc[ai][bj][m][0], v1 = acc[ai][bj][m][1];
                    u32x4 w; w.x = cvtpk(v0[0], v0[1]); w.y = cvtpk(v0[2], v0[3]); w.z = cvtpk(v1[0], v1[1]); w.w = cvtpk(v1[2], v1[3]);
                    *(u32x4*)(rowp + bj * 128) = w; } }
    }
};

struct EpiSwiglu8 {
    static constexpr bool PERM = true, AFTER_DRAIN = false;
    unsigned char* O; int ldc; int pnmod; float inv, oscale;
    __device__ __forceinline__ void operator()(const f32x4 (&acc)[2][2][4][2], const Unit& u, int wr, int wc, int fr, int fq) const {
        asm volatile("" : "+v"(fr), "+v"(fq));
        const int pnl = u.pn % pnmod; const int row0 = u.pm * 256 + wr * 64 + fr, col0 = pnl * 128 + wc * 32 + 8 * fq;
#pragma unroll
        for (int ai = 0; ai < 2; ++ai)
#pragma unroll
            for (int m = 0; m < 4; ++m) { unsigned char* rowp = O + (size_t)(row0 + ai * 128 + m * 16) * ldc + col0;
                const float kexp = -1.4426950409f * inv, kout = inv * inv * oscale;
                const f32x4 o0 = swiglu_4(acc[ai][0][m][0], acc[ai][1][m][0], kexp, kout), o1 = swiglu_4(acc[ai][0][m][1], acc[ai][1][m][1], kexp, kout);
                uint2 w; w.x = pack4_fp8(o0[0], o0[1], o0[2], o0[3]); w.y = pack4_fp8(o1[0], o1[1], o1[2], o1[3]);
                *(uint2*)rowp = w; }
    }
};

struct EpiBf16S {
    static constexpr bool PERM = true, AFTER_DRAIN = false;
    bf16_t* O; int ldc; int pnmod; float scale;
    __device__ __forceinline__ void operator()(const f32x4 (&acc)[2][2][4][2], const Unit& u, int wr, int wc, int fr, int fq) const {
        asm volatile("" : "+v"(fr), "+v"(fq));
        const int pnl = u.pn % pnmod; const int row0 = u.pm * 256 + wr * 64 + fr, col0 = pnl * 256 + wc * 32 + 8 * fq;
#pragma unroll
        for (int ai = 0; ai < 2; ++ai)
#pragma unroll
            for (int m = 0; m < 4; ++m) { bf16_t* rowp = O + (size_t)(row0 + ai * 128 + m * 16) * ldc + col0;
#pragma unroll
                for (int bj = 0; bj < 2; ++bj) { const f32x4 v0 = acc[ai][bj][m][0] * scale, v1 = acc[ai][bj][m][1] * scale;
                    u32x4 w; w.x = cvtpk(v0[0], v0[1]); w.y = cvtpk(v0[2], v0[3]); w.z = cvtpk(v1[0], v1[1]); w.w = cvtpk(v1[2], v1[3]);
                    *(u32x4*)(rowp + bj * 128) = w; } }
    }
};

struct EpiBf16H {
    static constexpr bool PERM = true, AFTER_DRAIN = false;
    bf16_t* O; int nrows;
    __device__ __forceinline__ void operator()(const f32x4 (&acc)[2][2][4][2], const Unit& u, int wr, int wc, int fr, int fq) const {
        asm volatile("" : "+v"(fr), "+v"(fq));
        const int row0 = u.pm * 256 + wr * 64 + fr, cin = wc * 32 + 8 * fq;
#pragma unroll
        for (int bj = 0; bj < 2; ++bj) { bf16_t* hp = O + (size_t)(u.pn * 2 + bj) * nrows * 128 + cin;
#pragma unroll
            for (int ai = 0; ai < 2; ++ai)
#pragma unroll
                for (int m = 0; m < 4; ++m) { const f32x4 v0 = acc[ai][bj][m][0], v1 = acc[ai][bj][m][1];
                    u32x4 w; w.x = cvtpk(v0[0], v0[1]); w.y = cvtpk(v0[2], v0[3]); w.z = cvtpk(v1[0], v1[1]); w.w = cvtpk(v1[2], v1[3]);
                    *(u32x4*)(hp + (size_t)(row0 + ai * 128 + m * 16) * 128) = w; } }
    }
};

struct EpiBf16SS {
    static constexpr bool PERM = true, AFTER_DRAIN = false;
    bf16_t* C; int ldc; float* ssp;
    __device__ __forceinline__ void operator()(const f32x4 (&acc)[2][2][4][2], const Unit& u, int wr, int wc, int fr, int fq) const {
        asm volatile("" : "+v"(fr), "+v"(fq));
        const int row0 = u.pm * 256 + wr * 64 + fr, col0 = u.pn * 256 + wc * 32 + 8 * fq;
#pragma unroll
        for (int ai = 0; ai < 2; ++ai)
#pragma unroll
            for (int m = 0; m < 4; ++m) { const int row = row0 + ai * 128 + m * 16; bf16_t* rowp = C + (size_t)row * ldc + col0; float s = 0.f;
#pragma unroll
                for (int bj = 0; bj < 2; ++bj) { const f32x4 v0 = acc[ai][bj][m][0], v1 = acc[ai][bj][m][1];
                    s += (v0[0] * v0[0] + v0[1] * v0[1]) + (v0[2] * v0[2] + v0[3] * v0[3]); s += (v1[0] * v1[0] + v1[1] * v1[1]) + (v1[2] * v1[2] + v1[3] * v1[3]);
                    u32x4 w; w.x = cvtpk(v0[0], v0[1]); w.y = cvtpk(v0[2], v0[3]); w.z = cvtpk(v1[0], v1[1]); w.w = cvtpk(v1[2], v1[3]);
                    *(u32x4*)(rowp + bj * 128) = w; }
                s += __shfl_xor(s, 16); s += __shfl_xor(s, 32); if (fq == 0) ssp[(size_t)row * SSP_N + u.pn * 4 + wc] = s; }
    }
};

__device__ __forceinline__ int ld_i(const int* p) { return __hip_atomic_load(p, __ATOMIC_RELAXED, __HIP_MEMORY_SCOPE_AGENT); }
__device__ __forceinline__ float ssp_sum32(const float* ssp, int row) {
    const f32x4* q = (const f32x4*)(ssp + (size_t)row * SSP_N); float t = 0.f;
#pragma unroll
    for (int i = 0; i < 8; ++i) { const f32x4 v = q[i]; t += v[0]; t += v[1]; t += v[2]; t += v[3]; }
    return t;
}

template <bool BF> __device__ __forceinline__ float4 ld4(const void* base, size_t idx4) {
    if constexpr (BF) { const uint2 w = ((const uint2*)base)[idx4]; return make_float4(bf2f(w.x & 0xffffu), bf2f(w.x >> 16), bf2f(w.y & 0xffffu), bf2f(w.y >> 16)); }
    else return ((const float4*)base)[idx4];
}
__device__ __forceinline__ void st4bf(bf16_t* base, size_t idx4, float4 v) { uint2 w; w.x = cvtpk(v.x, v.y); w.y = cvtpk(v.z, v.w); ((uint2*)base)[idx4] = w; }
struct RowIn { float4 b[8]; uint2 m[8]; };
template <bool BFBASE> __device__ __forceinline__ void row_load(RowIn& r, const void* base, const bf16_t* mix, int row, int lane) {
#pragma unroll
    for (int i = 0; i < 8; ++i) { const size_t o = (size_t)row * (DM / 4) + lane + 64 * i; r.b[i] = ld4<BFBASE>(base, o); r.m[i] = ((const uint2*)mix)[o]; }
}
__device__ __forceinline__ void row_resnorm_c(const RowIn& r, const float* ssp, const float* g_post, bf16_t* hout, const float* g1, bf16_t* xn1, const float* g2, bf16_t* xn2, int row, int lane) {
    const float rm = rsqrtf(ssp_sum32(ssp, row) * (1.0f / DM) + EPS);
    float4 h[8]; float ss = 0.f;
#pragma unroll
    for (int i = 0; i < 8; ++i) { const size_t o = (size_t)row * (DM / 4) + lane + 64 * i; const float4 b = r.b[i], gp = ((const float4*)g_post)[lane + 64 * i];
        const float4 m = make_float4(bf2f(r.m[i].x & 0xffffu), bf2f(r.m[i].x >> 16), bf2f(r.m[i].y & 0xffffu), bf2f(r.m[i].y >> 16));
        h[i].x = b.x + m.x * rm * gp.x; h[i].y = b.y + m.y * rm * gp.y; h[i].z = b.z + m.z * rm * gp.z; h[i].w = b.w + m.w * rm * gp.w;
        st4bf(hout, o, h[i]); ss += h[i].x * h[i].x + h[i].y * h[i].y + h[i].z * h[i].z + h[i].w * h[i].w; }
    ss = wave_sum(ss); const float rstd = rsqrtf(ss * (1.0f / DM) + EPS);
#pragma unroll
    for (int i = 0; i < 8; ++i) { const float4 gg = ((const float4*)g1)[lane + 64 * i];
        uint2 w; w.x = cvtpk(h[i].x * rstd * gg.x, h[i].y * rstd * gg.y); w.y = cvtpk(h[i].z * rstd * gg.z, h[i].w * rstd * gg.w);
        *(uint2*)(xn1 + (size_t)row * DM + (lane + 64 * i) * 4) = w;
        if (xn2) { const float4 g2v = ((const float4*)g2)[lane + 64 * i];
            uint2 w2; w2.x = cvtpk(h[i].x * rstd * g2v.x, h[i].y * rstd * g2v.y); w2.y = cvtpk(h[i].z * rstd * g2v.z, h[i].w * rstd * g2v.w);
            *(uint2*)(xn2 + (size_t)row * DM + (lane + 64 * i) * 4) = w2; } }
}
template <bool BFBASE> __device__ __forceinline__ void phase_resnorm(const void* base, const bf16_t* mix, const float* ssp, const float* g_post, bf16_t* hout, const float* g1, bf16_t* xn1, const float* g2, bf16_t* xn2, int wave, int lane, int G) {
    int row = blockIdx.x * 8 + wave; if (row >= NTOK) return;
    RowIn cur, nxt; row_load<BFBASE>(cur, base, mix, row, lane);
    for (;;) { const int nrow = row + G * 8; const bool has = nrow < NTOK;
        if (has) row_load<BFBASE>(nxt, base, mix, nrow, lane);
        row_resnorm_c(cur, ssp, g_post, hout, g1, xn1, g2, xn2, row, lane);
        if (!has) break; cur = nxt; row = nrow; }
}
__device__ __forceinline__ void row_router(const bf16_t* base, const bf16_t* mix, const float* ssp, const float* g_post, bf16_t* hout, const float* g_pre, const LAS3 float* wT  , unsigned char* xs8,
                                           int* counts, int* tok_s, float* tok_g, int row, int lane) {
    const float rm = rsqrtf(ssp_sum32(ssp, row) * (1.0f / DM) + EPS);
    float4 h[8]; float ss = 0.f;
#pragma unroll
    for (int i = 0; i < 8; ++i) { const size_t o = (size_t)row * (DM / 4) + lane + 64 * i; const float4 b = ld4<true>(base, o), m = ld4<true>(mix, o), gp = ((const float4*)g_post)[lane + 64 * i];
        h[i].x = b.x + m.x * rm * gp.x; h[i].y = b.y + m.y * rm * gp.y; h[i].z = b.z + m.z * rm * gp.z; h[i].w = b.w + m.w * rm * gp.w;
        st4bf(hout, o, h[i]); ss += h[i].x * h[i].x + h[i].y * h[i].y + h[i].z * h[i].z + h[i].w * h[i].w;
        if (i & 1) asm volatile("" ::: "memory"); }
    ss = wave_sum(ss); const float rstd = rsqrtf(ss * (1.0f / DM) + EPS);
    float lg[8]; unsigned q8[8];
#pragma unroll
    for (int e = 0; e < 8; ++e) lg[e] = 0.f;
#pragma unroll
    for (int i = 0; i < 8; ++i) { const float4 gg = ((const float4*)g_pre)[lane + 64 * i];
        const float n0 = h[i].x * rstd * gg.x, n1 = h[i].y * rstd * gg.y, n2 = h[i].z * rstd * gg.z, n3 = h[i].w * rstd * gg.w;
        q8[i] = pack4_fp8(n0 * F8_SA1, n1 * F8_SA1, n2 * F8_SA1, n3 * F8_SA1); asm volatile("" : "+v"(q8[i]));
        const int k = (lane + 64 * i) * 4;
#pragma unroll
        for (int e = 0; e < 8; ++e) { const f32x4 w = *(const LAS3 f32x4*)(wT + e * DM + k); lg[e] = fmaf(n0, w[0], lg[e]); lg[e] = fmaf(n1, w[1], lg[e]); lg[e] = fmaf(n2, w[2], lg[e]); lg[e] = fmaf(n3, w[3], lg[e]); }
        asm volatile("" ::: "memory"); }
#pragma unroll
    for (int e = 0; e < 8; ++e) lg[e] = wave_sum(lg[e]);
    int s1 = 0, s2 = 0;
    if (lane == 0) {
        int e1 = 0; float v1 = lg[0];
#pragma unroll
        for (int e = 1; e < 8; ++e) if (lg[e] > v1) { v1 = lg[e]; e1 = e; }
        int e2 = 0; float v2 = -3.0e38f;
#pragma unroll
        for (int e = 0; e < 8; ++e) if (e != e1 && lg[e] > v2) { v2 = lg[e]; e2 = e; }
        const float p2 = __expf(v2 - v1), inv = 1.0f / (1.0f + p2);
        s1 = e1 * ECAP + atomicAdd(&counts[e1], 1); s2 = e2 * ECAP + atomicAdd(&counts[e2], 1);
        tok_s[row * 2] = s1; tok_s[row * 2 + 1] = s2; tok_g[row * 2] = inv; tok_g[row * 2 + 1] = p2 * inv;
    }
    s1 = __builtin_amdgcn_readfirstlane(s1); s2 = __builtin_amdgcn_readfirstlane(s2);
    unsigned* d1 = (unsigned*)(xs8 + (size_t)s1 * DM); unsigned* d2 = (unsigned*)(xs8 + (size_t)s2 * DM);
#pragma unroll
    for (int i = 0; i < 8; ++i) { d1[lane + 64 * i] = q8[i]; d2[lane + 64 * i] = q8[i]; }
}
constexpr int KSPLIT = 4, C_TFLAG = 8192;
__device__ __forceinline__ void row_final(const bf16_t* h3, const bf16_t* Y, const float* Yp, const int* tflag, const int* tok_s, const float* tok_g, const float* gain, float* out, int row, int lane) {
    const int s1 = tok_s[row * 2], s2 = tok_s[row * 2 + 1]; const float g1 = tok_g[row * 2], g2 = tok_g[row * 2 + 1];
    float4 f[8]; float ss = 0.f;
#pragma unroll
    for (int i = 0; i < 8; ++i) {
        float4 a, b;
        { const int fl = tflag[(s1 >> 8) * 8 + i];
          if (fl == 0) { const uint2 w = ((const uint2*)(Y + (size_t)s1 * DM))[lane + 64 * i]; a = make_float4(bf2f(w.x & 0xffffu), bf2f(w.x >> 16), bf2f(w.y & 0xffffu), bf2f(w.y >> 16)); }
          else { const float4* q = (const float4*)(Yp + ((size_t)(fl - 1) * KSPLIT) * 65536 + (size_t)(s1 & 255) * 256) + lane; a = q[0];
#pragma unroll
              for (int k = 1; k < KSPLIT; ++k) { const float4 t = q[(size_t)k * 16384]; a.x += t.x; a.y += t.y; a.z += t.z; a.w += t.w; } } }
        { const int fl = tflag[(s2 >> 8) * 8 + i];
          if (fl == 0) { const uint2 w = ((const uint2*)(Y + (size_t)s2 * DM))[lane + 64 * i]; b = make_float4(bf2f(w.x & 0xffffu), bf2f(w.x >> 16), bf2f(w.y & 0xffffu), bf2f(w.y >> 16)); }
          else { const float4* q = (const float4*)(Yp + ((size_t)(fl - 1) * KSPLIT) * 65536 + (size_t)(s2 & 255) * 256) + lane; b = q[0];
#pragma unroll
              for (int k = 1; k < KSPLIT; ++k) { const float4 t = q[(size_t)k * 16384]; b.x += t.x; b.y += t.y; b.z += t.z; b.w += t.w; } } }
        f[i].x = a.x * g1 + b.x * g2; f[i].y = a.y * g1 + b.y * g2; f[i].z = a.z * g1 + b.z * g2; f[i].w = a.w * g1 + b.w * g2;
        ss += f[i].x * f[i].x + f[i].y * f[i].y + f[i].z * f[i].z + f[i].w * f[i].w; }
    ss = wave_sum(ss); const float rstd = rsqrtf(ss * (1.0f / DM) + EPS);
#pragma unroll
    for (int i = 0; i < 8; ++i) { const size_t o = (size_t)row * (DM / 4) + lane + 64 * i; const float4 b = ld4<true>(h3, o), gg = ((const float4*)gain)[lane + 64 * i]; float4 r;
        r.x = b.x + f[i].x * rstd * gg.x; r.y = b.y + f[i].y * rstd * gg.y; r.z = b.z + f[i].z * rstd * gg.z; r.w = b.w + f[i].w * rstd * gg.w; ((float4*)out)[o] = r; }
}
constexpr int MOE_TBL_OFF = 131072;
struct MoeOrder : pg8::StaticOrder {
    const LAS3 int* tbl; int NT; int lim;
    __device__ __forceinline__ bool next(int i, Unit& u) const { if ((long)i * G + c >= lim) return false; if (!pg8::StaticOrder::next(i, u)) return false;
        const int v = tbl[u.pm]; u.pm = v & 0xffff; u.pn += (v >> 16) * NT; return true; }
};
__device__ __forceinline__ int moe_table(const int* counts, LAS3 unsigned char* lds) {
    LAS3 int* tbl = (LAS3 int*)(lds + MOE_TBL_OFF); const int t = threadIdx.x; int q = 0, mine = -1;
#pragma unroll
    for (int e = 0; e < NEXP; ++e) { const int nb = (ld_i(counts + e) + 255) >> 8; if (t >= q && t < q + nb) mine = (e << 16) | (e * (ECAP / 256) + (t - q)); q += nb; }
    if (mine >= 0) tbl[t] = mine;
    __syncthreads();
    return q;
}

struct LeftOrder : pg8::StaticOrder {
    const LAS3 int* tbl; int NT; int L;
    __device__ __forceinline__ bool next(int i, Unit& u) const { if (i != 0 || L < 0) return false;
        pg8::StaticOrder t = *this; t.c = L; if (!t.pg8::StaticOrder::next(0, u)) return false;
        const int v = tbl[u.pm]; u.pm = v & 0xffff; u.pn += (v >> 16) * NT; return true; }
};
struct EpiF32Part {
    static constexpr bool PERM = false, AFTER_DRAIN = false;
    float* P; float scale; int* tflag; int li; int pnmod; int mark;
    __device__ __forceinline__ void operator()(const f32x4 (&acc)[2][2][4][2], const Unit& u, int wr, int wc, int fr, int fq) const {
        asm volatile("" : "+v"(fr), "+v"(fq));
        if (mark && threadIdx.x == 0) tflag[u.pm * 8 + (u.pn % pnmod)] = li + 1;
        const int r0 = wr * 64 + fr, c0 = wc * 32 + 4 * fq;
#pragma unroll
        for (int ai = 0; ai < 2; ++ai)
#pragma unroll
            for (int m = 0; m < 4; ++m) { float* rowp = P + (size_t)(r0 + ai * 128 + m * 16) * 256 + c0;
#pragma unroll
                for (int bj = 0; bj < 2; ++bj)
#pragma unroll
                    for (int n = 0; n < 2; ++n) *(f32x4*)(rowp + bj * 128 + n * 16) = acc[ai][bj][m][n] * scale; }
    }
};

__device__ __forceinline__ void stage_router(const float* wr, LAS3 unsigned char* lds) {
    LAS3 float* wT = (LAS3 float*)lds; const int t = threadIdx.x; float4 v[8];
#pragma unroll
    for (int j = 0; j < 8; ++j) v[j] = ((const float4*)(wr + (size_t)t * 32))[j];
    const float a[32] = {v[0].x, v[0].y, v[0].z, v[0].w, v[1].x, v[1].y, v[1].z, v[1].w, v[2].x, v[2].y, v[2].z, v[2].w, v[3].x, v[3].y, v[3].z, v[3].w,
                         v[4].x, v[4].y, v[4].z, v[4].w, v[5].x, v[5].y, v[5].z, v[5].w, v[6].x, v[6].y, v[6].z, v[6].w, v[7].x, v[7].y, v[7].z, v[7].w};
#pragma unroll
    for (int e = 0; e < 8; ++e) *(LAS3 f32x4*)(wT + e * DM + t * 4) = (f32x4){a[e], a[8 + e], a[16 + e], a[24 + e]};
    __syncthreads();
}

__device__ __forceinline__ void phase_sgu(const Params& p, LAS3 unsigned char* lds) {
    const int tid = threadIdx.x, lane = tid & 63, wave = __builtin_amdgcn_readfirstlane(tid >> 6), fr = lane & 15, fq = lane >> 4;
    unsigned char* ws = p.ws;
    const bf16_t* U = (const bf16_t*)(ws + OFF_U); const bf16_t* VT = (const bf16_t*)(ws + OFF_VT); bf16_t* GT = (bf16_t*)(ws + OFF_GT); const float* SSP = (const float*)(ws + OFF_SSP);
    LAS3 float* rs = (LAS3 float*)(lds + 36864);
    for (int unit = blockIdx.x; unit < 512; unit += (int)gridDim.x) {
        const int ch = unit >> 3, g = unit & 7;
        __syncthreads();
        if (tid < 128) rs[tid] = rsqrtf(ssp_sum32(SSP, ch * 128 + tid) * (1.0f / GH) + EPS);
        bf16x8 bfrag[4][4];
#pragma unroll
        for (int n = 0; n < 4; ++n) { const int chrow = g * 512 + wave * 64 + (n >> 1) * 32 + 8 * (fr >> 2) + 4 * (n & 1) + (fr & 3);
#pragma unroll
            for (int ks = 0; ks < 4; ++ks) bfrag[n][ks] = *(const bf16x8*)(VT + (size_t)chrow * NTOK + ch * 128 + ks * 32 + fq * 8); }
        __syncthreads();
        { const int t = tid >> 2, s0 = (tid & 3) * 32; const float* wp = p.a_w_s + ((size_t)g * 128 + t) * 128 + s0;
#pragma unroll
          for (int q = 0; q < 4; ++q) { const float4 a = *(const float4*)(wp + q * 8), b = *(const float4*)(wp + q * 8 + 4); float v[8] = {a.x, a.y, a.z, a.w, b.x, b.y, b.z, b.w};
#pragma unroll
              for (int j = 0; j < 8; ++j) { const int s = s0 + q * 8 + j; v[j] = (s <= t) ? v[j] * rs[s] : 0.f; }
              u32x4 w; w.x = cvtpk(v[0], v[1]); w.y = cvtpk(v[2], v[3]); w.z = cvtpk(v[4], v[5]); w.w = cvtpk(v[6], v[7]);
              *(LAS3 u32x4*)(lds + t * 272 + (s0 + q * 8) * 2) = w; } }
        __syncthreads();
#pragma unroll
        for (int mt = 0; mt < 8; ++mt) {
            f32x4 acc[4];
#pragma unroll
            for (int n = 0; n < 4; ++n) acc[n] = (f32x4){0.f, 0.f, 0.f, 0.f};
            const int nks = (16 * mt + 15) / 32 + 1;
#pragma unroll
            for (int ks = 0; ks < 4; ++ks) if (ks < nks) { const bf16x8 a = *(const LAS3 bf16x8*)(lds + (16 * mt + fr) * 272 + (ks * 32 + fq * 8) * 2);
#pragma unroll
                for (int n = 0; n < 4; ++n) acc[n] = __builtin_amdgcn_mfma_f32_16x16x32_bf16(bfrag[n][ks], a, acc[n], 0, 0, 0); }
            const int tl = 16 * mt + fr, tok = ch * 128 + tl; const float b = p.a_b_s[g * 128 + tl];
#pragma unroll
            for (int pp = 0; pp < 2; ++pp) { const int c0 = g * 512 + wave * 64 + pp * 32 + 8 * fq;
                const u32x4 uu = *(const u32x4*)(U + (size_t)tok * GH + c0); const f32x4 g0 = *(const f32x4*)(p.a_norm_v + c0), g1 = *(const f32x4*)(p.a_norm_v + c0 + 4);
                const f32x4 a0 = acc[2 * pp], a1 = acc[2 * pp + 1];
                u32x4 w;
                w.x = cvtpk(bf2f(uu.x & 0xffffu) * (g0[0] * a0[0] + b), bf2f(uu.x >> 16) * (g0[1] * a0[1] + b));
                w.y = cvtpk(bf2f(uu.y & 0xffffu) * (g0[2] * a0[2] + b), bf2f(uu.y >> 16) * (g0[3] * a0[3] + b));
                w.z = cvtpk(bf2f(uu.z & 0xffffu) * (g1[0] * a1[0] + b), bf2f(uu.z >> 16) * (g1[1] * a1[1] + b));
                w.w = cvtpk(bf2f(uu.w & 0xffffu) * (g1[2] * a1[2] + b), bf2f(uu.w >> 16) * (g1[3] * a1[3] + b));
                *(u32x4*)(GT + (size_t)tok * GH + c0) = w; }
        }
    }
    __syncthreads();
}

constexpr int AT_KP = 272, AT_VP = 288, AT_VOFF = 256 * AT_KP, AT_UNITS = 3072;
typedef short s16x4 __attribute__((ext_vector_type(4)));
struct AtUnit { int gi, b, h, r, n, dsh; };
__device__ __forceinline__ AtUnit at_decode(int unit) { AtUnit u; u.gi = unit >> 10; const int rem = unit & 1023; u.b = rem >> 8; u.h = (rem >> 4) & 15; const int rn = rem & 15;
    u.dsh = 2 * u.gi; const int nbsh = 4 - u.dsh; u.r = rn >> nbsh; u.n = rn & ((1 << nbsh) - 1); return u; }
#define AT_TR4(o0, o1, o2, o3, f0, f1, f2, f3) asm volatile("ds_read_b64_tr_b16 %0, %4 offset:%5\n\tds_read_b64_tr_b16 %1, %4 offset:%6\n\tds_read_b64_tr_b16 %2, %4 offset:%7\n\tds_read_b64_tr_b16 %3, %4 offset:%8" \
        : "=&v"(o0), "=&v"(o1), "=&v"(o2), "=&v"(o3) : "v"(vrow), "i"(f0), "i"(f1), "i"(f2), "i"(f3) : "memory")
__device__ __forceinline__ void phase_attn(const Params& p, LAS3 unsigned char* lds) {
    const int tid = threadIdx.x, lane = tid & 63, wave = __builtin_amdgcn_readfirstlane(tid >> 6), fr = lane & 15, fq = lane >> 4, G = (int)gridDim.x;
    unsigned char* ws = p.ws;
    const bf16_t* Q = (const bf16_t*)(ws + OFF_Q); const bf16_t* KV = (const bf16_t*)(ws + OFF_KV); bf16_t* OG = (bf16_t*)(ws + OFF_OG); float* LSE = (float*)(ws + OFF_LSE);
    const unsigned vbase = (unsigned)(size_t)(lds + AT_VOFF);
    const unsigned vrow = vbase + (unsigned)((16 * wave + 4 * fq + ((lane & 15) >> 2)) * AT_VP + (lane & 3) * 8);
    const int srow = tid >> 4, c16 = tid & 15;
    int unit = blockIdx.x;
    if (unit < AT_UNITS) {
        AtUnit cu = at_decode(unit);
        u32x4 kreg[8], vreg[8]; bf16x8 qf[4], qn[4];
#define AT_LOADQ(U, D) do { const int _tok = (U).b * SEQ + ((((U).n << 7) + wave * 16 + fr) << (U).dsh) + (U).r; _Pragma("unroll") for (int ks = 0; ks < 4; ++ks) D[ks] = *(const bf16x8*)(Q + (size_t)_tok * NQ + (U).gi * 2048 + (U).h * 128 + ks * 32 + fq * 8); } while (0)
#define AT_LOAD(U) do { _Pragma("unroll") for (int ps = 0; ps < 8; ++ps) if ((U).n > 0 || ps >= 4) { const int lk = ((U).n - 1) * 128 + ps * 32 + srow; \
            const bf16_t* src = KV + ((size_t)(U).h * NTOK + (U).b * SEQ + (lk << (U).dsh) + (U).r) * 128 + c16 * 8; kreg[ps] = *(const u32x4*)src; vreg[ps] = *(const u32x4*)(src + (size_t)16 * NTOK * 128); } } while (0)
        AT_LOAD(cu); AT_LOADQ(cu, qn);
        for (;;) {
            asm volatile("" ::: "memory"); __builtin_amdgcn_s_barrier(); asm volatile("" ::: "memory");
#pragma unroll
            for (int ps = 0; ps < 8; ++ps) if (cu.n > 0 || ps >= 4) { const int kk = ps * 32 + srow;
                *(LAS3 u32x4*)(lds + kk * AT_KP + c16 * 16) = kreg[ps]; *(LAS3 u32x4*)(lds + AT_VOFF + kk * AT_VP + c16 * 16) = vreg[ps]; }
            const int jq = wave * 16 + fr, qtok = cu.b * SEQ + (((cu.n << 7) + jq) << cu.dsh) + cu.r;
#pragma unroll
            for (int ks = 0; ks < 4; ++ks) qf[ks] = qn[ks];
            const int un = unit + G; const bool hasn = un < AT_UNITS; AtUnit nu = cu;
            if (hasn) { nu = at_decode(un); AT_LOAD(nu); AT_LOADQ(nu, qn); }
            asm volatile("s_waitcnt lgkmcnt(0)" ::: "memory"); __builtin_amdgcn_s_barrier(); asm volatile("" ::: "memory");
            const int c_lo = cu.n == 0 ? (8 - wave) : 0;
            f32x4 sc[9];
#pragma unroll
            for (int c = 0; c < 9; ++c) { sc[c] = (f32x4){0.f, 0.f, 0.f, 0.f};
                if (c >= c_lo) {
#pragma unroll
                    for (int ks = 0; ks < 4; ++ks) { const bf16x8 kf = *(const LAS3 bf16x8*)(lds + (16 * (wave + c) + fr) * AT_KP + (ks * 32 + fq * 8) * 2);
                        sc[c] = __builtin_amdgcn_mfma_f32_16x16x32_bf16(kf, qf[ks], sc[c], 0, 0, 0); } } }
            const float slope2 = exp2f(-0.5f * (float)(cu.h + 1)) * 1.4426950409f; const int dq = fr - 4 * fq; const float t0 = slope2 * (float)(128 + dq); float mx = -3.0e38f;
#pragma unroll
            for (int c = 0; c < 9; ++c) {
                if (c >= c_lo) {
#pragma unroll
                    for (int q = 0; q < 4; ++q) { float s2 = fmaf(sc[c][q], 0.08838834764831845f * 1.4426950409f, fmaf(slope2, (float)(16 * c + q), -t0));
                        if (c == 0) s2 = (dq - q <= 0) ? s2 : -3.0e38f;
                        if (c == 8) s2 = (dq - q >= 0) ? s2 : -3.0e38f;
                        sc[c][q] = s2; mx = fmaxf(mx, s2); }
                } else { sc[c] = (f32x4){-3.0e38f, -3.0e38f, -3.0e38f, -3.0e38f}; } }
            mx = fmaxf(mx, __shfl_xor(mx, 16)); mx = fmaxf(mx, __shfl_xor(mx, 32));
            float den = 0.f;
#pragma unroll
            for (int c = 0; c < 9; ++c) {
                if (c >= c_lo) {
#pragma unroll
                    for (int q = 0; q < 4; ++q) { const float e = __builtin_amdgcn_exp2f(sc[c][q] - mx); sc[c][q] = e; den += e; }
                } else { sc[c] = (f32x4){0.f, 0.f, 0.f, 0.f}; } }
            den += __shfl_xor(den, 16); den += __shfl_xor(den, 32);
            f32x4 o[8];
#pragma unroll
            for (int et = 0; et < 8; ++et) o[et] = (f32x4){0.f, 0.f, 0.f, 0.f};
#pragma unroll
            for (int pp = 0; pp < 5; ++pp) {
                if (2 * pp + 1 >= c_lo) {
                    u32x4 pw; pw.x = cvtpk(sc[2 * pp][0], sc[2 * pp][1]); pw.y = cvtpk(sc[2 * pp][2], sc[2 * pp][3]);
                    if (pp < 4) { pw.z = cvtpk(sc[2 * pp + 1][0], sc[2 * pp + 1][1]); pw.w = cvtpk(sc[2 * pp + 1][2], sc[2 * pp + 1][3]); } else { pw.z = 0u; pw.w = 0u; }
                    const bf16x8 pf = __builtin_bit_cast(bf16x8, pw);
                    constexpr int R1 = 16 * AT_VP;
                    const int r0 = (32 * pp) * AT_VP, r1 = (pp < 4 ? (32 * pp + 16) : (32 * pp)) * AT_VP; (void)R1;
                    s16x4 a0, a1, a2, a3, a4, a5, a6, a7, b0, b1, b2, b3, b4, b5, b6, b7;
                    AT_TR4(a0, a1, a2, a3, r0, r0 + 32, r0 + 64, r0 + 96); AT_TR4(a4, a5, a6, a7, r0 + 128, r0 + 160, r0 + 192, r0 + 224);
                    AT_TR4(b0, b1, b2, b3, r1, r1 + 32, r1 + 64, r1 + 96); AT_TR4(b4, b5, b6, b7, r1 + 128, r1 + 160, r1 + 192, r1 + 224);
                    asm volatile("s_waitcnt lgkmcnt(0)" : "+v"(a0), "+v"(a1), "+v"(a2), "+v"(a3), "+v"(a4), "+v"(a5), "+v"(a6), "+v"(a7), "+v"(b0), "+v"(b1), "+v"(b2), "+v"(b3), "+v"(b4), "+v"(b5), "+v"(b6), "+v"(b7) :: "memory");
                    if (2 * pp < c_lo) { const s16x4 z = {0, 0, 0, 0}; a0 = z; a1 = z; a2 = z; a3 = z; a4 = z; a5 = z; a6 = z; a7 = z; }
#define AT_PV(et, A, B) o[et] = __builtin_amdgcn_mfma_f32_16x16x32_bf16((bf16x8){A[0], A[1], A[2], A[3], B[0], B[1], B[2], B[3]}, pf, o[et], 0, 0, 0)
                    AT_PV(0, a0, b0); AT_PV(1, a1, b1); AT_PV(2, a2, b2); AT_PV(3, a3, b3); AT_PV(4, a4, b4); AT_PV(5, a5, b5); AT_PV(6, a6, b6); AT_PV(7, a7, b7);
#undef AT_PV
                } }
            const float inv = 1.0f / den;
            bf16_t* op = OG + ((size_t)cu.gi * NTOK + qtok) * DM + cu.h * 128 + 4 * fq;
#pragma unroll
            for (int et = 0; et < 8; ++et) { uint2 w; w.x = cvtpk(o[et][0] * inv, o[et][1] * inv); w.y = cvtpk(o[et][2] * inv, o[et][3] * inv); *(uint2*)(op + et * 16) = w; }
            if (fq == 0) LSE[((size_t)cu.gi * NTOK + qtok) * 16 + cu.h] = (mx + __log2f(den)) * 0.6931471806f;
            if (!hasn) break;
            unit = un; cu = nu;
        }
#undef AT_LOAD
#undef AT_LOADQ
    }
    __syncthreads();
}
#undef AT_TR4

__device__ __forceinline__ void phase_merge(const Params& p) {
    unsigned char* ws = p.ws; const bf16_t* OG = (const bf16_t*)(ws + OFF_OG); const float* LSE = (const float*)(ws + OFF_LSE); bf16_t* OM = (bf16_t*)(ws + OFF_OM);
    for (size_t i = (size_t)blockIdx.x * MK_THREADS + threadIdx.x; i < (size_t)NTOK * 256; i += (size_t)gridDim.x * MK_THREADS) {
        const int tok = (int)(i >> 8), c8 = (int)(i & 255), h = c8 >> 4;
        const float l0 = LSE[((size_t)0 * NTOK + tok) * 16 + h], l1 = LSE[((size_t)1 * NTOK + tok) * 16 + h], l2 = LSE[((size_t)2 * NTOK + tok) * 16 + h];
        const float m = fmaxf(l0, fmaxf(l1, l2)); const float a0 = __expf(l0 - m), a1 = __expf(l1 - m), a2 = __expf(l2 - m), inv = 1.0f / (a0 + a1 + a2);
        const uint4 x0 = *(const uint4*)(OG + ((size_t)0 * NTOK + tok) * DM + c8 * 8), x1 = *(const uint4*)(OG + ((size_t)1 * NTOK + tok) * DM + c8 * 8), x2 = *(const uint4*)(OG + ((size_t)2 * NTOK + tok) * DM + c8 * 8);
        const unsigned w0[4] = {x0.x, x0.y, x0.z, x0.w}, w1[4] = {x1.x, x1.y, x1.z, x1.w}, w2[4] = {x2.x, x2.y, x2.z, x2.w}; unsigned rr[4];
#pragma unroll
        for (int j = 0; j < 4; ++j) { const float lo = (a0 * bf2f(w0[j] & 0xffffu) + a1 * bf2f(w1[j] & 0xffffu) + a2 * bf2f(w2[j] & 0xffffu)) * inv;
            const float hi = (a0 * bf2f(w0[j] >> 16) + a1 * bf2f(w1[j] >> 16) + a2 * bf2f(w2[j] >> 16)) * inv; rr[j] = cvtpk(lo, hi); }
        *(uint4*)(OM + (size_t)tok * DM + c8 * 8) = make_uint4(rr[0], rr[1], rr[2], rr[3]);
    }
}
#define PHASE2_BODY phase_sgu(p, lds);
#define PHASE9_BODY phase_attn(p, lds);
#define PHASE10_BODY phase_merge(p);

__global__ void __launch_bounds__(MK_THREADS, 2) mega(Params p, int lo, int hi) {
    extern __shared__ __attribute__((aligned(16))) unsigned char shm[];
    LAS3 unsigned char* lds = (LAS3 unsigned char*)shm;
    const int tid = threadIdx.x, wave = __builtin_amdgcn_readfirstlane(tid >> 6), G = (int)gridDim.x;
#define MK_LANE() ((int)__builtin_amdgcn_mbcnt_hi(~0u, __builtin_amdgcn_mbcnt_lo(~0u, 0u)))
    unsigned char* ws = p.ws;
    volatile LAS3 unsigned* xbw = (volatile LAS3 unsigned*)(lds + MK_LDS_BAR);
    if (tid < 4) xbw[tid] = 0u;
    __syncthreads();
    XcdBarrier bar; bar.bar = (unsigned*)(ws + OFF_CTRL + CTRL_BAR_BYTE); bar.x = 0; bar.st = xbw;
    if (hi - lo > 1) bar = xcd_barrier_post((unsigned*)(ws + OFF_CTRL + CTRL_BAR_BYTE), xbw);
#define IN(k) (lo <= (k) && (k) < hi)
#define SEAM(k) do { if (IN(k) && IN((k) + 1)) xcd_barrier(bar); } while (0)
    float* SSP = (float*)(ws + OFF_SSP);
    bf16_t* XN = (bf16_t*)(ws + OFF_XN); bf16_t* XNQ = (bf16_t*)(ws + OFF_XNQ);
    bf16_t* MIX = (bf16_t*)(ws + OFF_MIX); bf16_t* H1 = (bf16_t*)(ws + OFF_H1); bf16_t* H2 = (bf16_t*)(ws + OFF_H2); bf16_t* H3 = (bf16_t*)(ws + OFF_H3);
    int* ictrl = (int*)(ws + OFF_CTRL);
    const float* gains = p.gains;

    constexpr int CR0 = CT1, CR1 = 12800, CR3 = 17408, CR5 = 34304, CR6 = 42496, CR8 = CT8;
    static_assert(CR1 >= CT6, "every dense weight is converted by the end of P1");
    const bool conv_first = (blockIdx.x & 1) == 0;
    constexpr int CVF = 9;
#define CV_MID(a, b) ((a) + (((b) - (a)) * CVF / 16))
    if (IN(0)) {
        phase_convert(p, lds, 0, CR0, (int)blockIdx.x, G);
        { const int lane = MK_LANE(); for (int row = blockIdx.x * 8 + wave; row < NTOK; row += G * 8) row_norm0(p, row, lane); }
    }
    SEAM(0);
    if (IN(1)) {
        if (conv_first) phase_convert(p, lds, CR0, CV_MID(CR0, CR1), (int)blockIdx.x >> 1, G >> 1);
        { pg8::Gemm g{XN, (const bf16_t*)(ws + OFF_WIN_T), NTOK, GH, DM}; pg8::StaticOrder S; S.init(NTOK, GH, G, (int)blockIdx.x);
          EpiGeluU E{(bf16_t*)(ws + OFF_U), GH, p.a_b_in};
          pg8::gemm_phase<EpiGeluU, pg8::StaticOrder>(lds, g, S, E, nullptr); }
        { pg8::Gemm g{(const bf16_t*)(ws + OFF_WIN_T) + (size_t)GH * DM, XN, GH, NTOK, DM}; pg8::StaticOrder S; S.init(GH, NTOK, G, (int)blockIdx.x);
          EpiGeluVT E{(bf16_t*)(ws + OFF_VT), p.a_b_in + GH, SSP};
          pg8::gemm_phase<EpiGeluVT, pg8::StaticOrder>(lds, g, S, E, nullptr); }
        if (!conv_first) phase_convert(p, lds, CV_MID(CR0, CR1), CR1, (int)blockIdx.x >> 1, G >> 1);
    }
    SEAM(1);
    if (IN(2)) { PHASE2_BODY }
    SEAM(2);
    if (IN(3)) {
        if (conv_first) phase_convert(p, lds, CR1, CV_MID(CR1, CR3), (int)blockIdx.x >> 1, G >> 1);
        pg8::Gemm g{(const bf16_t*)(ws + OFF_GT), (const bf16_t*)(ws + OFF_WOUT_T), NTOK, DM, GH}; pg8::StaticOrder S; S.init(NTOK, DM, G, (int)blockIdx.x);
        EpiBf16SS E{MIX, DM, SSP};
        pg8::gemm_phase<EpiBf16SS, pg8::StaticOrder>(lds, g, S, E, nullptr);
        if (!conv_first) phase_convert(p, lds, CV_MID(CR1, CR3), CR3, (int)blockIdx.x >> 1, G >> 1);
    }
    SEAM(3);
    if (IN(4)) { phase_resnorm<false>(p.x, MIX, SSP, gains + DM, H1, gains + 2 * DM, XN, nullptr, nullptr, wave, MK_LANE(), G); }
    SEAM(4);
    if (IN(5)) {
        if (conv_first) phase_convert(p, lds, CR3, CV_MID(CR3, CR5), (int)blockIdx.x >> 1, G >> 1);
        pg8::Gemm g{XN, (const bf16_t*)(ws + OFF_WGU_T), NTOK, 2 * DFF, DM}; pg8::StaticOrder S; S.init(NTOK, 2 * DFF, G, (int)blockIdx.x);
        EpiSwiglu E{(bf16_t*)(ws + OFF_ACT), DFF, 56};
        pg8::gemm_phase<EpiSwiglu, pg8::StaticOrder>(lds, g, S, E, nullptr);
        if (!conv_first) phase_convert(p, lds, CV_MID(CR3, CR5), CR5, (int)blockIdx.x >> 1, G >> 1);
    }
    SEAM(5);
    if (IN(6)) {
        if (conv_first) phase_convert(p, lds, CR5, CV_MID(CR5, CR6), (int)blockIdx.x >> 1, G >> 1);
        pg8::Gemm g{(const bf16_t*)(ws + OFF_ACT), (const bf16_t*)(ws + OFF_WDN_T), NTOK, DM, DFF}; pg8::StaticOrder S; S.init(NTOK, DM, G, (int)blockIdx.x);
        EpiBf16SS E{MIX, DM, SSP};
        pg8::gemm_phase<EpiBf16SS, pg8::StaticOrder>(lds, g, S, E, nullptr);
        if (!conv_first) phase_convert(p, lds, CV_MID(CR5, CR6), CR6, (int)blockIdx.x >> 1, G >> 1);
    }
    SEAM(6);
    if (IN(7)) { phase_resnorm<true>(H1, MIX, SSP, gains + 3 * DM, H2, p.kv_norm, XN, gains + 4 * DM, XNQ, wave, MK_LANE(), G); }
    SEAM(7);
    if (IN(8)) {
        if (conv_first) phase_convert(p, lds, CR6, CV_MID(CR6, CR8), (int)blockIdx.x >> 1, G >> 1);
        { pg8::Gemm g{XN, (const bf16_t*)(ws + OFF_WKV_T), NTOK, NKV, DM}; pg8::StaticOrder S; S.init(NTOK, NKV, G, (int)blockIdx.x);
          EpiBf16H E{(bf16_t*)(ws + OFF_KV), NTOK};
          pg8::gemm_phase<EpiBf16H, pg8::StaticOrder>(lds, g, S, E, nullptr); }
        { pg8::Gemm g{XNQ, (const bf16_t*)(ws + OFF_WQ_T), NTOK, NQ, DM}; pg8::StaticOrder S; S.init(NTOK, NQ, G, (int)blockIdx.x);
          EpiBf16P E{(bf16_t*)(ws + OFF_Q), NQ};
          pg8::gemm_phase<EpiBf16P, pg8::StaticOrder>(lds, g, S, E, nullptr); }
        if (!conv_first) phase_convert(p, lds, CV_MID(CR6, CR8), CR8, (int)blockIdx.x >> 1, G >> 1);
    }
    SEAM(8);
    if (IN(9)) { PHASE9_BODY }
    SEAM(9);
    if (IN(10)) { PHASE10_BODY }
    SEAM(10);
    if (IN(11)) {
        pg8::Gemm g{(const bf16_t*)(ws + OFF_OM), (const bf16_t*)(ws + OFF_WO_T), NTOK, DM, DM}; pg8::StaticOrder S; S.init(NTOK, DM, G, (int)blockIdx.x);
        EpiBf16SS E{MIX, DM, SSP};
        pg8::gemm_phase<EpiBf16SS, pg8::StaticOrder>(lds, g, S, E, nullptr);
    }
    SEAM(11);
    if (IN(12)) { stage_router(p.moe_router, lds); const int lane = MK_LANE(); for (int row = blockIdx.x * 8 + wave; row < NTOK; row += G * 8) { int ln = lane; asm volatile("" : "+v"(ln));
        row_router(H2, MIX, SSP, gains + 5 * DM, H3, gains + 6 * DM, (const LAS3 float*)lds, ws + OFF_XS, ictrl + C_CNT, (int*)(ws + OFF_TOKS), (float*)(ws + OFF_TOKG), row, ln); } }
    SEAM(12);
    if (IN(13)) {
        const int nblk = moe_table(ictrl + C_CNT, lds);
        pg8::Gemm g{(const bf16_t*)(ws + OFF_XS), (const bf16_t*)(ws + OFF_MGU_T), nblk * 256, 2 * DFF, DM}; MoeOrder S; S.init(nblk * 256, 2 * DFF, G, (int)blockIdx.x); S.tbl = (const LAS3 int*)(lds + MOE_TBL_OFF); S.NT = 56; S.lim = 0x7fffffff;
        EpiSwiglu8 E{ws + OFF_ACT2, DFF, 56, 1.0f / (F8_SA1 * F8_SW1), F8_SA2};
        pg8::gemm_phase<EpiSwiglu8, MoeOrder, false, true>(lds, g, S, E, nullptr);
    }
    SEAM(13);
    if (IN(14)) {
        const int nblk = moe_table(ictrl + C_CNT, lds); const int nunits = nblk * 8; int lim = 2 * G < nunits ? 2 * G : nunits; if ((nunits - lim) * KSPLIT > G) lim = nunits;
        { pg8::Gemm g{(const bf16_t*)(ws + OFF_ACT2), (const bf16_t*)(ws + OFF_MDN_T), nblk * 256, DM, DFF}; MoeOrder S; S.init(nblk * 256, DM, G, (int)blockIdx.x); S.tbl = (const LAS3 int*)(lds + MOE_TBL_OFF); S.NT = 8; S.lim = lim;
          EpiBf16S E{(bf16_t*)(ws + OFF_Y), DM, 8, 1.0f / (F8_SA2 * F8_SW2)};
          pg8::gemm_phase<EpiBf16S, MoeOrder, false, true>(lds, g, S, E, nullptr); }
        { const int nleft = nunits - lim, item = (int)blockIdx.x, li = item / KSPLIT, ch = item - li * KSPLIT;
          constexpr int CKT = DFF / 128 / KSPLIT;
          pg8::Gemm g{(const bf16_t*)(ws + OFF_ACT2 + (size_t)ch * CKT * 128), (const bf16_t*)(ws + OFF_MDN_T + (size_t)ch * CKT * 128), nblk * 256, DM, DFF, CKT};
          LeftOrder S; S.init(nblk * 256, DM, G, 0); S.tbl = (const LAS3 int*)(lds + MOE_TBL_OFF); S.NT = 8; S.L = li < nleft ? lim + li : -1;
          EpiF32Part E{(float*)(ws + OFF_U) + ((size_t)li * KSPLIT + ch) * 65536, 1.0f / (F8_SA2 * F8_SW2), ictrl + C_TFLAG, li, 8, ch == 0};
          pg8::gemm_phase<EpiF32Part, LeftOrder, false, true>(lds, g, S, E, nullptr); }
    }
    SEAM(14);
    if (IN(15)) { const int lane = MK_LANE(); for (int row = blockIdx.x * 8 + wave; row < NTOK; row += G * 8)
        row_final(H3, (const bf16_t*)(ws + OFF_Y), (const float*)(ws + OFF_U)  , ictrl + C_TFLAG, (const int*)(ws + OFF_TOKS), (const float*)(ws + OFF_TOKG), gains + 7 * DM, p.out, row, lane); }
#undef IN
#undef SEAM
}

extern "C" void kernel_launch(void* const* d_in, const int* in_sizes, int n_in, void* d_out, int out_size, void* d_ws, size_t ws_size, hipStream_t stream) {
    (void)in_sizes; (void)n_in; (void)out_size;
    if (ws_size < WS_NEED) { fprintf(stderr, "workspace too small: %zu < %zu\n", ws_size, (size_t)WS_NEED); return; }
    static int grid = 0;
    if (grid == 0) {
        int dev = 0, cus = 0, per_cu = 0;
        if (hipGetDevice(&dev) != hipSuccess || hipDeviceGetAttribute(&cus, hipDeviceAttributeMultiprocessorCount, dev) != hipSuccess) { fprintf(stderr, "device query failed\n"); grid = -1; return; }
        if (hipFuncSetAttribute((const void*)mega, hipFuncAttributeMaxDynamicSharedMemorySize, MK_LDS_BYTES) != hipSuccess) { fprintf(stderr, "hipFuncSetAttribute failed\n"); grid = -1; return; }
        if (hipOccupancyMaxActiveBlocksPerMultiprocessor(&per_cu, (const void*)mega, MK_THREADS, MK_LDS_BYTES) != hipSuccess || per_cu < 1) { fprintf(stderr, "occupancy query: %d blocks per CU\n", per_cu); (void)hipGetLastError(); }
        grid = cus;
    }
    if (grid < 0) return;
    const float* const* in = (const float* const*)d_in;
    Params P{};
    P.x = in[0]; P.gains = in[1]; P.a_w_in = in[2]; P.a_b_in = in[3]; P.a_norm_v = in[4]; P.a_w_s = in[5]; P.a_b_s = in[6]; P.a_w_out = in[7]; P.kv_norm = in[8]; P.w_kv = in[9]; P.w_q = in[10]; P.w_o = in[11];
    P.ffn_w_gu = in[12]; P.ffn_w_down = in[13]; P.moe_router = in[14]; P.moe_w_gu = in[15]; P.moe_w_down = in[16]; P.out = (float*)d_out; P.ws = (unsigned char*)d_ws;
#define MEGA(lo, hi) hipLaunchKernelGGL(mega, dim3(grid), dim3(MK_THREADS), MK_LDS_BYTES, stream, P, (lo), (hi))

    (void)hipMemsetAsync((char*)d_ws + OFF_CTRL, 0, CTRL_BYTES, stream);
    MEGA(0, NPH);
}
```

```cpp
#include <hip/hip_runtime.h>
#include <stdint.h>
#include <stdio.h>

typedef unsigned short bf16_t;

constexpr int NTOK = 8192, DM = 2048, SEQ = 2048, GH = 4096  , DFF = 7168, NEXP = 8;
constexpr int NQ = 6144, NKV = 4096;
constexpr int ECAP = NTOK, MAXSLOT = NEXP * ECAP;
constexpr float EPS = 1e-6f;

constexpr size_t AL(size_t x) { return (x + 255) & ~(size_t)255; }
constexpr size_t OFF_CTRL = 0;
constexpr size_t CTRL_BYTES = 1 << 16;
constexpr int C_CNT = 0  ;
constexpr int SSP_N = 64;
constexpr size_t OFF_SSP  = AL(OFF_CTRL + CTRL_BYTES);
constexpr size_t OFF_XN   = AL(OFF_SSP + (size_t)NTOK * SSP_N * 4);
constexpr size_t OFF_XNQ  = AL(OFF_XN + (size_t)NTOK * DM * 2);
constexpr size_t OFF_U    = AL(OFF_XNQ + (size_t)NTOK * DM * 2);
constexpr size_t OFF_VT   = AL(OFF_U + (size_t)NTOK * GH * 2);
constexpr size_t OFF_GT   = AL(OFF_VT + (size_t)NTOK * GH * 2);
constexpr size_t OFF_MIX  = AL(OFF_GT + (size_t)NTOK * GH * 2);
constexpr size_t OFF_H1   = AL(OFF_MIX + (size_t)NTOK * DM * 4);
constexpr size_t OFF_H2   = AL(OFF_H1 + (size_t)NTOK * DM * 4);
constexpr size_t OFF_H3   = AL(OFF_H2 + (size_t)NTOK * DM * 4);
constexpr size_t OFF_ACT  = AL(OFF_H3 + (size_t)NTOK * DM * 4);
constexpr size_t OFF_KV   = AL(OFF_ACT + (size_t)NTOK * DFF * 2);
constexpr size_t OFF_Q    = AL(OFF_KV + (size_t)NTOK * NKV * 2);
constexpr size_t OFF_OG   = AL(OFF_Q + (size_t)NTOK * NQ * 2);
constexpr size_t OFF_LSE  = AL(OFF_OG + (size_t)3 * NTOK * DM * 2);
constexpr size_t OFF_OM   = AL(OFF_LSE + (size_t)3 * NTOK * 16 * 4);
constexpr size_t OFF_TOKG = AL(OFF_OM + (size_t)NTOK * DM * 2);
constexpr size_t OFF_TOKS = AL(OFF_TOKG + (size_t)NTOK * 2 * 4);
constexpr size_t OFF_XS   = AL(OFF_TOKS + (size_t)NTOK * 2 * 4);
constexpr size_t OFF_ACT2 = AL(OFF_XS + (size_t)MAXSLOT * DM);
constexpr size_t OFF_Y    = AL(OFF_ACT2 + (size_t)MAXSLOT * DFF);
constexpr size_t OFF_WIN_T  = AL(OFF_Y + (size_t)MAXSLOT * DM * 2);
constexpr size_t OFF_WOUT_T = AL(OFF_WIN_T + (size_t)2 * GH * DM * 2);
constexpr size_t OFF_WGU_T  = AL(OFF_WOUT_T + (size_t)DM * GH * 2);
constexpr size_t OFF_WDN_T  = AL(OFF_WGU_T + (size_t)2 * DFF * DM * 2);
constexpr size_t OFF_WKV_T  = AL(OFF_WDN_T + (size_t)DM * DFF * 2);
constexpr size_t OFF_WQ_T   = AL(OFF_WKV_T + (size_t)NKV * DM * 2);
constexpr size_t OFF_WO_T   = AL(OFF_WQ_T + (size_t)NQ * DM * 2);
constexpr size_t OFF_MGU_T  = AL(OFF_WO_T + (size_t)DM * DM * 2);
constexpr size_t OFF_MDN_T  = AL(OFF_MGU_T + (size_t)NEXP * 2 * DFF * DM);
constexpr size_t WS_NEED  = AL(OFF_MDN_T + (size_t)NEXP * DM * DFF);
constexpr size_t CTRL_BAR_BYTE = 4096;

__device__ __forceinline__ float bf2f(unsigned v) { return __uint_as_float(v << 16); }
__device__ __forceinline__ bf16_t f2bf(float f) { unsigned u = __float_as_uint(f); u += 0x7FFFu + ((u >> 16) & 1u); return (bf16_t)(u >> 16); }
__device__ __forceinline__ unsigned pack2(float lo, float hi) { return (unsigned)f2bf(lo) | ((unsigned)f2bf(hi) << 16); }
__device__ __forceinline__ float gelu_tanh(float x) { const float t = 1.5957691216057308f * (x + 0.044715f * x * x * x); return x / (1.0f + __expf(-t)); }
__device__ __forceinline__ float silu(float x) { return x / (1.0f + __expf(-x)); }
__device__ __forceinline__ float wave_sum(float v) { for (int o = 32; o >= 1; o >>= 1) v += __shfl_xor(v, o); return v; }
__device__ __forceinline__ float wave_max(float v) { for (int o = 32; o >= 1; o >>= 1) v = fmaxf(v, __shfl_xor(v, o)); return v; }

namespace pg8 {
#define PG8_LAS __attribute__((address_space(3)))
typedef unsigned short bf16_t;
typedef short bf16x8 __attribute__((ext_vector_type(8)));
typedef float f32x4 __attribute__((ext_vector_type(4)));
typedef unsigned u32x4 __attribute__((ext_vector_type(4)));
constexpr int BM = 256, BK = 64, HALF = 128, HTB = HALF * BK * 2  , STAGE_BYTES = 8 * HTB, NXCD = 8, WGM = 8;

__host__ __device__ __forceinline__ int lds_byte(int r, int c) { const int st = (r >> 4) * 2 + (c >> 5), rr = r & 15, cc = c & 31, ob = rr * 64 + cc * 2; return st * 1024 + (ob ^ (((ob >> 9) & 1) << 5)); }
__host__ __device__ __forceinline__ void stage_rc(int b, int& R, int& C) { const int st = b / 1024, sb = b % 1024, swz = sb ^ (((sb >> 9) & 1) << 5); R = (st >> 1) * 16 + swz / 64; C = (st & 1) * 32 + (swz % 64) / 2; }
__host__ __device__ __forceinline__ int perm32(int rho) { const int n = rho >> 4, i = rho & 15; return 8 * (i >> 2) + 4 * n + (i & 3); }

struct Unit { int pm, pn; };
struct Gemm { const bf16_t* A; const bf16_t* Bt; int M, N, K; int kt; };

struct StaticOrder {
    int nM, nN, nwg, G, c;
    __host__ __device__ void init(int M, int N, int G_, int c_) { nM = M / BM; nN = N / BM; nwg = nM * nN; G = G_; c = c_; }
    __host__ __device__ bool next(int i, Unit& u) const {
        const long L = (long)i * G + c; if (L >= nwg) return false;
        int wgid = (int)L; { const int q = nwg / NXCD, r = nwg % NXCD, xcd = wgid % NXCD, off = wgid / NXCD; wgid = (xcd < r ? xcd * (q + 1) : r * (q + 1) + (xcd - r) * q) + off; }
        const int nig = WGM * nN, gid = wgid / nig, fm = gid * WGM, gsz = (nM - fm) < WGM ? (nM - fm) : WGM;
        u.pm = fm + ((wgid % nig) % gsz); u.pn = (wgid % nig) / gsz; return true;
    }
    __device__ __forceinline__ void a_ready(const Unit&) const {}
    __device__ __forceinline__ void done(const Unit&) const {}
};
__device__ __forceinline__ unsigned cvt_pk_bf16(float lo, float hi) { unsigned r; asm volatile("v_cvt_pk_bf16_f32 %0, %1, %2" : "=v"(r) : "v"(lo), "v"(hi)); return r; }
typedef float f32x2 __attribute__((ext_vector_type(2)));
typedef int pg8_v4i __attribute__((ext_vector_type(4))); typedef int pg8_v8i __attribute__((ext_vector_type(8)));
__device__ __forceinline__ pg8_v8i pg8_cat(bf16x8 a, bf16x8 b) { return __builtin_shufflevector(__builtin_bit_cast(pg8_v4i, a), __builtin_bit_cast(pg8_v4i, b), 0, 1, 2, 3, 4, 5, 6, 7); }
template <bool F8> struct pg8_frag; template <> struct pg8_frag<false> { bf16x8 v[2]; }; template <> struct pg8_frag<true> { pg8_v8i v; };
template <class Epi, class Sched, bool STAMP = false, bool F8 = false>
__device__ __forceinline__ void gemm_phase(PG8_LAS unsigned char* lds, const Gemm g, const Sched& S, const Epi& E, unsigned long long* stamps) {
    const int tid = threadIdx.x, wid = __builtin_amdgcn_readfirstlane(tid >> 6), lane = tid & 63, wr = wid >> 2, wc = wid & 3, fr = lane & 15, fq = lane >> 4;
    const int K = F8 ? (g.K >> 1) : g.K  , nt = g.kt ? g.kt : K / BK;
    int ts_lo = 0, ts_hi = 0, nts = 0; const unsigned long long rt_entry = STAMP ? (unsigned long long)wall_clock64() : 0ull;
#define PG8_STAMP() do { if (STAMP && wid == 0 && nts < 64) { const unsigned long long _c = (unsigned long long)clock64(); \
        ts_lo = (lane == nts) ? (int)(unsigned)_c : ts_lo; ts_hi = (lane == nts) ? (int)(unsigned)(_c >> 32) : ts_hi; ++nts; } } while (0)
    PG8_STAMP();
    unsigned voffA[2], voffB[2];
#pragma unroll
    for (int i = 0; i < 2; ++i) { int R, C; stage_rc(tid * 16 + i * 8192, R, C); const int Rb = Epi::PERM ? ((R & ~31) + perm32(R & 31)) : R;
        voffA[i] = (unsigned)(R * K + C) * 2u; voffB[i] = (unsigned)(Rb * K + C) * 2u; }
    const size_t kstep = (size_t)(BK * 2);
    const size_t hstep = (size_t)HALF * K * 2;
    const size_t tstep = 2 * hstep;
    const unsigned ldsw = (unsigned)wid * 1024u;
    const int aoff = lds_byte(wr * 64 + fr, fq * 8), boff = lds_byte(wc * 32 + fr, fq * 8);
#define PG8_SA(b, h) (((b) * 2 + (h)) * HTB)
#define PG8_SB(b, h) ((4 + (b) * 2 + (h)) * HTB)
#define PG8_STAGE(bufoff, gbase, voff) do { _Pragma("unroll") for (int _i = 0; _i < 2; ++_i) \
        __builtin_amdgcn_global_load_lds((const unsigned*)((const char*)(gbase) + (voff)[_i]), (PG8_LAS unsigned*)(lds + (bufoff) + ldsw + _i * 8192), 16, 0, 0); } while (0)
#define PG8_LDA(dst, b, h) do { _Pragma("unroll") for (int m = 0; m < 4; ++m) { const bf16x8 _l0 = *(const PG8_LAS bf16x8*)(lds + PG8_SA(b, h) + aoff + m * 2048), _l1 = *(const PG8_LAS bf16x8*)(lds + PG8_SA(b, h) + aoff + m * 2048 + 1024); \
        if constexpr (F8) dst[m].v = pg8_cat(_l0, _l1); else { dst[m].v[0] = _l0; dst[m].v[1] = _l1; } } } while (0)
#define PG8_LDB(dst, b, h) do { _Pragma("unroll") for (int n = 0; n < 2; ++n) { const bf16x8 _l0 = *(const PG8_LAS bf16x8*)(lds + PG8_SB(b, h) + boff + n * 2048), _l1 = *(const PG8_LAS bf16x8*)(lds + PG8_SB(b, h) + boff + n * 2048 + 1024); \
        if constexpr (F8) dst[n].v = pg8_cat(_l0, _l1); else { dst[n].v[0] = _l0; dst[n].v[1] = _l1; } } } while (0)
#define PG8_MMA(ai, bj, At, Bt) do { __builtin_amdgcn_s_setprio(1); _Pragma("unroll") for (int m = 0; m < 4; ++m) _Pragma("unroll") for (int n = 0; n < 2; ++n) { \
        if constexpr (F8) asm volatile("v_mfma_scale_f32_16x16x128_f8f6f4 %0, %1, %2, %0, %3, %3 op_sel_hi:[0,0,0]" : "+v"(acc[ai][bj][m][n]) : "v"(Bt[n].v), "v"(At[m].v), "v"(sc127)); \
        else { _Pragma("unroll") for (int k = 0; k < 2; ++k) acc[ai][bj][m][n] = __builtin_amdgcn_mfma_f32_16x16x32_bf16(Bt[n].v[k], At[m].v[k], acc[ai][bj][m][n], 0, 0, 0); } } __builtin_amdgcn_s_setprio(0); } while (0)
#define PG8_WAIT_V(n) asm volatile("s_waitcnt vmcnt(" #n ")" ::: "memory")
#define PG8_WAIT_L(n) asm volatile("s_waitcnt lgkmcnt(" #n ")" ::: "memory")
#define PG8_BAR __builtin_amdgcn_s_barrier()
#define PG8_SCHED __builtin_amdgcn_sched_barrier(0)
    Unit cur, nxt; int ui = 0;
    const int sc127 = 0x7f7f7f7f; (void)sc127;
    if (!S.next(0, cur)) return;
    f32x4 acc[2][2][4][2];
#pragma unroll
    for (int a = 0; a < 2; ++a)
#pragma unroll
        for (int b = 0; b < 2; ++b)
#pragma unroll
            for (int m = 0; m < 4; ++m)
#pragma unroll
                for (int n = 0; n < 2; ++n) acc[a][b][m][n] = (f32x4){0.f, 0.f, 0.f, 0.f};
    pg8_frag<F8> At[4], B0[2], B1[2];
    const char* cA = (const char*)g.A + (size_t)cur.pm * tstep; const char* cB = (const char*)g.Bt + (size_t)cur.pn * tstep;
    S.a_ready(cur);
    PG8_STAGE(PG8_SB(0, 0), cB, voffB); PG8_STAGE(PG8_SA(0, 0), cA, voffA); PG8_STAGE(PG8_SB(0, 1), cB + hstep, voffB); PG8_STAGE(PG8_SA(0, 1), cA + hstep, voffA);
    if (wr == 1) PG8_BAR;
    PG8_WAIT_V(4); PG8_BAR;
    PG8_STAGE(PG8_SB(1, 0), cB + kstep, voffB); PG8_STAGE(PG8_SA(1, 0), cA + kstep, voffA); PG8_STAGE(PG8_SB(1, 1), cB + hstep + kstep, voffB);
    PG8_WAIT_V(6); PG8_BAR;
    PG8_STAMP();
    for (;;) {
        const bool has_next = S.next(ui + 1, nxt);
        const char* nA = has_next ? (const char*)g.A + (size_t)nxt.pm * tstep : cA; const char* nB = has_next ? (const char*)g.Bt + (size_t)nxt.pn * tstep : cB;
        for (int t = 0; t < nt; t += 2) {
            const bool last = (t == nt - 2);
            const char* a1 = cA + (size_t)(t + 1) * kstep;
            const char* a2 = last ? nA : cA + (size_t)(t + 2) * kstep; const char* b2 = last ? nB : cB + (size_t)(t + 2) * kstep;
            const char* a3 = a2 + kstep; const char* b3 = b2 + kstep;
            if (last && has_next) S.a_ready(nxt);
            PG8_LDB(B0, 0, 0); PG8_SCHED; PG8_LDA(At, 0, 0); PG8_STAGE(PG8_SA(1, 1), a1 + hstep, voffA);
            PG8_WAIT_L(8); PG8_BAR; PG8_WAIT_L(0); PG8_MMA(0, 0, At, B0); PG8_BAR; PG8_SCHED;
            PG8_LDB(B1, 0, 1); PG8_STAGE(PG8_SB(0, 0), b2, voffB);
            PG8_BAR; PG8_WAIT_L(0); PG8_MMA(0, 1, At, B1); PG8_BAR;
            PG8_LDA(At, 0, 1); PG8_STAGE(PG8_SA(0, 0), a2, voffA);
            PG8_BAR; PG8_WAIT_L(0); PG8_MMA(1, 0, At, B0); PG8_BAR; PG8_SCHED;
            PG8_STAGE(PG8_SB(0, 1), b2 + hstep, voffB);
            PG8_WAIT_V(6); PG8_BAR; PG8_MMA(1, 1, At, B1); PG8_BAR;
            PG8_LDB(B0, 1, 0); PG8_SCHED; PG8_LDA(At, 1, 0); PG8_STAGE(PG8_SA(0, 1), a2 + hstep, voffA);
            PG8_WAIT_L(8); PG8_BAR; PG8_WAIT_L(0); PG8_MMA(0, 0, At, B0); PG8_BAR; PG8_SCHED;
            PG8_LDB(B1, 1, 1); PG8_STAGE(PG8_SB(1, 0), b3, voffB);
            PG8_BAR; PG8_WAIT_L(0); PG8_MMA(0, 1, At, B1); PG8_BAR;
            PG8_LDA(At, 1, 1); PG8_STAGE(PG8_SA(1, 0), a3, voffA);
            PG8_BAR; PG8_WAIT_L(0); PG8_MMA(1, 0, At, B0); PG8_BAR; PG8_SCHED;
            PG8_STAGE(PG8_SB(1, 1), b3 + hstep, voffB);
            PG8_WAIT_V(6); PG8_BAR; PG8_MMA(1, 1, At, B1); PG8_BAR;
        }
        PG8_STAMP();
        if constexpr (F8) {
            asm volatile("s_nop 15\n\ts_nop 15" ::: "memory");
#pragma unroll
            for (int a = 0; a < 2; ++a)
#pragma unroll
                for (int b = 0; b < 2; ++b)
#pragma unroll
                    for (int m = 0; m < 4; ++m) asm volatile("" : "+v"(acc[a][b][m][0]), "+v"(acc[a][b][m][1]));
        }
        if constexpr (!Epi::AFTER_DRAIN) { E(acc, cur, wr, wc, fr, fq); S.done(cur); }
        PG8_STAMP();
        if (!has_next) break;
#pragma unroll
        for (int a = 0; a < 2; ++a)
#pragma unroll
            for (int b = 0; b < 2; ++b)
#pragma unroll
                for (int m = 0; m < 4; ++m)
#pragma unroll
                    for (int n = 0; n < 2; ++n) acc[a][b][m][n] = (f32x4){0.f, 0.f, 0.f, 0.f};
        cur = nxt; cA = nA; cB = nB; ++ui;
    }
    PG8_WAIT_V(0);
    if (wr == 0) PG8_BAR;
    PG8_BAR;
    if constexpr (Epi::AFTER_DRAIN) { E.fused(acc, cur, wr, wc, fr, fq, lds, wid, lane); S.done(cur); }
    PG8_STAMP();
    if (STAMP && wid == 0) { stamps[lane] = lane < nts ? (((unsigned long long)(unsigned)ts_hi << 32) | (unsigned)ts_lo) : 0ull;
        if (lane == 62) stamps[62] = rt_entry; if (lane == 63) stamps[63] = (unsigned long long)wall_clock64(); }
#undef PG8_STAMP
#undef PG8_SA
#undef PG8_SB
#undef PG8_STAGE
#undef PG8_LDA
#undef PG8_LDB
#undef PG8_MMA
#undef PG8_WAIT_V
#undef PG8_WAIT_L
#undef PG8_BAR
#undef PG8_SCHED
}
}
#define XB_TMO      128
#define XB_XCNT(j)  (256  + 64 * (j))
#define XB_XSUB(j)  (1280 + 64 * (j))
#define XB_XGEN(j)  (2304 + 64 * (j))
#define XB_TOP      3328
#define XB_TOPGEN   3392
#define XCD_BAR_WORDS 3456
#define XB_SPIN_CAP (1u << 18)
#define LAS __attribute__((address_space(3)))

__device__ __forceinline__ unsigned xb_ld(unsigned* p)              { return __hip_atomic_load(p, __ATOMIC_RELAXED, __HIP_MEMORY_SCOPE_AGENT); }
__device__ __forceinline__ unsigned xb_add(unsigned* p, unsigned v) { return __hip_atomic_fetch_add(p, v, __ATOMIC_RELAXED, __HIP_MEMORY_SCOPE_AGENT); }
__device__ __forceinline__ unsigned xb_xcc_id() { return (unsigned)__builtin_amdgcn_s_getreg((3 << 11) | 20) & 0xFu; }
#define XB_SPIN(cond, bar) do { unsigned _sp = 0; while (cond) { __builtin_amdgcn_s_sleep(1); \
    if ((++_sp & 255u) == 0u) { if (xb_ld(&(bar)[XB_TMO])) break; if (_sp > XB_SPIN_CAP) { atomicAdd(&(bar)[XB_TMO], 1u); break; } } } } while (0)

struct XcdBarrier {
    unsigned* bar; unsigned x;
    volatile LAS unsigned* st;
};

__device__ __forceinline__ XcdBarrier xcd_barrier_post(unsigned* bar, volatile LAS unsigned* st) {
    XcdBarrier b; b.bar = bar; b.x = xb_xcc_id(); b.st = st;
    if (threadIdx.x == 0) (void)xb_add(&bar[XB_XCNT(b.x)], 1u);
    return b;
}
__device__ __forceinline__ void xcd_barrier_complete(unsigned* bar, unsigned x, unsigned& nloc, unsigned& nx) {
    const unsigned G = gridDim.x * gridDim.y * gridDim.z;
    unsigned sum, cnt, mine, sp = 0u;
    for (;;) {
        sum = 0u; cnt = 0u; mine = 0u;
#pragma unroll
        for (unsigned j = 0; j < 16; ++j) { const unsigned c = xb_ld(&bar[XB_XCNT(j)]); sum += c; cnt += (c > 0u) ? 1u : 0u; mine = (j == x) ? c : mine; }
        if (sum == G) break;
        __builtin_amdgcn_s_sleep(1);
        if ((++sp & 255u) == 0u) { if (xb_ld(&bar[XB_TMO])) break; if (sp > XB_SPIN_CAP) { atomicAdd(&bar[XB_TMO], 1u); break; } }
    }
    nloc = mine > 0u ? mine : 1u; nx = cnt > 0u ? cnt : 1u;
}

__device__ __forceinline__ void xcd_barrier(const XcdBarrier& b) {
    asm volatile("s_waitcnt vmcnt(0)" ::: "memory");
    __syncthreads();
    if (threadIdx.x == 0) {
        unsigned* bar = b.bar;
        __builtin_amdgcn_s_waitcnt(0);
        unsigned nloc = b.st[0], nx = b.st[1];
        if (nloc == 0u) { xcd_barrier_complete(bar, b.x, nloc, nx); b.st[0] = nloc; b.st[1] = nx; }
        const unsigned old = xb_add(&bar[XB_XSUB(b.x)], 1u);
        const unsigned gen = old / nloc;
        if (old + 1u == (gen + 1u) * nloc) {
            __builtin_amdgcn_fence(__ATOMIC_RELEASE, "agent");
            asm volatile("s_waitcnt vmcnt(0)" ::: "memory");
            const unsigned og = xb_add(&bar[XB_TOP], 1u);
            const unsigned tg = og / nx;
            if (og + 1u == (tg + 1u) * nx) xb_add(&bar[XB_TOPGEN], 1u);
            else XB_SPIN(xb_ld(&bar[XB_TOPGEN]) == tg, bar);
            __builtin_amdgcn_fence(__ATOMIC_ACQUIRE, "agent");
            xb_add(&bar[XB_XGEN(b.x)], 1u);
            asm volatile("s_waitcnt vmcnt(0)" ::: "memory");
        } else {
            XB_SPIN(xb_ld(&bar[XB_XGEN(b.x)]) == gen, bar);
            __builtin_amdgcn_fence(__ATOMIC_ACQUIRE, "agent");
            asm volatile("s_waitcnt vmcnt(0)" ::: "memory");
        }
    }
    __syncthreads();
}


#define LAS3 __attribute__((address_space(3)))
using pg8::bf16x8; using pg8::f32x4; using pg8::u32x4; using pg8::Unit;
constexpr int MK_THREADS = 512, MK_LDS_BYTES = 147456  , MK_LDS_BAR = MK_LDS_BYTES - 16;
constexpr int NPH = 16;

struct Params {
    const float* x; const float* gains; const float* a_w_in; const float* a_b_in; const float* a_norm_v; const float* a_w_s; const float* a_b_s; const float* a_w_out;
    const float* kv_norm; const float* w_kv; const float* w_q; const float* w_o; const float* ffn_w_gu; const float* ffn_w_down; const float* moe_router; const float* moe_w_gu; const float* moe_w_down;
    float* out; unsigned char* ws;
};

typedef __bf16 bf16x2_t __attribute__((ext_vector_type(2)));
__device__ __forceinline__ unsigned cvtpk(float lo, float hi) { const bf16x2_t v = {(__bf16)lo, (__bf16)hi}; return __builtin_bit_cast(unsigned, v); }
__device__ __forceinline__ float gelu_fast(float x) { const float t = x + 0.044715f * x * x * x; return x * __builtin_amdgcn_rcpf(1.0f + __builtin_amdgcn_exp2f(-2.3022081985f * t)); }
__device__ __forceinline__ float silu_fast(float x) { return x * __builtin_amdgcn_rcpf(1.0f + __builtin_amdgcn_exp2f(-1.4426950409f * x)); }
__device__ __forceinline__ f32x4 exp2_4(f32x4 a) { return (f32x4){__builtin_amdgcn_exp2f(a[0]), __builtin_amdgcn_exp2f(a[1]), __builtin_amdgcn_exp2f(a[2]), __builtin_amdgcn_exp2f(a[3])}; }
__device__ __forceinline__ f32x4 rcp_4(f32x4 a) { return (f32x4){__builtin_amdgcn_rcpf(a[0]), __builtin_amdgcn_rcpf(a[1]), __builtin_amdgcn_rcpf(a[2]), __builtin_amdgcn_rcpf(a[3])}; }
__device__ __forceinline__ f32x4 swiglu_4(f32x4 G, f32x4 U, float kexp, float kout) {
    const f32x4 r = rcp_4(exp2_4(G * kexp) + 1.0f); return (G * U) * (r * kout); }
__device__ __forceinline__ f32x4 gelu_4(f32x4 v) { const f32x4 t = (v * v * 0.044715f + 1.0f) * v; const f32x4 r = rcp_4(exp2_4(t * -2.3022081985f) + 1.0f); return v * r; }

constexpr float F8_SA1 = 16.f, F8_SW1 = 1024.f, F8_SA2 = 8.f, F8_SW2 = 2048.f;
__device__ __forceinline__ unsigned pack4_fp8(float a, float b, float c, float d) {
    a = __builtin_amdgcn_fmed3f(a, -448.f, 448.f); b = __builtin_amdgcn_fmed3f(b, -448.f, 448.f); c = __builtin_amdgcn_fmed3f(c, -448.f, 448.f); d = __builtin_amdgcn_fmed3f(d, -448.f, 448.f);
    int w = __builtin_amdgcn_cvt_pk_fp8_f32(a, b, 0, false); w = __builtin_amdgcn_cvt_pk_fp8_f32(c, d, w, true); return (unsigned)w; }
struct CTile { const float* src; bf16_t* dst; int N, K; int f8; float scale; };
constexpr int CT0 = 16 * 128, CT1 = CT0 + 32 * 32, CT2 = CT1 + 16 * 224, CT3 = CT2 + 56 * 32, CT4 = CT3 + 16 * 64, CT5 = CT4 + 16 * 96, CT6 = CT5 + 16 * 32, CT7 = CT6 + 8 * 16 * 224, CT8 = CT7 + 8 * 56 * 32;
__device__ __forceinline__ CTile conv_decode(const Params& p, int t) {
    const float* S; bf16_t* D; int K, N, inter = 0, tt, f8 = 0; float scale = 1.f;
    unsigned char* ws = p.ws;
    if (t < CT0)      { S = p.a_w_in;     D = (bf16_t*)(ws + OFF_WIN_T);  K = DM;  N = 2 * GH;  tt = t; }
    else if (t < CT1) { S = p.a_w_out;    D = (bf16_t*)(ws + OFF_WOUT_T); K = GH;  N = DM;      tt = t - CT0; }
    else if (t < CT2) { S = p.ffn_w_gu;   D = (bf16_t*)(ws + OFF_WGU_T);  K = DM;  N = 2 * DFF; tt = t - CT1; inter = 1; }
    else if (t < CT3) { S = p.ffn_w_down; D = (bf16_t*)(ws + OFF_WDN_T);  K = DFF; N = DM;      tt = t - CT2; }
    else if (t < CT4) { S = p.w_kv;       D = (bf16_t*)(ws + OFF_WKV_T);  K = DM;  N = NKV;     tt = t - CT3; }
    else if (t < CT5) { S = p.w_q;        D = (bf16_t*)(ws + OFF_WQ_T);   K = DM;  N = NQ;      tt = t - CT4; }
    else if (t < CT6) { S = p.w_o;        D = (bf16_t*)(ws + OFF_WO_T);   K = DM;  N = DM;      tt = t - CT5; }
    else if (t < CT7) { S = p.moe_w_gu;   D = (bf16_t*)(ws + OFF_MGU_T);  K = DM;  N = 2 * DFF; tt = t - CT6; inter = 1; f8 = 1; scale = F8_SW1; }
    else              { S = p.moe_w_down; D = (bf16_t*)(ws + OFF_MDN_T);  K = DFF; N = DM;      tt = t - CT7; f8 = 1; scale = F8_SW2; }
    const int KT = K >> 7, NT = N >> 6, per = KT * NT, b = tt / per, r = tt - b * per, kt = r / NT, nt = r - kt * NT, n0 = nt * 64;
    int drow = n0;
    if (inter) drow = n0 < DFF ? ((n0 >> 7) * 256 + (n0 & 127)) : (((n0 - DFF) >> 7) * 256 + 128 + ((n0 - DFF) & 127));
    CTile c; c.src = S + (size_t)b * K * N + (size_t)(kt * 128) * N + n0; c.N = N; c.K = K; c.f8 = f8; c.scale = scale;
    if (f8) c.dst = (bf16_t*)((unsigned char*)D + (size_t)b * N * K + (size_t)drow * K + kt * 128); else c.dst = D + (size_t)b * N * K + (size_t)drow * K + kt * 128;
    return c;
}
__device__ __forceinline__ void conv_to_lds(const CTile& c, const float4 (&r)[4], LAS3 unsigned* W, int n4, int kr) {
    if (c.f8) { const float sc = c.scale; LAS3 unsigned* w = W + (n4 * 4) * 33 + kr;
        w[0] = pack4_fp8(r[0].x * sc, r[1].x * sc, r[2].x * sc, r[3].x * sc); w[33] = pack4_fp8(r[0].y * sc, r[1].y * sc, r[2].y * sc, r[3].y * sc);
        w[66] = pack4_fp8(r[0].z * sc, r[1].z * sc, r[2].z * sc, r[3].z * sc); w[99] = pack4_fp8(r[0].w * sc, r[1].w * sc, r[2].w * sc, r[3].w * sc); }
    else {
#pragma unroll
        for (int i = 0; i < 2; ++i) { LAS3 unsigned* w = W + (n4 * 4) * 65 + kr + 32 * i;
            w[0] = cvtpk(r[2 * i].x, r[2 * i + 1].x); w[65] = cvtpk(r[2 * i].y, r[2 * i + 1].y); w[130] = cvtpk(r[2 * i].z, r[2 * i + 1].z); w[195] = cvtpk(r[2 * i].w, r[2 * i + 1].w); } }
}
__device__ __forceinline__ void conv_from_lds(const CTile& c, const LAS3 unsigned* W, int tid) {
    if (c.f8) { const int n = tid >> 3, kc = tid & 7; const LAS3 unsigned* q = W + n * 33 + kc * 4;
        uint4 w; w.x = q[0]; w.y = q[1]; w.z = q[2]; w.w = q[3]; __builtin_nontemporal_store((u32x4){w.x, w.y, w.z, w.w}, (u32x4*)((unsigned char*)c.dst + (size_t)n * c.K + kc * 16)); }
    else {
#pragma unroll
        for (int i = 0; i < 2; ++i) { const int it = tid + 512 * i, kc = it & 15, n = it >> 4; const LAS3 unsigned* q = W + n * 65 + kc * 4;
            uint4 w; w.x = q[0]; w.y = q[1]; w.z = q[2]; w.w = q[3]; __builtin_nontemporal_store((u32x4){w.x, w.y, w.z, w.w}, (u32x4*)(c.dst + (size_t)n * c.K + kc * 8)); } }
}
constexpr int CV_NT = 4;
__device__ __forceinline__ void phase_convert(const Params& p, LAS3 unsigned char* lds, int t0, int t1, int rank, int nrank) {
    LAS3 unsigned* LT = (LAS3 unsigned*)lds;
    const int tid = threadIdx.x, n4 = tid & 15, kr = tid >> 4, G = nrank;
    int t = t0 + rank;
#define CONV_LOAD(T, R) do { _Pragma("unroll") for (int j = 0; j < 4; ++j) { const int row = (T).f8 ? 4 * kr + j : 2 * (kr + 32 * (j >> 1)) + (j & 1); { const f32x4 _v = __builtin_nontemporal_load((const f32x4*)((T).src + (size_t)row * (T).N + n4 * 4)); R[j] = make_float4(_v[0], _v[1], _v[2], _v[3]); } } } while (0)
    if (t < t1) {
        CTile c[CV_NT]; bool h[CV_NT]; float4 r[CV_NT][4];
#pragma unroll
        for (int q = 0; q < CV_NT; ++q) { h[q] = t + q * G < t1; c[q] = conv_decode(p, h[q] ? t + q * G : t); if (h[q]) CONV_LOAD(c[q], r[q]); }
        int buf = 0;
        for (;;) {
            LAS3 unsigned* W = LT + buf * (CV_NT * 4160);
#pragma unroll
            for (int q = 0; q < CV_NT; ++q) if (h[q]) conv_to_lds(c[q], r[q], W + q * 4160, n4, kr);
            const int tn = t + CV_NT * G; const bool has = tn < t1;
            CTile cn[CV_NT]; bool hn[CV_NT];
#pragma unroll
            for (int q = 0; q < CV_NT; ++q) { hn[q] = tn + q * G < t1; cn[q] = c[q]; if (hn[q]) { cn[q] = conv_decode(p, tn + q * G); CONV_LOAD(cn[q], r[q]); } }
            __syncthreads();
#pragma unroll
            for (int q = 0; q < CV_NT; ++q) if (h[q]) conv_from_lds(c[q], W + q * 4160, tid);
            if (!has) break;
#pragma unroll
            for (int q = 0; q < CV_NT; ++q) { c[q] = cn[q]; h[q] = hn[q]; }
            t = tn; buf ^= 1;
        }
    }
#undef CONV_LOAD
    __syncthreads();
}

__device__ __forceinline__ void row_norm0(const Params& p, int row, int lane) {
    const float* gain = p.gains; bf16_t* xn = (bf16_t*)(p.ws + OFF_XN);
    const float4* xr = (const float4*)(p.x + (size_t)row * DM); float4 v[8]; float ss = 0.f;
#pragma unroll
    for (int i = 0; i < 8; ++i) { v[i] = xr[lane + 64 * i]; ss += v[i].x * v[i].x + v[i].y * v[i].y + v[i].z * v[i].z + v[i].w * v[i].w; }
    ss = wave_sum(ss); const float rstd = rsqrtf(ss * (1.0f / DM) + EPS);
#pragma unroll
    for (int i = 0; i < 8; ++i) { const float4 gg = ((const float4*)gain)[lane + 64 * i];
        uint2 w; w.x = cvtpk(v[i].x * rstd * gg.x, v[i].y * rstd * gg.y); w.y = cvtpk(v[i].z * rstd * gg.z, v[i].w * rstd * gg.w);
        *(uint2*)(xn + (size_t)row * DM + (lane + 64 * i) * 4) = w; }
}

struct EpiGeluU {
    static constexpr bool PERM = true, AFTER_DRAIN = false;
    bf16_t* O; int ldc; const float* bias;
    __device__ __forceinline__ void operator()(const f32x4 (&acc)[2][2][4][2], const Unit& u, int wr, int wc, int fr, int fq) const {
        asm volatile("" : "+v"(fr), "+v"(fq));
        const int row0 = u.pm * 256 + wr * 64 + fr, col0 = u.pn * 256 + wc * 32 + 8 * fq;
        f32x4 bv[2][2];
#pragma unroll
        for (int bj = 0; bj < 2; ++bj)
#pragma unroll
            for (int n = 0; n < 2; ++n) bv[bj][n] = *(const f32x4*)(bias + col0 + bj * 128 + 4 * n);
#pragma unroll
        for (int ai = 0; ai < 2; ++ai)
#pragma unroll
            for (int m = 0; m < 4; ++m) { bf16_t* rowp = O + (size_t)(row0 + ai * 128 + m * 16) * ldc + col0;
#pragma unroll
                for (int bj = 0; bj < 2; ++bj) { const f32x4 v0 = acc[ai][bj][m][0] + bv[bj][0], v1 = acc[ai][bj][m][1] + bv[bj][1];
                    const f32x4 y0 = gelu_4(v0), y1 = gelu_4(v1);
                    u32x4 w; w.x = cvtpk(y0[0], y0[1]); w.y = cvtpk(y0[2], y0[3]); w.z = cvtpk(y1[0], y1[1]); w.w = cvtpk(y1[2], y1[3]);
                    *(u32x4*)(rowp + bj * 128) = w; } }
    }
};
struct EpiGeluVT {
    static constexpr bool PERM = true, AFTER_DRAIN = false;
    bf16_t* O; const float* bias; float* ssp;
    __device__ __forceinline__ void operator()(const f32x4 (&acc)[2][2][4][2], const Unit& u, int wr, int wc, int fr, int fq) const {
        asm volatile("" : "+v"(fr), "+v"(fq));
        const int row0 = u.pm * 256 + wr * 64 + fr, col0 = u.pn * 256 + wc * 32 + 8 * fq;
        f32x4 cs[2][2];
#pragma unroll
        for (int bj = 0; bj < 2; ++bj)
#pragma unroll
            for (int n = 0; n < 2; ++n) cs[bj][n] = (f32x4){0.f, 0.f, 0.f, 0.f};
#pragma unroll
        for (int ai = 0; ai < 2; ++ai)
#pragma unroll
            for (int m = 0; m < 4; ++m) { const int row = row0 + ai * 128 + m * 16; const float b = bias[row]; bf16_t* rowp = O + (size_t)row * NTOK + col0;
#pragma unroll
                for (int bj = 0; bj < 2; ++bj) { f32x4 v0 = acc[ai][bj][m][0] + b, v1 = acc[ai][bj][m][1] + b;
                    v0 = gelu_4(v0); v1 = gelu_4(v1);
                    cs[bj][0] += v0 * v0; cs[bj][1] += v1 * v1;
                    u32x4 w; w.x = cvtpk(v0[0], v0[1]); w.y = cvtpk(v0[2], v0[3]); w.z = cvtpk(v1[0], v1[1]); w.w = cvtpk(v1[2], v1[3]);
                    *(u32x4*)(rowp + bj * 128) = w; } }
        const int slot = u.pm * 2 + wr;
#pragma unroll
        for (int bj = 0; bj < 2; ++bj)
#pragma unroll
            for (int n = 0; n < 2; ++n)
#pragma unroll
                for (int j = 0; j < 4; ++j) { float s = cs[bj][n][j]; s += __shfl_xor(s, 1); s += __shfl_xor(s, 2); s += __shfl_xor(s, 4); s += __shfl_xor(s, 8);
                    if (fr == 0) ssp[(size_t)(col0 + bj * 128 + 4 * n + j) * SSP_N + slot] = s; }
    }
};
struct EpiF32SS {
    static constexpr bool PERM = false, AFTER_DRAIN = false;
    float* C; int ldc; float* ssp; int pnmod; float scale;
    __device__ __forceinline__ void operator()(const f32x4 (&acc)[2][2][4][2], const Unit& u, int wr, int wc, int fr, int fq) const {
        asm volatile("" : "+v"(fr), "+v"(fq));
        const int pnl = u.pn % pnmod; const int row0 = u.pm * 256 + wr * 64 + fr, col0 = pnl * 256 + wc * 32 + 4 * fq;
#pragma unroll
        for (int ai = 0; ai < 2; ++ai)
#pragma unroll
            for (int m = 0; m < 4; ++m) { const int row = row0 + ai * 128 + m * 16; float* rowp = C + (size_t)row * ldc + col0; float s = 0.f;
#pragma unroll
                for (int bj = 0; bj < 2; ++bj)
#pragma unroll
                    for (int n = 0; n < 2; ++n) { const f32x4 v = acc[ai][bj][m][n] * scale; *(f32x4*)(rowp + bj * 128 + n * 16) = v; s += (v[0] * v[0] + v[1] * v[1]) + (v[2] * v[2] + v[3] * v[3]); }
                if (ssp) { s += __shfl_xor(s, 16); s += __shfl_xor(s, 32); if (fq == 0) ssp[(size_t)row * SSP_N + pnl * 4 + wc] = s; } }
    }
};
struct EpiSwiglu {
    static constexpr bool PERM = true, AFTER_DRAIN = false;
    bf16_t* O; int ldc; int pnmod;
    __device__ __forceinline__ void operator()(const f32x4 (&acc)[2][2][4][2], const Unit& u, int wr, int wc, int fr, int fq) const {
        asm volatile("" : "+v"(fr), "+v"(fq));
        const int pnl = u.pn % pnmod; const int row0 = u.pm * 256 + wr * 64 + fr, col0 = pnl * 128 + wc * 32 + 8 * fq;
#pragma unroll
        for (int ai = 0; ai < 2; ++ai)
#pragma unroll
            for (int m = 0; m < 4; ++m) { bf16_t* rowp = O + (size_t)(row0 + ai * 128 + m * 16) * ldc + col0;
                const f32x4 o0 = swiglu_4(acc[ai][0][m][0], acc[ai][1][m][0], -1.4426950409f, 1.0f), o1 = swiglu_4(acc[ai][0][m][1], acc[ai][1][m][1], -1.4426950409f, 1.0f);
                u32x4 w; w.x = cvtpk(o0[0], o0[1]); w.y = cvtpk(o0[2], o0[3]); w.z = cvtpk(o1[0], o1[1]); w.w = cvtpk(o1[2], o1[3]);
                *(u32x4*)rowp = w; }
    }
};
struct EpiBf16P {
    static constexpr bool PERM = true, AFTER_DRAIN = false;
    bf16_t* O; int ldc;
    __device__ __forceinline__ void operator()(const f32x4 (&acc)[2][2][4][2], const Unit& u, int wr, int wc, int fr, int fq) const {
        asm volatile("" : "+v"(fr), "+v"(fq));
        const int row0 = u.pm * 256 + wr * 64 + fr, col0 = u.pn * 256 + wc * 32 + 8 * fq;
#pragma unroll
        for (int ai = 0; ai < 2; ++ai)
#pragma unroll
            for (int m = 0; m < 4; ++m) { bf16_t* rowp = O + (size_t)(row0 + ai * 128 + m * 16) * ldc + col0;
#pragma unroll
                for (int bj = 0; bj < 2; ++bj) { const f32x4 v0 = acc[ai][bj][m][0], v1 = acc[ai][bj][m][1];
                    u32x4 w; w.x = cvtpk(v0[0], v0[1]); w.y = cvtpk(v0[2], v0[3]); w.z = cvtpk(v1[0], v1[1]); w.w = cvtpk(v1[2], v1[3]);
                    *(u32x4*)(rowp + bj * 128) = w; } }
    }
};

struct EpiSwiglu8 {
    static constexpr bool PERM = true, AFTER_DRAIN = false;
    unsigned char* O; int ldc; int pnmod; float inv, oscale;
    __device__ __forceinline__ void operator()(const f32x4 (&acc)[2][2][4][2], const Unit& u, int wr, int wc, int fr, int fq) const {
        asm volatile("" : "+v"(fr), "+v"(fq));
        const int pnl = u.pn % pnmod; const int row0 = u.pm * 256 + wr * 64 + fr, col0 = pnl * 128 + wc * 32 + 8 * fq;
#pragma unroll
        for (int ai = 0; ai < 2; ++ai)
#pragma unroll
            for (int m = 0; m < 4; ++m) { unsigned char* rowp = O + (size_t)(row0 + ai * 128 + m * 16) * ldc + col0;
                const float kexp = -1.4426950409f * inv, kout = inv * inv * oscale;
                const f32x4 o0 = swiglu_4(acc[ai][0][m][0], acc[ai][1][m][0], kexp, kout), o1 = swiglu_4(acc[ai][0][m][1], acc[ai][1][m][1], kexp, kout);
                uint2 w; w.x = pack4_fp8(o0[0], o0[1], o0[2], o0[3]); w.y = pack4_fp8(o1[0], o1[1], o1[2], o1[3]);
                *(uint2*)rowp = w; }
    }
};

struct EpiBf16S {
    static constexpr bool PERM = true, AFTER_DRAIN = false;
    bf16_t* O; int ldc; int pnmod; float scale;
    __device__ __forceinline__ void operator()(const f32x4 (&acc)[2][2][4][2], const Unit& u, int wr, int wc, int fr, int fq) const {
        asm volatile("" : "+v"(fr), "+v"(fq));
        const int pnl = u.pn % pnmod; const int row0 = u.pm * 256 + wr * 64 + fr, col0 = pnl * 256 + wc * 32 + 8 * fq;
#pragma unroll
        for (int ai = 0; ai < 2; ++ai)
#pragma unroll
            for (int m = 0; m < 4; ++m) { bf16_t* rowp = O + (size_t)(row0 + ai * 128 + m * 16) * ldc + col0;
#pragma unroll
                for (int bj = 0; bj < 2; ++bj) { const f32x4 v0 = acc[ai][bj][m][0] * scale, v1 = acc[ai][bj][m][1] * scale;
                    u32x4 w; w.x = cvtpk(v0[0], v0[1]); w.y = cvtpk(v0[2], v0[3]); w.z = cvtpk(v1[0], v1[1]); w.w = cvtpk(v1[2], v1[3]);
                    *(u32x4*)(rowp + bj * 128) = w; } }
    }
};

struct EpiBf16H {
    static constexpr bool PERM = true, AFTER_DRAIN = false;
    bf16_t* O; int nrows;
    __device__ __forceinline__ void operator()(const f32x4 (&acc)[2][2][4][2], const Unit& u, int wr, int wc, int fr, int fq) const {
        asm volatile("" : "+v"(fr), "+v"(fq));
        const int row0 = u.pm * 256 + wr * 64 + fr, cin = wc * 32 + 8 * fq;
#pragma unroll
        for (int bj = 0; bj < 2; ++bj) { bf16_t* hp = O + (size_t)(u.pn * 2 + bj) * nrows * 128 + cin;
#pragma unroll
            for (int ai = 0; ai < 2; ++ai)
#pragma unroll
                for (int m = 0; m < 4; ++m) { const f32x4 v0 = acc[ai][bj][m][0], v1 = acc[ai][bj][m][1];
                    u32x4 w; w.x = cvtpk(v0[0], v0[1]); w.y = cvtpk(v0[2], v0[3]); w.z = cvtpk(v1[0], v1[1]); w.w = cvtpk(v1[2], v1[3]);
                    *(u32x4*)(hp + (size_t)(row0 + ai * 128 + m * 16) * 128) = w; } }
    }
};

struct EpiBf16SS {
    static constexpr bool PERM = true, AFTER_DRAIN = false;
    bf16_t* C; int ldc; float* ssp;
    __device__ __forceinline__ void operator()(const f32x4 (&acc)[2][2][4][2], const Unit& u, int wr, int wc, int fr, int fq) const {
        asm volatile("" : "+v"(fr), "+v"(fq));
        const int row0 = u.pm * 256 + wr * 64 + fr, col0 = u.pn * 256 + wc * 32 + 8 * fq;
#pragma unroll
        for (int ai = 0; ai < 2; ++ai)
#pragma unroll
            for (int m = 0; m < 4; ++m) { const int row = row0 + ai * 128 + m * 16; bf16_t* rowp = C + (size_t)row * ldc + col0; float s = 0.f;
#pragma unroll
                for (int bj = 0; bj < 2; ++bj) { const f32x4 v0 = acc[ai][bj][m][0], v1 = acc[ai][bj][m][1];
                    s += (v0[0] * v0[0] + v0[1] * v0[1]) + (v0[2] * v0[2] + v0[3] * v0[3]); s += (v1[0] * v1[0] + v1[1] * v1[1]) + (v1[2] * v1[2] + v1[3] * v1[3]);
                    u32x4 w; w.x = cvtpk(v0[0], v0[1]); w.y = cvtpk(v0[2], v0[3]); w.z = cvtpk(v1[0], v1[1]); w.w = cvtpk(v1[2], v1[3]);
                    *(u32x4*)(rowp + bj * 128) = w; }
                s += __shfl_xor(s, 16); s += __shfl_xor(s, 32); if (fq == 0) ssp[(size_t)row * SSP_N + u.pn * 4 + wc] = s; }
    }
};

__device__ __forceinline__ int ld_i(const int* p) { return __hip_atomic_load(p, __ATOMIC_RELAXED, __HIP_MEMORY_SCOPE_AGENT); }
__device__ __forceinline__ float ssp_sum32(const float* ssp, int row) {
    const f32x4* q = (const f32x4*)(ssp + (size_t)row * SSP_N); float t = 0.f;
#pragma unroll
    for (int i = 0; i < 8; ++i) { const f32x4 v = q[i]; t += v[0]; t += v[1]; t += v[2]; t += v[3]; }
    return t;
}

template <bool BF> __device__ __forceinline__ float4 ld4(const void* base, size_t idx4) {
    if constexpr (BF) { const uint2 w = ((const uint2*)base)[idx4]; return make_float4(bf2f(w.x & 0xffffu), bf2f(w.x >> 16), bf2f(w.y & 0xffffu), bf2f(w.y >> 16)); }
    else return ((const float4*)base)[idx4];
}
__device__ __forceinline__ void st4bf(bf16_t* base, size_t idx4, float4 v) { uint2 w; w.x = cvtpk(v.x, v.y); w.y = cvtpk(v.z, v.w); ((uint2*)base)[idx4] = w; }
struct RowIn { float4 b[8]; uint2 m[8]; };
template <bool BFBASE> __device__ __forceinline__ void row_load(RowIn& r, const void* base, const bf16_t* mix, int row, int lane) {
#pragma unroll
    for (int i = 0; i < 8; ++i) { const size_t o = (size_t)row * (DM / 4) + lane + 64 * i; r.b[i] = ld4<BFBASE>(base, o); r.m[i] = ((const uint2*)mix)[o]; }
}
__device__ __forceinline__ void row_resnorm_c(const RowIn& r, const float* ssp, const float* g_post, bf16_t* hout, const float* g1, bf16_t* xn1, const float* g2, bf16_t* xn2, int row, int lane) {
    const float rm = rsqrtf(ssp_sum32(ssp, row) * (1.0f / DM) + EPS);
    float4 h[8]; float ss = 0.f;
#pragma unroll
    for (int i = 0; i < 8; ++i) { const size_t o = (size_t)row * (DM / 4) + lane + 64 * i; const float4 b = r.b[i], gp = ((const float4*)g_post)[lane + 64 * i];
        const float4 m = make_float4(bf2f(r.m[i].x & 0xffffu), bf2f(r.m[i].x >> 16), bf2f(r.m[i].y & 0xffffu), bf2f(r.m[i].y >> 16));
        h[i].x = b.x + m.x * rm * gp.x; h[i].y = b.y + m.y * rm * gp.y; h[i].z = b.z + m.z * rm * gp.z; h[i].w = b.w + m.w * rm * gp.w;
        st4bf(hout, o, h[i]); ss += h[i].x * h[i].x + h[i].y * h[i].y + h[i].z * h[i].z + h[i].w * h[i].w; }
    ss = wave_sum(ss); const float rstd = rsqrtf(ss * (1.0f / DM) + EPS);
#pragma unroll
    for (int i = 0; i < 8; ++i) { const float4 gg = ((const float4*)g1)[lane + 64 * i];
        uint2 w; w.x = cvtpk(h[i].x * rstd * gg.x, h[i].y * rstd * gg.y); w.y = cvtpk(h[i].z * rstd * gg.z, h[i].w * rstd * gg.w);
        *(uint2*)(xn1 + (size_t)row * DM + (lane + 64 * i) * 4) = w;
        if (xn2) { const float4 g2v = ((const float4*)g2)[lane + 64 * i];
            uint2 w2; w2.x = cvtpk(h[i].x * rstd * g2v.x, h[i].y * rstd * g2v.y); w2.y = cvtpk(h[i].z * rstd * g2v.z, h[i].w * rstd * g2v.w);
            *(uint2*)(xn2 + (size_t)row * DM + (lane + 64 * i) * 4) = w2; } }
}
template <bool BFBASE> __device__ __forceinline__ void phase_resnorm(const void* base, const bf16_t* mix, const float* ssp, const float* g_post, bf16_t* hout, const float* g1, bf16_t* xn1, const float* g2, bf16_t* xn2, int wave, int lane, int G) {
    int row = blockIdx.x * 8 + wave; if (row >= NTOK) return;
    RowIn cur, nxt; row_load<BFBASE>(cur, base, mix, row, lane);
    for (;;) { const int nrow = row + G * 8; const bool has = nrow < NTOK;
        if (has) row_load<BFBASE>(nxt, base, mix, nrow, lane);
        row_resnorm_c(cur, ssp, g_post, hout, g1, xn1, g2, xn2, row, lane);
        if (!has) break; cur = nxt; row = nrow; }
}
__device__ __forceinline__ void row_router(const bf16_t* base, const bf16_t* mix, const float* ssp, const float* g_post, bf16_t* hout, const float* g_pre, const LAS3 float* wT  ,
                                           LAS3 int* rt_cnt, LAS3 int* rt_info, LAS3 unsigned* rt_rows, float* tok_g, int row, int lr, int lane) {
    const float rm = rsqrtf(ssp_sum32(ssp, row) * (1.0f / DM) + EPS);
    float4 h[8]; float ss = 0.f;
#pragma unroll
    for (int i = 0; i < 8; ++i) { const size_t o = (size_t)row * (DM / 4) + lane + 64 * i; const float4 b = ld4<true>(base, o), m = ld4<true>(mix, o), gp = ((const float4*)g_post)[lane + 64 * i];
        h[i].x = b.x + m.x * rm * gp.x; h[i].y = b.y + m.y * rm * gp.y; h[i].z = b.z + m.z * rm * gp.z; h[i].w = b.w + m.w * rm * gp.w;
        st4bf(hout, o, h[i]); ss += h[i].x * h[i].x + h[i].y * h[i].y + h[i].z * h[i].z + h[i].w * h[i].w;
        if (i & 1) asm volatile("" ::: "memory"); }
    ss = wave_sum(ss); const float rstd = rsqrtf(ss * (1.0f / DM) + EPS);
    float lg[8]; unsigned q8[8];
#pragma unroll
    for (int e = 0; e < 8; ++e) lg[e] = 0.f;
#pragma unroll
    for (int i = 0; i < 8; ++i) { const float4 gg = ((const float4*)g_pre)[lane + 64 * i];
        const float n0 = h[i].x * rstd * gg.x, n1 = h[i].y * rstd * gg.y, n2 = h[i].z * rstd * gg.z, n3 = h[i].w * rstd * gg.w;
        q8[i] = pack4_fp8(n0 * F8_SA1, n1 * F8_SA1, n2 * F8_SA1, n3 * F8_SA1); asm volatile("" : "+v"(q8[i]));
        const int k = (lane + 64 * i) * 4;
#pragma unroll
        for (int e = 0; e < 8; ++e) { const f32x4 w = *(const LAS3 f32x4*)(wT + e * DM + k); lg[e] = fmaf(n0, w[0], lg[e]); lg[e] = fmaf(n1, w[1], lg[e]); lg[e] = fmaf(n2, w[2], lg[e]); lg[e] = fmaf(n3, w[3], lg[e]); }
        asm volatile("" ::: "memory"); }
#pragma unroll
    for (int e = 0; e < 8; ++e) lg[e] = wave_sum(lg[e]);
    if (lane == 0) {
        int e1 = 0; float v1 = lg[0];
#pragma unroll
        for (int e = 1; e < 8; ++e) if (lg[e] > v1) { v1 = lg[e]; e1 = e; }
        int e2 = 0; float v2 = -3.0e38f;
#pragma unroll
        for (int e = 0; e < 8; ++e) if (e != e1 && lg[e] > v2) { v2 = lg[e]; e2 = e; }
        const float p2 = __expf(v2 - v1), inv = 1.0f / (1.0f + p2);
        const int l1 = (int)__hip_atomic_fetch_add(rt_cnt + e1, 1, __ATOMIC_RELAXED, __HIP_MEMORY_SCOPE_WORKGROUP), l2 = (int)__hip_atomic_fetch_add(rt_cnt + e2, 1, __ATOMIC_RELAXED, __HIP_MEMORY_SCOPE_WORKGROUP);
        rt_info[lr * 2] = (e1 << 16) | l1; rt_info[lr * 2 + 1] = (e2 << 16) | l2;
        tok_g[row * 2] = inv; tok_g[row * 2 + 1] = p2 * inv;
    }
    LAS3 unsigned* rb = rt_rows + lr * (DM / 4);
#pragma unroll
    for (int i = 0; i < 8; ++i) rb[lane + 64 * i] = q8[i];
}
__device__ __forceinline__ void stage_router(const float* wr, LAS3 unsigned char* lds) {
    LAS3 float* wT = (LAS3 float*)lds; const int t = threadIdx.x; float4 v[8];
#pragma unroll
    for (int j = 0; j < 8; ++j) v[j] = ((const float4*)(wr + (size_t)t * 32))[j];
    const float a[32] = {v[0].x, v[0].y, v[0].z, v[0].w, v[1].x, v[1].y, v[1].z, v[1].w, v[2].x, v[2].y, v[2].z, v[2].w, v[3].x, v[3].y, v[3].z, v[3].w,
                         v[4].x, v[4].y, v[4].z, v[4].w, v[5].x, v[5].y, v[5].z, v[5].w, v[6].x, v[6].y, v[6].z, v[6].w, v[7].x, v[7].y, v[7].z, v[7].w};
#pragma unroll
    for (int e = 0; e < 8; ++e) *(LAS3 f32x4*)(wT + e * DM + t * 4) = (f32x4){a[e], a[8 + e], a[16 + e], a[24 + e]};
    __syncthreads();
}
constexpr int RT_CNT_OFF = 65536, RT_INFO_OFF = 65600, RT_ROWS_OFF = 66560, RT_BATCH = 32;
__device__ __forceinline__ void phase_router(const bf16_t* base, const bf16_t* mix, const float* ssp, const float* g_post, bf16_t* hout, const float* g_pre, const float* wr, unsigned char* xs8,
                                             int* counts, int* tok_s, float* tok_g, LAS3 unsigned char* lds, int wave, int lane, int G) {
    stage_router(wr, lds);
    LAS3 int* rt_cnt = (LAS3 int*)(lds + RT_CNT_OFF); LAS3 int* rt_base = rt_cnt + 8; LAS3 int* rt_info = (LAS3 int*)(lds + RT_INFO_OFF); LAS3 unsigned* rt_rows = (LAS3 unsigned*)(lds + RT_ROWS_OFF);
    const int tid = threadIdx.x;
    for (int r0 = blockIdx.x * 8; r0 < NTOK; r0 += G * 8 * 4) {
        if (tid < 8) rt_cnt[tid] = 0;
        __syncthreads();
#pragma unroll 1
        for (int k = 0; k < 4; ++k) { const int row = r0 + wave + k * G * 8; if (row < NTOK) { int ln = lane; asm volatile("" : "+v"(ln));
            row_router(base, mix, ssp, g_post, hout, g_pre, (const LAS3 float*)lds, rt_cnt, rt_info, rt_rows, tok_g, row, k * 8 + wave, ln); } }
        __syncthreads();
        if (tid < 8) rt_base[tid] = tid * ECAP + atomicAdd(&counts[tid], rt_cnt[tid]);
        __syncthreads();
#pragma unroll 1
        for (int k = 0; k < 4; ++k) { const int row = r0 + wave + k * G * 8; if (row < NTOK) { const int lr = k * 8 + wave;
            const int i1 = rt_info[lr * 2], i2 = rt_info[lr * 2 + 1]; const int s1 = rt_base[i1 >> 16] + (i1 & 0xffff), s2 = rt_base[i2 >> 16] + (i2 & 0xffff);
            if (lane == 0) { tok_s[row * 2] = s1; tok_s[row * 2 + 1] = s2; }
            const LAS3 unsigned* rb = rt_rows + lr * (DM / 4); unsigned* d1 = (unsigned*)(xs8 + (size_t)s1 * DM); unsigned* d2 = (unsigned*)(xs8 + (size_t)s2 * DM);
#pragma unroll
            for (int i = 0; i < 8; ++i) { const unsigned v = rb[lane + 64 * i]; d1[lane + 64 * i] = v; d2[lane + 64 * i] = v; } } }
        __syncthreads();
    }
}
constexpr int KSPLIT = 4, C_TFLAG = 8192;
__device__ __forceinline__ void row_final(const bf16_t* h3, const bf16_t* Y, const float* Yp, const int* tflag, const int* tok_s, const float* tok_g, const float* gain, float* out, int row, int lane) {
    const int s1 = tok_s[row * 2], s2 = tok_s[row * 2 + 1]; const float g1 = tok_g[row * 2], g2 = tok_g[row * 2 + 1];
    float4 f[8]; float ss = 0.f;
#pragma unroll
    for (int i = 0; i < 8; ++i) {
        float4 a, b;
        { const int fl = tflag[(s1 >> 8) * 8 + i];
          if (fl == 0) { const uint2 w = ((const uint2*)(Y + (size_t)s1 * DM))[lane + 64 * i]; a = make_float4(bf2f(w.x & 0xffffu), bf2f(w.x >> 16), bf2f(w.y & 0xffffu), bf2f(w.y >> 16)); }
          else { const float4* q = (const float4*)(Yp + ((size_t)(fl - 1) * KSPLIT) * 65536 + (size_t)(s1 & 255) * 256) + lane; a = q[0];
#pragma unroll
              for (int k = 1; k < KSPLIT; ++k) { const float4 t = q[(size_t)k * 16384]; a.x += t.x; a.y += t.y; a.z += t.z; a.w += t.w; } } }
        { const int fl = tflag[(s2 >> 8) * 8 + i];
          if (fl == 0) { const uint2 w = ((const uint2*)(Y + (size_t)s2 * DM))[lane + 64 * i]; b = make_float4(bf2f(w.x & 0xffffu), bf2f(w.x >> 16), bf2f(w.y & 0xffffu), bf2f(w.y >> 16)); }
          else { const float4* q = (const float4*)(Yp + ((size_t)(fl - 1) * KSPLIT) * 65536 + (size_t)(s2 & 255) * 256) + lane; b = q[0];
#pragma unroll
              for (int k = 1; k < KSPLIT; ++k) { const float4 t = q[(size_t)k * 16384]; b.x += t.x; b.y += t.y; b.z += t.z; b.w += t.w; } } }
        f[i].x = a.x * g1 + b.x * g2; f[i].y = a.y * g1 + b.y * g2; f[i].z = a.z * g1 + b.z * g2; f[i].w = a.w * g1 + b.w * g2;
        ss += f[i].x * f[i].x + f[i].y * f[i].y + f[i].z * f[i].z + f[i].w * f[i].w; }
    ss = wave_sum(ss); const float rstd = rsqrtf(ss * (1.0f / DM) + EPS);
#pragma unroll
    for (int i = 0; i < 8; ++i) { const size_t o = (size_t)row * (DM / 4) + lane + 64 * i; const float4 b = ld4<true>(h3, o), gg = ((const float4*)gain)[lane + 64 * i]; float4 r;
        r.x = b.x + f[i].x * rstd * gg.x; r.y = b.y + f[i].y * rstd * gg.y; r.z = b.z + f[i].z * rstd * gg.z; r.w = b.w + f[i].w * rstd * gg.w; ((float4*)out)[o] = r; }
}
constexpr int MOE_TBL_OFF = 131072;
struct MoeOrder : pg8::StaticOrder {
    const LAS3 int* tbl; int NT; int lim;
    __device__ __forceinline__ bool next(int i, Unit& u) const { if ((long)i * G + c >= lim) return false; if (!pg8::StaticOrder::next(i, u)) return false;
        const int v = tbl[u.pm]; u.pm = v & 0xffff; u.pn += (v >> 16) * NT; return true; }
};
__device__ __forceinline__ int moe_table(const int* counts, LAS3 unsigned char* lds) {
    LAS3 int* tbl = (LAS3 int*)(lds + MOE_TBL_OFF); const int t = threadIdx.x; int q = 0, mine = -1;
#pragma unroll
    for (int e = 0; e < NEXP; ++e) { const int nb = (ld_i(counts + e) + 255) >> 8; if (t >= q && t < q + nb) mine = (e << 16) | (e * (ECAP / 256) + (t - q)); q += nb; }
    if (mine >= 0) tbl[t] = mine;
    __syncthreads();
    return q;
}

struct LeftOrder : pg8::StaticOrder {
    const LAS3 int* tbl; int NT; int L;
    __device__ __forceinline__ bool next(int i, Unit& u) const { if (i != 0 || L < 0) return false;
        pg8::StaticOrder t = *this; t.c = L; if (!t.pg8::StaticOrder::next(0, u)) return false;
        const int v = tbl[u.pm]; u.pm = v & 0xffff; u.pn += (v >> 16) * NT; return true; }
};
struct EpiF32Part {
    static constexpr bool PERM = false, AFTER_DRAIN = false;
    float* P; float scale; int* tflag; int li; int pnmod; int mark;
    __device__ __forceinline__ void operator()(const f32x4 (&acc)[2][2][4][2], const Unit& u, int wr, int wc, int fr, int fq) const {
        asm volatile("" : "+v"(fr), "+v"(fq));
        if (mark && threadIdx.x == 0) tflag[u.pm * 8 + (u.pn % pnmod)] = li + 1;
        const int r0 = wr * 64 + fr, c0 = wc * 32 + 4 * fq;
#pragma unroll
        for (int ai = 0; ai < 2; ++ai)
#pragma unroll
            for (int m = 0; m < 4; ++m) { float* rowp = P + (size_t)(r0 + ai * 128 + m * 16) * 256 + c0;
#pragma unroll
                for (int bj = 0; bj < 2; ++bj)
#pragma unroll
                    for (int n = 0; n < 2; ++n) *(f32x4*)(rowp + bj * 128 + n * 16) = acc[ai][bj][m][n] * scale; }
    }
};


__device__ __forceinline__ void phase_sgu(const Params& p, LAS3 unsigned char* lds) {
    const int tid = threadIdx.x, lane = tid & 63, wave = __builtin_amdgcn_readfirstlane(tid >> 6), fr = lane & 15, fq = lane >> 4;
    unsigned char* ws = p.ws;
    const bf16_t* U = (const bf16_t*)(ws + OFF_U); const bf16_t* VT = (const bf16_t*)(ws + OFF_VT); bf16_t* GT = (bf16_t*)(ws + OFF_GT); const float* SSP = (const float*)(ws + OFF_SSP);
    LAS3 float* rs = (LAS3 float*)(lds + 36864);
    for (int unit = blockIdx.x; unit < 512; unit += (int)gridDim.x) {
        const int ch = unit >> 3, g = unit & 7;
        __syncthreads();
        if (tid < 128) rs[tid] = rsqrtf(ssp_sum32(SSP, ch * 128 + tid) * (1.0f / GH) + EPS);
        bf16x8 bfrag[4][4];
#pragma unroll
        for (int n = 0; n < 4; ++n) { const int chrow = g * 512 + wave * 64 + (n >> 1) * 32 + 8 * (fr >> 2) + 4 * (n & 1) + (fr & 3);
#pragma unroll
            for (int ks = 0; ks < 4; ++ks) bfrag[n][ks] = *(const bf16x8*)(VT + (size_t)chrow * NTOK + ch * 128 + ks * 32 + fq * 8); }
        __syncthreads();
        { const int t = tid >> 2, s0 = (tid & 3) * 32; const float* wp = p.a_w_s + ((size_t)g * 128 + t) * 128 + s0;
#pragma unroll
          for (int q = 0; q < 4; ++q) { const float4 a = *(const float4*)(wp + q * 8), b = *(const float4*)(wp + q * 8 + 4); float v[8] = {a.x, a.y, a.z, a.w, b.x, b.y, b.z, b.w};
#pragma unroll
              for (int j = 0; j < 8; ++j) { const int s = s0 + q * 8 + j; v[j] = (s <= t) ? v[j] * rs[s] : 0.f; }
              u32x4 w; w.x = cvtpk(v[0], v[1]); w.y = cvtpk(v[2], v[3]); w.z = cvtpk(v[4], v[5]); w.w = cvtpk(v[6], v[7]);
              *(LAS3 u32x4*)(lds + t * 272 + (s0 + q * 8) * 2) = w; } }
        __syncthreads();
#pragma unroll
        for (int mt = 0; mt < 8; ++mt) {
            f32x4 acc[4];
#pragma unroll
            for (int n = 0; n < 4; ++n) acc[n] = (f32x4){0.f, 0.f, 0.f, 0.f};
            const int nks = (16 * mt + 15) / 32 + 1;
#pragma unroll
            for (int ks = 0; ks < 4; ++ks) if (ks < nks) { const bf16x8 a = *(const LAS3 bf16x8*)(lds + (16 * mt + fr) * 272 + (ks * 32 + fq * 8) * 2);
#pragma unroll
                for (int n = 0; n < 4; ++n) acc[n] = __builtin_amdgcn_mfma_f32_16x16x32_bf16(bfrag[n][ks], a, acc[n], 0, 0, 0); }
            const int tl = 16 * mt + fr, tok = ch * 128 + tl; const float b = p.a_b_s[g * 128 + tl];
#pragma unroll
            for (int pp = 0; pp < 2; ++pp) { const int c0 = g * 512 + wave * 64 + pp * 32 + 8 * fq;
                const u32x4 uu = *(const u32x4*)(U + (size_t)tok * GH + c0); const f32x4 g0 = *(const f32x4*)(p.a_norm_v + c0), g1 = *(const f32x4*)(p.a_norm_v + c0 + 4);
                const f32x4 a0 = acc[2 * pp], a1 = acc[2 * pp + 1];
                u32x4 w;
                w.x = cvtpk(bf2f(uu.x & 0xffffu) * (g0[0] * a0[0] + b), bf2f(uu.x >> 16) * (g0[1] * a0[1] + b));
                w.y = cvtpk(bf2f(uu.y & 0xffffu) * (g0[2] * a0[2] + b), bf2f(uu.y >> 16) * (g0[3] * a0[3] + b));
                w.z = cvtpk(bf2f(uu.z & 0xffffu) * (g1[0] * a1[0] + b), bf2f(uu.z >> 16) * (g1[1] * a1[1] + b));
                w.w = cvtpk(bf2f(uu.w & 0xffffu) * (g1[2] * a1[2] + b), bf2f(uu.w >> 16) * (g1[3] * a1[3] + b));
                *(u32x4*)(GT + (size_t)tok * GH + c0) = w; }
        }
    }
    __syncthreads();
}

constexpr int AT_KP = 272, AT_VP = 288, AT_VOFF = 256 * AT_KP, AT_UNITS = 3072;
typedef short s16x4 __attribute__((ext_vector_type(4)));
struct AtUnit { int gi, b, h, r, n, dsh; };
__device__ __forceinline__ AtUnit at_decode(int unit) { AtUnit u; u.gi = unit >> 10; const int rem = unit & 1023; u.b = rem >> 8; u.h = (rem >> 4) & 15; const int rn = rem & 15;
    u.dsh = 2 * u.gi; const int nbsh = 4 - u.dsh; u.r = rn >> nbsh; u.n = rn & ((1 << nbsh) - 1); return u; }
#define AT_TR4(o0, o1, o2, o3, f0, f1, f2, f3) asm volatile("ds_read_b64_tr_b16 %0, %4 offset:%5\n\tds_read_b64_tr_b16 %1, %4 offset:%6\n\tds_read_b64_tr_b16 %2, %4 offset:%7\n\tds_read_b64_tr_b16 %3, %4 offset:%8" \
        : "=&v"(o0), "=&v"(o1), "=&v"(o2), "=&v"(o3) : "v"(vrow), "i"(f0), "i"(f1), "i"(f2), "i"(f3) : "memory")
__device__ __forceinline__ void phase_attn(const Params& p, LAS3 unsigned char* lds) {
    const int tid = threadIdx.x, lane = tid & 63, wave = __builtin_amdgcn_readfirstlane(tid >> 6), fr = lane & 15, fq = lane >> 4, G = (int)gridDim.x;
    unsigned char* ws = p.ws;
    const bf16_t* Q = (const bf16_t*)(ws + OFF_Q); const bf16_t* KV = (const bf16_t*)(ws + OFF_KV); bf16_t* OG = (bf16_t*)(ws + OFF_OG); float* LSE = (float*)(ws + OFF_LSE);
    const unsigned vbase = (unsigned)(size_t)(lds + AT_VOFF);
    const unsigned vrow = vbase + (unsigned)((16 * wave + 4 * fq + ((lane & 15) >> 2)) * AT_VP + (lane & 3) * 8);
    const int srow = tid >> 4, c16 = tid & 15;
    int unit = blockIdx.x;
    if (unit < AT_UNITS) {
        AtUnit cu = at_decode(unit);
        u32x4 kreg[8], vreg[8]; bf16x8 qf[4], qn[4];
#define AT_LOADQ(U, D) do { const int _tok = (U).b * SEQ + ((((U).n << 7) + wave * 16 + fr) << (U).dsh) + (U).r; _Pragma("unroll") for (int ks = 0; ks < 4; ++ks) D[ks] = *(const bf16x8*)(Q + (size_t)_tok * NQ + (U).gi * 2048 + (U).h * 128 + ks * 32 + fq * 8); } while (0)
#define AT_LOAD(U) do { _Pragma("unroll") for (int ps = 0; ps < 8; ++ps) if ((U).n > 0 || ps >= 4) { const int lk = ((U).n - 1) * 128 + ps * 32 + srow; \
            const bf16_t* src = KV + ((size_t)(U).h * NTOK + (U).b * SEQ + (lk << (U).dsh) + (U).r) * 128 + c16 * 8; kreg[ps] = *(const u32x4*)src; vreg[ps] = *(const u32x4*)(src + (size_t)16 * NTOK * 128); } } while (0)
        AT_LOAD(cu); AT_LOADQ(cu, qn);
        for (;;) {
            asm volatile("" ::: "memory"); __builtin_amdgcn_s_barrier(); asm volatile("" ::: "memory");
#pragma unroll
            for (int ps = 0; ps < 8; ++ps) if (cu.n > 0 || ps >= 4) { const int kk = ps * 32 + srow;
                *(LAS3 u32x4*)(lds + kk * AT_KP + c16 * 16) = kreg[ps]; *(LAS3 u32x4*)(lds + AT_VOFF + kk * AT_VP + c16 * 16) = vreg[ps]; }
            const int jq = wave * 16 + fr, qtok = cu.b * SEQ + (((cu.n << 7) + jq) << cu.dsh) + cu.r;
#pragma unroll
            for (int ks = 0; ks < 4; ++ks) qf[ks] = qn[ks];
            const int un = unit + G; const bool hasn = un < AT_UNITS; AtUnit nu = cu;
            if (hasn) { nu = at_decode(un); AT_LOAD(nu); AT_LOADQ(nu, qn); }
            asm volatile("s_waitcnt lgkmcnt(0)" ::: "memory"); __builtin_amdgcn_s_barrier(); asm volatile("" ::: "memory");
            const int c_lo = cu.n == 0 ? (8 - wave) : 0;
            f32x4 sc[9];
#pragma unroll
            for (int c = 0; c < 9; ++c) { sc[c] = (f32x4){0.f, 0.f, 0.f, 0.f};
                if (c >= c_lo) {
#pragma unroll
                    for (int ks = 0; ks < 4; ++ks) { const bf16x8 kf = *(const LAS3 bf16x8*)(lds + (16 * (wave + c) + fr) * AT_KP + (ks * 32 + fq * 8) * 2);
                        sc[c] = __builtin_amdgcn_mfma_f32_16x16x32_bf16(kf, qf[ks], sc[c], 0, 0, 0); } } }
            const float slope2 = exp2f(-0.5f * (float)(cu.h + 1)) * 1.4426950409f; const int dq = fr - 4 * fq; const float t0 = slope2 * (float)(128 + dq); float mx = -3.0e38f;
#pragma unroll
            for (int c = 0; c < 9; ++c) {
                if (c >= c_lo) {
#pragma unroll
                    for (int q = 0; q < 4; ++q) { float s2 = fmaf(sc[c][q], 0.08838834764831845f * 1.4426950409f, fmaf(slope2, (float)(16 * c + q), -t0));
                        if (c == 0) s2 = (dq - q <= 0) ? s2 : -3.0e38f;
                        if (c == 8) s2 = (dq - q >= 0) ? s2 : -3.0e38f;
                        sc[c][q] = s2; mx = fmaxf(mx, s2); }
                } else { sc[c] = (f32x4){-3.0e38f, -3.0e38f, -3.0e38f, -3.0e38f}; } }
            mx = fmaxf(mx, __shfl_xor(mx, 16)); mx = fmaxf(mx, __shfl_xor(mx, 32));
            float den = 0.f;
#pragma unroll
            for (int c = 0; c < 9; ++c) {
                if (c >= c_lo) {
#pragma unroll
                    for (int q = 0; q < 4; ++q) { const float e = __builtin_amdgcn_exp2f(sc[c][q] - mx); sc[c][q] = e; den += e; }
                } else { sc[c] = (f32x4){0.f, 0.f, 0.f, 0.f}; } }
            den += __shfl_xor(den, 16); den += __shfl_xor(den, 32);
            f32x4 o[8];
#pragma unroll
            for (int et = 0; et < 8; ++et) o[et] = (f32x4){0.f, 0.f, 0.f, 0.f};
#pragma unroll
            for (int pp = 0; pp < 5; ++pp) {
                if (2 * pp + 1 >= c_lo) {
                    u32x4 pw; pw.x = cvtpk(sc[2 * pp][0], sc[2 * pp][1]); pw.y = cvtpk(sc[2 * pp][2], sc[2 * pp][3]);
                    if (pp < 4) { pw.z = cvtpk(sc[2 * pp + 1][0], sc[2 * pp + 1][1]); pw.w = cvtpk(sc[2 * pp + 1][2], sc[2 * pp + 1][3]); } else { pw.z = 0u; pw.w = 0u; }
                    const bf16x8 pf = __builtin_bit_cast(bf16x8, pw);
                    constexpr int R1 = 16 * AT_VP;
                    const int r0 = (32 * pp) * AT_VP, r1 = (pp < 4 ? (32 * pp + 16) : (32 * pp)) * AT_VP; (void)R1;
                    s16x4 a0, a1, a2, a3, a4, a5, a6, a7, b0, b1, b2, b3, b4, b5, b6, b7;
                    AT_TR4(a0, a1, a2, a3, r0, r0 + 32, r0 + 64, r0 + 96); AT_TR4(a4, a5, a6, a7, r0 + 128, r0 + 160, r0 + 192, r0 + 224);
                    AT_TR4(b0, b1, b2, b3, r1, r1 + 32, r1 + 64, r1 + 96); AT_TR4(b4, b5, b6, b7, r1 + 128, r1 + 160, r1 + 192, r1 + 224);
                    asm volatile("s_waitcnt lgkmcnt(0)" : "+v"(a0), "+v"(a1), "+v"(a2), "+v"(a3), "+v"(a4), "+v"(a5), "+v"(a6), "+v"(a7), "+v"(b0), "+v"(b1), "+v"(b2), "+v"(b3), "+v"(b4), "+v"(b5), "+v"(b6), "+v"(b7) :: "memory");
                    if (2 * pp < c_lo) { const s16x4 z = {0, 0, 0, 0}; a0 = z; a1 = z; a2 = z; a3 = z; a4 = z; a5 = z; a6 = z; a7 = z; }
#define AT_PV(et, A, B) o[et] = __builtin_amdgcn_mfma_f32_16x16x32_bf16((bf16x8){A[0], A[1], A[2], A[3], B[0], B[1], B[2], B[3]}, pf, o[et], 0, 0, 0)
                    AT_PV(0, a0, b0); AT_PV(1, a1, b1); AT_PV(2, a2, b2); AT_PV(3, a3, b3); AT_PV(4, a4, b4); AT_PV(5, a5, b5); AT_PV(6, a6, b6); AT_PV(7, a7, b7);
#undef AT_PV
                } }
            const float inv = 1.0f / den;
            bf16_t* op = OG + ((size_t)cu.gi * NTOK + qtok) * DM + cu.h * 128 + 4 * fq;
#pragma unroll
            for (int et = 0; et < 8; ++et) { uint2 w; w.x = cvtpk(o[et][0] * inv, o[et][1] * inv); w.y = cvtpk(o[et][2] * inv, o[et][3] * inv); *(uint2*)(op + et * 16) = w; }
            if (fq == 0) LSE[((size_t)cu.gi * NTOK + qtok) * 16 + cu.h] = (mx + __log2f(den)) * 0.6931471806f;
            if (!hasn) break;
            unit = un; cu = nu;
        }
#undef AT_LOAD
#undef AT_LOADQ
    }
    __syncthreads();
}
#undef AT_TR4

__device__ __forceinline__ void phase_merge(const Params& p) {
    unsigned char* ws = p.ws; const bf16_t* OG = (const bf16_t*)(ws + OFF_OG); const float* LSE = (const float*)(ws + OFF_LSE); bf16_t* OM = (bf16_t*)(ws + OFF_OM);
    for (size_t i = (size_t)blockIdx.x * MK_THREADS + threadIdx.x; i < (size_t)NTOK * 256; i += (size_t)gridDim.x * MK_THREADS) {
        const int tok = (int)(i >> 8), c8 = (int)(i & 255), h = c8 >> 4;
        const float l0 = LSE[((size_t)0 * NTOK + tok) * 16 + h], l1 = LSE[((size_t)1 * NTOK + tok) * 16 + h], l2 = LSE[((size_t)2 * NTOK + tok) * 16 + h];
        const float m = fmaxf(l0, fmaxf(l1, l2)); const float a0 = __expf(l0 - m), a1 = __expf(l1 - m), a2 = __expf(l2 - m), inv = 1.0f / (a0 + a1 + a2);
        const uint4 x0 = *(const uint4*)(OG + ((size_t)0 * NTOK + tok) * DM + c8 * 8), x1 = *(const uint4*)(OG + ((size_t)1 * NTOK + tok) * DM + c8 * 8), x2 = *(const uint4*)(OG + ((size_t)2 * NTOK + tok) * DM + c8 * 8);
        const unsigned w0[4] = {x0.x, x0.y, x0.z, x0.w}, w1[4] = {x1.x, x1.y, x1.z, x1.w}, w2[4] = {x2.x, x2.y, x2.z, x2.w}; unsigned rr[4];
#pragma unroll
        for (int j = 0; j < 4; ++j) { const float lo = (a0 * bf2f(w0[j] & 0xffffu) + a1 * bf2f(w1[j] & 0xffffu) + a2 * bf2f(w2[j] & 0xffffu)) * inv;
            const float hi = (a0 * bf2f(w0[j] >> 16) + a1 * bf2f(w1[j] >> 16) + a2 * bf2f(w2[j] >> 16)) * inv; rr[j] = cvtpk(lo, hi); }
        *(uint4*)(OM + (size_t)tok * DM + c8 * 8) = make_uint4(rr[0], rr[1], rr[2], rr[3]);
    }
}
#define PHASE2_BODY phase_sgu(p, lds);
#define PHASE9_BODY phase_attn(p, lds);
#define PHASE10_BODY phase_merge(p);

__global__ void __launch_bounds__(MK_THREADS, 2) mega(Params p, int lo, int hi) {
    extern __shared__ __attribute__((aligned(16))) unsigned char shm[];
    LAS3 unsigned char* lds = (LAS3 unsigned char*)shm;
    const int tid = threadIdx.x, wave = __builtin_amdgcn_readfirstlane(tid >> 6), G = (int)gridDim.x;
#define MK_LANE() ((int)__builtin_amdgcn_mbcnt_hi(~0u, __builtin_amdgcn_mbcnt_lo(~0u, 0u)))
    unsigned char* ws = p.ws;
    volatile LAS3 unsigned* xbw = (volatile LAS3 unsigned*)(lds + MK_LDS_BAR);
    if (tid < 4) xbw[tid] = 0u;
    __syncthreads();
    XcdBarrier bar; bar.bar = (unsigned*)(ws + OFF_CTRL + CTRL_BAR_BYTE); bar.x = 0; bar.st = xbw;
    if (hi - lo > 1) bar = xcd_barrier_post((unsigned*)(ws + OFF_CTRL + CTRL_BAR_BYTE), xbw);
#define IN(k) (lo <= (k) && (k) < hi)
#define SEAM(k) do { if (IN(k) && IN((k) + 1)) xcd_barrier(bar); } while (0)
    float* SSP = (float*)(ws + OFF_SSP);
    bf16_t* XN = (bf16_t*)(ws + OFF_XN); bf16_t* XNQ = (bf16_t*)(ws + OFF_XNQ);
    bf16_t* MIX = (bf16_t*)(ws + OFF_MIX); bf16_t* H1 = (bf16_t*)(ws + OFF_H1); bf16_t* H2 = (bf16_t*)(ws + OFF_H2); bf16_t* H3 = (bf16_t*)(ws + OFF_H3);
    int* ictrl = (int*)(ws + OFF_CTRL);
    const float* gains = p.gains;

    constexpr int CR0 = CT1, CR1 = 12800, CR3 = 17408, CR5 = 34304, CR6 = 42496, CR8 = CT8;
    static_assert(CR1 >= CT6, "every dense weight is converted by the end of P1");
    const bool conv_first = (blockIdx.x & 1) == 0;
    constexpr int CVF = 9;
#define CV_MID(a, b) ((a) + (((b) - (a)) * CVF / 16))
    if (IN(0)) {
        phase_convert(p, lds, 0, CR0, (int)blockIdx.x, G);
        { const int lane = MK_LANE(); for (int row = blockIdx.x * 8 + wave; row < NTOK; row += G * 8) row_norm0(p, row, lane); }
    }
    SEAM(0);
    if (IN(1)) {
        if (conv_first) phase_convert(p, lds, CR0, CV_MID(CR0, CR1), (int)blockIdx.x >> 1, G >> 1);
        { pg8::Gemm g{XN, (const bf16_t*)(ws + OFF_WIN_T), NTOK, GH, DM}; pg8::StaticOrder S; S.init(NTOK, GH, G, (int)blockIdx.x);
          EpiGeluU E{(bf16_t*)(ws + OFF_U), GH, p.a_b_in};
          pg8::gemm_phase<EpiGeluU, pg8::StaticOrder>(lds, g, S, E, nullptr); }
        { pg8::Gemm g{(const bf16_t*)(ws + OFF_WIN_T) + (size_t)GH * DM, XN, GH, NTOK, DM}; pg8::StaticOrder S; S.init(GH, NTOK, G, (int)blockIdx.x);
          EpiGeluVT E{(bf16_t*)(ws + OFF_VT), p.a_b_in + GH, SSP};
          pg8::gemm_phase<EpiGeluVT, pg8::StaticOrder>(lds, g, S, E, nullptr); }
        if (!conv_first) phase_convert(p, lds, CV_MID(CR0, CR1), CR1, (int)blockIdx.x >> 1, G >> 1);
    }
    SEAM(1);
    if (IN(2)) { PHASE2_BODY }
    SEAM(2);
    if (IN(3)) {
        if (conv_first) phase_convert(p, lds, CR1, CV_MID(CR1, CR3), (int)blockIdx.x >> 1, G >> 1);
        pg8::Gemm g{(const bf16_t*)(ws + OFF_GT), (const bf16_t*)(ws + OFF_WOUT_T), NTOK, DM, GH}; pg8::StaticOrder S; S.init(NTOK, DM, G, (int)blockIdx.x);
        EpiBf16SS E{MIX, DM, SSP};
        pg8::gemm_phase<EpiBf16SS, pg8::StaticOrder>(lds, g, S, E, nullptr);
        if (!conv_first) phase_convert(p, lds, CV_MID(CR1, CR3), CR3, (int)blockIdx.x >> 1, G >> 1);
    }
    SEAM(3);
    if (IN(4)) { phase_resnorm<false>(p.x, MIX, SSP, gains + DM, H1, gains + 2 * DM, XN, nullptr, nullptr, wave, MK_LANE(), G); }
    SEAM(4);
    if (IN(5)) {
        if (conv_first) phase_convert(p, lds, CR3, CV_MID(CR3, CR5), (int)blockIdx.x >> 1, G >> 1);
        pg8::Gemm g{XN, (const bf16_t*)(ws + OFF_WGU_T), NTOK, 2 * DFF, DM}; pg8::StaticOrder S; S.init(NTOK, 2 * DFF, G, (int)blockIdx.x);
        EpiSwiglu E{(bf16_t*)(ws + OFF_ACT), DFF, 56};
        pg8::gemm_phase<EpiSwiglu, pg8::StaticOrder>(lds, g, S, E, nullptr);
        if (!conv_first) phase_convert(p, lds, CV_MID(CR3, CR5), CR5, (int)blockIdx.x >> 1, G >> 1);
    }
    SEAM(5);
    if (IN(6)) {
        if (conv_first) phase_convert(p, lds, CR5, CV_MID(CR5, CR6), (int)blockIdx.x >> 1, G >> 1);
        pg8::Gemm g{(const bf16_t*)(ws + OFF_ACT), (const bf16_t*)(ws + OFF_WDN_T), NTOK, DM, DFF}; pg8::StaticOrder S; S.init(NTOK, DM, G, (int)blockIdx.x);
        EpiBf16SS E{MIX, DM, SSP};
        pg8::gemm_phase<EpiBf16SS, pg8::StaticOrder>(lds, g, S, E, nullptr);
        if (!conv_first) phase_convert(p, lds, CV_MID(CR5, CR6), CR6, (int)blockIdx.x >> 1, G >> 1);
    }
    SEAM(6);
    if (IN(7)) { phase_resnorm<true>(H1, MIX, SSP, gains + 3 * DM, H2, p.kv_norm, XN, gains + 4 * DM, XNQ, wave, MK_LANE(), G); }
    SEAM(7);
    if (IN(8)) {
        if (conv_first) phase_convert(p, lds, CR6, CV_MID(CR6, CR8), (int)blockIdx.x >> 1, G >> 1);
        { pg8::Gemm g{XN, (const bf16_t*)(ws + OFF_WKV_T), NTOK, NKV, DM}; pg8::StaticOrder S; S.init(NTOK, NKV, G, (int)blockIdx.x);
          EpiBf16H E{(bf16_t*)(ws + OFF_KV), NTOK};
          pg8::gemm_phase<EpiBf16H, pg8::StaticOrder>(lds, g, S, E, nullptr); }
        { pg8::Gemm g{XNQ, (const bf16_t*)(ws + OFF_WQ_T), NTOK, NQ, DM}; pg8::StaticOrder S; S.init(NTOK, NQ, G, (int)blockIdx.x);
          EpiBf16P E{(bf16_t*)(ws + OFF_Q), NQ};
          pg8::gemm_phase<EpiBf16P, pg8::StaticOrder>(lds, g, S, E, nullptr); }
        if (!conv_first) phase_convert(p, lds, CV_MID(CR6, CR8), CR8, (int)blockIdx.x >> 1, G >> 1);
    }
    SEAM(8);
    if (IN(9)) { PHASE9_BODY }
    SEAM(9);
    if (IN(10)) { PHASE10_BODY }
    SEAM(10);
    if (IN(11)) {
        pg8::Gemm g{(const bf16_t*)(ws + OFF_OM), (const bf16_t*)(ws + OFF_WO_T), NTOK, DM, DM}; pg8::StaticOrder S; S.init(NTOK, DM, G, (int)blockIdx.x);
        EpiBf16SS E{MIX, DM, SSP};
        pg8::gemm_phase<EpiBf16SS, pg8::StaticOrder>(lds, g, S, E, nullptr);
    }
    SEAM(11);
    if (IN(12)) { phase_router(H2, MIX, SSP, gains + 5 * DM, H3, gains + 6 * DM, p.moe_router, ws + OFF_XS, ictrl + C_CNT, (int*)(ws + OFF_TOKS), (float*)(ws + OFF_TOKG), lds, wave, MK_LANE(), G); }
    SEAM(12);
    if (IN(13)) {
        const int nblk = moe_table(ictrl + C_CNT, lds);
        pg8::Gemm g{(const bf16_t*)(ws + OFF_XS), (const bf16_t*)(ws + OFF_MGU_T), nblk * 256, 2 * DFF, DM}; MoeOrder S; S.init(nblk * 256, 2 * DFF, G, (int)blockIdx.x); S.tbl = (const LAS3 int*)(lds + MOE_TBL_OFF); S.NT = 56; S.lim = 0x7fffffff;
        EpiSwiglu8 E{ws + OFF_ACT2, DFF, 56, 1.0f / (F8_SA1 * F8_SW1), F8_SA2};
        pg8::gemm_phase<EpiSwiglu8, MoeOrder, false, true>(lds, g, S, E, nullptr);
    }
    SEAM(13);
    if (IN(14)) {
        const int nblk = moe_table(ictrl + C_CNT, lds); const int nunits = nblk * 8; int lim = 2 * G < nunits ? 2 * G : nunits; if ((nunits - lim) * KSPLIT > G) lim = nunits;
        { pg8::Gemm g{(const bf16_t*)(ws + OFF_ACT2), (const bf16_t*)(ws + OFF_MDN_T), nblk * 256, DM, DFF}; MoeOrder S; S.init(nblk * 256, DM, G, (int)blockIdx.x); S.tbl = (const LAS3 int*)(lds + MOE_TBL_OFF); S.NT = 8; S.lim = lim;
          EpiBf16S E{(bf16_t*)(ws + OFF_Y), DM, 8, 1.0f / (F8_SA2 * F8_SW2)};
          pg8::gemm_phase<EpiBf16S, MoeOrder, false, true>(lds, g, S, E, nullptr); }
        { const int nleft = nunits - lim, item = (int)blockIdx.x, li = item / KSPLIT, ch = item - li * KSPLIT;
          constexpr int CKT = DFF / 128 / KSPLIT;
          pg8::Gemm g{(const bf16_t*)(ws + OFF_ACT2 + (size_t)ch * CKT * 128), (const bf16_t*)(ws + OFF_MDN_T + (size_t)ch * CKT * 128), nblk * 256, DM, DFF, CKT};
          LeftOrder S; S.init(nblk * 256, DM, G, 0); S.tbl = (const LAS3 int*)(lds + MOE_TBL_OFF); S.NT = 8; S.L = li < nleft ? lim + li : -1;
          EpiF32Part E{(float*)(ws + OFF_U) + ((size_t)li * KSPLIT + ch) * 65536, 1.0f / (F8_SA2 * F8_SW2), ictrl + C_TFLAG, li, 8, ch == 0};
          pg8::gemm_phase<EpiF32Part, LeftOrder, false, true>(lds, g, S, E, nullptr); }
    }
    SEAM(14);
    if (IN(15)) { const int lane = MK_LANE(); for (int row = blockIdx.x * 8 + wave; row < NTOK; row += G * 8)
        row_final(H3, (const bf16_t*)(ws + OFF_Y), (const float*)(ws + OFF_U)  , ictrl + C_TFLAG, (const int*)(ws + OFF_TOKS), (const float*)(ws + OFF_TOKG), gains + 7 * DM, p.out, row, lane); }
#undef IN
#undef SEAM
}

extern "C" void kernel_launch(void* const* d_in, const int* in_sizes, int n_in, void* d_out, int out_size, void* d_ws, size_t ws_size, hipStream_t stream) {
    (void)in_sizes; (void)n_in; (void)out_size;
    if (ws_size < WS_NEED) { fprintf(stderr, "workspace too small: %zu < %zu\n", ws_size, (size_t)WS_NEED); return; }
    static int grid = 0;
    if (grid == 0) {
        int dev = 0, cus = 0, per_cu = 0;
        if (hipGetDevice(&dev) != hipSuccess || hipDeviceGetAttribute(&cus, hipDeviceAttributeMultiprocessorCount, dev) != hipSuccess) { fprintf(stderr, "device query failed\n"); grid = -1; return; }
        if (hipFuncSetAttribute((const void*)mega, hipFuncAttributeMaxDynamicSharedMemorySize, MK_LDS_BYTES) != hipSuccess) { fprintf(stderr, "hipFuncSetAttribute failed\n"); grid = -1; return; }
        if (hipOccupancyMaxActiveBlocksPerMultiprocessor(&per_cu, (const void*)mega, MK_THREADS, MK_LDS_BYTES) != hipSuccess || per_cu < 1) { fprintf(stderr, "occupancy query: %d blocks per CU\n", per_cu); (void)hipGetLastError(); }
        grid = cus;
    }
    if (grid < 0) return;
    const float* const* in = (const float* const*)d_in;
    Params P{};
    P.x = in[0]; P.gains = in[1]; P.a_w_in = in[2]; P.a_b_in = in[3]; P.a_norm_v = in[4]; P.a_w_s = in[5]; P.a_b_s = in[6]; P.a_w_out = in[7]; P.kv_norm = in[8]; P.w_kv = in[9]; P.w_q = in[10]; P.w_o = in[11];
    P.ffn_w_gu = in[12]; P.ffn_w_down = in[13]; P.moe_router = in[14]; P.moe_w_gu = in[15]; P.moe_w_down = in[16]; P.out = (float*)d_out; P.ws = (unsigned char*)d_ws;
#define MEGA(lo, hi) hipLaunchKernelGGL(mega, dim3(grid), dim3(MK_THREADS), MK_LDS_BYTES, stream, P, (lo), (hi))

    (void)hipMemsetAsync((char*)d_ws + OFF_CTRL, 0, CTRL_BYTES, stream);
    MEGA(0, NPH);
}
```

```cpp
#include <hip/hip_runtime.h>
#include <stdint.h>
#include <stdio.h>

typedef unsigned short bf16_t;

constexpr int NTOK = 8192, DM = 2048, SEQ = 2048, GH = 4096  , DFF = 7168, NEXP = 8;
constexpr int NQ = 6144, NKV = 4096;
constexpr int ECAP = NTOK, MAXSLOT = NEXP * ECAP;
constexpr float EPS = 1e-6f;

constexpr size_t AL(size_t x) { return (x + 255) & ~(size_t)255; }
constexpr size_t OFF_CTRL = 0;
constexpr size_t CTRL_BYTES = 1 << 16;
constexpr int C_CNT = 0  ;
constexpr int SSP_N = 64;
constexpr size_t OFF_SSP  = AL(OFF_CTRL + CTRL_BYTES);
constexpr size_t OFF_XN   = AL(OFF_SSP + (size_t)NTOK * SSP_N * 4);
constexpr size_t OFF_XNQ  = AL(OFF_XN + (size_t)NTOK * DM * 2);
constexpr size_t OFF_U    = AL(OFF_XNQ + (size_t)NTOK * DM * 2);
constexpr size_t OFF_VT   = AL(OFF_U + (size_t)NTOK * GH * 2);
constexpr size_t OFF_GT   = AL(OFF_VT + (size_t)NTOK * GH * 2);
constexpr size_t OFF_MIX  = AL(OFF_GT + (size_t)NTOK * GH * 2);
constexpr size_t OFF_H1   = AL(OFF_MIX + (size_t)NTOK * DM * 4);
constexpr size_t OFF_H2   = AL(OFF_H1 + (size_t)NTOK * DM * 4);
constexpr size_t OFF_H3   = AL(OFF_H2 + (size_t)NTOK * DM * 4);
constexpr size_t OFF_ACT  = AL(OFF_H3 + (size_t)NTOK * DM * 4);
constexpr size_t OFF_KV   = AL(OFF_ACT + (size_t)NTOK * DFF * 2);
constexpr size_t OFF_Q    = AL(OFF_KV + (size_t)NTOK * NKV * 2);
constexpr size_t OFF_OG   = AL(OFF_Q + (size_t)NTOK * NQ * 2);
constexpr size_t OFF_LSE  = AL(OFF_OG + (size_t)3 * NTOK * DM * 2);
constexpr size_t OFF_OM   = AL(OFF_LSE + (size_t)3 * NTOK * 16 * 4);
constexpr size_t OFF_TOKG = AL(OFF_OM + (size_t)NTOK * DM * 2);
constexpr size_t OFF_TOKS = AL(OFF_TOKG + (size_t)NTOK * 2 * 4);
constexpr size_t OFF_XS   = AL(OFF_TOKS + (size_t)NTOK * 2 * 4);
constexpr size_t OFF_ACT2 = AL(OFF_XS + (size_t)MAXSLOT * DM);
constexpr size_t OFF_Y    = AL(OFF_ACT2 + (size_t)MAXSLOT * DFF);
constexpr size_t OFF_WIN_T  = AL(OFF_Y + (size_t)MAXSLOT * DM * 2);
constexpr size_t OFF_WOUT_T = AL(OFF_WIN_T + (size_t)2 * GH * DM * 2);
constexpr size_t OFF_WGU_T  = AL(OFF_WOUT_T + (size_t)DM * GH * 2);
constexpr size_t OFF_WDN_T  = AL(OFF_WGU_T + (size_t)2 * DFF * DM * 2);
constexpr size_t OFF_WKV_T  = AL(OFF_WDN_T + (size_t)DM * DFF * 2);
constexpr size_t OFF_WQ_T   = AL(OFF_WKV_T + (size_t)NKV * DM * 2);
constexpr size_t OFF_WO_T   = AL(OFF_WQ_T + (size_t)NQ * DM * 2);
constexpr size_t OFF_MGU_T  = AL(OFF_WO_T + (size_t)DM * DM * 2);
constexpr size_t OFF_MDN_T  = AL(OFF_MGU_T + (size_t)NEXP * 2 * DFF * DM);
constexpr size_t WS_NEED  = AL(OFF_MDN_T + (size_t)NEXP * DM * DFF);
constexpr size_t CTRL_BAR_BYTE = 4096;

__device__ __forceinline__ float bf2f(unsigned v) { return __uint_as_float(v << 16); }
__device__ __forceinline__ bf16_t f2bf(float f) { unsigned u = __float_as_uint(f); u += 0x7FFFu + ((u >> 16) & 1u); return (bf16_t)(u >> 16); }
__device__ __forceinline__ unsigned pack2(float lo, float hi) { return (unsigned)f2bf(lo) | ((unsigned)f2bf(hi) << 16); }
__device__ __forceinline__ float gelu_tanh(float x) { const float t = 1.5957691216057308f * (x + 0.044715f * x * x * x); return x / (1.0f + __expf(-t)); }
__device__ __forceinline__ float silu(float x) { return x / (1.0f + __expf(-x)); }
__device__ __forceinline__ float wave_sum(float v) { for (int o = 32; o >= 1; o >>= 1) v += __shfl_xor(v, o); return v; }
__device__ __forceinline__ float wave_max(float v) { for (int o = 32; o >= 1; o >>= 1) v = fmaxf(v, __shfl_xor(v, o)); return v; }

namespace pg8 {
#define PG8_LAS __attribute__((address_space(3)))
typedef unsigned short bf16_t;
typedef short bf16x8 __attribute__((ext_vector_type(8)));
typedef float f32x4 __attribute__((ext_vector_type(4)));
typedef unsigned u32x4 __attribute__((ext_vector_type(4)));
constexpr int BM = 256, BK = 64, HALF = 128, HTB = HALF * BK * 2  , STAGE_BYTES = 8 * HTB, NXCD = 8, WGM = 8;

__host__ __device__ __forceinline__ int lds_byte(int r, int c) { const int st = (r >> 4) * 2 + (c >> 5), rr = r & 15, cc = c & 31, ob = rr * 64 + cc * 2; return st * 1024 + (ob ^ (((ob >> 9) & 1) << 5)); }
__host__ __device__ __forceinline__ void stage_rc(int b, int& R, int& C) { const int st = b / 1024, sb = b % 1024, swz = sb ^ (((sb >> 9) & 1) << 5); R = (st >> 1) * 16 + swz / 64; C = (st & 1) * 32 + (swz % 64) / 2; }
__host__ __device__ __forceinline__ int perm32(int rho) { const int n = rho >> 4, i = rho & 15; return 8 * (i >> 2) + 4 * n + (i & 3); }

struct Unit { int pm, pn; };
struct Gemm { const bf16_t* A; const bf16_t* Bt; int M, N, K; int kt; };

struct StaticOrder {
    int nM, nN, nwg, G, c;
    __host__ __device__ void init(int M, int N, int G_, int c_) { nM = M / BM; nN = N / BM; nwg = nM * nN; G = G_; c = c_; }
    __host__ __device__ bool next(int i, Unit& u) const {
        const long L = (long)i * G + c; if (L >= nwg) return false;
        int wgid = (int)L; { const int q = nwg / NXCD, r = nwg % NXCD, xcd = wgid % NXCD, off = wgid / NXCD; wgid = (xcd < r ? xcd * (q + 1) : r * (q + 1) + (xcd - r) * q) + off; }
        const int nig = WGM * nN, gid = wgid / nig, fm = gid * WGM, gsz = (nM - fm) < WGM ? (nM - fm) : WGM;
        u.pm = fm + ((wgid % nig) % gsz); u.pn = (wgid % nig) / gsz; return true;
    }
    __device__ __forceinline__ void a_ready(const Unit&) const {}
    __device__ __forceinline__ void done(const Unit&) const {}
};
__device__ __forceinline__ unsigned cvt_pk_bf16(float lo, float hi) { unsigned r; asm volatile("v_cvt_pk_bf16_f32 %0, %1, %2" : "=v"(r) : "v"(lo), "v"(hi)); return r; }
typedef float f32x2 __attribute__((ext_vector_type(2)));
typedef int pg8_v4i __attribute__((ext_vector_type(4))); typedef int pg8_v8i __attribute__((ext_vector_type(8)));
__device__ __forceinline__ pg8_v8i pg8_cat(bf16x8 a, bf16x8 b) { return __builtin_shufflevector(__builtin_bit_cast(pg8_v4i, a), __builtin_bit_cast(pg8_v4i, b), 0, 1, 2, 3, 4, 5, 6, 7); }
template <bool F8> struct pg8_frag; template <> struct pg8_frag<false> { bf16x8 v[2]; }; template <> struct pg8_frag<true> { pg8_v8i v; };
template <class Epi, class Sched, bool STAMP = false, bool F8 = false>
__device__ __forceinline__ void gemm_phase(PG8_LAS unsigned char* lds, const Gemm g, const Sched& S, const Epi& E, unsigned long long* stamps) {
    const int tid = threadIdx.x, wid = __builtin_amdgcn_readfirstlane(tid >> 6), lane = tid & 63, wr = wid >> 2, wc = wid & 3, fr = lane & 15, fq = lane >> 4;
    const int K = F8 ? (g.K >> 1) : g.K  , nt = g.kt ? g.kt : K / BK;
    int ts_lo = 0, ts_hi = 0, nts = 0; const unsigned long long rt_entry = STAMP ? (unsigned long long)wall_clock64() : 0ull;
#define PG8_STAMP() do { if (STAMP && wid == 0 && nts < 64) { const unsigned long long _c = (unsigned long long)clock64(); \
        ts_lo = (lane == nts) ? (int)(unsigned)_c : ts_lo; ts_hi = (lane == nts) ? (int)(unsigned)(_c >> 32) : ts_hi; ++nts; } } while (0)
    PG8_STAMP();
    unsigned voffA[2], voffB[2];
#pragma unroll
    for (int i = 0; i < 2; ++i) { int R, C; stage_rc(tid * 16 + i * 8192, R, C); const int Rb = Epi::PERM ? ((R & ~31) + perm32(R & 31)) : R;
        voffA[i] = (unsigned)(R * K + C) * 2u; voffB[i] = (unsigned)(Rb * K + C) * 2u; }
    const size_t kstep = (size_t)(BK * 2);
    const size_t hstep = (size_t)HALF * K * 2;
    const size_t tstep = 2 * hstep;
    const unsigned ldsw = (unsigned)wid * 1024u;
    const int aoff = lds_byte(wr * 64 + fr, fq * 8), boff = lds_byte(wc * 32 + fr, fq * 8);
#define PG8_SA(b, h) (((b) * 2 + (h)) * HTB)
#define PG8_SB(b, h) ((4 + (b) * 2 + (h)) * HTB)
#define PG8_STAGE(bufoff, gbase, voff) do { _Pragma("unroll") for (int _i = 0; _i < 2; ++_i) \
        __builtin_amdgcn_global_load_lds((const unsigned*)((const char*)(gbase) + (voff)[_i]), (PG8_LAS unsigned*)(lds + (bufoff) + ldsw + _i * 8192), 16, 0, 0); } while (0)
#define PG8_LDA(dst, b, h) do { _Pragma("unroll") for (int m = 0; m < 4; ++m) { const bf16x8 _l0 = *(const PG8_LAS bf16x8*)(lds + PG8_SA(b, h) + aoff + m * 2048), _l1 = *(const PG8_LAS bf16x8*)(lds + PG8_SA(b, h) + aoff + m * 2048 + 1024); \
        if constexpr (F8) dst[m].v = pg8_cat(_l0, _l1); else { dst[m].v[0] = _l0; dst[m].v[1] = _l1; } } } while (0)
#define PG8_LDB(dst, b, h) do { _Pragma("unroll") for (int n = 0; n < 2; ++n) { const bf16x8 _l0 = *(const PG8_LAS bf16x8*)(lds + PG8_SB(b, h) + boff + n * 2048), _l1 = *(const PG8_LAS bf16x8*)(lds + PG8_SB(b, h) + boff + n * 2048 + 1024); \
        if constexpr (F8) dst[n].v = pg8_cat(_l0, _l1); else { dst[n].v[0] = _l0; dst[n].v[1] = _l1; } } } while (0)
#define PG8_MMA(ai, bj, At, Bt) do { __builtin_amdgcn_s_setprio(1); _Pragma("unroll") for (int m = 0; m < 4; ++m) _Pragma("unroll") for (int n = 0; n < 2; ++n) { \
        if constexpr (F8) asm volatile("v_mfma_scale_f32_16x16x128_f8f6f4 %0, %1, %2, %0, %3, %3 op_sel_hi:[0,0,0]" : "+v"(acc[ai][bj][m][n]) : "v"(Bt[n].v), "v"(At[m].v), "v"(sc127)); \
        else { _Pragma("unroll") for (int k = 0; k < 2; ++k) acc[ai][bj][m][n] = __builtin_amdgcn_mfma_f32_16x16x32_bf16(Bt[n].v[k], At[m].v[k], acc[ai][bj][m][n], 0, 0, 0); } } __builtin_amdgcn_s_setprio(0); } while (0)
#define PG8_WAIT_V(n) asm volatile("s_waitcnt vmcnt(" #n ")" ::: "memory")
#define PG8_WAIT_L(n) asm volatile("s_waitcnt lgkmcnt(" #n ")" ::: "memory")
#define PG8_BAR __builtin_amdgcn_s_barrier()
#define PG8_SCHED __builtin_amdgcn_sched_barrier(0)
    Unit cur, nxt; int ui = 0;
    const int sc127 = 0x7f7f7f7f; (void)sc127;
    if (!S.next(0, cur)) return;
    f32x4 acc[2][2][4][2];
#pragma unroll
    for (int a = 0; a < 2; ++a)
#pragma unroll
        for (int b = 0; b < 2; ++b)
#pragma unroll
            for (int m = 0; m < 4; ++m)
#pragma unroll
                for (int n = 0; n < 2; ++n) acc[a][b][m][n] = (f32x4){0.f, 0.f, 0.f, 0.f};
    pg8_frag<F8> At[4], B0[2], B1[2];
    const char* cA = (const char*)g.A + (size_t)cur.pm * tstep; const char* cB = (const char*)g.Bt + (size_t)cur.pn * tstep;
    S.a_ready(cur);
    PG8_STAGE(PG8_SB(0, 0), cB, voffB); PG8_STAGE(PG8_SA(0, 0), cA, voffA); PG8_STAGE(PG8_SB(0, 1), cB + hstep, voffB); PG8_STAGE(PG8_SA(0, 1), cA + hstep, voffA);
    if (wr == 1) PG8_BAR;
    PG8_WAIT_V(4); PG8_BAR;
    PG8_STAGE(PG8_SB(1, 0), cB + kstep, voffB); PG8_STAGE(PG8_SA(1, 0), cA + kstep, voffA); PG8_STAGE(PG8_SB(1, 1), cB + hstep + kstep, voffB);
    PG8_WAIT_V(6); PG8_BAR;
    PG8_STAMP();
    for (;;) {
        const bool has_next = S.next(ui + 1, nxt);
        const char* nA = has_next ? (const char*)g.A + (size_t)nxt.pm * tstep : cA; const char* nB = has_next ? (const char*)g.Bt + (size_t)nxt.pn * tstep : cB;
        for (int t = 0; t < nt; t += 2) {
            const bool last = (t == nt - 2);
            const char* a1 = cA + (size_t)(t + 1) * kstep;
            const char* a2 = last ? nA : cA + (size_t)(t + 2) * kstep; const char* b2 = last ? nB : cB + (size_t)(t + 2) * kstep;
            const char* a3 = a2 + kstep; const char* b3 = b2 + kstep;
            if (last && has_next) S.a_ready(nxt);
            PG8_LDB(B0, 0, 0); PG8_SCHED; PG8_LDA(At, 0, 0); PG8_STAGE(PG8_SA(1, 1), a1 + hstep, voffA);
            PG8_WAIT_L(8); PG8_BAR; PG8_WAIT_L(0); PG8_MMA(0, 0, At, B0); PG8_BAR; PG8_SCHED;
            PG8_LDB(B1, 0, 1); PG8_STAGE(PG8_SB(0, 0), b2, voffB);
            PG8_BAR; PG8_WAIT_L(0); PG8_MMA(0, 1, At, B1); PG8_BAR;
            PG8_LDA(At, 0, 1); PG8_STAGE(PG8_SA(0, 0), a2, voffA);
            PG8_BAR; PG8_WAIT_L(0); PG8_MMA(1, 0, At, B0); PG8_BAR; PG8_SCHED;
            PG8_STAGE(PG8_SB(0, 1), b2 + hstep, voffB);
            PG8_WAIT_V(6); PG8_BAR; PG8_MMA(1, 1, At, B1); PG8_BAR;
            PG8_LDB(B0, 1, 0); PG8_SCHED; PG8_LDA(At, 1, 0); PG8_STAGE(PG8_SA(0, 1), a2 + hstep, voffA);
            PG8_WAIT_L(8); PG8_BAR; PG8_WAIT_L(0); PG8_MMA(0, 0, At, B0); PG8_BAR; PG8_SCHED;
            PG8_LDB(B1, 1, 1); PG8_STAGE(PG8_SB(1, 0), b3, voffB);
            PG8_BAR; PG8_WAIT_L(0); PG8_MMA(0, 1, At, B1); PG8_BAR;
            PG8_LDA(At, 1, 1); PG8_STAGE(PG8_SA(1, 0), a3, voffA);
            PG8_BAR; PG8_WAIT_L(0); PG8_MMA(1, 0, At, B0); PG8_BAR; PG8_SCHED;
            PG8_STAGE(PG8_SB(1, 1), b3 + hstep, voffB);
            PG8_WAIT_V(6); PG8_BAR; PG8_MMA(1, 1, At, B1); PG8_BAR;
        }
        PG8_STAMP();
        if constexpr (F8) {
            asm volatile("s_nop 15\n\ts_nop 15" ::: "memory");
#pragma unroll
            for (int a = 0; a < 2; ++a)
#pragma unroll
                for (int b = 0; b < 2; ++b)
#pragma unroll
                    for (int m = 0; m < 4; ++m) asm volatile("" : "+v"(acc[a][b][m][0]), "+v"(acc[a][b][m][1]));
        }
        if constexpr (!Epi::AFTER_DRAIN) { E(acc, cur, wr, wc, fr, fq); S.done(cur); }
        PG8_STAMP();
        if (!has_next) break;
#pragma unroll
        for (int a = 0; a < 2; ++a)
#pragma unroll
            for (int b = 0; b < 2; ++b)
#pragma unroll
                for (int m = 0; m < 4; ++m)
#pragma unroll
                    for (int n = 0; n < 2; ++n) acc[a][b][m][n] = (f32x4){0.f, 0.f, 0.f, 0.f};
        cur = nxt; cA = nA; cB = nB; ++ui;
    }
    PG8_WAIT_V(0);
    if (wr == 0) PG8_BAR;
    PG8_BAR;
    if constexpr (Epi::AFTER_DRAIN) { E.fused(acc, cur, wr, wc, fr, fq, lds, wid, lane); S.done(cur); }
    PG8_STAMP();
    if (STAMP && wid == 0) { stamps[lane] = lane < nts ? (((unsigned long long)(unsigned)ts_hi << 32) | (unsigned)ts_lo) : 0ull;
        if (lane == 62) stamps[62] = rt_entry; if (lane == 63) stamps[63] = (unsigned long long)wall_clock64(); }
#undef PG8_STAMP
#undef PG8_SA
#undef PG8_SB
#undef PG8_STAGE
#undef PG8_LDA
#undef PG8_LDB
#undef PG8_MMA
#undef PG8_WAIT_V
#undef PG8_WAIT_L
#undef PG8_BAR
#undef PG8_SCHED
}
}
#define XB_TMO      128
#define XB_XCNT(j)  (256  + 64 * (j))
#define XB_XSUB(j)  (1280 + 64 * (j))
#define XB_XGEN(j)  (2304 + 64 * (j))
#define XB_TOP      3328
#define XB_TOPGEN   3392
#define XCD_BAR_WORDS 3456
#define XB_SPIN_CAP (1u << 18)
#define LAS __attribute__((address_space(3)))

__device__ __forceinline__ unsigned xb_ld(unsigned* p)              { return __hip_atomic_load(p, __ATOMIC_RELAXED, __HIP_MEMORY_SCOPE_AGENT); }
__device__ __forceinline__ unsigned xb_add(unsigned* p, unsigned v) { return __hip_atomic_fetch_add(p, v, __ATOMIC_RELAXED, __HIP_MEMORY_SCOPE_AGENT); }
__device__ __forceinline__ unsigned xb_xcc_id() { return (unsigned)__builtin_amdgcn_s_getreg((3 << 11) | 20) & 0xFu; }
#define XB_SPIN(cond, bar) do { unsigned _sp = 0; while (cond) { __builtin_amdgcn_s_sleep(1); \
    if ((++_sp & 255u) == 0u) { if (xb_ld(&(bar)[XB_TMO])) break; if (_sp > XB_SPIN_CAP) { atomicAdd(&(bar)[XB_TMO], 1u); break; } } } } while (0)

struct XcdBarrier {
    unsigned* bar; unsigned x;
    volatile LAS unsigned* st;
};

__device__ __forceinline__ XcdBarrier xcd_barrier_post(unsigned* bar, volatile LAS unsigned* st) {
    XcdBarrier b; b.bar = bar; b.x = xb_xcc_id(); b.st = st;
    if (threadIdx.x == 0) (void)xb_add(&bar[XB_XCNT(b.x)], 1u);
    return b;
}
__device__ __forceinline__ void xcd_barrier_complete(unsigned* bar, unsigned x, unsigned& nloc, unsigned& nx) {
    const unsigned G = gridDim.x * gridDim.y * gridDim.z;
    unsigned sum, cnt, mine, sp = 0u;
    for (;;) {
        sum = 0u; cnt = 0u; mine = 0u;
#pragma unroll
        for (unsigned j = 0; j < 16; ++j) { const unsigned c = xb_ld(&bar[XB_XCNT(j)]); sum += c; cnt += (c > 0u) ? 1u : 0u; mine = (j == x) ? c : mine; }
        if (sum == G) break;
        __builtin_amdgcn_s_sleep(1);
        if ((++sp & 255u) == 0u) { if (xb_ld(&bar[XB_TMO])) break; if (sp > XB_SPIN_CAP) { atomicAdd(&bar[XB_TMO], 1u); break; } }
    }
    nloc = mine > 0u ? mine : 1u; nx = cnt > 0u ? cnt : 1u;
}

__device__ __forceinline__ void xcd_barrier(const XcdBarrier& b) {
    asm volatile("s_waitcnt vmcnt(0)" ::: "memory");
    __syncthreads();
    if (threadIdx.x == 0) {
        unsigned* bar = b.bar;
        __builtin_amdgcn_s_waitcnt(0);
        unsigned nloc = b.st[0], nx = b.st[1];
        if (nloc == 0u) { xcd_barrier_complete(bar, b.x, nloc, nx); b.st[0] = nloc; b.st[1] = nx; }
        const unsigned old = xb_add(&bar[XB_XSUB(b.x)], 1u);
        const unsigned gen = old / nloc;
        if (old + 1u == (gen + 1u) * nloc) {
            __builtin_amdgcn_fence(__ATOMIC_RELEASE, "agent");
            asm volatile("s_waitcnt vmcnt(0)" ::: "memory");
            const unsigned og = xb_add(&bar[XB_TOP], 1u);
            const unsigned tg = og / nx;
            if (og + 1u == (tg + 1u) * nx) xb_add(&bar[XB_TOPGEN], 1u);
            else XB_SPIN(xb_ld(&bar[XB_TOPGEN]) == tg, bar);
            __builtin_amdgcn_fence(__ATOMIC_ACQUIRE, "agent");
            xb_add(&bar[XB_XGEN(b.x)], 1u);
            asm volatile("s_waitcnt vmcnt(0)" ::: "memory");
        } else {
            XB_SPIN(xb_ld(&bar[XB_XGEN(b.x)]) == gen, bar);
            __builtin_amdgcn_fence(__ATOMIC_ACQUIRE, "agent");
            asm volatile("s_waitcnt vmcnt(0)" ::: "memory");
        }
    }
    __syncthreads();
}


#define LAS3 __attribute__((address_space(3)))
using pg8::bf16x8; using pg8::f32x4; using pg8::u32x4; using pg8::Unit;
constexpr int MK_THREADS = 512, MK_LDS_BYTES = 147456  , MK_LDS_BAR = MK_LDS_BYTES - 16;
constexpr int NPH = 16;

struct Params {
    const float* x; const float* gains; const float* a_w_in; const float* a_b_in; const float* a_norm_v; const float* a_w_s; const float* a_b_s; const float* a_w_out;
    const float* kv_norm; const float* w_kv; const float* w_q; const float* w_o; const float* ffn_w_gu; const float* ffn_w_down; const float* moe_router; const float* moe_w_gu; const float* moe_w_down;
    float* out; unsigned char* ws;
};

typedef __bf16 bf16x2_t __attribute__((ext_vector_type(2)));
__device__ __forceinline__ unsigned cvtpk(float lo, float hi) { const bf16x2_t v = {(__bf16)lo, (__bf16)hi}; return __builtin_bit_cast(unsigned, v); }
__device__ __forceinline__ float gelu_fast(float x) { const float t = x + 0.044715f * x * x * x; return x * __builtin_amdgcn_rcpf(1.0f + __builtin_amdgcn_exp2f(-2.3022081985f * t)); }
__device__ __forceinline__ float silu_fast(float x) { return x * __builtin_amdgcn_rcpf(1.0f + __builtin_amdgcn_exp2f(-1.4426950409f * x)); }
__device__ __forceinline__ f32x4 exp2_4(f32x4 a) { return (f32x4){__builtin_amdgcn_exp2f(a[0]), __builtin_amdgcn_exp2f(a[1]), __builtin_amdgcn_exp2f(a[2]), __builtin_amdgcn_exp2f(a[3])}; }
__device__ __forceinline__ f32x4 rcp_4(f32x4 a) { return (f32x4){__builtin_amdgcn_rcpf(a[0]), __builtin_amdgcn_rcpf(a[1]), __builtin_amdgcn_rcpf(a[2]), __builtin_amdgcn_rcpf(a[3])}; }
__device__ __forceinline__ f32x4 swiglu_4(f32x4 G, f32x4 U, float kexp, float kout) {
    const f32x4 r = rcp_4(exp2_4(G * kexp) + 1.0f); return (G * U) * (r * kout); }
__device__ __forceinline__ f32x4 gelu_4(f32x4 v) { const f32x4 t = (v * v * 0.044715f + 1.0f) * v; const f32x4 r = rcp_4(exp2_4(t * -2.3022081985f) + 1.0f); return v * r; }

constexpr float F8_SA1 = 16.f, F8_SW1 = 1024.f, F8_SA2 = 8.f, F8_SW2 = 2048.f;
__device__ __forceinline__ unsigned pack4_fp8(float a, float b, float c, float d) {
    a = __builtin_amdgcn_fmed3f(a, -448.f, 448.f); b = __builtin_amdgcn_fmed3f(b, -448.f, 448.f); c = __builtin_amdgcn_fmed3f(c, -448.f, 448.f); d = __builtin_amdgcn_fmed3f(d, -448.f, 448.f);
    int w = __builtin_amdgcn_cvt_pk_fp8_f32(a, b, 0, false); w = __builtin_amdgcn_cvt_pk_fp8_f32(c, d, w, true); return (unsigned)w; }
struct CTile { const float* src; bf16_t* dst; int N, K; int f8; float scale; };
constexpr int CT0 = 16 * 128, CT1 = CT0 + 32 * 32, CT2 = CT1 + 16 * 224, CT3 = CT2 + 56 * 32, CT4 = CT3 + 16 * 64, CT5 = CT4 + 16 * 96, CT6 = CT5 + 16 * 32, CT7 = CT6 + 8 * 16 * 224, CT8 = CT7 + 8 * 56 * 32;
__device__ __forceinline__ CTile conv_decode(const Params& p, int t) {
    const float* S; bf16_t* D; int K, N, inter = 0, tt, f8 = 0; float scale = 1.f;
    unsigned char* ws = p.ws;
    if (t < CT0)      { S = p.a_w_in;     D = (bf16_t*)(ws + OFF_WIN_T);  K = DM;  N = 2 * GH;  tt = t; }
    else if (t < CT1) { S = p.a_w_out;    D = (bf16_t*)(ws + OFF_WOUT_T); K = GH;  N = DM;      tt = t - CT0; }
    else if (t < CT2) { S = p.ffn_w_gu;   D = (bf16_t*)(ws + OFF_WGU_T);  K = DM;  N = 2 * DFF; tt = t - CT1; inter = 1; }
    else if (t < CT3) { S = p.ffn_w_down; D = (bf16_t*)(ws + OFF_WDN_T);  K = DFF; N = DM;      tt = t - CT2; }
    else if (t < CT4) { S = p.w_kv;       D = (bf16_t*)(ws + OFF_WKV_T);  K = DM;  N = NKV;     tt = t - CT3; }
    else if (t < CT5) { S = p.w_q;        D = (bf16_t*)(ws + OFF_WQ_T);   K = DM;  N = NQ;      tt = t - CT4; }
    else if (t < CT6) { S = p.w_o;        D = (bf16_t*)(ws + OFF_WO_T);   K = DM;  N = DM;      tt = t - CT5; }
    else if (t < CT7) { S = p.moe_w_gu;   D = (bf16_t*)(ws + OFF_MGU_T);  K = DM;  N = 2 * DFF; tt = t - CT6; inter = 1; f8 = 1; scale = F8_SW1; }
    else              { S = p.moe_w_down; D = (bf16_t*)(ws + OFF_MDN_T);  K = DFF; N = DM;      tt = t - CT7; f8 = 1; scale = F8_SW2; }
    const int KT = K >> 7, NT = N >> 6, per = KT * NT, b = tt / per, r = tt - b * per, kt = r / NT, nt = r - kt * NT, n0 = nt * 64;
    int drow = n0;
    if (inter) drow = n0 < DFF ? ((n0 >> 7) * 256 + (n0 & 127)) : (((n0 - DFF) >> 7) * 256 + 128 + ((n0 - DFF) & 127));
    CTile c; c.src = S + (size_t)b * K * N + (size_t)(kt * 128) * N + n0; c.N = N; c.K = K; c.f8 = f8; c.scale = scale;
    if (f8) c.dst = (bf16_t*)((unsigned char*)D + (size_t)b * N * K + (size_t)drow * K + kt * 128); else c.dst = D + (size_t)b * N * K + (size_t)drow * K + kt * 128;
    return c;
}
__device__ __forceinline__ void conv_to_lds(const CTile& c, const float4 (&r)[4], LAS3 unsigned* W, int n4, int kr) {
    if (c.f8) { const float sc = c.scale; LAS3 unsigned* w = W + (n4 * 4) * 33 + kr;
        w[0] = pack4_fp8(r[0].x * sc, r[1].x * sc, r[2].x * sc, r[3].x * sc); w[33] = pack4_fp8(r[0].y * sc, r[1].y * sc, r[2].y * sc, r[3].y * sc);
        w[66] = pack4_fp8(r[0].z * sc, r[1].z * sc, r[2].z * sc, r[3].z * sc); w[99] = pack4_fp8(r[0].w * sc, r[1].w * sc, r[2].w * sc, r[3].w * sc); }
    else {
#pragma unroll
        for (int i = 0; i < 2; ++i) { LAS3 unsigned* w = W + (n4 * 4) * 65 + kr + 32 * i;
            w[0] = cvtpk(r[2 * i].x, r[2 * i + 1].x); w[65] = cvtpk(r[2 * i].y, r[2 * i + 1].y); w[130] = cvtpk(r[2 * i].z, r[2 * i + 1].z); w[195] = cvtpk(r[2 * i].w, r[2 * i + 1].w); } }
}
__device__ __forceinline__ void conv_from_lds(const CTile& c, const LAS3 unsigned* W, int tid) {
    if (c.f8) { const int n = tid >> 3, kc = tid & 7; const LAS3 unsigned* q = W + n * 33 + kc * 4;
        uint4 w; w.x = q[0]; w.y = q[1]; w.z = q[2]; w.w = q[3]; __builtin_nontemporal_store((u32x4){w.x, w.y, w.z, w.w}, (u32x4*)((unsigned char*)c.dst + (size_t)n * c.K + kc * 16)); }
    else {
#pragma unroll
        for (int i = 0; i < 2; ++i) { const int it = tid + 512 * i, kc = it & 15, n = it >> 4; const LAS3 unsigned* q = W + n * 65 + kc * 4;
            uint4 w; w.x = q[0]; w.y = q[1]; w.z = q[2]; w.w = q[3]; __builtin_nontemporal_store((u32x4){w.x, w.y, w.z, w.w}, (u32x4*)(c.dst + (size_t)n * c.K + kc * 8)); } }
}
constexpr int CV_NT = 4;
__device__ __forceinline__ void phase_convert(const Params& p, LAS3 unsigned char* lds, int t0, int t1, int rank, int nrank) {
    LAS3 unsigned* LT = (LAS3 unsigned*)lds;
    const int tid = threadIdx.x, n4 = tid & 15, kr = tid >> 4, G = nrank;
    int t = t0 + rank;
#define CONV_LOAD(T, R) do { _Pragma("unroll") for (int j = 0; j < 4; ++j) { const int row = (T).f8 ? 4 * kr + j : 2 * (kr + 32 * (j >> 1)) + (j & 1); { const f32x4 _v = __builtin_nontemporal_load((const f32x4*)((T).src + (size_t)row * (T).N + n4 * 4)); R[j] = make_float4(_v[0], _v[1], _v[2], _v[3]); } } } while (0)
    if (t < t1) {
        CTile c[CV_NT]; bool h[CV_NT]; float4 r[CV_NT][4];
#pragma unroll
        for (int q = 0; q < CV_NT; ++q) { h[q] = t + q * G < t1; c[q] = conv_decode(p, h[q] ? t + q * G : t); if (h[q]) CONV_LOAD(c[q], r[q]); }
        int buf = 0;
        for (;;) {
            LAS3 unsigned* W = LT + buf * (CV_NT * 4160);
#pragma unroll
            for (int q = 0; q < CV_NT; ++q) if (h[q]) conv_to_lds(c[q], r[q], W + q * 4160, n4, kr);
            const int tn = t + CV_NT * G; const bool has = tn < t1;
            CTile cn[CV_NT]; bool hn[CV_NT];
#pragma unroll
            for (int q = 0; q < CV_NT; ++q) { hn[q] = tn + q * G < t1; cn[q] = c[q]; if (hn[q]) { cn[q] = conv_decode(p, tn + q * G); CONV_LOAD(cn[q], r[q]); } }
            __syncthreads();
#pragma unroll
            for (int q = 0; q < CV_NT; ++q) if (h[q]) conv_from_lds(c[q], W + q * 4160, tid);
            if (!has) break;
#pragma unroll
            for (int q = 0; q < CV_NT; ++q) { c[q] = cn[q]; h[q] = hn[q]; }
            t = tn; buf ^= 1;
        }
    }
#undef CONV_LOAD
    __syncthreads();
}

__device__ __forceinline__ void row_norm0(const Params& p, int row, int lane) {
    const float* gain = p.gains; bf16_t* xn = (bf16_t*)(p.ws + OFF_XN);
    const float4* xr = (const float4*)(p.x + (size_t)row * DM); float4 v[8]; float ss = 0.f;
#pragma unroll
    for (int i = 0; i < 8; ++i) { v[i] = xr[lane + 64 * i]; ss += v[i].x * v[i].x + v[i].y * v[i].y + v[i].z * v[i].z + v[i].w * v[i].w; }
    ss = wave_sum(ss); const float rstd = rsqrtf(ss * (1.0f / DM) + EPS);
#pragma unroll
    for (int i = 0; i < 8; ++i) { const float4 gg = ((const float4*)gain)[lane + 64 * i];
        uint2 w; w.x = cvtpk(v[i].x * rstd * gg.x, v[i].y * rstd * gg.y); w.y = cvtpk(v[i].z * rstd * gg.z, v[i].w * rstd * gg.w);
        *(uint2*)(xn + (size_t)row * DM + (lane + 64 * i) * 4) = w; }
}

struct EpiGeluU {
    static constexpr bool PERM = true, AFTER_DRAIN = false;
    bf16_t* O; int ldc; const float* bias;
    __device__ __forceinline__ void operator()(const f32x4 (&acc)[2][2][4][2], const Unit& u, int wr, int wc, int fr, int fq) const {
        asm volatile("" : "+v"(fr), "+v"(fq));
        const int row0 = u.pm * 256 + wr * 64 + fr, col0 = u.pn * 256 + wc * 32 + 8 * fq;
        f32x4 bv[2][2];
#pragma unroll
        for (int bj = 0; bj < 2; ++bj)
#pragma unroll
            for (int n = 0; n < 2; ++n) bv[bj][n] = *(const f32x4*)(bias + col0 + bj * 128 + 4 * n);
#pragma unroll
        for (int ai = 0; ai < 2; ++ai)
#pragma unroll
            for (int m = 0; m < 4; ++m) { bf16_t* rowp = O + (size_t)(row0 + ai * 128 + m * 16) * ldc + col0;
#pragma unroll
                for (int bj = 0; bj < 2; ++bj) { const f32x4 v0 = acc[ai][bj][m][0] + bv[bj][0], v1 = acc[ai][bj][m][1] + bv[bj][1];
                    const f32x4 y0 = gelu_4(v0), y1 = gelu_4(v1);
                    u32x4 w; w.x = cvtpk(y0[0], y0[1]); w.y = cvtpk(y0[2], y0[3]); w.z = cvtpk(y1[0], y1[1]); w.w = cvtpk(y1[2], y1[3]);
                    *(u32x4*)(rowp + bj * 128) = w; } }
    }
};
struct EpiGeluVT {
    static constexpr bool PERM = true, AFTER_DRAIN = false;
    bf16_t* O; const float* bias; float* ssp;
    __device__ __forceinline__ void operator()(const f32x4 (&acc)[2][2][4][2], const Unit& u, int wr, int wc, int fr, int fq) const {
        asm volatile("" : "+v"(fr), "+v"(fq));
        const int row0 = u.pm * 256 + wr * 64 + fr, col0 = u.pn * 256 + wc * 32 + 8 * fq;
        f32x4 cs[2][2];
#pragma unroll
        for (int bj = 0; bj < 2; ++bj)
#pragma unroll
            for (int n = 0; n < 2; ++n) cs[bj][n] = (f32x4){0.f, 0.f, 0.f, 0.f};
#pragma unroll
        for (int ai = 0; ai < 2; ++ai)
#pragma unroll
            for (int m = 0; m < 4; ++m) { const int row = row0 + ai * 128 + m * 16; const float b = bias[row]; bf16_t* rowp = O + (size_t)row * NTOK + col0;
#pragma unroll
                for (int bj = 0; bj < 2; ++bj) { f32x4 v0 = acc[ai][bj][m][0] + b, v1 = acc[ai][bj][m][1] + b;
                    v0 = gelu_4(v0); v1 = gelu_4(v1);
                    cs[bj][0] += v0 * v0; cs[bj][1] += v1 * v1;
                    u32x4 w; w.x = cvtpk(v0[0], v0[1]); w.y = cvtpk(v0[2], v0[3]); w.z = cvtpk(v1[0], v1[1]); w.w = cvtpk(v1[2], v1[3]);
                    *(u32x4*)(rowp + bj * 128) = w; } }
        const int slot = u.pm * 2 + wr;
#pragma unroll
        for (int bj = 0; bj < 2; ++bj)
#pragma unroll
            for (int n = 0; n < 2; ++n)
#pragma unroll
                for (int j = 0; j < 4; ++j) { float s = cs[bj][n][j]; s += __shfl_xor(s, 1); s += __shfl_xor(s, 2); s += __shfl_xor(s, 4); s += __shfl_xor(s, 8);
                    if (fr == 0) ssp[(size_t)(col0 + bj * 128 + 4 * n + j) * SSP_N + slot] = s; }
    }
};
struct EpiF32SS {
    static constexpr bool PERM = false, AFTER_DRAIN = false;
    float* C; int ldc; float* ssp; int pnmod; float scale;
    __device__ __forceinline__ void operator()(const f32x4 (&acc)[2][2][4][2], const Unit& u, int wr, int wc, int fr, int fq) const {
        asm volatile("" : "+v"(fr), "+v"(fq));
        const int pnl = u.pn % pnmod; const int row0 = u.pm * 256 + wr * 64 + fr, col0 = pnl * 256 + wc * 32 + 4 * fq;
#pragma unroll
        for (int ai = 0; ai < 2; ++ai)
#pragma unroll
            for (int m = 0; m < 4; ++m) { const int row = row0 + ai * 128 + m * 16; float* rowp = C + (size_t)row * ldc + col0; float s = 0.f;
#pragma unroll
                for (int bj = 0; bj < 2; ++bj)
#pragma unroll
                    for (int n = 0; n < 2; ++n) { const f32x4 v = acc[ai][bj][m][n] * scale; *(f32x4*)(rowp + bj * 128 + n * 16) = v; s += (v[0] * v[0] + v[1] * v[1]) + (v[2] * v[2] + v[3] * v[3]); }
                if (ssp) { s += __shfl_xor(s, 16); s += __shfl_xor(s, 32); if (fq == 0) ssp[(size_t)row * SSP_N + pnl * 4 + wc] = s; } }
    }
};
struct EpiSwiglu {
    static constexpr bool PERM = true, AFTER_DRAIN = false;
    bf16_t* O; int ldc; int pnmod;
    __device__ __forceinline__ void operator()(const f32x4 (&acc)[2][2][4][2], const Unit& u, int wr, int wc, int fr, int fq) const {
        asm volatile("" : "+v"(fr), "+v"(fq));
        const int pnl = u.pn % pnmod; const int row0 = u.pm * 256 + wr * 64 + fr, col0 = pnl * 128 + wc * 32 + 8 * fq;
#pragma unroll
        for (int ai = 0; ai < 2; ++ai)
#pragma unroll
            for (int m = 0; m < 4; ++m) { bf16_t* rowp = O + (size_t)(row0 + ai * 128 + m * 16) * ldc + col0;
                const f32x4 o0 = swiglu_4(acc[ai][0][m][0], acc[ai][1][m][0], -1.4426950409f, 1.0f), o1 = swiglu_4(acc[ai][0][m][1], acc[ai][1][m][1], -1.4426950409f, 1.0f);
                u32x4 w; w.x = cvtpk(o0[0], o0[1]); w.y = cvtpk(o0[2], o0[3]); w.z = cvtpk(o1[0], o1[1]); w.w = cvtpk(o1[2], o1[3]);
                *(u32x4*)rowp = w; }
    }
};
struct EpiBf16P {
    static constexpr bool PERM = true, AFTER_DRAIN = false;
    bf16_t* O; int ldc;
    __device__ __forceinline__ void operator()(const f32x4 (&acc)[2][2][4][2], const Unit& u, int wr, int wc, int fr, int fq) const {
        asm volatile("" : "+v"(fr), "+v"(fq));
        const int row0 = u.pm * 256 + wr * 64 + fr, col0 = u.pn * 256 + wc * 32 + 8 * fq;
#pragma unroll
        for (int ai = 0; ai < 2; ++ai)
#pragma unroll
            for (int m = 0; m < 4; ++m) { bf16_t* rowp = O + (size_t)(row0 + ai * 128 + m * 16) * ldc + col0;
#pragma unroll
                for (int bj = 0; bj < 2; ++bj) { const f32x4 v0 = acc[ai][bj][m][0], v1 = acc[ai][bj][m][1];
                    u32x4 w; w.x = cvtpk(v0[0], v0[1]); w.y = cvtpk(v0[2], v0[3]); w.z = cvtpk(v1[0], v1[1]); w.w = cvtpk(v1[2], v1[3]);
                    *(u32x4*)(rowp + bj * 128) = w; } }
    }
};

struct EpiSwiglu8 {
    static constexpr bool PERM = true, AFTER_DRAIN = false;
    unsigned char* O; int ldc; int pnmod; float inv, oscale;
    __device__ __forceinline__ void operator()(const f32x4 (&acc)[2][2][4][2], const Unit& u, int wr, int wc, int fr, int fq) const {
        asm volatile("" : "+v"(fr), "+v"(fq));
        const int pnl = u.pn % pnmod; const int row0 = u.pm * 256 + wr * 64 + fr, col0 = pnl * 128 + wc * 32 + 8 * fq;
#pragma unroll
        for (int ai = 0; ai < 2; ++ai)
#pragma unroll
            for (int m = 0; m < 4; ++m) { unsigned char* rowp = O + (size_t)(row0 + ai * 128 + m * 16) * ldc + col0;
                const float kexp = -1.4426950409f * inv, kout = inv * inv * oscale;
                const f32x4 o0 = swiglu_4(acc[ai][0][m][0], acc[ai][1][m][0], kexp, kout), o1 = swiglu_4(acc[ai][0][m][1], acc[ai][1][m][1], kexp, kout);
                uint2 w; w.x = pack4_fp8(o0[0], o0[1], o0[2], o0[3]); w.y = pack4_fp8(o1[0], o1[1], o1[2], o1[3]);
                *(uint2*)rowp = w; }
    }
};

struct EpiBf16S {
    static constexpr bool PERM = true, AFTER_DRAIN = false;
    bf16_t* O; int ldc; int pnmod; float scale;
    __device__ __forceinline__ void operator()(const f32x4 (&acc)[2][2][4][2], const Unit& u, int wr, int wc, int fr, int fq) const {
        asm volatile("" : "+v"(fr), "+v"(fq));
        const int pnl = u.pn % pnmod; const int row0 = u.pm * 256 + wr * 64 + fr, col0 = pnl * 256 + wc * 32 + 8 * fq;
#pragma unroll
        for (int ai = 0; ai < 2; ++ai)
#pragma unroll
            for (int m = 0; m < 4; ++m) { bf16_t* rowp = O + (size_t)(row0 + ai * 128 + m * 16) * ldc + col0;
#pragma unroll
                for (int bj = 0; bj < 2; ++bj) { const f32x4 v0 = acc[ai][bj][m][0] * scale, v1 = acc[ai][bj][m][1] * scale;
                    u32x4 w; w.x = cvtpk(v0[0], v0[1]); w.y = cvtpk(v0[2], v0[3]); w.z = cvtpk(v1[0], v1[1]); w.w = cvtpk(v1[2], v1[3]);
                    *(u32x4*)(rowp + bj * 128) = w; } }
    }
};

struct EpiBf16H {
    static constexpr bool PERM = true, AFTER_DRAIN = false;
    bf16_t* O; int nrows;
    __device__ __forceinline__ void operator()(const f32x4 (&acc)[2][2][4][2], const Unit& u, int wr, int wc, int fr, int fq) const {
        asm volatile("" : "+v"(fr), "+v"(fq));
        const int row0 = u.pm * 256 + wr * 64 + fr, cin = wc * 32 + 8 * fq;
#pragma unroll
        for (int bj = 0; bj < 2; ++bj) { bf16_t* hp = O + (size_t)(u.pn * 2 + bj) * nrows * 128 + cin;
#pragma unroll
            for (int ai = 0; ai < 2; ++ai)
#pragma unroll
                for (int m = 0; m < 4; ++m) { const f32x4 v0 = acc[ai][bj][m][0], v1 = acc[ai][bj][m][1];
                    u32x4 w; w.x = cvtpk(v0[0], v0[1]); w.y = cvtpk(v0[2], v0[3]); w.z = cvtpk(v1[0], v1[1]); w.w = cvtpk(v1[2], v1[3]);
                    *(u32x4*)(hp + (size_t)(row0 + ai * 128 + m * 16) * 128) = w; } }
    }
};

struct EpiBf16SS {
    static constexpr bool PERM = true, AFTER_DRAIN = false;
    bf16_t* C; int ldc; float* ssp;
    __device__ __forceinline__ void operator()(const f32x4 (&acc)[2][2][4][2], const Unit& u, int wr, int wc, int fr, int fq) const {
        asm volatile("" : "+v"(fr), "+v"(fq));
        const int row0 = u.pm * 256 + wr * 64 + fr, col0 = u.pn * 256 + wc * 32 + 8 * fq;
#pragma unroll
        for (int ai = 0; ai < 2; ++ai)
#pragma unroll
            for (int m = 0; m < 4; ++m) { const int row = row0 + ai * 128 + m * 16; bf16_t* rowp = C + (size_t)row * ldc + col0; float s = 0.f;
#pragma unroll
                for (int bj = 0; bj < 2; ++bj) { const f32x4 v0 = acc[ai][bj][m][0], v1 = acc[ai][bj][m][1];
                    s += (v0[0] * v0[0] + v0[1] * v0[1]) + (v0[2] * v0[2] + v0[3] * v0[3]); s += (v1[0] * v1[0] + v1[1] * v1[1]) + (v1[2] * v1[2] + v1[3] * v1[3]);
                    u32x4 w; w.x = cvtpk(v0[0], v0[1]); w.y = cvtpk(v0[2], v0[3]); w.z = cvtpk(v1[0], v1[1]); w.w = cvtpk(v1[2], v1[3]);
                    *(u32x4*)(rowp + bj * 128) = w; }
                s += __shfl_xor(s, 16); s += __shfl_xor(s, 32); if (fq == 0) ssp[(size_t)row * SSP_N + u.pn * 4 + wc] = s; }
    }
};

__device__ __forceinline__ int ld_i(const int* p) { return __hip_atomic_load(p, __ATOMIC_RELAXED, __HIP_MEMORY_SCOPE_AGENT); }
__device__ __forceinline__ float ssp_sum32(const float* ssp, int row) {
    const f32x4* q = (const f32x4*)(ssp + (size_t)row * SSP_N); float t = 0.f;
#pragma unroll
    for (int i = 0; i < 8; ++i) { const f32x4 v = q[i]; t += v[0]; t += v[1]; t += v[2]; t += v[3]; }
    return t;
}

template <bool BF> __device__ __forceinline__ float4 ld4(const void* base, size_t idx4) {
    if constexpr (BF) { const uint2 w = ((const uint2*)base)[idx4]; return make_float4(bf2f(w.x & 0xffffu), bf2f(w.x >> 16), bf2f(w.y & 0xffffu), bf2f(w.y >> 16)); }
    else return ((const float4*)base)[idx4];
}
__device__ __forceinline__ void st4bf(bf16_t* base, size_t idx4, float4 v) { uint2 w; w.x = cvtpk(v.x, v.y); w.y = cvtpk(v.z, v.w); ((uint2*)base)[idx4] = w; }
struct RowIn { float4 b[8]; uint2 m[8]; };
template <bool BFBASE> __device__ __forceinline__ void row_load(RowIn& r, const void* base, const bf16_t* mix, int row, int lane) {
#pragma unroll
    for (int i = 0; i < 8; ++i) { const size_t o = (size_t)row * (DM / 4) + lane + 64 * i; r.b[i] = ld4<BFBASE>(base, o); r.m[i] = ((const uint2*)mix)[o]; }
}
__device__ __forceinline__ void row_resnorm_c(const RowIn& r, const float* ssp, const float* g_post, bf16_t* hout, const float* g1, bf16_t* xn1, const float* g2, bf16_t* xn2, int row, int lane) {
    const float rm = rsqrtf(ssp_sum32(ssp, row) * (1.0f / DM) + EPS);
    float4 h[8]; float ss = 0.f;
#pragma unroll
    for (int i = 0; i < 8; ++i) { const size_t o = (size_t)row * (DM / 4) + lane + 64 * i; const float4 b = r.b[i], gp = ((const float4*)g_post)[lane + 64 * i];
        const float4 m = make_float4(bf2f(r.m[i].x & 0xffffu), bf2f(r.m[i].x >> 16), bf2f(r.m[i].y & 0xffffu), bf2f(r.m[i].y >> 16));
        h[i].x = b.x + m.x * rm * gp.x; h[i].y = b.y + m.y * rm * gp.y; h[i].z = b.z + m.z * rm * gp.z; h[i].w = b.w + m.w * rm * gp.w;
        st4bf(hout, o, h[i]); ss += h[i].x * h[i].x + h[i].y * h[i].y + h[i].z * h[i].z + h[i].w * h[i].w; }
    ss = wave_sum(ss); const float rstd = rsqrtf(ss * (1.0f / DM) + EPS);
#pragma unroll
    for (int i = 0; i < 8; ++i) { const float4 gg = ((const float4*)g1)[lane + 64 * i];
        uint2 w; w.x = cvtpk(h[i].x * rstd * gg.x, h[i].y * rstd * gg.y); w.y = cvtpk(h[i].z * rstd * gg.z, h[i].w * rstd * gg.w);
        *(uint2*)(xn1 + (size_t)row * DM + (lane + 64 * i) * 4) = w;
        if (xn2) { const float4 g2v = ((const float4*)g2)[lane + 64 * i];
            uint2 w2; w2.x = cvtpk(h[i].x * rstd * g2v.x, h[i].y * rstd * g2v.y); w2.y = cvtpk(h[i].z * rstd * g2v.z, h[i].w * rstd * g2v.w);
            *(uint2*)(xn2 + (size_t)row * DM + (lane + 64 * i) * 4) = w2; } }
}
template <bool BFBASE> __device__ __forceinline__ void phase_resnorm(const void* base, const bf16_t* mix, const float* ssp, const float* g_post, bf16_t* hout, const float* g1, bf16_t* xn1, const float* g2, bf16_t* xn2, int wave, int lane, int G) {
    int row = blockIdx.x * 8 + wave; if (row >= NTOK) return;
    RowIn cur, nxt; row_load<BFBASE>(cur, base, mix, row, lane);
    for (;;) { const int nrow = row + G * 8; const bool has = nrow < NTOK;
        if (has) row_load<BFBASE>(nxt, base, mix, nrow, lane);
        row_resnorm_c(cur, ssp, g_post, hout, g1, xn1, g2, xn2, row, lane);
        if (!has) break; cur = nxt; row = nrow; }
}
__device__ __forceinline__ void row_router(const bf16_t* base, const bf16_t* mix, const float* ssp, const float* g_post, bf16_t* hout, const float* g_pre, const LAS3 float* wT  ,
                                           LAS3 int* rt_cnt, LAS3 int* rt_info, LAS3 unsigned* rt_rows, float* tok_g, int row, int lr, int lane) {
    const float rm = rsqrtf(ssp_sum32(ssp, row) * (1.0f / DM) + EPS);
    float4 h[8]; float ss = 0.f;
#pragma unroll
    for (int i = 0; i < 8; ++i) { const size_t o = (size_t)row * (DM / 4) + lane + 64 * i; const float4 b = ld4<true>(base, o), m = ld4<true>(mix, o), gp = ((const float4*)g_post)[lane + 64 * i];
        h[i].x = b.x + m.x * rm * gp.x; h[i].y = b.y + m.y * rm * gp.y; h[i].z = b.z + m.z * rm * gp.z; h[i].w = b.w + m.w * rm * gp.w;
        st4bf(hout, o, h[i]); ss += h[i].x * h[i].x + h[i].y * h[i].y + h[i].z * h[i].z + h[i].w * h[i].w;
        if (i & 1) asm volatile("" ::: "memory"); }
    ss = wave_sum(ss); const float rstd = rsqrtf(ss * (1.0f / DM) + EPS);
    float lg[8]; unsigned q8[8];
#pragma unroll
    for (int e = 0; e < 8; ++e) lg[e] = 0.f;
#pragma unroll
    for (int i = 0; i < 8; ++i) { const float4 gg = ((const float4*)g_pre)[lane + 64 * i];
        const float n0 = h[i].x * rstd * gg.x, n1 = h[i].y * rstd * gg.y, n2 = h[i].z * rstd * gg.z, n3 = h[i].w * rstd * gg.w;
        q8[i] = pack4_fp8(n0 * F8_SA1, n1 * F8_SA1, n2 * F8_SA1, n3 * F8_SA1); asm volatile("" : "+v"(q8[i]));
        const int k = (lane + 64 * i) * 4;
#pragma unroll
        for (int e = 0; e < 8; ++e) { const f32x4 w = *(const LAS3 f32x4*)(wT + e * DM + k); lg[e] = fmaf(n0, w[0], lg[e]); lg[e] = fmaf(n1, w[1], lg[e]); lg[e] = fmaf(n2, w[2], lg[e]); lg[e] = fmaf(n3, w[3], lg[e]); }
        asm volatile("" ::: "memory"); }
#pragma unroll
    for (int e = 0; e < 8; ++e) lg[e] = wave_sum(lg[e]);
    if (lane == 0) {
        int e1 = 0; float v1 = lg[0];
#pragma unroll
        for (int e = 1; e < 8; ++e) if (lg[e] > v1) { v1 = lg[e]; e1 = e; }
        int e2 = 0; float v2 = -3.0e38f;
#pragma unroll
        for (int e = 0; e < 8; ++e) if (e != e1 && lg[e] > v2) { v2 = lg[e]; e2 = e; }
        const float p2 = __expf(v2 - v1), inv = 1.0f / (1.0f + p2);
        const int l1 = (int)__hip_atomic_fetch_add(rt_cnt + e1, 1, __ATOMIC_RELAXED, __HIP_MEMORY_SCOPE_WORKGROUP), l2 = (int)__hip_atomic_fetch_add(rt_cnt + e2, 1, __ATOMIC_RELAXED, __HIP_MEMORY_SCOPE_WORKGROUP);
        rt_info[lr * 2] = (e1 << 16) | l1; rt_info[lr * 2 + 1] = (e2 << 16) | l2;
        tok_g[row * 2] = inv; tok_g[row * 2 + 1] = p2 * inv;
    }
    LAS3 unsigned* rb = rt_rows + lr * (DM / 4);
#pragma unroll
    for (int i = 0; i < 8; ++i) rb[lane + 64 * i] = q8[i];
}
__device__ __forceinline__ void stage_router(const float* wr, LAS3 unsigned char* lds) {
    LAS3 float* wT = (LAS3 float*)lds; const int t = threadIdx.x; float4 v[8];
#pragma unroll
    for (int j = 0; j < 8; ++j) v[j] = ((const float4*)(wr + (size_t)t * 32))[j];
    const float a[32] = {v[0].x, v[0].y, v[0].z, v[0].w, v[1].x, v[1].y, v[1].z, v[1].w, v[2].x, v[2].y, v[2].z, v[2].w, v[3].x, v[3].y, v[3].z, v[3].w,
                         v[4].x, v[4].y, v[4].z, v[4].w, v[5].x, v[5].y, v[5].z, v[5].w, v[6].x, v[6].y, v[6].z, v[6].w, v[7].x, v[7].y, v[7].z, v[7].w};
#pragma unroll
    for (int e = 0; e < 8; ++e) *(LAS3 f32x4*)(wT + e * DM + t * 4) = (f32x4){a[e], a[8 + e], a[16 + e], a[24 + e]};
    __syncthreads();
}
constexpr int RT_CNT_OFF = 65536, RT_INFO_OFF = 65600, RT_ROWS_OFF = 66560, RT_BATCH = 32;
__device__ __forceinline__ void phase_router(const bf16_t* base, const bf16_t* mix, const float* ssp, const float* g_post, bf16_t* hout, const float* g_pre, const float* wr, unsigned char* xs8,
                                             int* counts, int* tok_s, float* tok_g, LAS3 unsigned char* lds, int wave, int lane, int G) {
    stage_router(wr, lds);
    LAS3 int* rt_cnt = (LAS3 int*)(lds + RT_CNT_OFF); LAS3 int* rt_base = rt_cnt + 8; LAS3 int* rt_info = (LAS3 int*)(lds + RT_INFO_OFF); LAS3 unsigned* rt_rows = (LAS3 unsigned*)(lds + RT_ROWS_OFF);
    const int tid = threadIdx.x;
    for (int r0 = blockIdx.x * 8; r0 < NTOK; r0 += G * 8 * 4) {
        if (tid < 8) rt_cnt[tid] = 0;
        __syncthreads();
#pragma unroll 1
        for (int k = 0; k < 4; ++k) { const int row = r0 + wave + k * G * 8; if (row < NTOK) { int ln = lane; asm volatile("" : "+v"(ln));
            row_router(base, mix, ssp, g_post, hout, g_pre, (const LAS3 float*)lds, rt_cnt, rt_info, rt_rows, tok_g, row, k * 8 + wave, ln); } }
        __syncthreads();
        if (tid < 8) rt_base[tid] = tid * ECAP + atomicAdd(&counts[tid], rt_cnt[tid]);
        __syncthreads();
#pragma unroll 1
        for (int k = 0; k < 4; ++k) { const int row = r0 + wave + k * G * 8; if (row < NTOK) { const int lr = k * 8 + wave;
            const int i1 = rt_info[lr * 2], i2 = rt_info[lr * 2 + 1]; const int s1 = rt_base[i1 >> 16] + (i1 & 0xffff), s2 = rt_base[i2 >> 16] + (i2 & 0xffff);
            if (lane == 0) { tok_s[row * 2] = s1; tok_s[row * 2 + 1] = s2; }
            const LAS3 unsigned* rb = rt_rows + lr * (DM / 4); unsigned* d1 = (unsigned*)(xs8 + (size_t)s1 * DM); unsigned* d2 = (unsigned*)(xs8 + (size_t)s2 * DM);
#pragma unroll
            for (int i = 0; i < 8; ++i) { const unsigned v = rb[lane + 64 * i]; d1[lane + 64 * i] = v; d2[lane + 64 * i] = v; } } }
        __syncthreads();
    }
}
constexpr int KSPLIT = 4, C_TFLAG = 8192;
struct FinMeta { int s1, s2; float g1, g2; int fl1[8], fl2[8]; };
struct FinData { float4 a[8], b[8]; uint2 h[8]; };
__device__ __forceinline__ void fin_meta(FinMeta& m, const int* tflag, const int* tok_s, const float* tok_g, int row) {
    m.s1 = tok_s[row * 2]; m.s2 = tok_s[row * 2 + 1]; m.g1 = tok_g[row * 2]; m.g2 = tok_g[row * 2 + 1];
    const int4* f1 = (const int4*)(tflag + (m.s1 >> 8) * 8); const int4* f2 = (const int4*)(tflag + (m.s2 >> 8) * 8); const int4 x0 = f1[0], x1 = f1[1], y0 = f2[0], y1 = f2[1];
    m.fl1[0] = x0.x; m.fl1[1] = x0.y; m.fl1[2] = x0.z; m.fl1[3] = x0.w; m.fl1[4] = x1.x; m.fl1[5] = x1.y; m.fl1[6] = x1.z; m.fl1[7] = x1.w;
    m.fl2[0] = y0.x; m.fl2[1] = y0.y; m.fl2[2] = y0.z; m.fl2[3] = y0.w; m.fl2[4] = y1.x; m.fl2[5] = y1.y; m.fl2[6] = y1.z; m.fl2[7] = y1.w;
}
__device__ __forceinline__ float4 fin_tile(const bf16_t* Y, const float* Yp, int s, int fl, int i, int lane) {
    if (fl == 0) { const uint2 w = ((const uint2*)(Y + (size_t)s * DM))[lane + 64 * i]; return make_float4(bf2f(w.x & 0xffffu), bf2f(w.x >> 16), bf2f(w.y & 0xffffu), bf2f(w.y >> 16)); }
    const float4* q = (const float4*)(Yp + ((size_t)(fl - 1) * KSPLIT) * 65536 + (size_t)(s & 255) * 256) + lane; float4 a = q[0];
#pragma unroll
    for (int k = 1; k < KSPLIT; ++k) { const float4 t = q[(size_t)k * 16384]; a.x += t.x; a.y += t.y; a.z += t.z; a.w += t.w; }
    return a;
}
__device__ __forceinline__ void fin_load(FinData& d, const FinMeta& m, const bf16_t* h3, const bf16_t* Y, const float* Yp, int row, int lane) {
#pragma unroll
    for (int i = 0; i < 8; ++i) { d.a[i] = fin_tile(Y, Yp, m.s1, m.fl1[i], i, lane); d.b[i] = fin_tile(Y, Yp, m.s2, m.fl2[i], i, lane); d.h[i] = ((const uint2*)h3)[(size_t)row * (DM / 4) + lane + 64 * i]; }
}
__device__ __forceinline__ void fin_compute(const FinData& d, const FinMeta& m, const float* gain, float* out, int row, int lane) {
    float4 f[8]; float ss = 0.f;
#pragma unroll
    for (int i = 0; i < 8; ++i) { f[i].x = d.a[i].x * m.g1 + d.b[i].x * m.g2; f[i].y = d.a[i].y * m.g1 + d.b[i].y * m.g2; f[i].z = d.a[i].z * m.g1 + d.b[i].z * m.g2; f[i].w = d.a[i].w * m.g1 + d.b[i].w * m.g2;
        ss += f[i].x * f[i].x + f[i].y * f[i].y + f[i].z * f[i].z + f[i].w * f[i].w; }
    ss = wave_sum(ss); const float rstd = rsqrtf(ss * (1.0f / DM) + EPS);
#pragma unroll
    for (int i = 0; i < 8; ++i) { const size_t o = (size_t)row * (DM / 4) + lane + 64 * i; const float4 gg = ((const float4*)gain)[lane + 64 * i]; const uint2 w = d.h[i]; float4 r;
        r.x = bf2f(w.x & 0xffffu) + f[i].x * rstd * gg.x; r.y = bf2f(w.x >> 16) + f[i].y * rstd * gg.y; r.z = bf2f(w.y & 0xffffu) + f[i].z * rstd * gg.z; r.w = bf2f(w.y >> 16) + f[i].w * rstd * gg.w; ((float4*)out)[o] = r; }
}
__device__ __forceinline__ void phase_final(const bf16_t* h3, const bf16_t* Y, const float* Yp, const int* tflag, const int* tok_s, const float* tok_g, const float* gain, float* out, int wave, int lane, int G) {
    int row = blockIdx.x * 8 + wave; if (row >= NTOK) return;
    FinMeta mc, mn; FinData dc, dn;
    fin_meta(mc, tflag, tok_s, tok_g, row); fin_load(dc, mc, h3, Y, Yp, row, lane);
    int nrow = row + G * 8; bool has = nrow < NTOK; if (has) fin_meta(mn, tflag, tok_s, tok_g, nrow);
    for (;;) {
        if (has) fin_load(dn, mn, h3, Y, Yp, nrow, lane);
        const int n2 = nrow + G * 8; const bool has2 = has && n2 < NTOK; FinMeta m2 = mn; if (has2) fin_meta(m2, tflag, tok_s, tok_g, n2);
        fin_compute(dc, mc, gain, out, row, lane);
        if (!has) break;
        dc = dn; mc = mn; mn = m2; row = nrow; nrow = n2; has = has2;
    }
}
constexpr int MOE_TBL_OFF = 131072;
struct MoeOrder : pg8::StaticOrder {
    const LAS3 int* tbl; int NT; int lim;
    __device__ __forceinline__ bool next(int i, Unit& u) const { if ((long)i * G + c >= lim) return false; if (!pg8::StaticOrder::next(i, u)) return false;
        const int v = tbl[u.pm]; u.pm = v & 0xffff; u.pn += (v >> 16) * NT; return true; }
};
__device__ __forceinline__ int moe_table(const int* counts, LAS3 unsigned char* lds) {
    LAS3 int* tbl = (LAS3 int*)(lds + MOE_TBL_OFF); const int t = threadIdx.x; int q = 0, mine = -1;
#pragma unroll
    for (int e = 0; e < NEXP; ++e) { const int nb = (ld_i(counts + e) + 255) >> 8; if (t >= q && t < q + nb) mine = (e << 16) | (e * (ECAP / 256) + (t - q)); q += nb; }
    if (mine >= 0) tbl[t] = mine;
    __syncthreads();
    return q;
}

struct LeftOrder : pg8::StaticOrder {
    const LAS3 int* tbl; int NT; int L;
    __device__ __forceinline__ bool next(int i, Unit& u) const { if (i != 0 || L < 0) return false;
        pg8::StaticOrder t = *this; t.c = L; if (!t.pg8::StaticOrder::next(0, u)) return false;
        const int v = tbl[u.pm]; u.pm = v & 0xffff; u.pn += (v >> 16) * NT; return true; }
};
struct EpiF32Part {
    static constexpr bool PERM = false, AFTER_DRAIN = false;
    float* P; float scale; int* tflag; int li; int pnmod; int mark;
    __device__ __forceinline__ void operator()(const f32x4 (&acc)[2][2][4][2], const Unit& u, int wr, int wc, int fr, int fq) const {
        asm volatile("" : "+v"(fr), "+v"(fq));
        if (mark && threadIdx.x == 0) tflag[u.pm * 8 + (u.pn % pnmod)] = li + 1;
        const int r0 = wr * 64 + fr, c0 = wc * 32 + 4 * fq;
#pragma unroll
        for (int ai = 0; ai < 2; ++ai)
#pragma unroll
            for (int m = 0; m < 4; ++m) { float* rowp = P + (size_t)(r0 + ai * 128 + m * 16) * 256 + c0;
#pragma unroll
                for (int bj = 0; bj < 2; ++bj)
#pragma unroll
                    for (int n = 0; n < 2; ++n) *(f32x4*)(rowp + bj * 128 + n * 16) = acc[ai][bj][m][n] * scale; }
    }
};


__device__ __forceinline__ void phase_sgu(const Params& p, LAS3 unsigned char* lds) {
    const int tid = threadIdx.x, lane = tid & 63, wave = __builtin_amdgcn_readfirstlane(tid >> 6), fr = lane & 15, fq = lane >> 4;
    unsigned char* ws = p.ws;
    const bf16_t* U = (const bf16_t*)(ws + OFF_U); const bf16_t* VT = (const bf16_t*)(ws + OFF_VT); bf16_t* GT = (bf16_t*)(ws + OFF_GT); const float* SSP = (const float*)(ws + OFF_SSP);
    LAS3 float* rs = (LAS3 float*)(lds + 36864);
    for (int unit = blockIdx.x; unit < 512; unit += (int)gridDim.x) {
        const int ch = unit >> 3, g = unit & 7;
        __syncthreads();
        if (tid < 128) rs[tid] = rsqrtf(ssp_sum32(SSP, ch * 128 + tid) * (1.0f / GH) + EPS);
        bf16x8 bfrag[4][4];
#pragma unroll
        for (int n = 0; n < 4; ++n) { const int chrow = g * 512 + wave * 64 + (n >> 1) * 32 + 8 * (fr >> 2) + 4 * (n & 1) + (fr & 3);
#pragma unroll
            for (int ks = 0; ks < 4; ++ks) bfrag[n][ks] = *(const bf16x8*)(VT + (size_t)chrow * NTOK + ch * 128 + ks * 32 + fq * 8); }
        __syncthreads();
        { const int t = tid >> 2, s0 = (tid & 3) * 32; const float* wp = p.a_w_s + ((size_t)g * 128 + t) * 128 + s0;
#pragma unroll
          for (int q = 0; q < 4; ++q) { const float4 a = *(const float4*)(wp + q * 8), b = *(const float4*)(wp + q * 8 + 4); float v[8] = {a.x, a.y, a.z, a.w, b.x, b.y, b.z, b.w};
#pragma unroll
              for (int j = 0; j < 8; ++j) { const int s = s0 + q * 8 + j; v[j] = (s <= t) ? v[j] * rs[s] : 0.f; }
              u32x4 w; w.x = cvtpk(v[0], v[1]); w.y = cvtpk(v[2], v[3]); w.z = cvtpk(v[4], v[5]); w.w = cvtpk(v[6], v[7]);
              *(LAS3 u32x4*)(lds + t * 272 + (s0 + q * 8) * 2) = w; } }
        __syncthreads();
#pragma unroll
        for (int mt = 0; mt < 8; ++mt) {
            f32x4 acc[4];
#pragma unroll
            for (int n = 0; n < 4; ++n) acc[n] = (f32x4){0.f, 0.f, 0.f, 0.f};
            const int nks = (16 * mt + 15) / 32 + 1;
#pragma unroll
            for (int ks = 0; ks < 4; ++ks) if (ks < nks) { const bf16x8 a = *(const LAS3 bf16x8*)(lds + (16 * mt + fr) * 272 + (ks * 32 + fq * 8) * 2);
#pragma unroll
                for (int n = 0; n < 4; ++n) acc[n] = __builtin_amdgcn_mfma_f32_16x16x32_bf16(bfrag[n][ks], a, acc[n], 0, 0, 0); }
            const int tl = 16 * mt + fr, tok = ch * 128 + tl; const float b = p.a_b_s[g * 128 + tl];
#pragma unroll
            for (int pp = 0; pp < 2; ++pp) { const int c0 = g * 512 + wave * 64 + pp * 32 + 8 * fq;
                const u32x4 uu = *(const u32x4*)(U + (size_t)tok * GH + c0); const f32x4 g0 = *(const f32x4*)(p.a_norm_v + c0), g1 = *(const f32x4*)(p.a_norm_v + c0 + 4);
                const f32x4 a0 = acc[2 * pp], a1 = acc[2 * pp + 1];
                u32x4 w;
                w.x = cvtpk(bf2f(uu.x & 0xffffu) * (g0[0] * a0[0] + b), bf2f(uu.x >> 16) * (g0[1] * a0[1] + b));
                w.y = cvtpk(bf2f(uu.y & 0xffffu) * (g0[2] * a0[2] + b), bf2f(uu.y >> 16) * (g0[3] * a0[3] + b));
                w.z = cvtpk(bf2f(uu.z & 0xffffu) * (g1[0] * a1[0] + b), bf2f(uu.z >> 16) * (g1[1] * a1[1] + b));
                w.w = cvtpk(bf2f(uu.w & 0xffffu) * (g1[2] * a1[2] + b), bf2f(uu.w >> 16) * (g1[3] * a1[3] + b));
                *(u32x4*)(GT + (size_t)tok * GH + c0) = w; }
        }
    }
    __syncthreads();
}

constexpr int AT_KP = 272, AT_VP = 288, AT_VOFF = 256 * AT_KP, AT_UNITS = 3072;
typedef short s16x4 __attribute__((ext_vector_type(4)));
struct AtUnit { int gi, b, h, r, n, dsh; };
__device__ __forceinline__ AtUnit at_decode(int unit) { AtUnit u; u.gi = unit >> 10; const int rem = unit & 1023; u.b = rem >> 8; u.h = (rem >> 4) & 15; const int rn = rem & 15;
    u.dsh = 2 * u.gi; const int nbsh = 4 - u.dsh; u.r = rn >> nbsh; u.n = rn & ((1 << nbsh) - 1); return u; }
#define AT_TR4(o0, o1, o2, o3, f0, f1, f2, f3) asm volatile("ds_read_b64_tr_b16 %0, %4 offset:%5\n\tds_read_b64_tr_b16 %1, %4 offset:%6\n\tds_read_b64_tr_b16 %2, %4 offset:%7\n\tds_read_b64_tr_b16 %3, %4 offset:%8" \
        : "=&v"(o0), "=&v"(o1), "=&v"(o2), "=&v"(o3) : "v"(vrow), "i"(f0), "i"(f1), "i"(f2), "i"(f3) : "memory")
__device__ __forceinline__ void phase_attn(const Params& p, LAS3 unsigned char* lds) {
    const int tid = threadIdx.x, lane = tid & 63, wave = __builtin_amdgcn_readfirstlane(tid >> 6), fr = lane & 15, fq = lane >> 4, G = (int)gridDim.x;
    unsigned char* ws = p.ws;
    const bf16_t* Q = (const bf16_t*)(ws + OFF_Q); const bf16_t* KV = (const bf16_t*)(ws + OFF_KV); bf16_t* OG = (bf16_t*)(ws + OFF_OG); float* LSE = (float*)(ws + OFF_LSE);
    const unsigned vbase = (unsigned)(size_t)(lds + AT_VOFF);
    const unsigned vrow = vbase + (unsigned)((16 * wave + 4 * fq + ((lane & 15) >> 2)) * AT_VP + (lane & 3) * 8);
    const int srow = tid >> 4, c16 = tid & 15;
    int unit = blockIdx.x;
    if (unit < AT_UNITS) {
        AtUnit cu = at_decode(unit);
        u32x4 kreg[8], vreg[8]; bf16x8 qf[4], qn[4];
#define AT_LOADQ(U, D) do { const int _tok = (U).b * SEQ + ((((U).n << 7) + wave * 16 + fr) << (U).dsh) + (U).r; _Pragma("unroll") for (int ks = 0; ks < 4; ++ks) D[ks] = *(const bf16x8*)(Q + (size_t)_tok * NQ + (U).gi * 2048 + (U).h * 128 + ks * 32 + fq * 8); } while (0)
#define AT_LOAD(U) do { _Pragma("unroll") for (int ps = 0; ps < 8; ++ps) if ((U).n > 0 || ps >= 4) { const int lk = ((U).n - 1) * 128 + ps * 32 + srow; \
            const bf16_t* src = KV + ((size_t)(U).h * NTOK + (U).b * SEQ + (lk << (U).dsh) + (U).r) * 128 + c16 * 8; kreg[ps] = *(const u32x4*)src; vreg[ps] = *(const u32x4*)(src + (size_t)16 * NTOK * 128); } } while (0)
        AT_LOAD(cu); AT_LOADQ(cu, qn);
        for (;;) {
            asm volatile("" ::: "memory"); __builtin_amdgcn_s_barrier(); asm volatile("" ::: "memory");
#pragma unroll
            for (int ps = 0; ps < 8; ++ps) if (cu.n > 0 || ps >= 4) { const int kk = ps * 32 + srow;
                *(LAS3 u32x4*)(lds + kk * AT_KP + c16 * 16) = kreg[ps]; *(LAS3 u32x4*)(lds + AT_VOFF + kk * AT_VP + c16 * 16) = vreg[ps]; }
            const int jq = wave * 16 + fr, qtok = cu.b * SEQ + (((cu.n << 7) + jq) << cu.dsh) + cu.r;
#pragma unroll
            for (int ks = 0; ks < 4; ++ks) qf[ks] = qn[ks];
            const int un = unit + G; const bool hasn = un < AT_UNITS; AtUnit nu = cu;
            if (hasn) { nu = at_decode(un); AT_LOAD(nu); AT_LOADQ(nu, qn); }
            asm volatile("s_waitcnt lgkmcnt(0)" ::: "memory"); __builtin_amdgcn_s_barrier(); asm volatile("" ::: "memory");
            const int c_lo = cu.n == 0 ? (8 - wave) : 0;
            f32x4 sc[9];
#pragma unroll
            for (int c = 0; c < 9; ++c) { sc[c] = (f32x4){0.f, 0.f, 0.f, 0.f};
                if (c >= c_lo) {
#pragma unroll
                    for (int ks = 0; ks < 4; ++ks) { const bf16x8 kf = *(const LAS3 bf16x8*)(lds + (16 * (wave + c) + fr) * AT_KP + (ks * 32 + fq * 8) * 2);
                        sc[c] = __builtin_amdgcn_mfma_f32_16x16x32_bf16(kf, qf[ks], sc[c], 0, 0, 0); } } }
            const float slope2 = exp2f(-0.5f * (float)(cu.h + 1)) * 1.4426950409f; const int dq = fr - 4 * fq; const float t0 = slope2 * (float)(128 + dq); float mx = -3.0e38f;
#pragma unroll
            for (int c = 0; c < 9; ++c) {
                if (c >= c_lo) {
#pragma unroll
                    for (int q = 0; q < 4; ++q) { float s2 = fmaf(sc[c][q], 0.08838834764831845f * 1.4426950409f, fmaf(slope2, (float)(16 * c + q), -t0));
                        if (c == 0) s2 = (dq - q <= 0) ? s2 : -3.0e38f;
                        if (c == 8) s2 = (dq - q >= 0) ? s2 : -3.0e38f;
                        sc[c][q] = s2; mx = fmaxf(mx, s2); }
                } else { sc[c] = (f32x4){-3.0e38f, -3.0e38f, -3.0e38f, -3.0e38f}; } }
            mx = fmaxf(mx, __shfl_xor(mx, 16)); mx = fmaxf(mx, __shfl_xor(mx, 32));
            float den = 0.f;
#pragma unroll
            for (int c = 0; c < 9; ++c) {
                if (c >= c_lo) {
#pragma unroll
                    for (int q = 0; q < 4; ++q) { const float e = __builtin_amdgcn_exp2f(sc[c][q] - mx); sc[c][q] = e; den += e; }
                } else { sc[c] = (f32x4){0.f, 0.f, 0.f, 0.f}; } }
            den += __shfl_xor(den, 16); den += __shfl_xor(den, 32);
            f32x4 o[8];
#pragma unroll
            for (int et = 0; et < 8; ++et) o[et] = (f32x4){0.f, 0.f, 0.f, 0.f};
#pragma unroll
            for (int pp = 0; pp < 5; ++pp) {
                if (2 * pp + 1 >= c_lo) {
                    u32x4 pw; pw.x = cvtpk(sc[2 * pp][0], sc[2 * pp][1]); pw.y = cvtpk(sc[2 * pp][2], sc[2 * pp][3]);
                    if (pp < 4) { pw.z = cvtpk(sc[2 * pp + 1][0], sc[2 * pp + 1][1]); pw.w = cvtpk(sc[2 * pp + 1][2], sc[2 * pp + 1][3]); } else { pw.z = 0u; pw.w = 0u; }
                    const bf16x8 pf = __builtin_bit_cast(bf16x8, pw);
                    constexpr int R1 = 16 * AT_VP;
                    const int r0 = (32 * pp) * AT_VP, r1 = (pp < 4 ? (32 * pp + 16) : (32 * pp)) * AT_VP; (void)R1;
                    s16x4 a0, a1, a2, a3, a4, a5, a6, a7, b0, b1, b2, b3, b4, b5, b6, b7;
                    AT_TR4(a0, a1, a2, a3, r0, r0 + 32, r0 + 64, r0 + 96); AT_TR4(a4, a5, a6, a7, r0 + 128, r0 + 160, r0 + 192, r0 + 224);
                    AT_TR4(b0, b1, b2, b3, r1, r1 + 32, r1 + 64, r1 + 96); AT_TR4(b4, b5, b6, b7, r1 + 128, r1 + 160, r1 + 192, r1 + 224);
                    asm volatile("s_waitcnt lgkmcnt(0)" : "+v"(a0), "+v"(a1), "+v"(a2), "+v"(a3), "+v"(a4), "+v"(a5), "+v"(a6), "+v"(a7), "+v"(b0), "+v"(b1), "+v"(b2), "+v"(b3), "+v"(b4), "+v"(b5), "+v"(b6), "+v"(b7) :: "memory");
                    if (2 * pp < c_lo) { const s16x4 z = {0, 0, 0, 0}; a0 = z; a1 = z; a2 = z; a3 = z; a4 = z; a5 = z; a6 = z; a7 = z; }
#define AT_PV(et, A, B) o[et] = __builtin_amdgcn_mfma_f32_16x16x32_bf16((bf16x8){A[0], A[1], A[2], A[3], B[0], B[1], B[2], B[3]}, pf, o[et], 0, 0, 0)
                    AT_PV(0, a0, b0); AT_PV(1, a1, b1); AT_PV(2, a2, b2); AT_PV(3, a3, b3); AT_PV(4, a4, b4); AT_PV(5, a5, b5); AT_PV(6, a6, b6); AT_PV(7, a7, b7);
#undef AT_PV
                } }
            const float inv = 1.0f / den;
            bf16_t* op = OG + ((size_t)cu.gi * NTOK + qtok) * DM + cu.h * 128 + 4 * fq;
#pragma unroll
            for (int et = 0; et < 8; ++et) { uint2 w; w.x = cvtpk(o[et][0] * inv, o[et][1] * inv); w.y = cvtpk(o[et][2] * inv, o[et][3] * inv); *(uint2*)(op + et * 16) = w; }
            if (fq == 0) LSE[((size_t)cu.gi * NTOK + qtok) * 16 + cu.h] = (mx + __log2f(den)) * 0.6931471806f;
            if (!hasn) break;
            unit = un; cu = nu;
        }
#undef AT_LOAD
#undef AT_LOADQ
    }
    __syncthreads();
}
#undef AT_TR4

__device__ __forceinline__ void phase_merge(const Params& p) {
    unsigned char* ws = p.ws; const bf16_t* OG = (const bf16_t*)(ws + OFF_OG); const float* LSE = (const float*)(ws + OFF_LSE); bf16_t* OM = (bf16_t*)(ws + OFF_OM);
    for (size_t i = (size_t)blockIdx.x * MK_THREADS + threadIdx.x; i < (size_t)NTOK * 256; i += (size_t)gridDim.x * MK_THREADS) {
        const int tok = (int)(i >> 8), c8 = (int)(i & 255), h = c8 >> 4;
        const float l0 = LSE[((size_t)0 * NTOK + tok) * 16 + h], l1 = LSE[((size_t)1 * NTOK + tok) * 16 + h], l2 = LSE[((size_t)2 * NTOK + tok) * 16 + h];
        const float m = fmaxf(l0, fmaxf(l1, l2)); const float a0 = __expf(l0 - m), a1 = __expf(l1 - m), a2 = __expf(l2 - m), inv = 1.0f / (a0 + a1 + a2);
        const uint4 x0 = *(const uint4*)(OG + ((size_t)0 * NTOK + tok) * DM + c8 * 8), x1 = *(const uint4*)(OG + ((size_t)1 * NTOK + tok) * DM + c8 * 8), x2 = *(const uint4*)(OG + ((size_t)2 * NTOK + tok) * DM + c8 * 8);
        const unsigned w0[4] = {x0.x, x0.y, x0.z, x0.w}, w1[4] = {x1.x, x1.y, x1.z, x1.w}, w2[4] = {x2.x, x2.y, x2.z, x2.w}; unsigned rr[4];
#pragma unroll
        for (int j = 0; j < 4; ++j) { const float lo = (a0 * bf2f(w0[j] & 0xffffu) + a1 * bf2f(w1[j] & 0xffffu) + a2 * bf2f(w2[j] & 0xffffu)) * inv;
            const float hi = (a0 * bf2f(w0[j] >> 16) + a1 * bf2f(w1[j] >> 16) + a2 * bf2f(w2[j] >> 16)) * inv; rr[j] = cvtpk(lo, hi); }
        *(uint4*)(OM + (size_t)tok * DM + c8 * 8) = make_uint4(rr[0], rr[1], rr[2], rr[3]);
    }
}
#define PHASE2_BODY phase_sgu(p, lds);
#define PHASE9_BODY phase_attn(p, lds);
#define PHASE10_BODY phase_merge(p);

__global__ void __launch_bounds__(MK_THREADS, 2) mega(Params p, int lo, int hi) {
    extern __shared__ __attribute__((aligned(16))) unsigned char shm[];
    LAS3 unsigned char* lds = (LAS3 unsigned char*)shm;
    const int tid = threadIdx.x, wave = __builtin_amdgcn_readfirstlane(tid >> 6), G = (int)gridDim.x;
#define MK_LANE() ((int)__builtin_amdgcn_mbcnt_hi(~0u, __builtin_amdgcn_mbcnt_lo(~0u, 0u)))
    unsigned char* ws = p.ws;
    volatile LAS3 unsigned* xbw = (volatile LAS3 unsigned*)(lds + MK_LDS_BAR);
    if (tid < 4) xbw[tid] = 0u;
    __syncthreads();
    XcdBarrier bar; bar.bar = (unsigned*)(ws + OFF_CTRL + CTRL_BAR_BYTE); bar.x = 0; bar.st = xbw;
    if (hi - lo > 1) bar = xcd_barrier_post((unsigned*)(ws + OFF_CTRL + CTRL_BAR_BYTE), xbw);
#define IN(k) (lo <= (k) && (k) < hi)
#define SEAM(k) do { if (IN(k) && IN((k) + 1)) xcd_barrier(bar); } while (0)
    float* SSP = (float*)(ws + OFF_SSP);
    bf16_t* XN = (bf16_t*)(ws + OFF_XN); bf16_t* XNQ = (bf16_t*)(ws + OFF_XNQ);
    bf16_t* MIX = (bf16_t*)(ws + OFF_MIX); bf16_t* H1 = (bf16_t*)(ws + OFF_H1); bf16_t* H2 = (bf16_t*)(ws + OFF_H2); bf16_t* H3 = (bf16_t*)(ws + OFF_H3);
    int* ictrl = (int*)(ws + OFF_CTRL);
    const float* gains = p.gains;

    constexpr int CR0 = CT1, CR1 = 12800, CR3 = 17408, CR5 = 34304, CR6 = 42496, CR8 = CT8;
    static_assert(CR1 >= CT6, "every dense weight is converted by the end of P1");
    const bool conv_first = (blockIdx.x & 1) == 0;
    constexpr int CVF = 9;
#define CV_MID(a, b) ((a) + (((b) - (a)) * CVF / 16))
    if (IN(0)) {
        phase_convert(p, lds, 0, CR0, (int)blockIdx.x, G);
        { const int lane = MK_LANE(); for (int row = blockIdx.x * 8 + wave; row < NTOK; row += G * 8) row_norm0(p, row, lane); }
    }
    SEAM(0);
    if (IN(1)) {
        if (conv_first) phase_convert(p, lds, CR0, CV_MID(CR0, CR1), (int)blockIdx.x >> 1, G >> 1);
        { pg8::Gemm g{XN, (const bf16_t*)(ws + OFF_WIN_T), NTOK, GH, DM}; pg8::StaticOrder S; S.init(NTOK, GH, G, (int)blockIdx.x);
          EpiGeluU E{(bf16_t*)(ws + OFF_U), GH, p.a_b_in};
          pg8::gemm_phase<EpiGeluU, pg8::StaticOrder>(lds, g, S, E, nullptr); }
        { pg8::Gemm g{(const bf16_t*)(ws + OFF_WIN_T) + (size_t)GH * DM, XN, GH, NTOK, DM}; pg8::StaticOrder S; S.init(GH, NTOK, G, (int)blockIdx.x);
          EpiGeluVT E{(bf16_t*)(ws + OFF_VT), p.a_b_in + GH, SSP};
          pg8::gemm_phase<EpiGeluVT, pg8::StaticOrder>(lds, g, S, E, nullptr); }
        if (!conv_first) phase_convert(p, lds, CV_MID(CR0, CR1), CR1, (int)blockIdx.x >> 1, G >> 1);
    }
    SEAM(1);
    if (IN(2)) { PHASE2_BODY }
    SEAM(2);
    if (IN(3)) {
        if (conv_first) phase_convert(p, lds, CR1, CV_MID(CR1, CR3), (int)blockIdx.x >> 1, G >> 1);
        pg8::Gemm g{(const bf16_t*)(ws + OFF_GT), (const bf16_t*)(ws + OFF_WOUT_T), NTOK, DM, GH}; pg8::StaticOrder S; S.init(NTOK, DM, G, (int)blockIdx.x);
        EpiBf16SS E{MIX, DM, SSP};
        pg8::gemm_phase<EpiBf16SS, pg8::StaticOrder>(lds, g, S, E, nullptr);
        if (!conv_first) phase_convert(p, lds, CV_MID(CR1, CR3), CR3, (int)blockIdx.x >> 1, G >> 1);
    }
    SEAM(3);
    if (IN(4)) { phase_resnorm<false>(p.x, MIX, SSP, gains + DM, H1, gains + 2 * DM, XN, nullptr, nullptr, wave, MK_LANE(), G); }
    SEAM(4);
    if (IN(5)) {
        if (conv_first) phase_convert(p, lds, CR3, CV_MID(CR3, CR5), (int)blockIdx.x >> 1, G >> 1);
        pg8::Gemm g{XN, (const bf16_t*)(ws + OFF_WGU_T), NTOK, 2 * DFF, DM}; pg8::StaticOrder S; S.init(NTOK, 2 * DFF, G, (int)blockIdx.x);
        EpiSwiglu E{(bf16_t*)(ws + OFF_ACT), DFF, 56};
        pg8::gemm_phase<EpiSwiglu, pg8::StaticOrder>(lds, g, S, E, nullptr);
        if (!conv_first) phase_convert(p, lds, CV_MID(CR3, CR5), CR5, (int)blockIdx.x >> 1, G >> 1);
    }
    SEAM(5);
    if (IN(6)) {
        if (conv_first) phase_convert(p, lds, CR5, CV_MID(CR5, CR6), (int)blockIdx.x >> 1, G >> 1);
        pg8::Gemm g{(const bf16_t*)(ws + OFF_ACT), (const bf16_t*)(ws + OFF_WDN_T), NTOK, DM, DFF}; pg8::StaticOrder S; S.init(NTOK, DM, G, (int)blockIdx.x);
        EpiBf16SS E{MIX, DM, SSP};
        pg8::gemm_phase<EpiBf16SS, pg8::StaticOrder>(lds, g, S, E, nullptr);
        if (!conv_first) phase_convert(p, lds, CV_MID(CR5, CR6), CR6, (int)blockIdx.x >> 1, G >> 1);
    }
    SEAM(6);
    if (IN(7)) { phase_resnorm<true>(H1, MIX, SSP, gains + 3 * DM, H2, p.kv_norm, XN, gains + 4 * DM, XNQ, wave, MK_LANE(), G); }
    SEAM(7);
    if (IN(8)) {
        if (conv_first) phase_convert(p, lds, CR6, CV_MID(CR6, CR8), (int)blockIdx.x >> 1, G >> 1);
        { pg8::Gemm g{XN, (const bf16_t*)(ws + OFF_WKV_T), NTOK, NKV, DM}; pg8::StaticOrder S; S.init(NTOK, NKV, G, (int)blockIdx.x);
          EpiBf16H E{(bf16_t*)(ws + OFF_KV), NTOK};
          pg8::gemm_phase<EpiBf16H, pg8::StaticOrder>(lds, g, S, E, nullptr); }
        { pg8::Gemm g{XNQ, (const bf16_t*)(ws + OFF_WQ_T), NTOK, NQ, DM}; pg8::StaticOrder S; S.init(NTOK, NQ, G, (int)blockIdx.x);
          EpiBf16P E{(bf16_t*)(ws + OFF_Q), NQ};
          pg8::gemm_phase<EpiBf16P, pg8::StaticOrder>(lds, g, S, E, nullptr); }
        if (!conv_first) phase_convert(p, lds, CV_MID(CR6, CR8), CR8, (int)blockIdx.x >> 1, G >> 1);
    }
    SEAM(8);
    if (IN(9)) { PHASE9_BODY }
    SEAM(9);
    if (IN(10)) { PHASE10_BODY }
    SEAM(10);
    if (IN(11)) {
        pg8::Gemm g{(const bf16_t*)(ws + OFF_OM), (const bf16_t*)(ws + OFF_WO_T), NTOK, DM, DM}; pg8::StaticOrder S; S.init(NTOK, DM, G, (int)blockIdx.x);
        EpiBf16SS E{MIX, DM, SSP};
        pg8::gemm_phase<EpiBf16SS, pg8::StaticOrder>(lds, g, S, E, nullptr);
    }
    SEAM(11);
    if (IN(12)) { phase_router(H2, MIX, SSP, gains + 5 * DM, H3, gains + 6 * DM, p.moe_router, ws + OFF_XS, ictrl + C_CNT, (int*)(ws + OFF_TOKS), (float*)(ws + OFF_TOKG), lds, wave, MK_LANE(), G); }
    SEAM(12);
    if (IN(13)) {
        const int nblk = moe_table(ictrl + C_CNT, lds);
        pg8::Gemm g{(const bf16_t*)(ws + OFF_XS), (const bf16_t*)(ws + OFF_MGU_T), nblk * 256, 2 * DFF, DM}; MoeOrder S; S.init(nblk * 256, 2 * DFF, G, (int)blockIdx.x); S.tbl = (const LAS3 int*)(lds + MOE_TBL_OFF); S.NT = 56; S.lim = 0x7fffffff;
        EpiSwiglu8 E{ws + OFF_ACT2, DFF, 56, 1.0f / (F8_SA1 * F8_SW1), F8_SA2};
        pg8::gemm_phase<EpiSwiglu8, MoeOrder, false, true>(lds, g, S, E, nullptr);
    }
    SEAM(13);
    if (IN(14)) {
        const int nblk = moe_table(ictrl + C_CNT, lds); const int nunits = nblk * 8; int lim = 2 * G < nunits ? 2 * G : nunits; if ((nunits - lim) * KSPLIT > G) lim = nunits;
        { pg8::Gemm g{(const bf16_t*)(ws + OFF_ACT2), (const bf16_t*)(ws + OFF_MDN_T), nblk * 256, DM, DFF}; MoeOrder S; S.init(nblk * 256, DM, G, (int)blockIdx.x); S.tbl = (const LAS3 int*)(lds + MOE_TBL_OFF); S.NT = 8; S.lim = lim;
          EpiBf16S E{(bf16_t*)(ws + OFF_Y), DM, 8, 1.0f / (F8_SA2 * F8_SW2)};
          pg8::gemm_phase<EpiBf16S, MoeOrder, false, true>(lds, g, S, E, nullptr); }
        { const int nleft = nunits - lim, item = (int)blockIdx.x, li = item / KSPLIT, ch = item - li * KSPLIT;
          constexpr int CKT = DFF / 128 / KSPLIT;
          pg8::Gemm g{(const bf16_t*)(ws + OFF_ACT2 + (size_t)ch * CKT * 128), (const bf16_t*)(ws + OFF_MDN_T + (size_t)ch * CKT * 128), nblk * 256, DM, DFF, CKT};
          LeftOrder S; S.init(nblk * 256, DM, G, 0); S.tbl = (const LAS3 int*)(lds + MOE_TBL_OFF); S.NT = 8; S.L = li < nleft ? lim + li : -1;
          EpiF32Part E{(float*)(ws + OFF_U) + ((size_t)li * KSPLIT + ch) * 65536, 1.0f / (F8_SA2 * F8_SW2), ictrl + C_TFLAG, li, 8, ch == 0};
          pg8::gemm_phase<EpiF32Part, LeftOrder, false, true>(lds, g, S, E, nullptr); }
    }
    SEAM(14);
    if (IN(15)) { phase_final(H3, (const bf16_t*)(ws + OFF_Y), (const float*)(ws + OFF_U)  , ictrl + C_TFLAG, (const int*)(ws + OFF_TOKS), (const float*)(ws + OFF_TOKG), gains + 7 * DM, p.out, wave, MK_LANE(), G); }
#undef IN
#undef SEAM
}

extern "C" void kernel_launch(void* const* d_in, const int* in_sizes, int n_in, void* d_out, int out_size, void* d_ws, size_t ws_size, hipStream_t stream) {
    (void)in_sizes; (void)n_in; (void)out_size;
    if (ws_size < WS_NEED) { fprintf(stderr, "workspace too small: %zu < %zu\n", ws_size, (size_t)WS_NEED); return; }
    static int grid = 0;
    if (grid == 0) {
        int dev = 0, cus = 0, per_cu = 0;
        if (hipGetDevice(&dev) != hipSuccess || hipDeviceGetAttribute(&cus, hipDeviceAttributeMultiprocessorCount, dev) != hipSuccess) { fprintf(stderr, "device query failed\n"); grid = -1; return; }
        if (hipFuncSetAttribute((const void*)mega, hipFuncAttributeMaxDynamicSharedMemorySize, MK_LDS_BYTES) != hipSuccess) { fprintf(stderr, "hipFuncSetAttribute failed\n"); grid = -1; return; }
        if (hipOccupancyMaxActiveBlocksPerMultiprocessor(&per_cu, (const void*)mega, MK_THREADS, MK_LDS_BYTES) != hipSuccess || per_cu < 1) { fprintf(stderr, "occupancy query: %d blocks per CU\n", per_cu); (void)hipGetLastError(); }
        grid = cus;
    }
    if (grid < 0) return;
    const float* const* in = (const float* const*)d_in;
    Params P{};
    P.x = in[0]; P.gains = in[1]; P.a_w_in = in[2]; P.a_b_in = in[3]; P.a_norm_v = in[4]; P.a_w_s = in[5]; P.a_b_s = in[6]; P.a_w_out = in[7]; P.kv_norm = in[8]; P.w_kv = in[9]; P.w_q = in[10]; P.w_o = in[11];
    P.ffn_w_gu = in[12]; P.ffn_w_down = in[13]; P.moe_router = in[14]; P.moe_w_gu = in[15]; P.moe_w_down = in[16]; P.out = (float*)d_out; P.ws = (unsigned char*)d_ws;
#define MEGA(lo, hi) hipLaunchKernelGGL(mega, dim3(grid), dim3(MK_THREADS), MK_LDS_BYTES, stream, P, (lo), (hi))

    (void)hipMemsetAsync((char*)d_ws + OFF_CTRL, 0, CTRL_BYTES, stream);
    MEGA(0, NPH);
}
```

```cpp
#include <hip/hip_runtime.h>
#include <stdint.h>
#include <stdio.h>

typedef unsigned short bf16_t;

constexpr int NTOK = 8192, DM = 2048, SEQ = 2048, GH = 4096  , DFF = 7168, NEXP = 8;
constexpr int NQ = 6144, NKV = 4096;
constexpr int ECAP = NTOK, MAXSLOT = NEXP * ECAP;
constexpr float EPS = 1e-6f;

constexpr size_t AL(size_t x) { return (x + 255) & ~(size_t)255; }
constexpr size_t OFF_CTRL = 0;
constexpr size_t CTRL_BYTES = 1 << 16;
constexpr int C_CNT = 0  ;
constexpr int SSP_N = 64;
constexpr size_t OFF_SSP  = AL(OFF_CTRL + CTRL_BYTES);
constexpr size_t OFF_XN   = AL(OFF_SSP + (size_t)NTOK * SSP_N * 4);
constexpr size_t OFF_XNQ  = AL(OFF_XN + (size_t)NTOK * DM * 2);
constexpr size_t OFF_U    = AL(OFF_XNQ + (size_t)NTOK * DM * 2);
constexpr size_t OFF_VT   = AL(OFF_U + (size_t)NTOK * GH * 2);
constexpr size_t OFF_GT   = AL(OFF_VT + (size_t)NTOK * GH * 2);
constexpr size_t OFF_MIX  = AL(OFF_GT + (size_t)NTOK * GH * 2);
constexpr size_t OFF_H1   = AL(OFF_MIX + (size_t)NTOK * DM * 4);
constexpr size_t OFF_H2   = AL(OFF_H1 + (size_t)NTOK * DM * 4);
constexpr size_t OFF_H3   = AL(OFF_H2 + (size_t)NTOK * DM * 4);
constexpr size_t OFF_ACT  = AL(OFF_H3 + (size_t)NTOK * DM * 4);
constexpr size_t OFF_KV   = AL(OFF_ACT + (size_t)NTOK * DFF * 2);
constexpr size_t OFF_Q    = AL(OFF_KV + (size_t)NTOK * NKV * 2);
constexpr size_t OFF_OG   = AL(OFF_Q + (size_t)NTOK * NQ * 2);
constexpr size_t OFF_LSE  = AL(OFF_OG + (size_t)3 * NTOK * DM * 2);
constexpr size_t OFF_OM   = AL(OFF_LSE + (size_t)3 * NTOK * 16 * 4);
constexpr size_t OFF_TOKG = AL(OFF_OM + (size_t)NTOK * DM * 2);
constexpr size_t OFF_TOKS = AL(OFF_TOKG + (size_t)NTOK * 2 * 4);
constexpr size_t OFF_XS   = AL(OFF_TOKS + (size_t)NTOK * 2 * 4);
constexpr size_t OFF_ACT2 = AL(OFF_XS + (size_t)MAXSLOT * DM);
constexpr size_t OFF_Y    = AL(OFF_ACT2 + (size_t)MAXSLOT * DFF);
constexpr size_t OFF_WIN_T  = AL(OFF_Y + (size_t)MAXSLOT * DM * 2);
constexpr size_t OFF_WOUT_T = AL(OFF_WIN_T + (size_t)2 * GH * DM * 2);
constexpr size_t OFF_WGU_T  = AL(OFF_WOUT_T + (size_t)DM * GH * 2);
constexpr size_t OFF_WDN_T  = AL(OFF_WGU_T + (size_t)2 * DFF * DM * 2);
constexpr size_t OFF_WKV_T  = AL(OFF_WDN_T + (size_t)DM * DFF * 2);
constexpr size_t OFF_WQ_T   = AL(OFF_WKV_T + (size_t)NKV * DM * 2);
constexpr size_t OFF_WO_T   = AL(OFF_WQ_T + (size_t)NQ * DM * 2);
constexpr size_t OFF_MGU_T  = AL(OFF_WO_T + (size_t)DM * DM * 2);
constexpr size_t OFF_MDN_T  = AL(OFF_MGU_T + (size_t)NEXP * 2 * DFF * DM);
constexpr size_t WS_NEED  = AL(OFF_MDN_T + (size_t)NEXP * DM * DFF);
constexpr size_t CTRL_BAR_BYTE = 4096;

__device__ __forceinline__ float bf2f(unsigned v) { return __uint_as_float(v << 16); }
__device__ __forceinline__ bf16_t f2bf(float f) { unsigned u = __float_as_uint(f); u += 0x7FFFu + ((u >> 16) & 1u); return (bf16_t)(u >> 16); }
__device__ __forceinline__ unsigned pack2(float lo, float hi) { return (unsigned)f2bf(lo) | ((unsigned)f2bf(hi) << 16); }
__device__ __forceinline__ float gelu_tanh(float x) { const float t = 1.5957691216057308f * (x + 0.044715f * x * x * x); return x / (1.0f + __expf(-t)); }
__device__ __forceinline__ float silu(float x) { return x / (1.0f + __expf(-x)); }
__device__ __forceinline__ float wave_sum(float v) { for (int o = 32; o >= 1; o >>= 1) v += __shfl_xor(v, o); return v; }
__device__ __forceinline__ float wave_max(float v) { for (int o = 32; o >= 1; o >>= 1) v = fmaxf(v, __shfl_xor(v, o)); return v; }

namespace pg8 {
#define PG8_LAS __attribute__((address_space(3)))
typedef unsigned short bf16_t;
typedef short bf16x8 __attribute__((ext_vector_type(8)));
typedef float f32x4 __attribute__((ext_vector_type(4)));
typedef unsigned u32x4 __attribute__((ext_vector_type(4)));
constexpr int BM = 256, BK = 64, HALF = 128, HTB = HALF * BK * 2  , STAGE_BYTES = 8 * HTB, NXCD = 8, WGM = 8;

__host__ __device__ __forceinline__ int lds_byte(int r, int c) { const int st = (r >> 4) * 2 + (c >> 5), rr = r & 15, cc = c & 31, ob = rr * 64 + cc * 2; return st * 1024 + (ob ^ (((ob >> 9) & 1) << 5)); }
__host__ __device__ __forceinline__ void stage_rc(int b, int& R, int& C) { const int st = b / 1024, sb = b % 1024, swz = sb ^ (((sb >> 9) & 1) << 5); R = (st >> 1) * 16 + swz / 64; C = (st & 1) * 32 + (swz % 64) / 2; }
__host__ __device__ __forceinline__ int perm32(int rho) { const int n = rho >> 4, i = rho & 15; return 8 * (i >> 2) + 4 * n + (i & 3); }

struct Unit { int pm, pn; };
struct Gemm { const bf16_t* A; const bf16_t* Bt; int M, N, K; int kt; };

struct StaticOrder {
    int nM, nN, nwg, G, c;
    __host__ __device__ void init(int M, int N, int G_, int c_) { nM = M / BM; nN = N / BM; nwg = nM * nN; G = G_; c = c_; }
    __host__ __device__ bool next(int i, Unit& u) const {
        const long L = (long)i * G + c; if (L >= nwg) return false;
        int wgid = (int)L; { const int q = nwg / NXCD, r = nwg % NXCD, xcd = wgid % NXCD, off = wgid / NXCD; wgid = (xcd < r ? xcd * (q + 1) : r * (q + 1) + (xcd - r) * q) + off; }
        const int nig = WGM * nN, gid = wgid / nig, fm = gid * WGM, gsz = (nM - fm) < WGM ? (nM - fm) : WGM;
        u.pm = fm + ((wgid % nig) % gsz); u.pn = (wgid % nig) / gsz; return true;
    }
    __device__ __forceinline__ void a_ready(const Unit&) const {}
    __device__ __forceinline__ void done(const Unit&) const {}
};
__device__ __forceinline__ unsigned cvt_pk_bf16(float lo, float hi) { unsigned r; asm volatile("v_cvt_pk_bf16_f32 %0, %1, %2" : "=v"(r) : "v"(lo), "v"(hi)); return r; }
typedef float f32x2 __attribute__((ext_vector_type(2)));
typedef int pg8_v4i __attribute__((ext_vector_type(4))); typedef int pg8_v8i __attribute__((ext_vector_type(8)));
__device__ __forceinline__ pg8_v8i pg8_cat(bf16x8 a, bf16x8 b) { return __builtin_shufflevector(__builtin_bit_cast(pg8_v4i, a), __builtin_bit_cast(pg8_v4i, b), 0, 1, 2, 3, 4, 5, 6, 7); }
template <bool F8> struct pg8_frag; template <> struct pg8_frag<false> { bf16x8 v[2]; }; template <> struct pg8_frag<true> { pg8_v8i v; };
template <class Epi, class Sched, bool STAMP = false, bool F8 = false>
__device__ __forceinline__ void gemm_phase(PG8_LAS unsigned char* lds, const Gemm g, const Sched& S, const Epi& E, unsigned long long* stamps) {
    const int tid = threadIdx.x, wid = __builtin_amdgcn_readfirstlane(tid >> 6), lane = tid & 63, wr = wid >> 2, wc = wid & 3, fr = lane & 15, fq = lane >> 4;
    const int K = F8 ? (g.K >> 1) : g.K  , nt = g.kt ? g.kt : K / BK;
    int ts_lo = 0, ts_hi = 0, nts = 0; const unsigned long long rt_entry = STAMP ? (unsigned long long)wall_clock64() : 0ull;
#define PG8_STAMP() do { if (STAMP && wid == 0 && nts < 64) { const unsigned long long _c = (unsigned long long)clock64(); \
        ts_lo = (lane == nts) ? (int)(unsigned)_c : ts_lo; ts_hi = (lane == nts) ? (int)(unsigned)(_c >> 32) : ts_hi; ++nts; } } while (0)
    PG8_STAMP();
    unsigned voffA[2], voffB[2];
#pragma unroll
    for (int i = 0; i < 2; ++i) { int R, C; stage_rc(tid * 16 + i * 8192, R, C); const int Rb = Epi::PERM ? ((R & ~31) + perm32(R & 31)) : R;
        voffA[i] = (unsigned)(R * K + C) * 2u; voffB[i] = (unsigned)(Rb * K + C) * 2u; }
    const size_t kstep = (size_t)(BK * 2);
    const size_t hstep = (size_t)HALF * K * 2;
    const size_t tstep = 2 * hstep;
    const unsigned ldsw = (unsigned)wid * 1024u;
    const int aoff = lds_byte(wr * 64 + fr, fq * 8), boff = lds_byte(wc * 32 + fr, fq * 8);
#define PG8_SA(b, h) (((b) * 2 + (h)) * HTB)
#define PG8_SB(b, h) ((4 + (b) * 2 + (h)) * HTB)
#define PG8_STAGE(bufoff, gbase, voff) do { _Pragma("unroll") for (int _i = 0; _i < 2; ++_i) \
        __builtin_amdgcn_global_load_lds((const unsigned*)((const char*)(gbase) + (voff)[_i]), (PG8_LAS unsigned*)(lds + (bufoff) + ldsw + _i * 8192), 16, 0, 0); } while (0)
#define PG8_LDA(dst, b, h) do { _Pragma("unroll") for (int m = 0; m < 4; ++m) { const bf16x8 _l0 = *(const PG8_LAS bf16x8*)(lds + PG8_SA(b, h) + aoff + m * 2048), _l1 = *(const PG8_LAS bf16x8*)(lds + PG8_SA(b, h) + aoff + m * 2048 + 1024); \
        if constexpr (F8) dst[m].v = pg8_cat(_l0, _l1); else { dst[m].v[0] = _l0; dst[m].v[1] = _l1; } } } while (0)
#define PG8_LDB(dst, b, h) do { _Pragma("unroll") for (int n = 0; n < 2; ++n) { const bf16x8 _l0 = *(const PG8_LAS bf16x8*)(lds + PG8_SB(b, h) + boff + n * 2048), _l1 = *(const PG8_LAS bf16x8*)(lds + PG8_SB(b, h) + boff + n * 2048 + 1024); \
        if constexpr (F8) dst[n].v = pg8_cat(_l0, _l1); else { dst[n].v[0] = _l0; dst[n].v[1] = _l1; } } } while (0)
#define PG8_MMA(ai, bj, At, Bt) do { __builtin_amdgcn_s_setprio(1); _Pragma("unroll") for (int m = 0; m < 4; ++m) _Pragma("unroll") for (int n = 0; n < 2; ++n) { \
        if constexpr (F8) asm volatile("v_mfma_scale_f32_16x16x128_f8f6f4 %0, %1, %2, %0, %3, %3 op_sel_hi:[0,0,0]" : "+v"(acc[ai][bj][m][n]) : "v"(Bt[n].v), "v"(At[m].v), "v"(sc127)); \
        else { _Pragma("unroll") for (int k = 0; k < 2; ++k) acc[ai][bj][m][n] = __builtin_amdgcn_mfma_f32_16x16x32_bf16(Bt[n].v[k], At[m].v[k], acc[ai][bj][m][n], 0, 0, 0); } } __builtin_amdgcn_s_setprio(0); } while (0)
#define PG8_WAIT_V(n) asm volatile("s_waitcnt vmcnt(" #n ")" ::: "memory")
#define PG8_WAIT_L(n) asm volatile("s_waitcnt lgkmcnt(" #n ")" ::: "memory")
#define PG8_BAR __builtin_amdgcn_s_barrier()
#define PG8_SCHED __builtin_amdgcn_sched_barrier(0)
    Unit cur, nxt; int ui = 0;
    const int sc127 = 0x7f7f7f7f; (void)sc127;
    if (!S.next(0, cur)) return;
    f32x4 acc[2][2][4][2];
#pragma unroll
    for (int a = 0; a < 2; ++a)
#pragma unroll
        for (int b = 0; b < 2; ++b)
#pragma unroll
            for (int m = 0; m < 4; ++m)
#pragma unroll
                for (int n = 0; n < 2; ++n) acc[a][b][m][n] = (f32x4){0.f, 0.f, 0.f, 0.f};
    pg8_frag<F8> At[4], B0[2], B1[2];
    const char* cA = (const char*)g.A + (size_t)cur.pm * tstep; const char* cB = (const char*)g.Bt + (size_t)cur.pn * tstep;
    S.a_ready(cur);
    PG8_STAGE(PG8_SB(0, 0), cB, voffB); PG8_STAGE(PG8_SA(0, 0), cA, voffA); PG8_STAGE(PG8_SB(0, 1), cB + hstep, voffB); PG8_STAGE(PG8_SA(0, 1), cA + hstep, voffA);
    if (wr == 1) PG8_BAR;
    PG8_WAIT_V(4); PG8_BAR;
    PG8_STAGE(PG8_SB(1, 0), cB + kstep, voffB); PG8_STAGE(PG8_SA(1, 0), cA + kstep, voffA); PG8_STAGE(PG8_SB(1, 1), cB + hstep + kstep, voffB);
    PG8_WAIT_V(6); PG8_BAR;
    PG8_STAMP();
    for (;;) {
        const bool has_next = S.next(ui + 1, nxt);
        const char* nA = has_next ? (const char*)g.A + (size_t)nxt.pm * tstep : cA; const char* nB = has_next ? (const char*)g.Bt + (size_t)nxt.pn * tstep : cB;
        for (int t = 0; t < nt; t += 2) {
            const bool last = (t == nt - 2);
            const char* a1 = cA + (size_t)(t + 1) * kstep;
            const char* a2 = last ? nA : cA + (size_t)(t + 2) * kstep; const char* b2 = last ? nB : cB + (size_t)(t + 2) * kstep;
            const char* a3 = a2 + kstep; const char* b3 = b2 + kstep;
            if (last && has_next) S.a_ready(nxt);
            PG8_LDB(B0, 0, 0); PG8_SCHED; PG8_LDA(At, 0, 0); PG8_STAGE(PG8_SA(1, 1), a1 + hstep, voffA);
            PG8_WAIT_L(8); PG8_BAR; PG8_WAIT_L(0); PG8_MMA(0, 0, At, B0); PG8_BAR; PG8_SCHED;
            PG8_LDB(B1, 0, 1); PG8_STAGE(PG8_SB(0, 0), b2, voffB);
            PG8_BAR; PG8_WAIT_L(0); PG8_MMA(0, 1, At, B1); PG8_BAR;
            PG8_LDA(At, 0, 1); PG8_STAGE(PG8_SA(0, 0), a2, voffA);
            PG8_BAR; PG8_WAIT_L(0); PG8_MMA(1, 0, At, B0); PG8_BAR; PG8_SCHED;
            PG8_STAGE(PG8_SB(0, 1), b2 + hstep, voffB);
            PG8_WAIT_V(6); PG8_BAR; PG8_MMA(1, 1, At, B1); PG8_BAR;
            PG8_LDB(B0, 1, 0); PG8_SCHED; PG8_LDA(At, 1, 0); PG8_STAGE(PG8_SA(0, 1), a2 + hstep, voffA);
            PG8_WAIT_L(8); PG8_BAR; PG8_WAIT_L(0); PG8_MMA(0, 0, At, B0); PG8_BAR; PG8_SCHED;
            PG8_LDB(B1, 1, 1); PG8_STAGE(PG8_SB(1, 0), b3, voffB);
            PG8_BAR; PG8_WAIT_L(0); PG8_MMA(0, 1, At, B1); PG8_BAR;
            PG8_LDA(At, 1, 1); PG8_STAGE(PG8_SA(1, 0), a3, voffA);
            PG8_BAR; PG8_WAIT_L(0); PG8_MMA(1, 0, At, B0); PG8_BAR; PG8_SCHED;
            PG8_STAGE(PG8_SB(1, 1), b3 + hstep, voffB);
            PG8_WAIT_V(6); PG8_BAR; PG8_MMA(1, 1, At, B1); PG8_BAR;
        }
        PG8_STAMP();
        if constexpr (F8) {
            asm volatile("s_nop 15\n\ts_nop 15" ::: "memory");
#pragma unroll
            for (int a = 0; a < 2; ++a)
#pragma unroll
                for (int b = 0; b < 2; ++b)
#pragma unroll
                    for (int m = 0; m < 4; ++m) asm volatile("" : "+v"(acc[a][b][m][0]), "+v"(acc[a][b][m][1]));
        }
        if constexpr (!Epi::AFTER_DRAIN) { E(acc, cur, wr, wc, fr, fq); S.done(cur); }
        PG8_STAMP();
        if (!has_next) break;
#pragma unroll
        for (int a = 0; a < 2; ++a)
#pragma unroll
            for (int b = 0; b < 2; ++b)
#pragma unroll
                for (int m = 0; m < 4; ++m)
#pragma unroll
                    for (int n = 0; n < 2; ++n) acc[a][b][m][n] = (f32x4){0.f, 0.f, 0.f, 0.f};
        cur = nxt; cA = nA; cB = nB; ++ui;
    }
    PG8_WAIT_V(0);
    if (wr == 0) PG8_BAR;
    PG8_BAR;
    if constexpr (Epi::AFTER_DRAIN) { E.fused(acc, cur, wr, wc, fr, fq, lds, wid, lane); S.done(cur); }
    PG8_STAMP();
    if (STAMP && wid == 0) { stamps[lane] = lane < nts ? (((unsigned long long)(unsigned)ts_hi << 32) | (unsigned)ts_lo) : 0ull;
        if (lane == 62) stamps[62] = rt_entry; if (lane == 63) stamps[63] = (unsigned long long)wall_clock64(); }
#undef PG8_STAMP
#undef PG8_SA
#undef PG8_SB
#undef PG8_STAGE
#undef PG8_LDA
#undef PG8_LDB
#undef PG8_MMA
#undef PG8_WAIT_V
#undef PG8_WAIT_L
#undef PG8_BAR
#undef PG8_SCHED
}
}
#define XB_TMO      128
#define XB_XCNT(j)  (256  + 64 * (j))
#define XB_XSUB(j)  (1280 + 64 * (j))
#define XB_XGEN(j)  (2304 + 64 * (j))
#define XB_TOP      3328
#define XB_TOPGEN   3392
#define XCD_BAR_WORDS 3456
#define XB_SPIN_CAP (1u << 18)
#define LAS __attribute__((address_space(3)))

__device__ __forceinline__ unsigned xb_ld(unsigned* p)              { return __hip_atomic_load(p, __ATOMIC_RELAXED, __HIP_MEMORY_SCOPE_AGENT); }
__device__ __forceinline__ unsigned xb_add(unsigned* p, unsigned v) { return __hip_atomic_fetch_add(p, v, __ATOMIC_RELAXED, __HIP_MEMORY_SCOPE_AGENT); }
__device__ __forceinline__ unsigned xb_xcc_id() { return (unsigned)__builtin_amdgcn_s_getreg((3 << 11) | 20) & 0xFu; }
#define XB_SPIN(cond, bar) do { unsigned _sp = 0; while (cond) { __builtin_amdgcn_s_sleep(1); \
    if ((++_sp & 255u) == 0u) { if (xb_ld(&(bar)[XB_TMO])) break; if (_sp > XB_SPIN_CAP) { atomicAdd(&(bar)[XB_TMO], 1u); break; } } } } while (0)

struct XcdBarrier {
    unsigned* bar; unsigned x;
    volatile LAS unsigned* st;
};

__device__ __forceinline__ XcdBarrier xcd_barrier_post(unsigned* bar, volatile LAS unsigned* st) {
    XcdBarrier b; b.bar = bar; b.x = xb_xcc_id(); b.st = st;
    if (threadIdx.x == 0) (void)xb_add(&bar[XB_XCNT(b.x)], 1u);
    return b;
}
__device__ __forceinline__ void xcd_barrier_complete(unsigned* bar, unsigned x, unsigned& nloc, unsigned& nx) {
    const unsigned G = gridDim.x * gridDim.y * gridDim.z;
    unsigned sum, cnt, mine, sp = 0u;
    for (;;) {
        sum = 0u; cnt = 0u; mine = 0u;
#pragma unroll
        for (unsigned j = 0; j < 16; ++j) { const unsigned c = xb_ld(&bar[XB_XCNT(j)]); sum += c; cnt += (c > 0u) ? 1u : 0u; mine = (j == x) ? c : mine; }
        if (sum == G) break;
        __builtin_amdgcn_s_sleep(1);
        if ((++sp & 255u) == 0u) { if (xb_ld(&bar[XB_TMO])) break; if (sp > XB_SPIN_CAP) { atomicAdd(&bar[XB_TMO], 1u); break; } }
    }
    nloc = mine > 0u ? mine : 1u; nx = cnt > 0u ? cnt : 1u;
}

__device__ __forceinline__ void xcd_barrier(const XcdBarrier& b) {
    asm volatile("s_waitcnt vmcnt(0)" ::: "memory");
    __syncthreads();
    if (threadIdx.x == 0) {
        unsigned* bar = b.bar;
        __builtin_amdgcn_s_waitcnt(0);
        unsigned nloc = b.st[0], nx = b.st[1];
        if (nloc == 0u) { xcd_barrier_complete(bar, b.x, nloc, nx); b.st[0] = nloc; b.st[1] = nx; }
        const unsigned old = xb_add(&bar[XB_XSUB(b.x)], 1u);
        const unsigned gen = old / nloc;
        if (old + 1u == (gen + 1u) * nloc) {
            __builtin_amdgcn_fence(__ATOMIC_RELEASE, "agent");
            asm volatile("s_waitcnt vmcnt(0)" ::: "memory");
            const unsigned og = xb_add(&bar[XB_TOP], 1u);
            const unsigned tg = og / nx;
            asm volatile("buffer_inv sc1" ::: "memory");
            if (og + 1u == (tg + 1u) * nx) xb_add(&bar[XB_TOPGEN], 1u);
            else XB_SPIN(xb_ld(&bar[XB_TOPGEN]) == tg, bar);
            asm volatile("s_waitcnt vmcnt(0)" ::: "memory");
            xb_add(&bar[XB_XGEN(b.x)], 1u);
            asm volatile("s_waitcnt vmcnt(0)" ::: "memory");
        } else {
            asm volatile("buffer_inv sc1" ::: "memory");
            XB_SPIN(xb_ld(&bar[XB_XGEN(b.x)]) == gen, bar);
            asm volatile("s_waitcnt vmcnt(0)" ::: "memory");
        }
    }
    __syncthreads();
}


#define LAS3 __attribute__((address_space(3)))
using pg8::bf16x8; using pg8::f32x4; using pg8::u32x4; using pg8::Unit;
constexpr int MK_THREADS = 512, MK_LDS_BYTES = 147456  , MK_LDS_BAR = MK_LDS_BYTES - 16;
constexpr int NPH = 16;

struct Params {
    const float* x; const float* gains; const float* a_w_in; const float* a_b_in; const float* a_norm_v; const float* a_w_s; const float* a_b_s; const float* a_w_out;
    const float* kv_norm; const float* w_kv; const float* w_q; const float* w_o; const float* ffn_w_gu; const float* ffn_w_down; const float* moe_router; const float* moe_w_gu; const float* moe_w_down;
    float* out; unsigned char* ws;
};

typedef __bf16 bf16x2_t __attribute__((ext_vector_type(2)));
__device__ __forceinline__ unsigned cvtpk(float lo, float hi) { const bf16x2_t v = {(__bf16)lo, (__bf16)hi}; return __builtin_bit_cast(unsigned, v); }
__device__ __forceinline__ float gelu_fast(float x) { const float t = x + 0.044715f * x * x * x; return x * __builtin_amdgcn_rcpf(1.0f + __builtin_amdgcn_exp2f(-2.3022081985f * t)); }
__device__ __forceinline__ float silu_fast(float x) { return x * __builtin_amdgcn_rcpf(1.0f + __builtin_amdgcn_exp2f(-1.4426950409f * x)); }
__device__ __forceinline__ f32x4 exp2_4(f32x4 a) { return (f32x4){__builtin_amdgcn_exp2f(a[0]), __builtin_amdgcn_exp2f(a[1]), __builtin_amdgcn_exp2f(a[2]), __builtin_amdgcn_exp2f(a[3])}; }
__device__ __forceinline__ f32x4 rcp_4(f32x4 a) { return (f32x4){__builtin_amdgcn_rcpf(a[0]), __builtin_amdgcn_rcpf(a[1]), __builtin_amdgcn_rcpf(a[2]), __builtin_amdgcn_rcpf(a[3])}; }
__device__ __forceinline__ f32x4 swiglu_4(f32x4 G, f32x4 U, float kexp, float kout) {
    const f32x4 r = rcp_4(exp2_4(G * kexp) + 1.0f); return (G * U) * (r * kout); }
__device__ __forceinline__ f32x4 gelu_4(f32x4 v) { const f32x4 t = (v * v * 0.044715f + 1.0f) * v; const f32x4 r = rcp_4(exp2_4(t * -2.3022081985f) + 1.0f); return v * r; }

constexpr float F8_SA1 = 16.f, F8_SW1 = 1024.f, F8_SA2 = 8.f, F8_SW2 = 2048.f;
__device__ __forceinline__ unsigned pack4_fp8(float a, float b, float c, float d) {
    a = __builtin_amdgcn_fmed3f(a, -448.f, 448.f); b = __builtin_amdgcn_fmed3f(b, -448.f, 448.f); c = __builtin_amdgcn_fmed3f(c, -448.f, 448.f); d = __builtin_amdgcn_fmed3f(d, -448.f, 448.f);
    int w = __builtin_amdgcn_cvt_pk_fp8_f32(a, b, 0, false); w = __builtin_amdgcn_cvt_pk_fp8_f32(c, d, w, true); return (unsigned)w; }
struct CTile { const float* src; bf16_t* dst; int N, K; int f8; float scale; const float* gk; };
constexpr int CT0 = 16 * 128, CT1 = CT0 + 32 * 32, CT2 = CT1 + 16 * 224, CT3 = CT2 + 56 * 32, CT4 = CT3 + 16 * 64, CT5 = CT4 + 16 * 96, CT6 = CT5 + 16 * 32, CT7 = CT6 + 8 * 16 * 224, CT8 = CT7 + 8 * 56 * 32;
__device__ __forceinline__ CTile conv_decode(const Params& p, int t) {
    const float* S; bf16_t* D; int K, N, inter = 0, tt, f8 = 0; float scale = 1.f; const float* GK = nullptr;
    unsigned char* ws = p.ws;
    if (t < CT0)      { S = p.a_w_in;     D = (bf16_t*)(ws + OFF_WIN_T);  K = DM;  N = 2 * GH;  tt = t; }
    else if (t < CT1) { S = p.a_w_out;    D = (bf16_t*)(ws + OFF_WOUT_T); K = GH;  N = DM;      tt = t - CT0; }
    else if (t < CT2) { S = p.ffn_w_gu;   D = (bf16_t*)(ws + OFF_WGU_T);  K = DM;  N = 2 * DFF; tt = t - CT1; inter = 1; GK = p.gains + 2 * DM; }
    else if (t < CT3) { S = p.ffn_w_down; D = (bf16_t*)(ws + OFF_WDN_T);  K = DFF; N = DM;      tt = t - CT2; }
    else if (t < CT4) { S = p.w_kv;       D = (bf16_t*)(ws + OFF_WKV_T);  K = DM;  N = NKV;     tt = t - CT3; GK = p.kv_norm; }
    else if (t < CT5) { S = p.w_q;        D = (bf16_t*)(ws + OFF_WQ_T);   K = DM;  N = NQ;      tt = t - CT4; GK = p.gains + 4 * DM; }
    else if (t < CT6) { S = p.w_o;        D = (bf16_t*)(ws + OFF_WO_T);   K = DM;  N = DM;      tt = t - CT5; }
    else if (t < CT7) { S = p.moe_w_gu;   D = (bf16_t*)(ws + OFF_MGU_T);  K = DM;  N = 2 * DFF; tt = t - CT6; inter = 1; f8 = 1; scale = F8_SW1; }
    else              { S = p.moe_w_down; D = (bf16_t*)(ws + OFF_MDN_T);  K = DFF; N = DM;      tt = t - CT7; f8 = 1; scale = F8_SW2; }
    const int KT = K >> 7, NT = N >> 6, per = KT * NT, b = tt / per, r = tt - b * per, kt = r / NT, nt = r - kt * NT, n0 = nt * 64;
    int drow = n0;
    if (inter) drow = n0 < DFF ? ((n0 >> 7) * 256 + (n0 & 127)) : (((n0 - DFF) >> 7) * 256 + 128 + ((n0 - DFF) & 127));
    CTile c; c.src = S + (size_t)b * K * N + (size_t)(kt * 128) * N + n0; c.N = N; c.K = K; c.f8 = f8; c.scale = scale; c.gk = GK ? GK + kt * 128 : nullptr;
    if (f8) c.dst = (bf16_t*)((unsigned char*)D + (size_t)b * N * K + (size_t)drow * K + kt * 128); else c.dst = D + (size_t)b * N * K + (size_t)drow * K + kt * 128;
    return c;
}
__device__ __forceinline__ void conv_to_lds(const CTile& c, const float4 (&r)[4], LAS3 unsigned* W, int n4, int kr) {
    if (c.f8) { const float sc = c.scale; LAS3 unsigned* w = W + (n4 * 4) * 33 + kr;
        w[0] = pack4_fp8(r[0].x * sc, r[1].x * sc, r[2].x * sc, r[3].x * sc); w[33] = pack4_fp8(r[0].y * sc, r[1].y * sc, r[2].y * sc, r[3].y * sc);
        w[66] = pack4_fp8(r[0].z * sc, r[1].z * sc, r[2].z * sc, r[3].z * sc); w[99] = pack4_fp8(r[0].w * sc, r[1].w * sc, r[2].w * sc, r[3].w * sc); }
    else {
#pragma unroll
        for (int i = 0; i < 2; ++i) { LAS3 unsigned* w = W + (n4 * 4) * 65 + kr + 32 * i;
            float ga = 1.f, gb = 1.f; if (c.gk) { const float2 g2 = *(const float2*)(c.gk + 2 * (kr + 32 * i)); ga = g2.x; gb = g2.y; }
            w[0] = cvtpk(r[2 * i].x * ga, r[2 * i + 1].x * gb); w[65] = cvtpk(r[2 * i].y * ga, r[2 * i + 1].y * gb); w[130] = cvtpk(r[2 * i].z * ga, r[2 * i + 1].z * gb); w[195] = cvtpk(r[2 * i].w * ga, r[2 * i + 1].w * gb); } }
}
__device__ __forceinline__ void conv_from_lds(const CTile& c, const LAS3 unsigned* W, int tid) {
    if (c.f8) { const int n = tid >> 3, kc = tid & 7; const LAS3 unsigned* q = W + n * 33 + kc * 4;
        uint4 w; w.x = q[0]; w.y = q[1]; w.z = q[2]; w.w = q[3]; __builtin_nontemporal_store((u32x4){w.x, w.y, w.z, w.w}, (u32x4*)((unsigned char*)c.dst + (size_t)n * c.K + kc * 16)); }
    else {
#pragma unroll
        for (int i = 0; i < 2; ++i) { const int it = tid + 512 * i, kc = it & 15, n = it >> 4; const LAS3 unsigned* q = W + n * 65 + kc * 4;
            uint4 w; w.x = q[0]; w.y = q[1]; w.z = q[2]; w.w = q[3]; __builtin_nontemporal_store((u32x4){w.x, w.y, w.z, w.w}, (u32x4*)(c.dst + (size_t)n * c.K + kc * 8)); } }
}
constexpr int CV_NT = 4;
__device__ __forceinline__ void phase_convert(const Params& p, LAS3 unsigned char* lds, int t0, int t1, int rank, int nrank) {
    LAS3 unsigned* LT = (LAS3 unsigned*)lds;
    const int tid = threadIdx.x, n4 = tid & 15, kr = tid >> 4, G = nrank;
    int t = t0 + rank;
#define CONV_LOAD(T, R) do { _Pragma("unroll") for (int j = 0; j < 4; ++j) { const int row = (T).f8 ? 4 * kr + j : 2 * (kr + 32 * (j >> 1)) + (j & 1); { const f32x4 _v = __builtin_nontemporal_load((const f32x4*)((T).src + (size_t)row * (T).N + n4 * 4)); R[j] = make_float4(_v[0], _v[1], _v[2], _v[3]); } } } while (0)
    if (t < t1) {
        CTile c[CV_NT]; bool h[CV_NT]; float4 r[CV_NT][4];
#pragma unroll
        for (int q = 0; q < CV_NT; ++q) { h[q] = t + q * G < t1; c[q] = conv_decode(p, h[q] ? t + q * G : t); if (h[q]) CONV_LOAD(c[q], r[q]); }
        int buf = 0;
        for (;;) {
            LAS3 unsigned* W = LT + buf * (CV_NT * 4160);
#pragma unroll
            for (int q = 0; q < CV_NT; ++q) if (h[q]) conv_to_lds(c[q], r[q], W + q * 4160, n4, kr);
            const int tn = t + CV_NT * G; const bool has = tn < t1;
            CTile cn[CV_NT]; bool hn[CV_NT];
#pragma unroll
            for (int q = 0; q < CV_NT; ++q) { hn[q] = tn + q * G < t1; cn[q] = c[q]; if (hn[q]) { cn[q] = conv_decode(p, tn + q * G); CONV_LOAD(cn[q], r[q]); } }
            __syncthreads();
#pragma unroll
            for (int q = 0; q < CV_NT; ++q) if (h[q]) conv_from_lds(c[q], W + q * 4160, tid);
            if (!has) break;
#pragma unroll
            for (int q = 0; q < CV_NT; ++q) { c[q] = cn[q]; h[q] = hn[q]; }
            t = tn; buf ^= 1;
        }
    }
#undef CONV_LOAD
    __syncthreads();
}

__device__ __forceinline__ void row_norm0(const Params& p, int row, int lane) {
    const float* gain = p.gains; bf16_t* xn = (bf16_t*)(p.ws + OFF_XN);
    const float4* xr = (const float4*)(p.x + (size_t)row * DM); float4 v[8]; float ss = 0.f;
#pragma unroll
    for (int i = 0; i < 8; ++i) { v[i] = xr[lane + 64 * i]; ss += v[i].x * v[i].x + v[i].y * v[i].y + v[i].z * v[i].z + v[i].w * v[i].w; }
    ss = wave_sum(ss); const float rstd = rsqrtf(ss * (1.0f / DM) + EPS);
#pragma unroll
    for (int i = 0; i < 8; ++i) { const float4 gg = ((const float4*)gain)[lane + 64 * i];
        uint2 w; w.x = cvtpk(v[i].x * rstd * gg.x, v[i].y * rstd * gg.y); w.y = cvtpk(v[i].z * rstd * gg.z, v[i].w * rstd * gg.w);
        *(uint2*)(xn + (size_t)row * DM + (lane + 64 * i) * 4) = w; }
}
__device__ __forceinline__ void phase_norm0(const Params& p, int wave, int lane, int G) {
    const float* gain = p.gains; bf16_t* xn = (bf16_t*)(p.ws + OFF_XN);
    int row = blockIdx.x * 8 + wave; if (row >= NTOK) return;
    float4 gv[8], cur[8], nxt[8];
#pragma unroll
    for (int i = 0; i < 8; ++i) { gv[i] = ((const float4*)gain)[lane + 64 * i]; cur[i] = ((const float4*)(p.x + (size_t)row * DM))[lane + 64 * i]; }
    for (;;) { const int nrow = row + G * 8; const bool has = nrow < NTOK;
        if (has) {
#pragma unroll
            for (int i = 0; i < 8; ++i) nxt[i] = ((const float4*)(p.x + (size_t)nrow * DM))[lane + 64 * i]; }
        float ss = 0.f;
#pragma unroll
        for (int i = 0; i < 8; ++i) ss += cur[i].x * cur[i].x + cur[i].y * cur[i].y + cur[i].z * cur[i].z + cur[i].w * cur[i].w;
        ss = wave_sum(ss); const float rstd = rsqrtf(ss * (1.0f / DM) + EPS);
#pragma unroll
        for (int i = 0; i < 8; ++i) { uint2 w; w.x = cvtpk(cur[i].x * rstd * gv[i].x, cur[i].y * rstd * gv[i].y); w.y = cvtpk(cur[i].z * rstd * gv[i].z, cur[i].w * rstd * gv[i].w);
            *(uint2*)(xn + (size_t)row * DM + (lane + 64 * i) * 4) = w; }
        if (!has) break;
#pragma unroll
        for (int i = 0; i < 8; ++i) cur[i] = nxt[i];
        row = nrow; }
}

struct EpiGeluU {
    static constexpr bool PERM = true, AFTER_DRAIN = false;
    bf16_t* O; int ldc; const float* bias;
    __device__ __forceinline__ void operator()(const f32x4 (&acc)[2][2][4][2], const Unit& u, int wr, int wc, int fr, int fq) const {
        asm volatile("" : "+v"(fr), "+v"(fq));
        const int row0 = u.pm * 256 + wr * 64 + fr, col0 = u.pn * 256 + wc * 32 + 8 * fq;
        f32x4 bv[2][2];
#pragma unroll
        for (int bj = 0; bj < 2; ++bj)
#pragma unroll
            for (int n = 0; n < 2; ++n) bv[bj][n] = *(const f32x4*)(bias + col0 + bj * 128 + 4 * n);
#pragma unroll
        for (int ai = 0; ai < 2; ++ai)
#pragma unroll
            for (int m = 0; m < 4; ++m) { bf16_t* rowp = O + (size_t)(row0 + ai * 128 + m * 16) * ldc + col0;
#pragma unroll
                for (int bj = 0; bj < 2; ++bj) { const f32x4 v0 = acc[ai][bj][m][0] + bv[bj][0], v1 = acc[ai][bj][m][1] + bv[bj][1];
                    const f32x4 y0 = gelu_4(v0), y1 = gelu_4(v1);
                    u32x4 w; w.x = cvtpk(y0[0], y0[1]); w.y = cvtpk(y0[2], y0[3]); w.z = cvtpk(y1[0], y1[1]); w.w = cvtpk(y1[2], y1[3]);
                    *(u32x4*)(rowp + bj * 128) = w; } }
    }
};
struct EpiGeluVT {
    static constexpr bool PERM = true, AFTER_DRAIN = false;
    bf16_t* O; const float* bias; float* ssp;
    __device__ __forceinline__ void operator()(const f32x4 (&acc)[2][2][4][2], const Unit& u, int wr, int wc, int fr, int fq) const {
        asm volatile("" : "+v"(fr), "+v"(fq));
        const int row0 = u.pm * 256 + wr * 64 + fr, col0 = u.pn * 256 + wc * 32 + 8 * fq;
        f32x4 cs[2][2];
#pragma unroll
        for (int bj = 0; bj < 2; ++bj)
#pragma unroll
            for (int n = 0; n < 2; ++n) cs[bj][n] = (f32x4){0.f, 0.f, 0.f, 0.f};
#pragma unroll
        for (int ai = 0; ai < 2; ++ai)
#pragma unroll
            for (int m = 0; m < 4; ++m) { const int row = row0 + ai * 128 + m * 16; const float b = bias[row]; bf16_t* rowp = O + (size_t)row * NTOK + col0;
#pragma unroll
                for (int bj = 0; bj < 2; ++bj) { f32x4 v0 = acc[ai][bj][m][0] + b, v1 = acc[ai][bj][m][1] + b;
                    v0 = gelu_4(v0); v1 = gelu_4(v1);
                    cs[bj][0] += v0 * v0; cs[bj][1] += v1 * v1;
                    u32x4 w; w.x = cvtpk(v0[0], v0[1]); w.y = cvtpk(v0[2], v0[3]); w.z = cvtpk(v1[0], v1[1]); w.w = cvtpk(v1[2], v1[3]);
                    *(u32x4*)(rowp + bj * 128) = w; } }
        const int slot = u.pm * 2 + wr;
#pragma unroll
        for (int bj = 0; bj < 2; ++bj)
#pragma unroll
            for (int n = 0; n < 2; ++n)
#pragma unroll
                for (int j = 0; j < 4; ++j) { float s = cs[bj][n][j]; s += __shfl_xor(s, 1); s += __shfl_xor(s, 2); s += __shfl_xor(s, 4); s += __shfl_xor(s, 8);
                    if (fr == 0) ssp[(size_t)(col0 + bj * 128 + 4 * n + j) * SSP_N + slot] = s; }
    }
};
struct EpiF32SS {
    static constexpr bool PERM = false, AFTER_DRAIN = false;
    float* C; int ldc; float* ssp; int pnmod; float scale;
    __device__ __forceinline__ void operator()(const f32x4 (&acc)[2][2][4][2], const Unit& u, int wr, int wc, int fr, int fq) const {
        asm volatile("" : "+v"(fr), "+v"(fq));
        const int pnl = u.pn % pnmod; const int row0 = u.pm * 256 + wr * 64 + fr, col0 = pnl * 256 + wc * 32 + 4 * fq;
#pragma unroll
        for (int ai = 0; ai < 2; ++ai)
#pragma unroll
            for (int m = 0; m < 4; ++m) { const int row = row0 + ai * 128 + m * 16; float* rowp = C + (size_t)row * ldc + col0; float s = 0.f;
#pragma unroll
                for (int bj = 0; bj < 2; ++bj)
#pragma unroll
                    for (int n = 0; n < 2; ++n) { const f32x4 v = acc[ai][bj][m][n] * scale; *(f32x4*)(rowp + bj * 128 + n * 16) = v; s += (v[0] * v[0] + v[1] * v[1]) + (v[2] * v[2] + v[3] * v[3]); }
                if (ssp) { s += __shfl_xor(s, 16); s += __shfl_xor(s, 32); if (fq == 0) ssp[(size_t)row * SSP_N + pnl * 4 + wc] = s; } }
    }
};
struct EpiSwiglu {
    static constexpr bool PERM = true, AFTER_DRAIN = false;
    bf16_t* O; int ldc; int pnmod;
    __device__ __forceinline__ void operator()(const f32x4 (&acc)[2][2][4][2], const Unit& u, int wr, int wc, int fr, int fq) const {
        asm volatile("" : "+v"(fr), "+v"(fq));
        const int pnl = u.pn % pnmod; const int row0 = u.pm * 256 + wr * 64 + fr, col0 = pnl * 128 + wc * 32 + 8 * fq;
#pragma unroll
        for (int ai = 0; ai < 2; ++ai)
#pragma unroll
            for (int m = 0; m < 4; ++m) { bf16_t* rowp = O + (size_t)(row0 + ai * 128 + m * 16) * ldc + col0;
                const f32x4 o0 = swiglu_4(acc[ai][0][m][0], acc[ai][1][m][0], -1.4426950409f, 1.0f), o1 = swiglu_4(acc[ai][0][m][1], acc[ai][1][m][1], -1.4426950409f, 1.0f);
                u32x4 w; w.x = cvtpk(o0[0], o0[1]); w.y = cvtpk(o0[2], o0[3]); w.z = cvtpk(o1[0], o1[1]); w.w = cvtpk(o1[2], o1[3]);
                *(u32x4*)rowp = w; }
    }
};
struct EpiBf16P {
    static constexpr bool PERM = true, AFTER_DRAIN = false;
    bf16_t* O; int ldc;
    __device__ __forceinline__ void operator()(const f32x4 (&acc)[2][2][4][2], const Unit& u, int wr, int wc, int fr, int fq) const {
        asm volatile("" : "+v"(fr), "+v"(fq));
        const int row0 = u.pm * 256 + wr * 64 + fr, col0 = u.pn * 256 + wc * 32 + 8 * fq;
#pragma unroll
        for (int ai = 0; ai < 2; ++ai)
#pragma unroll
            for (int m = 0; m < 4; ++m) { bf16_t* rowp = O + (size_t)(row0 + ai * 128 + m * 16) * ldc + col0;
#pragma unroll
                for (int bj = 0; bj < 2; ++bj) { const f32x4 v0 = acc[ai][bj][m][0], v1 = acc[ai][bj][m][1];
                    u32x4 w; w.x = cvtpk(v0[0], v0[1]); w.y = cvtpk(v0[2], v0[3]); w.z = cvtpk(v1[0], v1[1]); w.w = cvtpk(v1[2], v1[3]);
                    *(u32x4*)(rowp + bj * 128) = w; } }
    }
};

struct EpiSwiglu8 {
    static constexpr bool PERM = true, AFTER_DRAIN = false;
    unsigned char* O; int ldc; int pnmod; float inv, oscale;
    __device__ __forceinline__ void operator()(const f32x4 (&acc)[2][2][4][2], const Unit& u, int wr, int wc, int fr, int fq) const {
        asm volatile("" : "+v"(fr), "+v"(fq));
        const int pnl = u.pn % pnmod; const int row0 = u.pm * 256 + wr * 64 + fr, col0 = pnl * 128 + wc * 32 + 8 * fq;
#pragma unroll
        for (int ai = 0; ai < 2; ++ai)
#pragma unroll
            for (int m = 0; m < 4; ++m) { unsigned char* rowp = O + (size_t)(row0 + ai * 128 + m * 16) * ldc + col0;
                const float kexp = -1.4426950409f * inv, kout = inv * inv * oscale;
                const f32x4 o0 = swiglu_4(acc[ai][0][m][0], acc[ai][1][m][0], kexp, kout), o1 = swiglu_4(acc[ai][0][m][1], acc[ai][1][m][1], kexp, kout);
                uint2 w; w.x = pack4_fp8(o0[0], o0[1], o0[2], o0[3]); w.y = pack4_fp8(o1[0], o1[1], o1[2], o1[3]);
                *(uint2*)rowp = w; }
    }
};

struct EpiBf16S {
    static constexpr bool PERM = true, AFTER_DRAIN = false;
    bf16_t* O; int ldc; int pnmod; float scale;
    __device__ __forceinline__ void operator()(const f32x4 (&acc)[2][2][4][2], const Unit& u, int wr, int wc, int fr, int fq) const {
        asm volatile("" : "+v"(fr), "+v"(fq));
        const int pnl = u.pn % pnmod; const int row0 = u.pm * 256 + wr * 64 + fr, col0 = pnl * 256 + wc * 32 + 8 * fq;
#pragma unroll
        for (int ai = 0; ai < 2; ++ai)
#pragma unroll
            for (int m = 0; m < 4; ++m) { bf16_t* rowp = O + (size_t)(row0 + ai * 128 + m * 16) * ldc + col0;
#pragma unroll
                for (int bj = 0; bj < 2; ++bj) { const f32x4 v0 = acc[ai][bj][m][0] * scale, v1 = acc[ai][bj][m][1] * scale;
                    u32x4 w; w.x = cvtpk(v0[0], v0[1]); w.y = cvtpk(v0[2], v0[3]); w.z = cvtpk(v1[0], v1[1]); w.w = cvtpk(v1[2], v1[3]);
                    *(u32x4*)(rowp + bj * 128) = w; } }
    }
};

struct EpiBf16H {
    static constexpr bool PERM = true, AFTER_DRAIN = false;
    bf16_t* O; int nrows;
    __device__ __forceinline__ void operator()(const f32x4 (&acc)[2][2][4][2], const Unit& u, int wr, int wc, int fr, int fq) const {
        asm volatile("" : "+v"(fr), "+v"(fq));
        const int row0 = u.pm * 256 + wr * 64 + fr, cin = wc * 32 + 8 * fq;
#pragma unroll
        for (int bj = 0; bj < 2; ++bj) { bf16_t* hp = O + (size_t)(u.pn * 2 + bj) * nrows * 128 + cin;
#pragma unroll
            for (int ai = 0; ai < 2; ++ai)
#pragma unroll
                for (int m = 0; m < 4; ++m) { const f32x4 v0 = acc[ai][bj][m][0], v1 = acc[ai][bj][m][1];
                    u32x4 w; w.x = cvtpk(v0[0], v0[1]); w.y = cvtpk(v0[2], v0[3]); w.z = cvtpk(v1[0], v1[1]); w.w = cvtpk(v1[2], v1[3]);
                    *(u32x4*)(hp + (size_t)(row0 + ai * 128 + m * 16) * 128) = w; } }
    }
};


struct EpiSwigluR {
    static constexpr bool PERM = true, AFTER_DRAIN = false;
    bf16_t* O; int ldc; int pnmod; const float* rs;
    __device__ __forceinline__ void operator()(const f32x4 (&acc)[2][2][4][2], const Unit& u, int wr, int wc, int fr, int fq) const {
        asm volatile("" : "+v"(fr), "+v"(fq));
        const int pnl = u.pn % pnmod; const int row0 = u.pm * 256 + wr * 64 + fr, col0 = pnl * 128 + wc * 32 + 8 * fq;
        float rv[2][4];
#pragma unroll
        for (int ai = 0; ai < 2; ++ai)
#pragma unroll
            for (int m = 0; m < 4; ++m) rv[ai][m] = rs[row0 + ai * 128 + m * 16];
#pragma unroll
        for (int ai = 0; ai < 2; ++ai)
#pragma unroll
            for (int m = 0; m < 4; ++m) { bf16_t* rowp = O + (size_t)(row0 + ai * 128 + m * 16) * ldc + col0; const float s = rv[ai][m], kexp = -1.4426950409f * s, kout = s * s;
                const f32x4 o0 = swiglu_4(acc[ai][0][m][0], acc[ai][1][m][0], kexp, kout), o1 = swiglu_4(acc[ai][0][m][1], acc[ai][1][m][1], kexp, kout);
                u32x4 w; w.x = cvtpk(o0[0], o0[1]); w.y = cvtpk(o0[2], o0[3]); w.z = cvtpk(o1[0], o1[1]); w.w = cvtpk(o1[2], o1[3]);
                *(u32x4*)rowp = w; }
    }
};
struct EpiBf16PR {
    static constexpr bool PERM = true, AFTER_DRAIN = false;
    bf16_t* O; int ldc; const float* rs;
    __device__ __forceinline__ void operator()(const f32x4 (&acc)[2][2][4][2], const Unit& u, int wr, int wc, int fr, int fq) const {
        asm volatile("" : "+v"(fr), "+v"(fq));
        const int row0 = u.pm * 256 + wr * 64 + fr, col0 = u.pn * 256 + wc * 32 + 8 * fq;
        float rv[2][4];
#pragma unroll
        for (int ai = 0; ai < 2; ++ai)
#pragma unroll
            for (int m = 0; m < 4; ++m) rv[ai][m] = rs[row0 + ai * 128 + m * 16];
#pragma unroll
        for (int ai = 0; ai < 2; ++ai)
#pragma unroll
            for (int m = 0; m < 4; ++m) { bf16_t* rowp = O + (size_t)(row0 + ai * 128 + m * 16) * ldc + col0; const float s = rv[ai][m];
#pragma unroll
                for (int bj = 0; bj < 2; ++bj) { const f32x4 v0 = acc[ai][bj][m][0] * s, v1 = acc[ai][bj][m][1] * s;
                    u32x4 w; w.x = cvtpk(v0[0], v0[1]); w.y = cvtpk(v0[2], v0[3]); w.z = cvtpk(v1[0], v1[1]); w.w = cvtpk(v1[2], v1[3]);
                    *(u32x4*)(rowp + bj * 128) = w; } }
    }
};
struct EpiBf16HR {
    static constexpr bool PERM = true, AFTER_DRAIN = false;
    bf16_t* O; int nrows; const float* rs;
    __device__ __forceinline__ void operator()(const f32x4 (&acc)[2][2][4][2], const Unit& u, int wr, int wc, int fr, int fq) const {
        asm volatile("" : "+v"(fr), "+v"(fq));
        const int row0 = u.pm * 256 + wr * 64 + fr, cin = wc * 32 + 8 * fq;
        float rv[2][4];
#pragma unroll
        for (int ai = 0; ai < 2; ++ai)
#pragma unroll
            for (int m = 0; m < 4; ++m) rv[ai][m] = rs[row0 + ai * 128 + m * 16];
#pragma unroll
        for (int bj = 0; bj < 2; ++bj) { bf16_t* hp = O + (size_t)(u.pn * 2 + bj) * nrows * 128 + cin;
#pragma unroll
            for (int ai = 0; ai < 2; ++ai)
#pragma unroll
                for (int m = 0; m < 4; ++m) { const float s = rv[ai][m]; const f32x4 v0 = acc[ai][bj][m][0] * s, v1 = acc[ai][bj][m][1] * s;
                    u32x4 w; w.x = cvtpk(v0[0], v0[1]); w.y = cvtpk(v0[2], v0[3]); w.z = cvtpk(v1[0], v1[1]); w.w = cvtpk(v1[2], v1[3]);
                    *(u32x4*)(hp + (size_t)(row0 + ai * 128 + m * 16) * 128) = w; } }
    }
};

struct EpiKVQ {
    static constexpr bool PERM = true, AFTER_DRAIN = false;
    bf16_t* KV; int nrows; bf16_t* Q; int ldq; const float* rs;
    __device__ __forceinline__ void operator()(const f32x4 (&acc)[2][2][4][2], const Unit& u, int wr, int wc, int fr, int fq) const {
        asm volatile("" : "+v"(fr), "+v"(fq));
        const int row0 = u.pm * 256 + wr * 64 + fr;
        float rv[2][4];
#pragma unroll
        for (int ai = 0; ai < 2; ++ai)
#pragma unroll
            for (int m = 0; m < 4; ++m) rv[ai][m] = rs[row0 + ai * 128 + m * 16];
        if (u.pn < NKV / 256) {
            const int cin = wc * 32 + 8 * fq;
#pragma unroll
            for (int bj = 0; bj < 2; ++bj) { bf16_t* hp = KV + (size_t)(u.pn * 2 + bj) * nrows * 128 + cin;
#pragma unroll
                for (int ai = 0; ai < 2; ++ai)
#pragma unroll
                    for (int m = 0; m < 4; ++m) { const float s = rv[ai][m]; const f32x4 v0 = acc[ai][bj][m][0] * s, v1 = acc[ai][bj][m][1] * s;
                        u32x4 w; w.x = cvtpk(v0[0], v0[1]); w.y = cvtpk(v0[2], v0[3]); w.z = cvtpk(v1[0], v1[1]); w.w = cvtpk(v1[2], v1[3]);
                        *(u32x4*)(hp + (size_t)(row0 + ai * 128 + m * 16) * 128) = w; } }
        } else {
            const int col0 = (u.pn - NKV / 256) * 256 + wc * 32 + 8 * fq;
#pragma unroll
            for (int ai = 0; ai < 2; ++ai)
#pragma unroll
                for (int m = 0; m < 4; ++m) { bf16_t* rowp = Q + (size_t)(row0 + ai * 128 + m * 16) * ldq + col0; const float s = rv[ai][m];
#pragma unroll
                    for (int bj = 0; bj < 2; ++bj) { const f32x4 v0 = acc[ai][bj][m][0] * s, v1 = acc[ai][bj][m][1] * s;
                        u32x4 w; w.x = cvtpk(v0[0], v0[1]); w.y = cvtpk(v0[2], v0[3]); w.z = cvtpk(v1[0], v1[1]); w.w = cvtpk(v1[2], v1[3]);
                        *(u32x4*)(rowp + bj * 128) = w; } }
        }
    }
};
struct EpiBf16SS {
    static constexpr bool PERM = true, AFTER_DRAIN = false;
    bf16_t* C; int ldc; float* ssp;
    __device__ __forceinline__ void operator()(const f32x4 (&acc)[2][2][4][2], const Unit& u, int wr, int wc, int fr, int fq) const {
        asm volatile("" : "+v"(fr), "+v"(fq));
        const int row0 = u.pm * 256 + wr * 64 + fr, col0 = u.pn * 256 + wc * 32 + 8 * fq;
#pragma unroll
        for (int ai = 0; ai < 2; ++ai)
#pragma unroll
            for (int m = 0; m < 4; ++m) { const int row = row0 + ai * 128 + m * 16; bf16_t* rowp = C + (size_t)row * ldc + col0; float s = 0.f;
#pragma unroll
                for (int bj = 0; bj < 2; ++bj) { const f32x4 v0 = acc[ai][bj][m][0], v1 = acc[ai][bj][m][1];
                    s += (v0[0] * v0[0] + v0[1] * v0[1]) + (v0[2] * v0[2] + v0[3] * v0[3]); s += (v1[0] * v1[0] + v1[1] * v1[1]) + (v1[2] * v1[2] + v1[3] * v1[3]);
                    u32x4 w; w.x = cvtpk(v0[0], v0[1]); w.y = cvtpk(v0[2], v0[3]); w.z = cvtpk(v1[0], v1[1]); w.w = cvtpk(v1[2], v1[3]);
                    *(u32x4*)(rowp + bj * 128) = w; }
                s += __shfl_xor(s, 16); s += __shfl_xor(s, 32); if (fq == 0) ssp[(size_t)row * SSP_N + u.pn * 4 + wc] = s; }
    }
};

__device__ __forceinline__ int ld_i(const int* p) { return __hip_atomic_load(p, __ATOMIC_RELAXED, __HIP_MEMORY_SCOPE_AGENT); }
__device__ __forceinline__ float ssp_sum32(const float* ssp, int row) {
    const f32x4* q = (const f32x4*)(ssp + (size_t)row * SSP_N); float t = 0.f;
#pragma unroll
    for (int i = 0; i < 8; ++i) { const f32x4 v = q[i]; t += v[0]; t += v[1]; t += v[2]; t += v[3]; }
    return t;
}

template <bool BF> __device__ __forceinline__ float4 ld4(const void* base, size_t idx4) {
    if constexpr (BF) { const uint2 w = ((const uint2*)base)[idx4]; return make_float4(bf2f(w.x & 0xffffu), bf2f(w.x >> 16), bf2f(w.y & 0xffffu), bf2f(w.y >> 16)); }
    else return ((const float4*)base)[idx4];
}
__device__ __forceinline__ void st4bf(bf16_t* base, size_t idx4, float4 v) { uint2 w; w.x = cvtpk(v.x, v.y); w.y = cvtpk(v.z, v.w); ((uint2*)base)[idx4] = w; }
struct RowIn { float4 b[8]; uint2 m[8]; float sp; };
template <bool BFBASE> __device__ __forceinline__ void row_load(RowIn& r, const void* base, const bf16_t* mix, const float* ssp, int row, int lane) {
    r.sp = ssp[(size_t)row * SSP_N + (lane & 31)];
#pragma unroll
    for (int i = 0; i < 8; ++i) { const size_t o = (size_t)row * (DM / 4) + lane + 64 * i; r.b[i] = ld4<BFBASE>(base, o); r.m[i] = ((const uint2*)mix)[o]; }
}
__device__ __forceinline__ float row_ssq(const RowIn& r, int lane) { return wave_sum(lane < 32 ? r.sp : 0.f); }
__device__ __forceinline__ void row_resnorm_c(const RowIn& r, const float4 (&gpv)[8], bf16_t* hout, float* rs_out, int row, int lane) {
    const float rm = rsqrtf(row_ssq(r, lane) * (1.0f / DM) + EPS);
    float4 h[8]; float ss = 0.f;
#pragma unroll
    for (int i = 0; i < 8; ++i) { const size_t o = (size_t)row * (DM / 4) + lane + 64 * i; const float4 b = r.b[i], gp = gpv[i];
        const float4 m = make_float4(bf2f(r.m[i].x & 0xffffu), bf2f(r.m[i].x >> 16), bf2f(r.m[i].y & 0xffffu), bf2f(r.m[i].y >> 16));
        h[i].x = b.x + m.x * rm * gp.x; h[i].y = b.y + m.y * rm * gp.y; h[i].z = b.z + m.z * rm * gp.z; h[i].w = b.w + m.w * rm * gp.w;
        st4bf(hout, o, h[i]); ss += h[i].x * h[i].x + h[i].y * h[i].y + h[i].z * h[i].z + h[i].w * h[i].w; }
    ss = wave_sum(ss); if (lane == 0) rs_out[row] = rsqrtf(ss * (1.0f / DM) + EPS);
}
template <bool BFBASE> __device__ __forceinline__ void phase_resnorm(const void* base, const bf16_t* mix, const float* ssp, const float* g_post, bf16_t* hout, float* rs_out, int wave, int lane, int G) {
    int row = blockIdx.x * 8 + wave; if (row >= NTOK) return;
    float4 gpv[8];
#pragma unroll
    for (int i = 0; i < 8; ++i) gpv[i] = ((const float4*)g_post)[lane + 64 * i];
    RowIn cur, nxt; row_load<BFBASE>(cur, base, mix, ssp, row, lane);
    for (;;) { const int nrow = row + G * 8; const bool has = nrow < NTOK;
        if (has) row_load<BFBASE>(nxt, base, mix, ssp, nrow, lane);
        row_resnorm_c(cur, gpv, hout, rs_out, row, lane);
        if (!has) break; cur = nxt; row = nrow; }
}
__device__ __forceinline__ void row_router(const RowIn& rin, const float4 (&gpv)[8]  , bf16_t* hout, const LAS3 f32x4* g_pre  , const LAS3 float* wT  ,
                                           LAS3 int* rt_cnt, LAS3 int* rt_info, LAS3 unsigned* rt_rows, float* tok_g, int row, int lr, int lane) {
    const float rm = rsqrtf(row_ssq(rin, lane) * (1.0f / DM) + EPS);
    float4 h[8]; float ss = 0.f;
#pragma unroll
    for (int i = 0; i < 8; ++i) { const size_t o = (size_t)row * (DM / 4) + lane + 64 * i; const float4 b = rin.b[i], gp = gpv[i];
        const float4 m = make_float4(bf2f(rin.m[i].x & 0xffffu), bf2f(rin.m[i].x >> 16), bf2f(rin.m[i].y & 0xffffu), bf2f(rin.m[i].y >> 16));
        h[i].x = b.x + m.x * rm * gp.x; h[i].y = b.y + m.y * rm * gp.y; h[i].z = b.z + m.z * rm * gp.z; h[i].w = b.w + m.w * rm * gp.w;
        st4bf(hout, o, h[i]); ss += h[i].x * h[i].x + h[i].y * h[i].y + h[i].z * h[i].z + h[i].w * h[i].w; }
    ss = wave_sum(ss); const float rstd = rsqrtf(ss * (1.0f / DM) + EPS);
    float lg[8]; unsigned q8[8];
#pragma unroll
    for (int e = 0; e < 8; ++e) lg[e] = 0.f;
#pragma unroll
    for (int i = 0; i < 8; ++i) { const f32x4 ggx = g_pre[lane + 64 * i]; const float4 gg = make_float4(ggx[0], ggx[1], ggx[2], ggx[3]);
        const float n0 = h[i].x * rstd * gg.x, n1 = h[i].y * rstd * gg.y, n2 = h[i].z * rstd * gg.z, n3 = h[i].w * rstd * gg.w;
        q8[i] = pack4_fp8(n0 * F8_SA1, n1 * F8_SA1, n2 * F8_SA1, n3 * F8_SA1); asm volatile("" : "+v"(q8[i]));
        const int k = (lane + 64 * i) * 4;
#pragma unroll
        for (int e = 0; e < 8; ++e) { const f32x4 w = *(const LAS3 f32x4*)(wT + e * DM + k); lg[e] = fmaf(n0, w[0], lg[e]); lg[e] = fmaf(n1, w[1], lg[e]); lg[e] = fmaf(n2, w[2], lg[e]); lg[e] = fmaf(n3, w[3], lg[e]); }
        asm volatile("" ::: "memory"); }
#pragma unroll
    for (int e = 0; e < 8; ++e) lg[e] = wave_sum(lg[e]);
    if (lane == 0) {
        int e1 = 0; float v1 = lg[0];
#pragma unroll
        for (int e = 1; e < 8; ++e) if (lg[e] > v1) { v1 = lg[e]; e1 = e; }
        int e2 = 0; float v2 = -3.0e38f;
#pragma unroll
        for (int e = 0; e < 8; ++e) if (e != e1 && lg[e] > v2) { v2 = lg[e]; e2 = e; }
        const float p2 = __expf(v2 - v1), inv = 1.0f / (1.0f + p2);
        const int l1 = (int)__hip_atomic_fetch_add(rt_cnt + e1, 1, __ATOMIC_RELAXED, __HIP_MEMORY_SCOPE_WORKGROUP), l2 = (int)__hip_atomic_fetch_add(rt_cnt + e2, 1, __ATOMIC_RELAXED, __HIP_MEMORY_SCOPE_WORKGROUP);
        rt_info[lr * 2] = (e1 << 16) | l1; rt_info[lr * 2 + 1] = (e2 << 16) | l2;
        tok_g[row * 2] = inv; tok_g[row * 2 + 1] = p2 * inv;
    }
    LAS3 unsigned* rb = rt_rows + lr * (DM / 4);
#pragma unroll
    for (int i = 0; i < 8; ++i) rb[lane + 64 * i] = q8[i];
}
__device__ __forceinline__ void stage_router(const float* wr, LAS3 unsigned char* lds) {
    LAS3 float* wT = (LAS3 float*)lds; const int t = threadIdx.x; float4 v[8];
#pragma unroll
    for (int j = 0; j < 8; ++j) v[j] = ((const float4*)(wr + (size_t)t * 32))[j];
    const float a[32] = {v[0].x, v[0].y, v[0].z, v[0].w, v[1].x, v[1].y, v[1].z, v[1].w, v[2].x, v[2].y, v[2].z, v[2].w, v[3].x, v[3].y, v[3].z, v[3].w,
                         v[4].x, v[4].y, v[4].z, v[4].w, v[5].x, v[5].y, v[5].z, v[5].w, v[6].x, v[6].y, v[6].z, v[6].w, v[7].x, v[7].y, v[7].z, v[7].w};
#pragma unroll
    for (int e = 0; e < 8; ++e) *(LAS3 f32x4*)(wT + e * DM + t * 4) = (f32x4){a[e], a[8 + e], a[16 + e], a[24 + e]};
    __syncthreads();
}
constexpr int RT_CNT_OFF = 65536, RT_INFO_OFF = 65600, RT_ROWS_OFF = 66560, RT_BATCH = 32, RT_GAIN_OFF = RT_ROWS_OFF + RT_BATCH * DM;
__device__ __forceinline__ void phase_router(const bf16_t* base, const bf16_t* mix, const float* ssp, const float* g_post, bf16_t* hout, const float* g_pre, const float* wr, unsigned char* xs8,
                                             int* counts, int* tok_s, float* tok_g, LAS3 unsigned char* lds, int wave, int lane, int G) {
    stage_router(wr, lds);
    ((LAS3 f32x4*)(lds + RT_GAIN_OFF))[threadIdx.x] = ((const f32x4*)g_pre)[threadIdx.x];
    LAS3 int* rt_cnt = (LAS3 int*)(lds + RT_CNT_OFF); LAS3 int* rt_base = rt_cnt + 8; LAS3 int* rt_info = (LAS3 int*)(lds + RT_INFO_OFF); LAS3 unsigned* rt_rows = (LAS3 unsigned*)(lds + RT_ROWS_OFF);
    const int tid = threadIdx.x;
    for (int r0 = blockIdx.x * 8; r0 < NTOK; r0 += G * 8 * 4) {
        if (tid < 8) rt_cnt[tid] = 0;
        __syncthreads();
        { RowIn cur, nxt; int ln = lane; asm volatile("" : "+v"(ln));
          if (r0 + wave < NTOK) row_load<true>(cur, base, mix, ssp, r0 + wave, ln);
#pragma unroll 1
          for (int k = 0; k < 4; ++k) { const int row = r0 + wave + k * G * 8, nrow = row + G * 8; if (row < NTOK) {
              float4 gpv[8];
#pragma unroll
              for (int i = 0; i < 8; ++i) gpv[i] = ((const float4*)g_post)[ln + 64 * i];
              asm volatile("" ::: "memory");
              if (k < 3 && nrow < NTOK) row_load<true>(nxt, base, mix, ssp, nrow, ln);
              row_router(cur, gpv, hout, (const LAS3 f32x4*)(lds + RT_GAIN_OFF), (const LAS3 float*)lds, rt_cnt, rt_info, rt_rows, tok_g, row, k * 8 + wave, ln); cur = nxt; } } }
        __syncthreads();
        if (tid < 8) rt_base[tid] = tid * ECAP + atomicAdd(&counts[tid], rt_cnt[tid]);
        __syncthreads();
#pragma unroll 1
        for (int k = 0; k < 4; ++k) { const int row = r0 + wave + k * G * 8; if (row < NTOK) { const int lr = k * 8 + wave;
            const int i1 = rt_info[lr * 2], i2 = rt_info[lr * 2 + 1]; const int s1 = rt_base[i1 >> 16] + (i1 & 0xffff), s2 = rt_base[i2 >> 16] + (i2 & 0xffff);
            if (lane == 0) { tok_s[row * 2] = s1; tok_s[row * 2 + 1] = s2; }
            const LAS3 unsigned* rb = rt_rows + lr * (DM / 4); unsigned* d1 = (unsigned*)(xs8 + (size_t)s1 * DM); unsigned* d2 = (unsigned*)(xs8 + (size_t)s2 * DM);
#pragma unroll
            for (int i = 0; i < 8; ++i) { const unsigned v = rb[lane + 64 * i]; d1[lane + 64 * i] = v; d2[lane + 64 * i] = v; } } }
        __syncthreads();
    }
}
constexpr int KSPLIT = 4, C_TFLAG = 8192;
struct FinMeta { int s1, s2; float g1, g2; int fl1[8], fl2[8]; };
struct FinData { float4 a[8], b[8]; uint2 h[8]; };
__device__ __forceinline__ void fin_meta(FinMeta& m, const int* tflag, const int* tok_s, const float* tok_g, int row) {
    m.s1 = tok_s[row * 2]; m.s2 = tok_s[row * 2 + 1]; m.g1 = tok_g[row * 2]; m.g2 = tok_g[row * 2 + 1];
    const int4* f1 = (const int4*)(tflag + (m.s1 >> 8) * 8); const int4* f2 = (const int4*)(tflag + (m.s2 >> 8) * 8); const int4 x0 = f1[0], x1 = f1[1], y0 = f2[0], y1 = f2[1];
    m.fl1[0] = x0.x; m.fl1[1] = x0.y; m.fl1[2] = x0.z; m.fl1[3] = x0.w; m.fl1[4] = x1.x; m.fl1[5] = x1.y; m.fl1[6] = x1.z; m.fl1[7] = x1.w;
    m.fl2[0] = y0.x; m.fl2[1] = y0.y; m.fl2[2] = y0.z; m.fl2[3] = y0.w; m.fl2[4] = y1.x; m.fl2[5] = y1.y; m.fl2[6] = y1.z; m.fl2[7] = y1.w;
}
__device__ __forceinline__ float4 fin_tile(const bf16_t* Y, const float* Yp, int s, int fl, int i, int lane) {
    if (fl == 0) { const uint2 w = ((const uint2*)(Y + (size_t)s * DM))[lane + 64 * i]; return make_float4(bf2f(w.x & 0xffffu), bf2f(w.x >> 16), bf2f(w.y & 0xffffu), bf2f(w.y >> 16)); }
    const int ks = fl >> 16, li = (fl & 0xffff) - 1;
    const uint2* q = (const uint2*)((const bf16_t*)Yp + ((size_t)li * ks) * 65536 + (size_t)(s & 255) * 256) + lane; float4 a = make_float4(0.f, 0.f, 0.f, 0.f);
    uint2 w[14];
#pragma unroll
    for (int k = 0; k < 14; ++k) { w[k] = make_uint2(0u, 0u); if (k < ks) w[k] = q[(size_t)k * 16384]; }
#pragma unroll
    for (int k = 0; k < 14; ++k) { a.x += bf2f(w[k].x & 0xffffu); a.y += bf2f(w[k].x >> 16); a.z += bf2f(w[k].y & 0xffffu); a.w += bf2f(w[k].y >> 16); }
    return a;
}
__device__ __forceinline__ void fin_load(FinData& d, const FinMeta& m, const bf16_t* h3, const bf16_t* Y, const float* Yp, int row, int lane) {
#pragma unroll
    for (int i = 0; i < 8; ++i) { d.a[i] = fin_tile(Y, Yp, m.s1, m.fl1[i], i, lane); d.b[i] = fin_tile(Y, Yp, m.s2, m.fl2[i], i, lane); d.h[i] = ((const uint2*)h3)[(size_t)row * (DM / 4) + lane + 64 * i]; }
}
__device__ __forceinline__ void fin_compute(const FinData& d, const FinMeta& m, const LAS3 f32x4* gain  , float* out, int row, int lane) {
    float4 f[8]; float ss = 0.f;
#pragma unroll
    for (int i = 0; i < 8; ++i) { f[i].x = d.a[i].x * m.g1 + d.b[i].x * m.g2; f[i].y = d.a[i].y * m.g1 + d.b[i].y * m.g2; f[i].z = d.a[i].z * m.g1 + d.b[i].z * m.g2; f[i].w = d.a[i].w * m.g1 + d.b[i].w * m.g2;
        ss += f[i].x * f[i].x + f[i].y * f[i].y + f[i].z * f[i].z + f[i].w * f[i].w; }
    ss = wave_sum(ss); const float rstd = rsqrtf(ss * (1.0f / DM) + EPS);
#pragma unroll
    for (int i = 0; i < 8; ++i) { const size_t o = (size_t)row * (DM / 4) + lane + 64 * i; asm volatile("" ::: "memory"); const f32x4 ggx = gain[lane + 64 * i]; const float4 gg = make_float4(ggx[0], ggx[1], ggx[2], ggx[3]); const uint2 w = d.h[i]; float4 r;
        r.x = bf2f(w.x & 0xffffu) + f[i].x * rstd * gg.x; r.y = bf2f(w.x >> 16) + f[i].y * rstd * gg.y; r.z = bf2f(w.y & 0xffffu) + f[i].z * rstd * gg.z; r.w = bf2f(w.y >> 16) + f[i].w * rstd * gg.w; ((float4*)out)[o] = r; }
}
__device__ __forceinline__ void phase_final(const bf16_t* h3, const bf16_t* Y, const float* Yp, const int* tflag, const int* tok_s, const float* tok_g, const float* gain_g, float* out, LAS3 unsigned char* lds, int wave, int lane, int G) {
    LAS3 f32x4* gain = (LAS3 f32x4*)lds; gain[threadIdx.x] = ((const f32x4*)gain_g)[threadIdx.x];
    __syncthreads();
    int row = blockIdx.x * 8 + wave; if (row >= NTOK) return;
    FinMeta mc, mn; FinData dc, dn;
    fin_meta(mc, tflag, tok_s, tok_g, row); fin_load(dc, mc, h3, Y, Yp, row, lane);
    int nrow = row + G * 8; bool has = nrow < NTOK; if (has) fin_meta(mn, tflag, tok_s, tok_g, nrow);
    for (;;) {
        if (has) fin_load(dn, mn, h3, Y, Yp, nrow, lane);
        const int n2 = nrow + G * 8; const bool has2 = has && n2 < NTOK; FinMeta m2 = mn; if (has2) fin_meta(m2, tflag, tok_s, tok_g, n2);
        fin_compute(dc, mc, gain, out, row, lane);
        if (!has) break;
        dc = dn; mc = mn; mn = m2; row = nrow; nrow = n2; has = has2;
    }
}
constexpr int MOE_TBL_OFF = 131072;
struct MoeOrder : pg8::StaticOrder {
    const LAS3 int* tbl; int NT; int lim;
    __device__ __forceinline__ bool next(int i, Unit& u) const { if ((long)i * G + c >= lim) return false; if (!pg8::StaticOrder::next(i, u)) return false;
        const int v = tbl[u.pm]; u.pm = v & 0xffff; u.pn += (v >> 16) * NT; return true; }
};
__device__ __forceinline__ int moe_table(const int* counts, LAS3 unsigned char* lds) {
    LAS3 int* tbl = (LAS3 int*)(lds + MOE_TBL_OFF); const int t = threadIdx.x; int q = 0, mine = -1;
#pragma unroll
    for (int e = 0; e < NEXP; ++e) { const int nb = (ld_i(counts + e) + 255) >> 8; if (t >= q && t < q + nb) mine = (e << 16) | (e * (ECAP / 256) + (t - q)); q += nb; }
    if (mine >= 0) tbl[t] = mine;
    __syncthreads();
    return q;
}

struct LeftOrder : pg8::StaticOrder {
    const LAS3 int* tbl; int NT; int L;
    __device__ __forceinline__ bool next(int i, Unit& u) const { if (i != 0 || L < 0) return false;
        pg8::StaticOrder t = *this; t.c = L; if (!t.pg8::StaticOrder::next(0, u)) return false;
        const int v = tbl[u.pm]; u.pm = v & 0xffff; u.pn += (v >> 16) * NT; return true; }
};
struct EpiBf16Part {
    static constexpr bool PERM = true, AFTER_DRAIN = false;
    bf16_t* P; float scale; int* tflag; int code; int pnmod; int mark;
    __device__ __forceinline__ void operator()(const f32x4 (&acc)[2][2][4][2], const Unit& u, int wr, int wc, int fr, int fq) const {
        asm volatile("" : "+v"(fr), "+v"(fq));
        if (mark && threadIdx.x == 0) tflag[u.pm * 8 + (u.pn % pnmod)] = code;
        const int r0 = wr * 64 + fr, c0 = wc * 32 + 8 * fq;
#pragma unroll
        for (int ai = 0; ai < 2; ++ai)
#pragma unroll
            for (int m = 0; m < 4; ++m) { bf16_t* rowp = P + (size_t)(r0 + ai * 128 + m * 16) * 256 + c0;
#pragma unroll
                for (int bj = 0; bj < 2; ++bj) { const f32x4 v0 = acc[ai][bj][m][0] * scale, v1 = acc[ai][bj][m][1] * scale;
                    u32x4 w; w.x = cvtpk(v0[0], v0[1]); w.y = cvtpk(v0[2], v0[3]); w.z = cvtpk(v1[0], v1[1]); w.w = cvtpk(v1[2], v1[3]);
                    *(u32x4*)(rowp + bj * 128) = w; } }
    }
};


__device__ __forceinline__ void phase_sgu(const Params& p, LAS3 unsigned char* lds) {
    const int tid = threadIdx.x, lane = tid & 63, wave = __builtin_amdgcn_readfirstlane(tid >> 6), fr = lane & 15, fq = lane >> 4;
    unsigned char* ws = p.ws;
    const bf16_t* U = (const bf16_t*)(ws + OFF_U); const bf16_t* VT = (const bf16_t*)(ws + OFF_VT); bf16_t* GT = (bf16_t*)(ws + OFF_GT); const float* SSP = (const float*)(ws + OFF_SSP);
    LAS3 float* rs = (LAS3 float*)(lds + 36864);
    for (int unit = blockIdx.x; unit < 512; unit += (int)gridDim.x) {
        const int ch = unit >> 3, g = unit & 7;
        __syncthreads();
        if (tid < 128) rs[tid] = rsqrtf(ssp_sum32(SSP, ch * 128 + tid) * (1.0f / GH) + EPS);
        bf16x8 bfrag[4][4];
#pragma unroll
        for (int n = 0; n < 4; ++n) { const int chrow = g * 512 + wave * 64 + (n >> 1) * 32 + 8 * (fr >> 2) + 4 * (n & 1) + (fr & 3);
#pragma unroll
            for (int ks = 0; ks < 4; ++ks) bfrag[n][ks] = *(const bf16x8*)(VT + (size_t)chrow * NTOK + ch * 128 + ks * 32 + fq * 8); }
        __syncthreads();
        { const int t = tid >> 2, s0 = (tid & 3) * 32; const float* wp = p.a_w_s + ((size_t)g * 128 + t) * 128 + s0;
#pragma unroll
          for (int q = 0; q < 4; ++q) { const float4 a = *(const float4*)(wp + q * 8), b = *(const float4*)(wp + q * 8 + 4); float v[8] = {a.x, a.y, a.z, a.w, b.x, b.y, b.z, b.w};
#pragma unroll
              for (int j = 0; j < 8; ++j) { const int s = s0 + q * 8 + j; v[j] = (s <= t) ? v[j] * rs[s] : 0.f; }
              u32x4 w; w.x = cvtpk(v[0], v[1]); w.y = cvtpk(v[2], v[3]); w.z = cvtpk(v[4], v[5]); w.w = cvtpk(v[6], v[7]);
              *(LAS3 u32x4*)(lds + t * 272 + (s0 + q * 8) * 2) = w; } }
        __syncthreads();
        u32x4 ureg[8][2]; f32x4 gvr[2][2]; float bsr[8];
#pragma unroll
        for (int mt = 0; mt < 8; ++mt) { bsr[mt] = p.a_b_s[g * 128 + 16 * mt + fr];
#pragma unroll
            for (int pp = 0; pp < 2; ++pp) ureg[mt][pp] = *(const u32x4*)(U + (size_t)(ch * 128 + 16 * mt + fr) * GH + g * 512 + wave * 64 + pp * 32 + 8 * fq); }
#pragma unroll
        for (int pp = 0; pp < 2; ++pp) { gvr[pp][0] = *(const f32x4*)(p.a_norm_v + g * 512 + wave * 64 + pp * 32 + 8 * fq); gvr[pp][1] = *(const f32x4*)(p.a_norm_v + g * 512 + wave * 64 + pp * 32 + 8 * fq + 4); }
#pragma unroll
        for (int mt = 0; mt < 8; ++mt) {
            f32x4 acc[4];
#pragma unroll
            for (int n = 0; n < 4; ++n) acc[n] = (f32x4){0.f, 0.f, 0.f, 0.f};
            const int nks = (16 * mt + 15) / 32 + 1;
#pragma unroll
            for (int ks = 0; ks < 4; ++ks) if (ks < nks) { const bf16x8 a = *(const LAS3 bf16x8*)(lds + (16 * mt + fr) * 272 + (ks * 32 + fq * 8) * 2);
#pragma unroll
                for (int n = 0; n < 4; ++n) acc[n] = __builtin_amdgcn_mfma_f32_16x16x32_bf16(bfrag[n][ks], a, acc[n], 0, 0, 0); }
            const int tl = 16 * mt + fr, tok = ch * 128 + tl; const float b = bsr[mt];
#pragma unroll
            for (int pp = 0; pp < 2; ++pp) { const int c0 = g * 512 + wave * 64 + pp * 32 + 8 * fq;
                const u32x4 uu = ureg[mt][pp]; const f32x4 g0 = gvr[pp][0], g1 = gvr[pp][1];
                const f32x4 a0 = acc[2 * pp], a1 = acc[2 * pp + 1];
                u32x4 w;
                w.x = cvtpk(bf2f(uu.x & 0xffffu) * (g0[0] * a0[0] + b), bf2f(uu.x >> 16) * (g0[1] * a0[1] + b));
                w.y = cvtpk(bf2f(uu.y & 0xffffu) * (g0[2] * a0[2] + b), bf2f(uu.y >> 16) * (g0[3] * a0[3] + b));
                w.z = cvtpk(bf2f(uu.z & 0xffffu) * (g1[0] * a1[0] + b), bf2f(uu.z >> 16) * (g1[1] * a1[1] + b));
                w.w = cvtpk(bf2f(uu.w & 0xffffu) * (g1[2] * a1[2] + b), bf2f(uu.w >> 16) * (g1[3] * a1[3] + b));
                *(u32x4*)(GT + (size_t)tok * GH + c0) = w; }
        }
    }
    __syncthreads();
}

constexpr int AT_KP = 272, AT_VP = 288, AT_VOFF = 256 * AT_KP, AT_UNITS = 3072;
typedef short s16x4 __attribute__((ext_vector_type(4)));
struct AtUnit { int gi, b, h, r, n, dsh; };
__device__ __forceinline__ AtUnit at_decode(int unit) { AtUnit u; u.gi = unit >> 10; const int rem = unit & 1023; u.b = rem >> 8; u.h = (rem >> 4) & 15; const int rn = (rem + u.b) & 15;
    u.dsh = 2 * u.gi; const int nbsh = 4 - u.dsh; u.r = rn >> nbsh; u.n = rn & ((1 << nbsh) - 1); return u; }
#define AT_TR4(o0, o1, o2, o3, f0, f1, f2, f3) asm volatile("ds_read_b64_tr_b16 %0, %4 offset:%5\n\tds_read_b64_tr_b16 %1, %4 offset:%6\n\tds_read_b64_tr_b16 %2, %4 offset:%7\n\tds_read_b64_tr_b16 %3, %4 offset:%8" \
        : "=&v"(o0), "=&v"(o1), "=&v"(o2), "=&v"(o3) : "v"(vrow), "i"(f0), "i"(f1), "i"(f2), "i"(f3) : "memory")
template <bool MERGE> __device__ __forceinline__ void phase_attn(const Params& p, LAS3 unsigned char* lds, const int U0, const int U1) {
    const int tid = threadIdx.x, lane = tid & 63, wave = __builtin_amdgcn_readfirstlane(tid >> 6), fr = lane & 15, fq = lane >> 4, G = (int)gridDim.x;
    unsigned char* ws = p.ws;
    const bf16_t* Q = (const bf16_t*)(ws + OFF_Q); const bf16_t* KV = (const bf16_t*)(ws + OFF_KV); bf16_t* OG = (bf16_t*)(ws + OFF_OG); float* LSE = (float*)(ws + OFF_LSE);
    const unsigned vbase = (unsigned)(size_t)(lds + AT_VOFF);
    const unsigned vrow = vbase + (unsigned)((16 * wave + 4 * fq + ((lane & 15) >> 2)) * AT_VP + (lane & 3) * 8);
    const int srow = tid >> 4, c16 = tid & 15;
    int unit = U0 + (int)blockIdx.x;
    if (unit < U1) {
        AtUnit cu = at_decode(unit);
        u32x4 kreg[8], vreg[8]; bf16x8 qf[4], qn[4];
#define AT_LOADQ(U, D) do { const int _tok = (U).b * SEQ + ((((U).n << 7) + wave * 16 + fr) << (U).dsh) + (U).r; _Pragma("unroll") for (int ks = 0; ks < 4; ++ks) D[ks] = *(const bf16x8*)(Q + (size_t)_tok * NQ + (U).gi * 2048 + (U).h * 128 + ks * 32 + fq * 8); } while (0)
#define AT_LOAD_R(U, P0, P1) do { _Pragma("unroll") for (int ps = P0; ps < P1; ++ps) if ((U).n > 0 || ps >= 4) { const int lk = ((U).n - 1) * 128 + ps * 32 + srow; \
            const bf16_t* src = KV + ((size_t)(U).h * NTOK + (U).b * SEQ + (lk << (U).dsh) + (U).r) * 128 + c16 * 8; kreg[ps] = *(const u32x4*)src; vreg[ps] = *(const u32x4*)(src + (size_t)16 * NTOK * 128); } } while (0)
#define AT_LOAD(U) AT_LOAD_R(U, 0, 8)
#define AT_SB() __builtin_amdgcn_sched_barrier(0)
        AT_LOAD(cu); AT_LOADQ(cu, qn);
        for (;;) {
            asm volatile("" ::: "memory"); __builtin_amdgcn_s_barrier(); asm volatile("" ::: "memory");
#pragma unroll
            for (int ps = 0; ps < 8; ++ps) if (cu.n > 0 || ps >= 4) { const int kk = ps * 32 + srow;
                *(LAS3 u32x4*)(lds + kk * AT_KP + c16 * 16) = kreg[ps]; *(LAS3 u32x4*)(lds + AT_VOFF + kk * AT_VP + c16 * 16) = vreg[ps]; }
            const int jq = wave * 16 + fr, qtok = cu.b * SEQ + (((cu.n << 7) + jq) << cu.dsh) + cu.r;
#pragma unroll
            for (int ks = 0; ks < 4; ++ks) qf[ks] = qn[ks];
            const int un = unit + G; const bool hasn = un < U1; AtUnit nu = cu;
            if (hasn) nu = at_decode(un);
            asm volatile("s_waitcnt lgkmcnt(0)" ::: "memory"); __builtin_amdgcn_s_barrier(); asm volatile("" ::: "memory");
            const int c_lo = cu.n == 0 ? (8 - wave) : 0;
            f32x4 sc[9];
#pragma unroll
            for (int c = 0; c < 9; ++c) { sc[c] = (f32x4){0.f, 0.f, 0.f, 0.f};
                if (c >= c_lo) {
#pragma unroll
                    for (int ks = 0; ks < 4; ++ks) { const bf16x8 kf = *(const LAS3 bf16x8*)(lds + (16 * (wave + c) + fr) * AT_KP + (ks * 32 + fq * 8) * 2);
                        sc[c] = __builtin_amdgcn_mfma_f32_16x16x32_bf16(kf, qf[ks], sc[c], 0, 0, 0); } } }
            AT_SB(); if (hasn) AT_LOAD_R(nu, 4, 8); AT_SB();
            const float slope2 = exp2f(-0.5f * (float)(cu.h + 1)) * 1.4426950409f; const int dq = fr - 4 * fq; const float t0 = slope2 * (float)(128 + dq); float mx = -3.0e38f;
#pragma unroll
            for (int c = 0; c < 9; ++c) {
                if (c >= c_lo) {
#pragma unroll
                    for (int q = 0; q < 4; ++q) { float s2 = fmaf(sc[c][q], 0.08838834764831845f * 1.4426950409f, fmaf(slope2, (float)(16 * c + q), -t0));
                        if (c == 0) s2 = (dq - q <= 0) ? s2 : -3.0e38f;
                        if (c == 8) s2 = (dq - q >= 0) ? s2 : -3.0e38f;
                        sc[c][q] = s2; mx = fmaxf(mx, s2); }
                } else { sc[c] = (f32x4){-3.0e38f, -3.0e38f, -3.0e38f, -3.0e38f}; } }
            mx = fmaxf(mx, __shfl_xor(mx, 16)); mx = fmaxf(mx, __shfl_xor(mx, 32));
            float den = 0.f;
#pragma unroll
            for (int c = 0; c < 9; ++c) {
                if (c >= c_lo) {
#pragma unroll
                    for (int q = 0; q < 4; ++q) { const float e = __builtin_amdgcn_exp2f(sc[c][q] - mx); sc[c][q] = e; den += e; }
                } else { sc[c] = (f32x4){0.f, 0.f, 0.f, 0.f}; } }
            den += __shfl_xor(den, 16); den += __shfl_xor(den, 32);
            AT_SB(); if (hasn) AT_LOAD_R(nu, 0, 4); AT_SB();
            uint2 x1[8], x2[8]; float l1 = 0.f, l2 = 0.f;
            if constexpr (MERGE) { const bf16_t* g1 = OG + ((size_t)1 * NTOK + qtok) * DM + cu.h * 128 + 4 * fq; const bf16_t* g2 = g1 + (size_t)NTOK * DM;
                l1 = LSE[((size_t)1 * NTOK + qtok) * 16 + cu.h]; l2 = LSE[((size_t)2 * NTOK + qtok) * 16 + cu.h];
#pragma unroll
                for (int et = 0; et < 8; ++et) { x1[et] = *(const uint2*)(g1 + et * 16); x2[et] = *(const uint2*)(g2 + et * 16); }
                AT_SB(); }
            f32x4 o[8];
#pragma unroll
            for (int et = 0; et < 8; ++et) o[et] = (f32x4){0.f, 0.f, 0.f, 0.f};
#pragma unroll
            for (int pp = 0; pp < 5; ++pp) {
                if (2 * pp + 1 >= c_lo) {
                    u32x4 pw; pw.x = cvtpk(sc[2 * pp][0], sc[2 * pp][1]); pw.y = cvtpk(sc[2 * pp][2], sc[2 * pp][3]);
                    if (pp < 4) { pw.z = cvtpk(sc[2 * pp + 1][0], sc[2 * pp + 1][1]); pw.w = cvtpk(sc[2 * pp + 1][2], sc[2 * pp + 1][3]); } else { pw.z = 0u; pw.w = 0u; }
                    const bf16x8 pf = __builtin_bit_cast(bf16x8, pw);
                    constexpr int R1 = 16 * AT_VP;
                    const int r0 = (32 * pp) * AT_VP, r1 = (pp < 4 ? (32 * pp + 16) : (32 * pp)) * AT_VP; (void)R1;
                    s16x4 a0, a1, a2, a3, a4, a5, a6, a7, b0, b1, b2, b3, b4, b5, b6, b7;
                    AT_TR4(a0, a1, a2, a3, r0, r0 + 32, r0 + 64, r0 + 96); AT_TR4(a4, a5, a6, a7, r0 + 128, r0 + 160, r0 + 192, r0 + 224);
                    AT_TR4(b0, b1, b2, b3, r1, r1 + 32, r1 + 64, r1 + 96); AT_TR4(b4, b5, b6, b7, r1 + 128, r1 + 160, r1 + 192, r1 + 224);
                    asm volatile("s_waitcnt lgkmcnt(0)" : "+v"(a0), "+v"(a1), "+v"(a2), "+v"(a3), "+v"(a4), "+v"(a5), "+v"(a6), "+v"(a7), "+v"(b0), "+v"(b1), "+v"(b2), "+v"(b3), "+v"(b4), "+v"(b5), "+v"(b6), "+v"(b7) :: "memory");
                    if (2 * pp < c_lo) { const s16x4 z = {0, 0, 0, 0}; a0 = z; a1 = z; a2 = z; a3 = z; a4 = z; a5 = z; a6 = z; a7 = z; }
#define AT_PV(et, A, B) o[et] = __builtin_amdgcn_mfma_f32_16x16x32_bf16((bf16x8){A[0], A[1], A[2], A[3], B[0], B[1], B[2], B[3]}, pf, o[et], 0, 0, 0)
                    AT_PV(0, a0, b0); AT_PV(1, a1, b1); AT_PV(2, a2, b2); AT_PV(3, a3, b3); AT_PV(4, a4, b4); AT_PV(5, a5, b5); AT_PV(6, a6, b6); AT_PV(7, a7, b7);
#undef AT_PV
                } }
            AT_SB(); if (hasn) AT_LOADQ(nu, qn); AT_SB();
            const float inv = 1.0f / den;
            if constexpr (!MERGE) {
                bf16_t* op = OG + ((size_t)cu.gi * NTOK + qtok) * DM + cu.h * 128 + 4 * fq;
#pragma unroll
                for (int et = 0; et < 8; ++et) { uint2 w; w.x = cvtpk(o[et][0] * inv, o[et][1] * inv); w.y = cvtpk(o[et][2] * inv, o[et][3] * inv); *(uint2*)(op + et * 16) = w; }
                if (fq == 0) LSE[((size_t)cu.gi * NTOK + qtok) * 16 + cu.h] = (mx + __log2f(den)) * 0.6931471806f;
            } else {
                const float l0 = (mx + __log2f(den)) * 0.6931471806f;
                const float lm = fmaxf(l0, fmaxf(l1, l2)); const float a0 = __expf(l0 - lm), a1 = __expf(l1 - lm), a2 = __expf(l2 - lm), isum = 1.0f / (a0 + a1 + a2);
                const float c0 = a0 * inv * isum, c1 = a1 * isum, c2 = a2 * isum;
                bf16_t* om = (bf16_t*)(ws + OFF_OM) + (size_t)qtok * DM + cu.h * 128 + 4 * fq;
#pragma unroll
                for (int et = 0; et < 8; ++et) { uint2 w;
                    w.x = cvtpk(c0 * o[et][0] + c1 * bf2f(x1[et].x & 0xffffu) + c2 * bf2f(x2[et].x & 0xffffu), c0 * o[et][1] + c1 * bf2f(x1[et].x >> 16) + c2 * bf2f(x2[et].x >> 16));
                    w.y = cvtpk(c0 * o[et][2] + c1 * bf2f(x1[et].y & 0xffffu) + c2 * bf2f(x2[et].y & 0xffffu), c0 * o[et][3] + c1 * bf2f(x1[et].y >> 16) + c2 * bf2f(x2[et].y >> 16));
                    *(uint2*)(om + et * 16) = w; }
            }
            if (!hasn) break;
            unit = un; cu = nu;
        }
#undef AT_LOAD
#undef AT_LOAD_R
#undef AT_SB
#undef AT_LOADQ
    }
    __syncthreads();
}
#undef AT_TR4

__device__ __forceinline__ void phase_merge(const Params& p) {
    unsigned char* ws = p.ws; const bf16_t* OG = (const bf16_t*)(ws + OFF_OG); const float* LSE = (const float*)(ws + OFF_LSE); bf16_t* OM = (bf16_t*)(ws + OFF_OM);
    for (size_t i = (size_t)blockIdx.x * MK_THREADS + threadIdx.x; i < (size_t)NTOK * 256; i += (size_t)gridDim.x * MK_THREADS) {
        const int tok = (int)(i >> 8), c8 = (int)(i & 255), h = c8 >> 4;
        const float l0 = LSE[((size_t)0 * NTOK + tok) * 16 + h], l1 = LSE[((size_t)1 * NTOK + tok) * 16 + h], l2 = LSE[((size_t)2 * NTOK + tok) * 16 + h];
        const float m = fmaxf(l0, fmaxf(l1, l2)); const float a0 = __expf(l0 - m), a1 = __expf(l1 - m), a2 = __expf(l2 - m), inv = 1.0f / (a0 + a1 + a2);
        const uint4 x0 = *(const uint4*)(OG + ((size_t)0 * NTOK + tok) * DM + c8 * 8), x1 = *(const uint4*)(OG + ((size_t)1 * NTOK + tok) * DM + c8 * 8), x2 = *(const uint4*)(OG + ((size_t)2 * NTOK + tok) * DM + c8 * 8);
        const unsigned w0[4] = {x0.x, x0.y, x0.z, x0.w}, w1[4] = {x1.x, x1.y, x1.z, x1.w}, w2[4] = {x2.x, x2.y, x2.z, x2.w}; unsigned rr[4];
#pragma unroll
        for (int j = 0; j < 4; ++j) { const float lo = (a0 * bf2f(w0[j] & 0xffffu) + a1 * bf2f(w1[j] & 0xffffu) + a2 * bf2f(w2[j] & 0xffffu)) * inv;
            const float hi = (a0 * bf2f(w0[j] >> 16) + a1 * bf2f(w1[j] >> 16) + a2 * bf2f(w2[j] >> 16)) * inv; rr[j] = cvtpk(lo, hi); }
        *(uint4*)(OM + (size_t)tok * DM + c8 * 8) = make_uint4(rr[0], rr[1], rr[2], rr[3]);
    }
}
#define PHASE2_BODY phase_sgu(p, lds);
#define PHASE9_BODY phase_attn<false>(p, lds, 1024, AT_UNITS);
#define PHASE10_BODY phase_attn<true>(p, lds, 0, 1024);

__global__ void __launch_bounds__(MK_THREADS, 2) mega(Params p, int lo, int hi) {
    extern __shared__ __attribute__((aligned(16))) unsigned char shm[];
    LAS3 unsigned char* lds = (LAS3 unsigned char*)shm;
    const int tid = threadIdx.x, wave = __builtin_amdgcn_readfirstlane(tid >> 6), G = (int)gridDim.x;
#define MK_LANE() ((int)__builtin_amdgcn_mbcnt_hi(~0u, __builtin_amdgcn_mbcnt_lo(~0u, 0u)))
    unsigned char* ws = p.ws;
    volatile LAS3 unsigned* xbw = (volatile LAS3 unsigned*)(lds + MK_LDS_BAR);
    if (tid < 4) xbw[tid] = 0u;
    __syncthreads();
    XcdBarrier bar; bar.bar = (unsigned*)(ws + OFF_CTRL + CTRL_BAR_BYTE); bar.x = 0; bar.st = xbw;
    if (hi - lo > 1) bar = xcd_barrier_post((unsigned*)(ws + OFF_CTRL + CTRL_BAR_BYTE), xbw);
#define IN(k) (lo <= (k) && (k) < hi)
#define SEAM(k) do { if (IN(k) && IN((k) + 1)) xcd_barrier(bar); } while (0)
    float* SSP = (float*)(ws + OFF_SSP);
    bf16_t* XN = (bf16_t*)(ws + OFF_XN); float* RS = (float*)(ws + OFF_XNQ);
    bf16_t* MIX = (bf16_t*)(ws + OFF_MIX); bf16_t* H1 = (bf16_t*)(ws + OFF_H1); bf16_t* H2 = (bf16_t*)(ws + OFF_H2); bf16_t* H3 = (bf16_t*)(ws + OFF_H3);
    int* ictrl = (int*)(ws + OFF_CTRL);
    const float* gains = p.gains;

    constexpr int CR0 = CT0  , CR1 = 12800, CR3 = 17408, CR5 = 34304, CR6 = 42496, CR8 = CT8;
    static_assert(CR1 >= CT6, "every dense weight is converted by the end of P1");
    const bool conv_first = (blockIdx.x & 1) == 0;
    constexpr int CVF = 9;
#define CV_MID(a, b) ((a) + (((b) - (a)) * CVF / 16))
    if (IN(0)) {
        phase_convert(p, lds, 0, CR0, (int)blockIdx.x, G);
        phase_norm0(p, wave, MK_LANE(), G);
    }
    SEAM(0);
    if (IN(1)) {
        if (conv_first) phase_convert(p, lds, CR0, CV_MID(CR0, CR1), (int)blockIdx.x >> 1, G >> 1);
        { pg8::Gemm g{XN, (const bf16_t*)(ws + OFF_WIN_T), NTOK, GH, DM}; pg8::StaticOrder S; S.init(NTOK, GH, G, (int)blockIdx.x);
          EpiGeluU E{(bf16_t*)(ws + OFF_U), GH, p.a_b_in};
          pg8::gemm_phase<EpiGeluU, pg8::StaticOrder>(lds, g, S, E, nullptr); }
        { pg8::Gemm g{(const bf16_t*)(ws + OFF_WIN_T) + (size_t)GH * DM, XN, GH, NTOK, DM}; pg8::StaticOrder S; S.init(GH, NTOK, G, (int)blockIdx.x);
          EpiGeluVT E{(bf16_t*)(ws + OFF_VT), p.a_b_in + GH, SSP};
          pg8::gemm_phase<EpiGeluVT, pg8::StaticOrder>(lds, g, S, E, nullptr); }
        if (!conv_first) phase_convert(p, lds, CV_MID(CR0, CR1), CR1, (int)blockIdx.x >> 1, G >> 1);
    }
    SEAM(1);
    if (IN(2)) { PHASE2_BODY }
    SEAM(2);
    if (IN(3)) {
        if (conv_first) phase_convert(p, lds, CR1, CV_MID(CR1, CR3), (int)blockIdx.x >> 1, G >> 1);
        pg8::Gemm g{(const bf16_t*)(ws + OFF_GT), (const bf16_t*)(ws + OFF_WOUT_T), NTOK, DM, GH}; pg8::StaticOrder S; S.init(NTOK, DM, G, (int)blockIdx.x);
        EpiBf16SS E{MIX, DM, SSP};
        pg8::gemm_phase<EpiBf16SS, pg8::StaticOrder>(lds, g, S, E, nullptr);
        if (!conv_first) phase_convert(p, lds, CV_MID(CR1, CR3), CR3, (int)blockIdx.x >> 1, G >> 1);
    }
    SEAM(3);
    if (IN(4)) { phase_resnorm<false>(p.x, MIX, SSP, gains + DM, H1, RS, wave, MK_LANE(), G); }
    SEAM(4);
    if (IN(5)) {
        if (conv_first) phase_convert(p, lds, CR3, CV_MID(CR3, CR5), (int)blockIdx.x >> 1, G >> 1);
        pg8::Gemm g{H1, (const bf16_t*)(ws + OFF_WGU_T), NTOK, 2 * DFF, DM}; pg8::StaticOrder S; S.init(NTOK, 2 * DFF, G, (int)blockIdx.x);
        EpiSwigluR E{(bf16_t*)(ws + OFF_ACT), DFF, 56, RS};
        pg8::gemm_phase<EpiSwigluR, pg8::StaticOrder>(lds, g, S, E, nullptr);
        if (!conv_first) phase_convert(p, lds, CV_MID(CR3, CR5), CR5, (int)blockIdx.x >> 1, G >> 1);
    }
    SEAM(5);
    if (IN(6)) {
        if (conv_first) phase_convert(p, lds, CR5, CV_MID(CR5, CR6), (int)blockIdx.x >> 1, G >> 1);
        pg8::Gemm g{(const bf16_t*)(ws + OFF_ACT), (const bf16_t*)(ws + OFF_WDN_T), NTOK, DM, DFF}; pg8::StaticOrder S; S.init(NTOK, DM, G, (int)blockIdx.x);
        EpiBf16SS E{MIX, DM, SSP};
        pg8::gemm_phase<EpiBf16SS, pg8::StaticOrder>(lds, g, S, E, nullptr);
        if (!conv_first) phase_convert(p, lds, CV_MID(CR5, CR6), CR6, (int)blockIdx.x >> 1, G >> 1);
    }
    SEAM(6);
    if (IN(7)) { phase_resnorm<true>(H1, MIX, SSP, gains + 3 * DM, H2, RS  , wave, MK_LANE(), G); }
    SEAM(7);
    if (IN(8)) {
        if (conv_first) phase_convert(p, lds, CR6, CV_MID(CR6, CR8), (int)blockIdx.x >> 1, G >> 1);
        { static_assert(OFF_WQ_T == OFF_WKV_T + (size_t)NKV * DM * 2, "w_kv^T and w_q^T are one [NKV + NQ][DM] matrix");
          pg8::Gemm g{H2, (const bf16_t*)(ws + OFF_WKV_T), NTOK, NKV + NQ, DM}; pg8::StaticOrder S; S.init(NTOK, NKV + NQ, G, (int)blockIdx.x);
          EpiKVQ E{(bf16_t*)(ws + OFF_KV), NTOK, (bf16_t*)(ws + OFF_Q), NQ, RS};
          pg8::gemm_phase<EpiKVQ, pg8::StaticOrder>(lds, g, S, E, nullptr); }
        if (!conv_first) phase_convert(p, lds, CV_MID(CR6, CR8), CR8, (int)blockIdx.x >> 1, G >> 1);
    }
    SEAM(8);
    if (IN(9)) { PHASE9_BODY }
    SEAM(9);
    if (IN(10)) { PHASE10_BODY }
    SEAM(10);
    if (IN(11)) {
        pg8::Gemm g{(const bf16_t*)(ws + OFF_OM), (const bf16_t*)(ws + OFF_WO_T), NTOK, DM, DM}; pg8::StaticOrder S; S.init(NTOK, DM, G, (int)blockIdx.x);
        EpiBf16SS E{MIX, DM, SSP};
        pg8::gemm_phase<EpiBf16SS, pg8::StaticOrder>(lds, g, S, E, nullptr);
    }
    SEAM(11);
    if (IN(12)) { phase_router(H2, MIX, SSP, gains + 5 * DM, H3, gains + 6 * DM, p.moe_router, ws + OFF_XS, ictrl + C_CNT, (int*)(ws + OFF_TOKS), (float*)(ws + OFF_TOKG), lds, wave, MK_LANE(), G); }
    SEAM(12);
    if (IN(13)) {
        const int nblk = moe_table(ictrl + C_CNT, lds);
        pg8::Gemm g{(const bf16_t*)(ws + OFF_XS), (const bf16_t*)(ws + OFF_MGU_T), nblk * 256, 2 * DFF, DM}; MoeOrder S; S.init(nblk * 256, 2 * DFF, G, (int)blockIdx.x); S.tbl = (const LAS3 int*)(lds + MOE_TBL_OFF); S.NT = 56; S.lim = 0x7fffffff;
        EpiSwiglu8 E{ws + OFF_ACT2, DFF, 56, 1.0f / (F8_SA1 * F8_SW1), F8_SA2};
        pg8::gemm_phase<EpiSwiglu8, MoeOrder, false, true>(lds, g, S, E, nullptr);
    }
    SEAM(13);
    if (IN(14)) {
        const int nblk = moe_table(ictrl + C_CNT, lds); const int nunits = nblk * 8; int lim = 2 * G < nunits ? 2 * G : nunits;
        int ks = (nunits - lim) * 14 <= G ? 14 : ((nunits - lim) * 7 <= G ? 7 : 4);
#ifdef FORCE_KS
        ks = FORCE_KS;
#endif
        if ((nunits - lim) * ks > G) lim = nunits;
        { pg8::Gemm g{(const bf16_t*)(ws + OFF_ACT2), (const bf16_t*)(ws + OFF_MDN_T), nblk * 256, DM, DFF}; MoeOrder S; S.init(nblk * 256, DM, G, (int)blockIdx.x); S.tbl = (const LAS3 int*)(lds + MOE_TBL_OFF); S.NT = 8; S.lim = lim;
          EpiBf16S E{(bf16_t*)(ws + OFF_Y), DM, 8, 1.0f / (F8_SA2 * F8_SW2)};
          pg8::gemm_phase<EpiBf16S, MoeOrder, false, true>(lds, g, S, E, nullptr); }
        { const int nleft = nunits - lim, item = (int)blockIdx.x, li = item / ks, ch = item - li * ks;
          const int CKT = DFF / 128 / ks;
          pg8::Gemm g{(const bf16_t*)(ws + OFF_ACT2 + (size_t)ch * CKT * 128), (const bf16_t*)(ws + OFF_MDN_T + (size_t)ch * CKT * 128), nblk * 256, DM, DFF, CKT};
          LeftOrder S; S.init(nblk * 256, DM, G, 0); S.tbl = (const LAS3 int*)(lds + MOE_TBL_OFF); S.NT = 8; S.L = li < nleft ? lim + li : -1;
          EpiBf16Part E{(bf16_t*)(ws + OFF_U) + ((size_t)li * ks + ch) * 65536, 1.0f / (F8_SA2 * F8_SW2), ictrl + C_TFLAG, (li + 1) | (ks << 16), 8, ch == 0};
          pg8::gemm_phase<EpiBf16Part, LeftOrder, false, true>(lds, g, S, E, nullptr); }
    }
    SEAM(14);
    if (IN(15)) { phase_final(H3, (const bf16_t*)(ws + OFF_Y), (const float*)(ws + OFF_U)  , ictrl + C_TFLAG, (const int*)(ws + OFF_TOKS), (const float*)(ws + OFF_TOKG), gains + 7 * DM, p.out, lds, wave, MK_LANE(), G); }
#undef IN
#undef SEAM
}

extern "C" void kernel_launch(void* const* d_in, const int* in_sizes, int n_in, void* d_out, int out_size, void* d_ws, size_t ws_size, hipStream_t stream) {
    (void)in_sizes; (void)n_in; (void)out_size;
    if (ws_size < WS_NEED) { fprintf(stderr, "workspace too small: %zu < %zu\n", ws_size, (size_t)WS_NEED); return; }
    static int grid = 0;
    if (grid == 0) {
        int dev = 0, cus = 0, per_cu = 0;
        if (hipGetDevice(&dev) != hipSuccess || hipDeviceGetAttribute(&cus, hipDeviceAttributeMultiprocessorCount, dev) != hipSuccess) { fprintf(stderr, "device query failed\n"); grid = -1; return; }
        if (hipFuncSetAttribute((const void*)mega, hipFuncAttributeMaxDynamicSharedMemorySize, MK_LDS_BYTES) != hipSuccess) { fprintf(stderr, "hipFuncSetAttribute failed\n"); grid = -1; return; }
        if (hipOccupancyMaxActiveBlocksPerMultiprocessor(&per_cu, (const void*)mega, MK_THREADS, MK_LDS_BYTES) != hipSuccess || per_cu < 1) { fprintf(stderr, "occupancy query: %d blocks per CU\n", per_cu); (void)hipGetLastError(); }
        grid = cus;
    }
    if (grid < 0) return;
    const float* const* in = (const float* const*)d_in;
    Params P{};
    P.x = in[0]; P.gains = in[1]; P.a_w_in = in[2]; P.a_b_in = in[3]; P.a_norm_v = in[4]; P.a_w_s = in[5]; P.a_b_s = in[6]; P.a_w_out = in[7]; P.kv_norm = in[8]; P.w_kv = in[9]; P.w_q = in[10]; P.w_o = in[11];
    P.ffn_w_gu = in[12]; P.ffn_w_down = in[13]; P.moe_router = in[14]; P.moe_w_gu = in[15]; P.moe_w_down = in[16]; P.out = (float*)d_out; P.ws = (unsigned char*)d_ws;
#define MEGA(lo, hi) hipLaunchKernelGGL(mega, dim3(grid), dim3(MK_THREADS), MK_LDS_BYTES, stream, P, (lo), (hi))

    (void)hipMemsetAsync((char*)d_ws + OFF_CTRL, 0, CTRL_BYTES, stream);
    MEGA(0, NPH);
}
```
